# Optimizing an MI355X kernel written in HIP

```python
import math
import jax, jax.numpy as jnp
from jax import lax
import numpy as np

D_MODEL = 2048
BATCH = 4
SEQ = 4096
DEPTH = 2

GRID_W = 64
CTX_LEN = 256
ATTN_WIDTH = D_MODEL // 2
DA_HEAD_DIM = 128
DA_HEADS = ATTN_WIDTH // (2 * DA_HEAD_DIM)
SSM_WIDTH = D_MODEL // 4
SSM_GROUP = 16
SSM_GROUPS = SSM_WIDTH // SSM_GROUP
SSM_STATE = 64
FOURIER_WIDTH = D_MODEL - ATTN_WIDTH - SSM_WIDTH
FOURIER_HEADS = 4
FOURIER_GROUP = FOURIER_WIDTH // FOURIER_HEADS
MIX_WIDTH = ATTN_WIDTH + SSM_WIDTH + FOURIER_WIDTH
IN_WIDTH = 3 * ATTN_WIDTH + SSM_WIDTH + FOURIER_WIDTH
D_FF = -(-8 * D_MODEL // (3 * 256)) * 256
N_MOD = 6
Q_BLOCK = 128
ROPE_BASE = 10000.0
ROPE_PAIRS = DA_HEAD_DIM // 4
NORM_EPS = 1e-6
SUBLN_EPS = 1e-5
DT_MIN = 1e-3
DT_MAX = 1e-1
C_SCALE = 0.5

kernel_name = 'hybrid_diffattn_s5_fnet_dit_block'


def rmsnorm(x, g, eps=NORM_EPS):
    xf = x.astype(jnp.float32)
    y = xf * lax.rsqrt(jnp.mean(xf * xf, axis=-1, keepdims=True) + eps)
    return (y * g.astype(jnp.float32)).astype(x.dtype)


def rope_tables(n_tokens):
    rows = n_tokens // GRID_W
    r = jnp.broadcast_to(jnp.arange(rows, dtype=jnp.float32)[:, None], (rows, GRID_W)).reshape(-1)
    col = jnp.broadcast_to(jnp.arange(GRID_W, dtype=jnp.float32)[None, :], (rows, GRID_W)).reshape(-1)
    inv = ROPE_BASE ** (-jnp.arange(ROPE_PAIRS, dtype=jnp.float32) / ROPE_PAIRS)
    ang = jnp.stack([r[:, None] * inv, col[:, None] * inv], axis=1)
    return jnp.cos(ang), jnp.sin(ang)


def apply_rope2d(x, cos, sin):
    b, t, h, m, d = x.shape
    xf = x.astype(jnp.float32).reshape(b, t, h, m, 2, 2, ROPE_PAIRS)
    x1, x2 = xf[..., 0, :], xf[..., 1, :]
    cs = cos[None, :, None, None]
    sn = sin[None, :, None, None]
    out = jnp.stack([x1 * cs - x2 * sn, x2 * cs + x1 * sn], axis=-2)
    return out.reshape(b, t, h, m, d).astype(x.dtype)


def diff_attend(q, k, v, lam):
    s = jnp.einsum('bqhcd,bkhcd->bhcqk', q, k).astype(jnp.float32) * (DA_HEAD_DIM ** -0.5)
    p = jax.nn.softmax(s, axis=-1)
    a = p[:, :, 0] - lam * p[:, :, 1]
    return jnp.einsum('bhqk,bkhe->bqhe', a.astype(v.dtype), v)


def diff_attention(q, k, v, qc, kc, vc, lam_q1, lam_k1, lam_q2, lam_k2, g_subln, lam_init, cos, sin, need_ctx):
    f32 = jnp.float32
    b, t = q.shape[:2]
    lam = (jnp.exp(jnp.sum(lam_q1.astype(f32) * lam_k1.astype(f32)))
           - jnp.exp(jnp.sum(lam_q2.astype(f32) * lam_k2.astype(f32))) + lam_init)
    q = apply_rope2d(q, cos, sin)
    k = apply_rope2d(k, cos, sin)
    k_all = jnp.concatenate([kc, k], axis=1)
    v_all = jnp.concatenate([vc, v], axis=1)
    nq = t // Q_BLOCK
    qb = q.reshape(b, nq, Q_BLOCK, DA_HEADS, 2, DA_HEAD_DIM).swapaxes(0, 1)
    o = lax.map(lambda blk: diff_attend(blk, k_all, v_all, lam), qb)
    o = o.swapaxes(0, 1).reshape(b, t, DA_HEADS, 2 * DA_HEAD_DIM)

    def finish(o_):
        return (rmsnorm(o_, g_subln, SUBLN_EPS) * (1.0 - lam_init)).reshape(o_.shape[0], o_.shape[1], ATTN_WIDTH)

    out = finish(o)
    out_c = finish(diff_attend(qc, kc, vc, lam)) if need_ctx else None
    return out, out_c


def _scan_combine(left, right):
    a1, b1 = left
    a2, b2 = right
    return a1 * a2, a2 * b1 + b2


def linear_recurrence(a_bar, bu, reverse):
    a_full = jnp.broadcast_to(a_bar, bu.shape)
    return lax.associative_scan(_scan_combine, (a_full, bu), reverse=reverse, axis=1)[1]


def s5_bidirectional(u, uc, a_re, a_im, log_dt, b_re, b_im, c_re, c_im, d_skip, w_glu, b_glu, need_ctx):
    f32 = jnp.float32
    bsz, t = u.shape[:2]
    ug = u.astype(f32).reshape(bsz, t, SSM_GROUPS, SSM_GROUP)
    ucg = uc.astype(f32).reshape(bsz, uc.shape[1], SSM_GROUPS, SSM_GROUP)
    dsk = d_skip.astype(f32).reshape(SSM_GROUPS, SSM_GROUP)
    y = dsk * ug
    yc = dsk * ucg if need_ctx else None
    u_cplx = ug.astype(jnp.complex64)
    uc_cplx = ucg.astype(jnp.complex64)
    for direction in range(2):
        rev = direction == 1
        lam_a = lax.complex(a_re[direction].astype(f32), a_im[direction].astype(f32))
        dt = jnp.exp(log_dt[direction].astype(f32))[:, None]
        a_bar = jnp.exp(lam_a * dt)
        b_bar = ((a_bar - 1.0) / lam_a)[:, :, None] * lax.complex(b_re[direction].astype(f32), b_im[direction].astype(f32))
        c_mat = lax.complex(c_re[direction].astype(f32), c_im[direction].astype(f32))
        h_ctx = linear_recurrence(a_bar, jnp.einsum('btgh,gph->btgp', uc_cplx, b_bar), rev)
        h0 = h_ctx[:, 0] if rev else h_ctx[:, -1]
        bu = jnp.einsum('btgh,gph->btgp', u_cplx, b_bar)
        edge = -1 if rev else 0
        bu = bu.at[:, edge].add(a_bar * h0)
        h = linear_recurrence(a_bar, bu, rev)
        y = y + jnp.real(jnp.einsum('btgp,ghp->btgh', h, c_mat))
        if need_ctx:
            yc = yc + jnp.real(jnp.einsum('btgp,ghp->btgh', h_ctx, c_mat))

    def glu(yy):
        g = jax.nn.gelu(yy.reshape(yy.shape[0], yy.shape[1], SSM_WIDTH))
        return g * jax.nn.sigmoid(g @ w_glu.astype(f32) + b_glu.astype(f32))

    out = glu(y).astype(u.dtype)
    out_c = glu(yc).astype(uc.dtype) if need_ctx else None
    return out, out_c


def fourier_mix(u, w_four, b_four):
    bsz, t = u.shape[:2]
    ug = u.astype(jnp.float32).reshape(bsz, t, FOURIER_HEADS, FOURIER_GROUP)
    mixed = jnp.real(jnp.fft.fft2(ug, axes=(1, 3), norm='ortho')).astype(u.dtype)
    out = jnp.einsum('btgc,gcd->btgd', mixed, w_four) + b_four
    return out.reshape(bsz, t, FOURIER_WIDTH)


def split_in(z):
    b, t = z.shape[:2]
    q = z[..., :ATTN_WIDTH].reshape(b, t, DA_HEADS, 2, DA_HEAD_DIM)
    k = z[..., ATTN_WIDTH:2 * ATTN_WIDTH].reshape(b, t, DA_HEADS, 2, DA_HEAD_DIM)
    v = z[..., 2 * ATTN_WIDTH:3 * ATTN_WIDTH].reshape(b, t, DA_HEADS, 2 * DA_HEAD_DIM)
    u_ssm = z[..., 3 * ATTN_WIDTH:3 * ATTN_WIDTH + SSM_WIDTH]
    u_four = z[..., 3 * ATTN_WIDTH + SSM_WIDTH:]
    return q, k, v, u_ssm, u_four


def swiglu(h, w_gate, w_up, w_down):
    return (jax.nn.silu(h @ w_gate) * (h @ w_up)) @ w_down


def setup_inputs(seed: int = 0) -> dict:
    key = jax.random.key(seed)
    ks = jax.random.split(key, 32)
    f32 = jnp.float32
    L, D, G, P, H = DEPTH, D_MODEL, SSM_GROUPS, SSM_STATE, SSM_GROUP

    def nrm(k, shape, scale):
        return jax.random.normal(k, shape, f32) * scale

    n_idx = jnp.arange(P, dtype=f32)
    return {
        'x': nrm(ks[0], (BATCH, SEQ, D), 1.0),
        'c': nrm(ks[1], (BATCH, D), 1.0),
        'ctx': nrm(ks[2], (BATCH, CTX_LEN, D), 1.0),
        'c_ctx': nrm(ks[3], (D,), 1.0),
        'w_mod': nrm(ks[4], (L, D, N_MOD * D), D ** -0.5),
        'b_mod': nrm(ks[5], (L, N_MOD * D), 0.01),
        'g_mix_pre': 1.0 + nrm(ks[6], (L, D), 0.02),
        'g_mix_post': 1.0 + nrm(ks[7], (L, D), 0.02),
        'g_ffn_pre': 1.0 + nrm(ks[8], (L, D), 0.02),
        'g_ffn_post': 1.0 + nrm(ks[9], (L, D), 0.02),
        'w_in': nrm(ks[10], (L, D, IN_WIDTH), D ** -0.5),
        'w_out': nrm(ks[11], (L, MIX_WIDTH, D), MIX_WIDTH ** -0.5),
        'lam_q1': nrm(ks[12], (L, DA_HEAD_DIM), 0.1),
        'lam_k1': nrm(ks[13], (L, DA_HEAD_DIM), 0.1),
        'lam_q2': nrm(ks[14], (L, DA_HEAD_DIM), 0.1),
        'lam_k2': nrm(ks[15], (L, DA_HEAD_DIM), 0.1),
        'g_subln': 1.0 + nrm(ks[16], (L, 2 * DA_HEAD_DIM), 0.02),
        'ssm_a_re': -0.5 + nrm(ks[17], (L, 2, G, P), 0.01),
        'ssm_a_im': math.pi * n_idx + nrm(ks[18], (L, 2, G, P), 0.01),
        'ssm_log_dt': jax.random.uniform(ks[19], (L, 2, G), f32, minval=math.log(DT_MIN), maxval=math.log(DT_MAX)),
        'ssm_b_re': nrm(ks[20], (L, 2, G, P, H), (2 * H) ** -0.5),
        'ssm_b_im': nrm(ks[21], (L, 2, G, P, H), (2 * H) ** -0.5),
        'ssm_c_re': nrm(ks[22], (L, 2, G, H, P), C_SCALE),
        'ssm_c_im': nrm(ks[23], (L, 2, G, H, P), C_SCALE),
        'ssm_d': nrm(ks[24], (L, SSM_WIDTH), 1.0),
        'w_glu': nrm(ks[25], (L, SSM_WIDTH, SSM_WIDTH), SSM_WIDTH ** -0.5),
        'b_glu': nrm(ks[26], (L, SSM_WIDTH), 0.01),
        'w_four': nrm(ks[27], (L, FOURIER_HEADS, FOURIER_GROUP, FOURIER_GROUP), FOURIER_GROUP ** -0.5),
        'b_four': nrm(ks[28], (L, FOURIER_HEADS, FOURIER_GROUP), 0.01),
        'w_gate': nrm(ks[29], (L, D, D_FF), D ** -0.5),
        'w_up': nrm(ks[30], (L, D, D_FF), D ** -0.5),
        'w_down': nrm(ks[31], (L, D_FF, D), D_FF ** -0.5),
    }


def reference(x, c, ctx, c_ctx, w_mod, b_mod, g_mix_pre, g_mix_post, g_ffn_pre, g_ffn_post, w_in, w_out,
              lam_q1, lam_k1, lam_q2, lam_k2, g_subln, ssm_a_re, ssm_a_im, ssm_log_dt, ssm_b_re, ssm_b_im,
              ssm_c_re, ssm_c_im, ssm_d, w_glu, b_glu, w_four, b_four, w_gate, w_up, w_down):
    n_tok = x.shape[1]
    cos, sin = rope_tables(n_tok)
    xl, xc = x, ctx
    for l in range(DEPTH):
        need_ctx = l < DEPTH - 1
        lam_init = 0.8 - 0.6 * math.exp(-0.3 * l)
        m = (jax.nn.silu(c) @ w_mod[l] + b_mod[l]).reshape(c.shape[0], 1, N_MOD, D_MODEL)
        mc = (jax.nn.silu(c_ctx) @ w_mod[l] + b_mod[l]).reshape(1, 1, N_MOD, D_MODEL)

        h = rmsnorm(xl, g_mix_pre[l]) * (1.0 + m[:, :, 1]) + m[:, :, 0]
        hc = rmsnorm(xc, g_mix_pre[l]) * (1.0 + mc[:, :, 1]) + mc[:, :, 0]
        q, k, v, u_ssm, u_four = split_in(h @ w_in[l])
        qc, kc, vc, uc_ssm, uc_four = split_in(hc @ w_in[l])
        att, att_c = diff_attention(q, k, v, qc, kc, vc, lam_q1[l], lam_k1[l], lam_q2[l], lam_k2[l],
                                    g_subln[l], lam_init, cos, sin, need_ctx)
        ssm, ssm_c = s5_bidirectional(u_ssm, uc_ssm, ssm_a_re[l], ssm_a_im[l], ssm_log_dt[l], ssm_b_re[l],
                                      ssm_b_im[l], ssm_c_re[l], ssm_c_im[l], ssm_d[l], w_glu[l], b_glu[l], need_ctx)
        four = fourier_mix(u_four, w_four[l], b_four[l])
        mix = jnp.concatenate([att, ssm, four], axis=-1) @ w_out[l]
        xl = xl + m[:, :, 2] * rmsnorm(mix, g_mix_post[l])

        f = swiglu(rmsnorm(xl, g_ffn_pre[l]) * (1.0 + m[:, :, 4]) + m[:, :, 3], w_gate[l], w_up[l], w_down[l])
        xl = xl + m[:, :, 5] * rmsnorm(f, g_ffn_post[l])

        if need_ctx:
            four_c = fourier_mix(uc_four, w_four[l], b_four[l])
            mix_c = jnp.concatenate([att_c, ssm_c, four_c], axis=-1) @ w_out[l]
            xc = xc + mc[:, :, 2] * rmsnorm(mix_c, g_mix_post[l])
            fc = swiglu(rmsnorm(xc, g_ffn_pre[l]) * (1.0 + mc[:, :, 4]) + mc[:, :, 3], w_gate[l], w_up[l], w_down[l])
            xc = xc + mc[:, :, 5] * rmsnorm(fc, g_ffn_post[l])
    return xl
```

```cpp
#include <hip/hip_runtime.h>
#include <hip/hip_cooperative_groups.h>
#include <cstdio>
#include <cstdint>
namespace cg = cooperative_groups;

typedef unsigned short bf16_t;
using bf16x8 = __attribute__((ext_vector_type(8))) short;
using s16x4  = __attribute__((ext_vector_type(4))) short;
using f32x4  = __attribute__((ext_vector_type(4))) float;
using f32x16 = __attribute__((ext_vector_type(16))) float;
using u32x4  = __attribute__((ext_vector_type(4))) unsigned;
using u32x2  = __attribute__((ext_vector_type(2))) unsigned;
#define LAS __attribute__((address_space(3)))

constexpr int NB = 4, SEQ = 4096, CTXL = 256, TPB = SEQ + CTXL  , TT = NB * TPB  ;
constexpr int DM = 2048, NIN = 4608, DFF = 5632, NMODC = 6 * DM  ;
constexpr int NTHREADS = 512, SHM_BYTES = 131072;

constexpr size_t al256(size_t x) { return (x + 255) / 256 * 256; }
constexpr size_t OFF_X    = 0;
constexpr size_t OFF_WIN  = OFF_X + (size_t)TT * DM * 4;
constexpr size_t OFF_WOUT = OFF_WIN + (size_t)NIN * DM * 2;
constexpr size_t OFF_WGU  = OFF_WOUT + (size_t)DM * DM * 2;
constexpr size_t OFF_WD   = OFF_WGU + (size_t)2 * DFF * DM * 2;
constexpr size_t OFF_WGLU = OFF_WD + (size_t)DM * DFF * 2;
constexpr size_t OFF_DFTL = OFF_WGLU + (size_t)512 * 512 * 2;
constexpr size_t OFF_DFTC = OFF_DFTL + (size_t)2 * 4096 * 4096 * 2;
constexpr size_t OFF_MP   = OFF_DFTC + (size_t)2 * 256 * 256 * 2;
constexpr size_t OFF_MOD  = OFF_MP + (size_t)16 * 5 * 24576 * 4;
constexpr size_t OFF_ROPE = OFF_MOD + (size_t)2 * 5 * NMODC * 4;
constexpr size_t OFF_WCS  = OFF_ROPE + (size_t)2 * 64 * 32 * 4;
constexpr size_t OFF_HN   = OFF_WCS + (size_t)2 * 2 * 4 * 128 * 128 * 4;
constexpr size_t OFF_Z1   = OFF_HN + (size_t)TT * DM * 2;
constexpr size_t Z1_Q = 0, Z1_K = (size_t)TT * 1024 * 2, Z1_V = 2 * Z1_K, Z1_U = 3 * Z1_K;
constexpr size_t OFF_Z2   = OFF_Z1 + (size_t)TT * DM * 4;
constexpr size_t Z2_FC = 0, Z2_FS = Z2_FC + (size_t)TT * 512 * 4, Z2_YF = Z2_FS + (size_t)TT * 512 * 4, Z2_YR = Z2_YF + (size_t)TT * 512 * 4;
constexpr size_t Z2_S = Z2_YR + (size_t)TT * 512 * 4;
constexpr size_t Z2_CAT = Z2_S + (size_t)NB * 2 * 32 * 68 * 64 * 8;
constexpr size_t Z2_GG = Z2_CAT + (size_t)TT * DM * 2;
constexpr size_t Z2_END = Z2_GG + (size_t)TT * 512 * 2;
constexpr size_t Z2_SIZE = Z2_END > (size_t)TT * DFF * 2 ? Z2_END : (size_t)TT * DFF * 2;
constexpr size_t WS_NEED = OFF_Z2 + Z2_SIZE;
static_assert(WS_NEED <= (size_t)805306368, "workspace over 768 MiB");
static_assert(Z1_U + (size_t)TT * 512 * 4 <= (size_t)TT * DM * 4, "Z1 overflow");

struct Params {
  const float *x, *c, *ctx, *c_ctx, *w_mod, *b_mod, *g_mix_pre, *g_mix_post, *g_ffn_pre, *g_ffn_post, *w_in, *w_out;
  const float *lam_q1, *lam_k1, *lam_q2, *lam_k2, *g_subln, *ssm_a_re, *ssm_a_im, *ssm_log_dt, *ssm_b_re, *ssm_b_im;
  const float *ssm_c_re, *ssm_c_im, *ssm_d, *w_glu, *b_glu, *w_four, *b_four, *w_gate, *w_up, *w_down;
  float* out; char* ws;
};

__device__ __forceinline__ unsigned cvtpk(float lo, float hi) { unsigned r; asm volatile("v_cvt_pk_bf16_f32 %0, %1, %2" : "=v"(r) : "v"(lo), "v"(hi)); return r; }
__device__ __forceinline__ float bf2f(unsigned short b) { return __uint_as_float((unsigned)b << 16); }
__device__ __forceinline__ float wave_sum(float v) {
  v += __shfl_xor(v, 32); v += __shfl_xor(v, 16); v += __shfl_xor(v, 8); v += __shfl_xor(v, 4); v += __shfl_xor(v, 2); v += __shfl_xor(v, 1); return v;
}
__device__ __forceinline__ void my_sincos(float x, float& s, float& c) {
  const double xd = (double)x; const double kd = rint(xd * 0.63661977236758134); const double r = xd - kd * 1.5707963267948966;
  const double r2 = r * r;
  const double sn = r * (1.0 - r2 / 6.0 * (1.0 - r2 / 20.0 * (1.0 - r2 / 42.0 * (1.0 - r2 / 72.0 * (1.0 - r2 / 110.0 * (1.0 - r2 / 156.0))))));
  const double cs = 1.0 - r2 / 2.0 * (1.0 - r2 / 12.0 * (1.0 - r2 / 30.0 * (1.0 - r2 / 56.0 * (1.0 - r2 / 90.0 * (1.0 - r2 / 132.0)))));
  const int q = ((int)kd) & 3;
  const double ss = (q == 0) ? sn : (q == 1) ? cs : (q == 2) ? -sn : -cs;
  const double cc = (q == 0) ? cs : (q == 1) ? -sn : (q == 2) ? -cs : sn;
  s = (float)ss; c = (float)cc;
}
__device__ __forceinline__ float sigmoidf_(float x) { return 1.f / (1.f + __expf(-x)); }
__device__ __forceinline__ float gelu_tanh(float y) { const float u = 0.7978845608028654f * (y + 0.044715f * y * y * y); return y * sigmoidf_(2.f * u); }

namespace gm {
constexpr int BM = 256, BK = 64, HALF = 128, HTB = HALF * BK * 2, NXCD = 8, WGM = 8;
__device__ __forceinline__ int lds_byte(int r, int c) { const int st = (r >> 4) * 2 + (c >> 5), rr = r & 15, cc = c & 31, ob = rr * 64 + cc * 2; return st * 1024 + (ob ^ (((ob >> 9) & 1) << 5)); }
__device__ __forceinline__ void stage_rc(int b, int& R, int& C) { const int st = b / 1024, sb = b % 1024, swz = sb ^ (((sb >> 9) & 1) << 5); R = (st >> 1) * 16 + swz / 64; C = (st & 1) * 32 + (swz % 64) / 2; }
__device__ __forceinline__ void tile_of(int wgid, int nM, int nN, int& pm, int& pn) {
  const int nwg = nM * nN; { const int q = nwg / NXCD, r = nwg % NXCD, xcd = wgid % NXCD, off = wgid / NXCD; wgid = (xcd < r ? xcd * (q + 1) : r * (q + 1) + (xcd - r) * q) + off; }
  const int nig = WGM * nN, gid = wgid / nig, fm = gid * WGM, gsz = (nM - fm) < WGM ? (nM - fm) : WGM;
  pm = fm + ((wgid % nig) % gsz); pn = (wgid % nig) / gsz;
}
struct Unit { int pm, pn; };

template <bool SWAP, class Epi, class Sched>
__device__ __forceinline__ void gemm_phase(LAS unsigned char* lds, const int lda, const int ldb, const int K, const Sched& S, const Epi& E) {
  int tid_ = threadIdx.x; asm volatile("" : "+v"(tid_));
  const int tid = tid_, wid = __builtin_amdgcn_readfirstlane(tid >> 6), lane = tid & 63, wr = wid >> 2, wc = wid & 3, fr = lane & 15, fq = lane >> 4;
  const int nt = K / BK;
  unsigned voffA[2], voffB[2];
#pragma unroll
  for (int i = 0; i < 2; ++i) { int R, C; stage_rc(tid * 16 + i * 8192, R, C); voffA[i] = (unsigned)(R * lda + C) * 2u; voffB[i] = (unsigned)(R * ldb + C) * 2u; }
  const size_t kstep = (size_t)(BK * 2), hstepA = (size_t)HALF * lda * 2, hstepB = (size_t)HALF * ldb * 2;
  const unsigned ldsw = (unsigned)wid * 1024u;
  const int aoff = lds_byte(wr * 64 + fr, fq * 8), boff = lds_byte(wc * 32 + fr, fq * 8);
#define PG8_SA(b, h) (((b) * 2 + (h)) * HTB)
#define PG8_SB(b, h) ((4 + (b) * 2 + (h)) * HTB)
#define PG8_STAGE(bufoff, gbase, voff) do { _Pragma("unroll") for (int _i = 0; _i < 2; ++_i) \
    __builtin_amdgcn_global_load_lds((const unsigned*)((const char*)(gbase) + (voff)[_i]), (LAS unsigned*)(lds + (bufoff) + ldsw + _i * 8192), 16, 0, 0); } while (0)
#define PG8_LDA(dst, b, h) do { _Pragma("unroll") for (int m = 0; m < 4; ++m) _Pragma("unroll") for (int k = 0; k < 2; ++k) dst[m][k] = *(const LAS bf16x8*)(lds + PG8_SA(b, h) + aoff + m * 2048 + k * 1024); } while (0)
#define PG8_LDB(dst, b, h) do { _Pragma("unroll") for (int n = 0; n < 2; ++n) _Pragma("unroll") for (int k = 0; k < 2; ++k) dst[n][k] = *(const LAS bf16x8*)(lds + PG8_SB(b, h) + boff + n * 2048 + k * 1024); } while (0)
#define PG8_MMA(ai, bj, At, Bt) do { __builtin_amdgcn_s_setprio(1); _Pragma("unroll") for (int m = 0; m < 4; ++m) _Pragma("unroll") for (int n = 0; n < 2; ++n) _Pragma("unroll") for (int k = 0; k < 2; ++k) \
    acc[ai][bj][m][n] = SWAP ? __builtin_amdgcn_mfma_f32_16x16x32_bf16(Bt[n][k], At[m][k], acc[ai][bj][m][n], 0, 0, 0) \
                             : __builtin_amdgcn_mfma_f32_16x16x32_bf16(At[m][k], Bt[n][k], acc[ai][bj][m][n], 0, 0, 0); __builtin_amdgcn_s_setprio(0); } while (0)
#define PG8_WAIT_V(n) asm volatile("s_waitcnt vmcnt(" #n ")" ::: "memory")
#define PG8_WAIT_L(n) asm volatile("s_waitcnt lgkmcnt(" #n ")" ::: "memory")
#define PG8_BAR __builtin_amdgcn_s_barrier()
#define PG8_SCHED __builtin_amdgcn_sched_barrier(0)
  Unit cur, nxt; int ui = 0;
  if (!S.next(0, cur)) return;
  f32x4 acc[2][2][4][2];
#pragma unroll
  for (int a = 0; a < 2; ++a)
#pragma unroll
    for (int b = 0; b < 2; ++b)
#pragma unroll
      for (int m = 0; m < 4; ++m)
#pragma unroll
        for (int n = 0; n < 2; ++n) acc[a][b][m][n] = (f32x4){0.f, 0.f, 0.f, 0.f};
  bf16x8 At[4][2], B0[2][2], B1[2][2];
  const char* cA = S.pA(cur); const char* cB = S.pB(cur);
  PG8_STAGE(PG8_SB(0, 0), cB, voffB); PG8_STAGE(PG8_SB(0, 1), cB + hstepB, voffB); PG8_STAGE(PG8_SA(0, 0), cA, voffA); PG8_STAGE(PG8_SA(0, 1), cA + hstepA, voffA);
  if (wr == 1) PG8_BAR;
  PG8_WAIT_V(2); PG8_BAR;
  PG8_STAGE(PG8_SB(1, 0), cB + kstep, voffB); PG8_STAGE(PG8_SA(1, 0), cA + kstep, voffA); PG8_STAGE(PG8_SB(1, 1), cB + hstepB + kstep, voffB);
  PG8_WAIT_V(6); PG8_BAR;
  for (;;) {
    const bool has_next = S.next(ui + 1, nxt);
    const char* nA = has_next ? S.pA(nxt) : cA; const char* nB = has_next ? S.pB(nxt) : cB;
    for (int t = 0; t < nt; t += 2) {
      const bool last = (t == nt - 2);
      const char* a1 = cA + (size_t)(t + 1) * kstep;
      const char* a2 = last ? nA : cA + (size_t)(t + 2) * kstep; const char* b2 = last ? nB : cB + (size_t)(t + 2) * kstep;
      const char* a3 = a2 + kstep; const char* b3 = b2 + kstep;
      PG8_LDB(B0, 0, 0); PG8_LDB(B1, 0, 1); PG8_SCHED; PG8_LDA(At, 0, 0); PG8_STAGE(PG8_SA(1, 1), a1 + hstepA, voffA);
      PG8_WAIT_V(8); PG8_WAIT_L(0); PG8_BAR; PG8_MMA(0, 0, At, B0); PG8_MMA(0, 1, At, B1); PG8_BAR; PG8_SCHED;
      PG8_LDA(At, 0, 1); PG8_STAGE(PG8_SB(0, 0), b2, voffB); PG8_STAGE(PG8_SB(0, 1), b2 + hstepB, voffB); PG8_STAGE(PG8_SA(0, 0), a2, voffA);
      PG8_WAIT_V(8); PG8_WAIT_L(0); PG8_BAR; PG8_MMA(1, 0, At, B0); PG8_MMA(1, 1, At, B1); PG8_BAR; PG8_SCHED;
      PG8_LDB(B0, 1, 0); PG8_LDB(B1, 1, 1); PG8_SCHED; PG8_LDA(At, 1, 0); PG8_STAGE(PG8_SA(0, 1), a2 + hstepA, voffA);
      PG8_WAIT_V(8); PG8_WAIT_L(0); PG8_BAR; PG8_MMA(0, 0, At, B0); PG8_MMA(0, 1, At, B1); PG8_BAR; PG8_SCHED;
      PG8_LDA(At, 1, 1); PG8_STAGE(PG8_SB(1, 0), b3, voffB); PG8_STAGE(PG8_SB(1, 1), b3 + hstepB, voffB); PG8_STAGE(PG8_SA(1, 0), a3, voffA);
      PG8_WAIT_V(8); PG8_WAIT_L(0); PG8_BAR; PG8_MMA(1, 0, At, B0); PG8_MMA(1, 1, At, B1); PG8_BAR; PG8_SCHED;
    }
    if (wr == 0) PG8_BAR;
    { int fr2 = fr, fq2 = fq; asm volatile("" : "+v"(fr2), "+v"(fq2));
      E(acc, cur, wr, wc, fr2, fq2); }
    if (!has_next) break;
#pragma unroll
    for (int a = 0; a < 2; ++a)
#pragma unroll
      for (int b = 0; b < 2; ++b)
#pragma unroll
        for (int m = 0; m < 4; ++m)
#pragma unroll
          for (int n = 0; n < 2; ++n) acc[a][b][m][n] = (f32x4){0.f, 0.f, 0.f, 0.f};
    cur = nxt; cA = nA; cB = nB; ++ui;
    if (wr == 1) PG8_BAR;
  }
  PG8_WAIT_V(0);
  PG8_BAR;
#undef PG8_SA
#undef PG8_SB
#undef PG8_STAGE
#undef PG8_LDA
#undef PG8_LDB
#undef PG8_MMA
#undef PG8_WAIT_V
#undef PG8_WAIT_L
#undef PG8_BAR
#undef PG8_SCHED
}
}

namespace at {
constexpr int D = 128, NW = 8, QBLK = 32, KVBLK = 64;
constexpr float SCALE = 0.088388347648318440f;
constexpr float THR = 8.f;
constexpr int LDQ = 1024, LDK = 1024, LDV = 1024, LDO = 2048;
constexpr size_t SHM_V = KVBLK * D * 2, SHM_K = KVBLK * D * 2;
#define KSWZ(row, colB) ((row) * 256 + ((colB) ^ (((row) & 7) << 4)))
#define SBAR() __builtin_amdgcn_sched_barrier(0)
__device__ __forceinline__ int crow(int r, int hi) { return (r & 3) + 8 * (r >> 2) + 4 * hi; }
__device__ __forceinline__ void partialSM(f32x16& p0, f32x16& p1, float& m_reg, float& mn, float& alpha) {
  constexpr float C = SCALE * 1.4426950408889634f;
  float pmax = p0[0];
#pragma unroll
  for (int r = 1; r < 16; ++r) pmax = fmaxf(pmax, p0[r]);
#pragma unroll
  for (int r = 0; r < 16; ++r) pmax = fmaxf(pmax, p1[r]);
  { auto rr = __builtin_amdgcn_permlane32_swap(__float_as_uint(pmax), __float_as_uint(pmax), false, false);
    pmax = fmaxf(__uint_as_float(rr[0]), __uint_as_float(rr[1])); }
  if (__builtin_expect(__all(pmax - m_reg <= THR / SCALE), 1)) { mn = m_reg; alpha = 1.f; }
  else { mn = fmaxf(m_reg, pmax); alpha = __builtin_amdgcn_exp2f((m_reg - mn) * C); m_reg = mn; }
  float mnC = -mn * C;
#pragma unroll
  for (int r = 0; r < 16; ++r) p0[r] = fmaf(p0[r], C, mnC);
#pragma unroll
  for (int r = 0; r < 16; ++r) p1[r] = fmaf(p1[r], C, mnC);
#pragma unroll
  for (int r = 0; r < 16; ++r) p0[r] = __builtin_amdgcn_exp2f(p0[r]);
}
__device__ __forceinline__ void finishSM(f32x16& p0, f32x16& p1, float alpha, float& l_reg, bf16x8& pa0, bf16x8& pa1, bf16x8& pa2, bf16x8& pa3) {
#pragma unroll
  for (int r = 0; r < 16; ++r) p1[r] = __builtin_amdgcn_exp2f(p1[r]);
  float ps = 0;
#pragma unroll
  for (int r = 0; r < 16; ++r) ps += p0[r];
#pragma unroll
  for (int r = 0; r < 16; ++r) ps += p1[r];
  { auto rr = __builtin_amdgcn_permlane32_swap(__float_as_uint(ps), __float_as_uint(ps), false, false);
    ps = __uint_as_float(rr[0]) + __uint_as_float(rr[1]); }
  l_reg = l_reg * alpha + ps;
#define PK4(P, BASE, OUT) do { unsigned a0 = cvtpk(P[BASE + 0], P[BASE + 1]), a1 = cvtpk(P[BASE + 2], P[BASE + 3]);   \
    unsigned b0 = cvtpk(P[BASE + 4], P[BASE + 5]), b1 = cvtpk(P[BASE + 6], P[BASE + 7]);                              \
    auto r0 = __builtin_amdgcn_permlane32_swap(a0, b0, false, false); auto r1 = __builtin_amdgcn_permlane32_swap(a1, b1, false, false); \
    u32x4 w = {r0[0], r1[0], r0[1], r1[1]}; OUT = *reinterpret_cast<bf16x8*>(&w); } while (0)
  PK4(p0, 0, pa0); PK4(p0, 8, pa1); PK4(p1, 0, pa2); PK4(p1, 8, pa3);
#undef PK4
}
__device__ __forceinline__ void qkt(f32x16& p0, f32x16& p1, const char* Ks, const bf16x8* qr, int r32, int hi) {
  p0 = f32x16{}; p1 = f32x16{};
#pragma unroll
  for (int d0 = 0; d0 < 8; ++d0) { int cb = (d0 * 16 + hi * 8) * 2;
    bf16x8 b0 = *reinterpret_cast<const bf16x8*>(Ks + KSWZ(r32, cb));
    bf16x8 b1 = *reinterpret_cast<const bf16x8*>(Ks + KSWZ(32 + r32, cb));
    p0 = __builtin_amdgcn_mfma_f32_32x32x16_bf16(b0, qr[d0], p0, 0, 0, 0);
    p1 = __builtin_amdgcn_mfma_f32_32x32x16_bf16(b1, qr[d0], p1, 0, 0, 0); }
}
__device__ __forceinline__ int v_st(int k, int c) { const int kk = (k & ~0xC) | ((k & 4) << 1) | ((k & 8) >> 1); return ((kk >> 3) * 4 + (c >> 5)) * 512 + ((kk & 7) * 32 + (c & 31)) * 2; }
__device__ __forceinline__ int v_rd_base(int lane) { return ((lane & 3) << 3) | (((lane >> 2) & 3) << 6) | (((lane >> 4) & 1) << 5) | (((lane >> 5) & 1) << 8); }
constexpr int v_rd_off(int d0, int ks, int half) { return d0 * 512 + ks * 4096 + half * 2048; }
template <int OFF> __device__ __forceinline__ s16x4 tr_read(int vb) {
  s16x4 r; asm volatile("ds_read_b64_tr_b16 %0, %1 offset:%2" : "=&v"(r) : "v"(vb), "i"(OFF) : "memory"); return r;
}
template <int D0> __device__ __forceinline__ void pv_one(f32x16& od, int vb, bf16x8 pa0, bf16x8 pa1, bf16x8 pa2, bf16x8 pa3) {
  const s16x4 l0 = tr_read<v_rd_off(D0, 0, 0)>(vb), h0 = tr_read<v_rd_off(D0, 0, 1)>(vb), l1 = tr_read<v_rd_off(D0, 1, 0)>(vb), h1 = tr_read<v_rd_off(D0, 1, 1)>(vb);
  const s16x4 l2 = tr_read<v_rd_off(D0, 2, 0)>(vb), h2 = tr_read<v_rd_off(D0, 2, 1)>(vb), l3 = tr_read<v_rd_off(D0, 3, 0)>(vb), h3 = tr_read<v_rd_off(D0, 3, 1)>(vb);
  asm volatile("s_waitcnt lgkmcnt(0)" ::: "memory"); SBAR();
#define PK(L, H) (bf16x8){L[0], L[1], L[2], L[3], H[0], H[1], H[2], H[3]}
  od = __builtin_amdgcn_mfma_f32_32x32x16_bf16(pa0, PK(l0, h0), od, 0, 0, 0);
  od = __builtin_amdgcn_mfma_f32_32x32x16_bf16(pa1, PK(l1, h1), od, 0, 0, 0);
  od = __builtin_amdgcn_mfma_f32_32x32x16_bf16(pa2, PK(l2, h2), od, 0, 0, 0);
  od = __builtin_amdgcn_mfma_f32_32x32x16_bf16(pa3, PK(l3, h3), od, 0, 0, 0);
#undef PK
}
__device__ __forceinline__ void pv_d0(f32x16* o, int vb, bf16x8 pa0, bf16x8 pa1, bf16x8 pa2, bf16x8 pa3) {
  pv_one<0>(o[0], vb, pa0, pa1, pa2, pa3); pv_one<1>(o[1], vb, pa0, pa1, pa2, pa3); pv_one<2>(o[2], vb, pa0, pa1, pa2, pa3); pv_one<3>(o[3], vb, pa0, pa1, pa2, pa3);
}
__device__ __forceinline__ void body(const bf16_t* __restrict__ Qb, const bf16_t* __restrict__ Kh, const bf16_t* __restrict__ Vh, bf16_t* __restrict__ Ob, int seq, char* lds) {
  int tid_ = threadIdx.x; asm volatile("" : "+v"(tid_));
  const int tid = tid_, wid = tid >> 6, lane = tid & 63, r32 = lane & 31, hi = lane >> 5;
  char* V_lds = lds; char* K_lds = lds + 2 * SHM_V;
  float* ws = (float*)(lds + 2 * SHM_V + 2 * SHM_K) + wid * 64; float* li_l = ws; float* al_l = ws + 32;
  float m_reg = -1e30f, l_reg = 0; f32x16 o[4] = {}; bf16x8 qr[8];
  const bf16_t* Qw = Qb + (long)(wid * QBLK + r32) * LDQ + hi * 8;
#pragma unroll
  for (int d0 = 0; d0 < 8; ++d0) qr[d0] = *reinterpret_cast<const bf16x8*>(Qw + d0 * 16);
  const int sr = tid >> 4, sc = (tid & 15) * 8, vst0 = v_st(sr, sc), vst1 = v_st(32 + sr, sc);
  const int vb0 = (int)(uintptr_t)(LAS char*)V_lds + v_rd_base(lane);
  bf16x8 sA_vs0, sA_vs1, sA_ks0, sA_ks1, sB_vs0, sB_vs1, sB_ks0, sB_ks1;
#define SLOAD(S, k0) do { S##_vs0 = *reinterpret_cast<const bf16x8*>(&Vh[(long)((k0) + sr) * LDV + sc]); S##_vs1 = *reinterpret_cast<const bf16x8*>(&Vh[(long)((k0) + 32 + sr) * LDV + sc]); \
    S##_ks0 = *reinterpret_cast<const bf16x8*>(&Kh[(long)((k0) + sr) * LDK + sc]); S##_ks1 = *reinterpret_cast<const bf16x8*>(&Kh[(long)((k0) + 32 + sr) * LDK + sc]); } while (0)
#define SWRITE(b, S) do { *(bf16x8*)(V_lds + (b) * SHM_V + vst0) = S##_vs0; *(bf16x8*)(V_lds + (b) * SHM_V + vst1) = S##_vs1; int kc = sc * 2; \
    *(bf16x8*)(K_lds + (b) * SHM_K + KSWZ(sr, kc)) = S##_ks0; *(bf16x8*)(K_lds + (b) * SHM_K + KSWZ(32 + sr, kc)) = S##_ks1; } while (0)
#define SWAIT() asm volatile("s_waitcnt vmcnt(4)" ::: "memory")
#define RESC(a) do { if (__any((a) < 1.f)) { if (hi == 0) al_l[r32] = (a); asm volatile("s_waitcnt lgkmcnt(0)" ::: "memory"); \
    for (int d = 0; d < 4; ++d) for (int r = 0; r < 16; ++r) o[d][r] *= al_l[crow(r, hi)]; } } while (0)
  f32x16 pA0, pA1, pB0, pB1; float mnA, mnB, alA, alB; bf16x8 pa0, pa1, pa2, pa3; const int NT = seq / KVBLK;
  SLOAD(sA, 0); asm volatile("s_waitcnt vmcnt(0)" ::: "memory"); SWRITE(0, sA); __syncthreads();
  qkt(pA0, pA1, K_lds, qr, r32, hi); partialSM(pA0, pA1, m_reg, mnA, alA);
  SLOAD(sB, KVBLK); if (2 < NT) SLOAD(sA, 2 * KVBLK);
  SWAIT(); SWRITE(1, sB); __syncthreads();
  for (int j = 1; j + 1 < NT; j += 2) {
    SBAR(); qkt(pB0, pB1, K_lds + SHM_K, qr, r32, hi);
    finishSM(pA0, pA1, alA, l_reg, pa0, pa1, pa2, pa3); SBAR();
    SLOAD(sB, (j + 2) * KVBLK); SBAR();
    pv_d0(o, vb0, pa0, pa1, pa2, pa3); partialSM(pB0, pB1, m_reg, mnB, alB);
    __syncthreads(); SWAIT(); SWRITE(0, sA);
    RESC(alB); __syncthreads();
    SBAR(); qkt(pA0, pA1, K_lds, qr, r32, hi);
    finishSM(pB0, pB1, alB, l_reg, pa0, pa1, pa2, pa3); SBAR();
    if (j + 3 < NT) SLOAD(sA, (j + 3) * KVBLK); SBAR();
    pv_d0(o, vb0 + (int)SHM_V, pa0, pa1, pa2, pa3); partialSM(pA0, pA1, m_reg, mnA, alA);
    __syncthreads(); SWAIT(); SWRITE(1, sB);
    RESC(alA); __syncthreads();
  }
  SBAR(); qkt(pB0, pB1, K_lds + SHM_K, qr, r32, hi);
  finishSM(pA0, pA1, alA, l_reg, pa0, pa1, pa2, pa3); SBAR();
  pv_d0(o, vb0, pa0, pa1, pa2, pa3); partialSM(pB0, pB1, m_reg, mnB, alB);
  __syncthreads(); RESC(alB);
  finishSM(pB0, pB1, alB, l_reg, pa0, pa1, pa2, pa3); SBAR();
  pv_d0(o, vb0 + (int)SHM_V, pa0, pa1, pa2, pa3);
  if (hi == 0) li_l[r32] = l_reg; asm volatile("s_waitcnt lgkmcnt(0)" ::: "memory");
  float rli[16];
#pragma unroll
  for (int r = 0; r < 16; ++r) rli[r] = __builtin_amdgcn_rcpf(li_l[crow(r, hi)]);
  bf16_t* Ow = Ob + (long)(wid * QBLK) * LDO;
#pragma unroll
  for (int r = 0; r < 16; ++r) { int orow = crow(r, hi);
#pragma unroll
    for (int d0 = 0; d0 < 4; ++d0) Ow[(long)orow * LDO + d0 * 32 + r32] = (bf16_t)(cvtpk(o[d0][r] * rli[r], 0.f) & 0xffff); }
#undef SLOAD
#undef SWRITE
#undef SWAIT
#undef RESC
  __syncthreads();
}
}

struct Ctx {
  int tid, wid, lane, blk, nblk, gwave, nwave; long gtid, nthr;
};

__device__ __forceinline__ const float* modp(const Params& p, int l, int v, int j) { return (const float*)(p.ws + OFF_MOD) + ((size_t)(l * 5 + v) * NMODC + (size_t)j * DM); }

__device__ __forceinline__ void convert_weights(const Params& p, const Ctx& c, int l, float* lds) {
  constexpr int T0 = 56 * 32, T1 = 32 * 32, T2 = 176 * 32, T3 = 32 * 88, T4 = 8 * 8, TALL = T0 + T1 + T2 + T3 + T4;
  for (int it = c.blk; it < TALL; it += c.nblk) {
    int mat, ti = it;
    if (ti < T0) mat = 0; else if ((ti -= T0) < T1) mat = 1; else if ((ti -= T1) < T2) mat = 2; else if ((ti -= T2) < T3) mat = 3; else { ti -= T3; mat = 4; }
    const float* src; long ld; bf16_t* dst; long dld; int nkt;
    if (mat == 0) { src = p.w_in + (size_t)l * DM * 4096; ld = 4096; dst = (bf16_t*)(p.ws + OFF_WIN); dld = DM; nkt = 32; }
    else if (mat == 1) { src = p.w_out + (size_t)l * DM * DM; ld = DM; dst = (bf16_t*)(p.ws + OFF_WOUT); dld = DM; nkt = 32; }
    else if (mat == 2) { src = p.w_gate + (size_t)l * DM * DFF; ld = DFF; dst = (bf16_t*)(p.ws + OFF_WGU); dld = DM; nkt = 32; }
    else if (mat == 3) { src = p.w_down + (size_t)l * DFF * DM; ld = DM; dst = (bf16_t*)(p.ws + OFF_WD); dld = DFF; nkt = 88; }
    else { src = p.w_glu + (size_t)l * 512 * 512; ld = 512; dst = (bf16_t*)(p.ws + OFF_WGLU); dld = 512; nkt = 8; }
    const int n0 = (ti / nkt) * 64, k0 = (ti % nkt) * 64;
    {
      const int nn = c.tid & 63, np = n0 + nn; int scol = np;
      if (mat == 0) { if (np < 2048) scol = (np & ~0x30) | ((np & 16) << 1) | ((np & 32) >> 1); }
      else if (mat == 2) { const int pn = np >> 8, bj = (np >> 7) & 1; scol = pn * 128 + (np & 127); if (bj) src = p.w_up + (size_t)l * DM * DFF; }
#pragma unroll
      for (int i = 0; i < 8; ++i) { const int kk = (c.tid >> 6) + 8 * i; lds[kk * 65 + nn] = src[(size_t)(k0 + kk) * ld + scol]; }
    }
    __syncthreads();
    {
      const int nn = c.tid >> 3, kc = (c.tid & 7) * 8;
      float v[8];
#pragma unroll
      for (int i = 0; i < 8; ++i) v[i] = lds[(kc + i) * 65 + nn];
      u32x4 w = {cvtpk(v[0], v[1]), cvtpk(v[2], v[3]), cvtpk(v[4], v[5]), cvtpk(v[6], v[7])};
      *(u32x4*)(dst + (size_t)(n0 + nn) * dld + k0 + kc) = w;
    }
    __syncthreads();
  }
}

__device__ __forceinline__ void fold_four(const Params& p, const Ctx& c, int l, float* lds) {
  float* WlT = lds;
  float* Wc = lds + 128 * 68;
  const float* wcs = (const float*)(p.ws + OFF_WCS) + (size_t)l * 2 * 4 * 128 * 128;
  bf16_t* dstb = (bf16_t*)(p.ws + OFF_WIN);
  for (int u = c.blk; u < 256; u += c.nblk) {
    const int kt = u & 31, cs = (u >> 5) & 1, g = u >> 6, k0 = kt * 64;
    const float* src = p.w_in + (size_t)l * DM * 4096 + 3584 + g * 128;
    for (int i = c.tid; i < 64 * 128; i += NTHREADS) { const int kk = i >> 7, cc = i & 127; WlT[cc * 68 + kk] = src[(size_t)(k0 + kk) * 4096 + cc]; }
    const float* wsrc = wcs + (size_t)(cs * 4 + g) * 128 * 128;
    for (int i = c.tid; i < 128 * 128; i += NTHREADS) Wc[i] = wsrc[i];
    __syncthreads();
    const int kq = c.tid & 15, dq = c.tid >> 4;
    f32x4 acc[4] = {};
    for (int cc = 0; cc < 128; ++cc) {
      const f32x4 a = *(const f32x4*)(WlT + cc * 68 + kq * 4), w = *(const f32x4*)(Wc + cc * 128 + dq * 4);
#pragma unroll
      for (int di = 0; di < 4; ++di) acc[di] += a * w[di];
    }
#pragma unroll
    for (int di = 0; di < 4; ++di) { u32x2 o = {cvtpk(acc[di][0], acc[di][1]), cvtpk(acc[di][2], acc[di][3])};
      *(u32x2*)(dstb + (size_t)(3584 + cs * 512 + g * 128 + dq * 4 + di) * DM + k0 + kq * 4) = o; }
    __syncthreads();
  }
}

__device__ __forceinline__ void phase0a(const Params& p, const Ctx& c, float* lds) {
  for (int i = c.tid; i < 5 * DM; i += NTHREADS) { const float v = i < 4 * DM ? p.c[i] : p.c_ctx[i - 4 * DM]; lds[i] = v * sigmoidf_(v); }
  __syncthreads();
  {
    float* MP = (float*)(p.ws + OFF_MP);
    for (long it = c.gtid; it < 16 * 6144; it += c.nthr) {
      const int cq = (int)(it % 6144), ks = (int)(it / 6144); const int gc = cq * 4, l = gc / NMODC, col = gc % NMODC;
      const float* wp = p.w_mod + ((size_t)l * DM + (size_t)ks * 128) * NMODC + col;
      f32x4 a[5] = {};
#pragma unroll 8
      for (int k = 0; k < 128; ++k) { const f32x4 w = *(const f32x4*)(wp + (size_t)k * NMODC);
#pragma unroll
        for (int v = 0; v < 5; ++v) a[v] += w * lds[v * DM + ks * 128 + k]; }
#pragma unroll
      for (int v = 0; v < 5; ++v) *(f32x4*)(MP + ((size_t)ks * 5 + v) * 24576 + gc) = a[v];
    }
  }
  __syncthreads();
  {
    f32x4* X = (f32x4*)(p.ws + OFF_X);
    for (long i = c.gtid; i < (long)TT * 512; i += c.nthr) { const int r = (int)(i >> 9), c4 = (int)(i & 511), b = r / TPB, t = r % TPB;
      const f32x4* src = t < CTXL ? (const f32x4*)(p.ctx + ((size_t)b * CTXL + t) * DM) : (const f32x4*)(p.x + ((size_t)b * SEQ + (t - CTXL)) * DM);
      X[i] = src[c4]; }
  }
  {
    float* rc = (float*)(p.ws + OFF_ROPE); float* rs = rc + 64 * 32;
    for (long i = c.gtid; i < 64 * 32; i += c.nthr) { const int pos = (int)(i >> 5), pp = (int)(i & 31);
      const float inv = (float)exp2(-(double)pp / 32.0 * 13.287712379549449); float s, cc; my_sincos((float)pos * inv, s, cc); rc[i] = cc; rs[i] = s; }
  }
  {
    bf16_t* DL = (bf16_t*)(p.ws + OFF_DFTL);
    for (long i = c.gtid; i < 2L * 4096 * 512; i += c.nthr) { const int part = (int)(i >> 21), k = (int)((i >> 9) & 4095), t0 = (int)(i & 511) * 8; float v[8];
#pragma unroll
      for (int j = 0; j < 8; ++j) { const float ph = (float)((k * (t0 + j)) & 4095) * (1.f / 4096.f); v[j] = (part ? __builtin_amdgcn_sinf(ph) : __builtin_amdgcn_cosf(ph)) * (1.f / 64.f); }
      u32x4 w = {cvtpk(v[0], v[1]), cvtpk(v[2], v[3]), cvtpk(v[4], v[5]), cvtpk(v[6], v[7])}; *(u32x4*)(DL + i * 8) = w; }
    bf16_t* DC = (bf16_t*)(p.ws + OFF_DFTC);
    for (long i = c.gtid; i < 2L * 256 * 32; i += c.nthr) { const int part = (int)(i >> 13), k = (int)((i >> 5) & 255), t0 = (int)(i & 31) * 8; float v[8];
#pragma unroll
      for (int j = 0; j < 8; ++j) { const float ph = (float)((k * (t0 + j)) & 255) * (1.f / 256.f); v[j] = (part ? __builtin_amdgcn_sinf(ph) : __builtin_amdgcn_cosf(ph)) * (1.f / 16.f); }
      u32x4 w = {cvtpk(v[0], v[1]), cvtpk(v[2], v[3]), cvtpk(v[4], v[5]), cvtpk(v[6], v[7])}; *(u32x4*)(DC + i * 8) = w; }
  }
  {
    float* W = (float*)(p.ws + OFF_WCS);
    for (long i = c.gtid; i < 2L * 2 * 4 * 128 * 128; i += c.nthr) { const int d = (int)(i & 127), cc = (int)((i >> 7) & 127), g = (int)((i >> 14) & 3), cs = (int)((i >> 16) & 1), l = (int)(i >> 17);
      const float* wf = p.w_four + ((size_t)(l * 4 + g) * 128) * 128 + d; float a = 0.f;
      for (int j = 0; j < 128; ++j) { const float ph = (float)((j * cc) & 127) * (1.f / 128.f); a += (cs ? __builtin_amdgcn_sinf(ph) : __builtin_amdgcn_cosf(ph)) * wf[(size_t)j * 128]; }
      W[i] = a * 0.08838834764831845f; }
  }
}

__device__ __forceinline__ void reduce_mod(const Params& p, const Ctx& c) {
  const float* MP = (const float*)(p.ws + OFF_MP); float* MOD = (float*)(p.ws + OFF_MOD);
  for (long o = c.gtid; o < 5L * 24576; o += c.nthr) { const int v = (int)(o / 24576), gc = (int)(o % 24576), l = gc / NMODC, col = gc % NMODC;
    float a = p.b_mod[gc];
#pragma unroll
    for (int ks = 0; ks < 16; ++ks) a += MP[((size_t)ks * 5 + v) * 24576 + gc];
    MOD[(size_t)(l * 5 + v) * NMODC + col] = a; }
}

__device__ __forceinline__ void prenorm_row(const f32x4 (&x)[8], float rinv, const float* g, const float* sc, const float* sh, bf16_t* dst, int lane) {
#pragma unroll
  for (int i = 0; i < 8; ++i) { const int col = (lane + 64 * i) * 4; const f32x4 gg = *(const f32x4*)(g + col), s1 = *(const f32x4*)(sc + col), s0 = *(const f32x4*)(sh + col);
    const f32x4 y = (x[i] * rinv * gg) * (s1 + 1.f) + s0; u32x2 o = {cvtpk(y[0], y[1]), cvtpk(y[2], y[3])}; *(u32x2*)(dst + col) = o; }
}
__device__ __forceinline__ float sumsq8(const f32x4 (&x)[8]) { float s = 0.f;
#pragma unroll
  for (int i = 0; i < 8; ++i) s += x[i][0] * x[i][0] + x[i][1] * x[i][1] + x[i][2] * x[i][2] + x[i][3] * x[i][3];
  return wave_sum(s); }

__device__ __forceinline__ void phase_prenorm(const Params& p, const Ctx& c, int l) {
  const float* X = (const float*)(p.ws + OFF_X); bf16_t* Hn = (bf16_t*)(p.ws + OFF_HN);
  for (int row = c.gwave; row < TT; row += c.nwave) { const int b = row / TPB, t = row % TPB, v = t < CTXL ? 4 : b;
    f32x4 x[8]; const f32x4* xr = (const f32x4*)(X + (size_t)row * DM);
#pragma unroll
    for (int i = 0; i < 8; ++i) x[i] = xr[c.lane + 64 * i];
    const float rinv = rsqrtf(sumsq8(x) * (1.f / DM) + 1e-6f);
    prenorm_row(x, rinv, p.g_mix_pre + (size_t)l * DM, modp(p, l, v, 1), modp(p, l, v, 0), Hn + (size_t)row * DM, c.lane); }
}
__device__ __forceinline__ void phase_postmix(const Params& p, const Ctx& c, int l, bool last) {
  float* X = (float*)(p.ws + OFF_X); const float* MIX = (const float*)(p.ws + OFF_Z1); bf16_t* Hn = (bf16_t*)(p.ws + OFF_HN);
  for (int row = c.gwave; row < TT; row += c.nwave) { const int b = row / TPB, t = row % TPB, v = t < CTXL ? 4 : b; if (last && t < CTXL) continue;
    f32x4 m[8], x[8]; const f32x4* mr = (const f32x4*)(MIX + (size_t)row * DM); f32x4* xr = (f32x4*)(X + (size_t)row * DM);
#pragma unroll
    for (int i = 0; i < 8; ++i) { m[i] = mr[c.lane + 64 * i]; x[i] = xr[c.lane + 64 * i]; }
    const float r1 = rsqrtf(sumsq8(m) * (1.f / DM) + 1e-6f); const float* gp = p.g_mix_post + (size_t)l * DM; const float* m2 = modp(p, l, v, 2);
#pragma unroll
    for (int i = 0; i < 8; ++i) { const int col = (c.lane + 64 * i) * 4; x[i] += *(const f32x4*)(m2 + col) * (m[i] * r1 * *(const f32x4*)(gp + col)); xr[c.lane + 64 * i] = x[i]; }
    const float r2 = rsqrtf(sumsq8(x) * (1.f / DM) + 1e-6f);
    prenorm_row(x, r2, p.g_ffn_pre + (size_t)l * DM, modp(p, l, v, 4), modp(p, l, v, 3), Hn + (size_t)row * DM, c.lane); }
}
__device__ __forceinline__ void phase_postffn(const Params& p, const Ctx& c, int l, bool last) {
  float* X = (float*)(p.ws + OFF_X); const float* F = (const float*)(p.ws + OFF_Z1); bf16_t* Hn = (bf16_t*)(p.ws + OFF_HN);
  for (int row = c.gwave; row < TT; row += c.nwave) { const int b = row / TPB, t = row % TPB, v = t < CTXL ? 4 : b; if (last && t < CTXL) continue;
    f32x4 m[8], x[8]; const f32x4* mr = (const f32x4*)(F + (size_t)row * DM); f32x4* xr = (f32x4*)(X + (size_t)row * DM);
#pragma unroll
    for (int i = 0; i < 8; ++i) { m[i] = mr[c.lane + 64 * i]; x[i] = xr[c.lane + 64 * i]; }
    const float r1 = rsqrtf(sumsq8(m) * (1.f / DM) + 1e-6f); const float* gp = p.g_ffn_post + (size_t)l * DM; const float* m5 = modp(p, l, v, 5);
#pragma unroll
    for (int i = 0; i < 8; ++i) { const int col = (c.lane + 64 * i) * 4; x[i] += *(const f32x4*)(m5 + col) * (m[i] * r1 * *(const f32x4*)(gp + col)); }
    if (last) { f32x4* o = (f32x4*)(p.out + ((size_t)b * SEQ + (t - CTXL)) * DM);
#pragma unroll
      for (int i = 0; i < 8; ++i) o[c.lane + 64 * i] = x[i]; }
    else {
#pragma unroll
      for (int i = 0; i < 8; ++i) xr[c.lane + 64 * i] = x[i];
      const float r2 = rsqrtf(sumsq8(x) * (1.f / DM) + 1e-6f);
      prenorm_row(x, r2, p.g_mix_pre + (size_t)(l + 1) * DM, modp(p, l + 1, v, 1), modp(p, l + 1, v, 0), Hn + (size_t)row * DM, c.lane); } }
}

typedef f32x4 Acc[2][2][4][2];
__device__ __forceinline__ int lat_pm(int i) { return (i >> 4) * 17 + 1 + (i & 15); }

struct SchedMN {
  const char* A; const char* B; size_t strA, strB;
  int nM, nN, pn0, latonly, nextra, blk, nblk;
  __device__ __forceinline__ bool next(int i, gm::Unit& u) const {
    const int it = i * nblk + blk, nmain = nM * nN;
    if (it < nmain) { gm::tile_of(it, nM, nN, u.pm, u.pn); if (latonly) u.pm = lat_pm(u.pm); u.pn += pn0; return true; }
    if (it < nmain + nextra) { const int j = it - nmain; u.pm = (j / 10) * 17; u.pn = 4 + (j % 10); return true; }
    return false;
  }
  __device__ __forceinline__ const char* pA(const gm::Unit& u) const { return A + (size_t)u.pm * strA; }
  __device__ __forceinline__ const char* pB(const gm::Unit& u) const { return B + (size_t)u.pn * strB; }
};

struct EpiIn {
  bf16_t *Qb, *Kb, *Vb; float* U; const float *rc, *rs;
  __device__ __forceinline__ void operator()(const Acc& acc, const gm::Unit& u, int wr, int wc, int fr, int fq) const {
    const int pm = u.pm, pn = u.pn; const bool isctx = (pm % 17) == 0; const int brow = pm * 256;
#pragma unroll
    for (int ai = 0; ai < 2; ++ai)
#pragma unroll
      for (int m = 0; m < 4; ++m) { const int row = brow + ai * 128 + wr * 64 + m * 16 + fr;
        if (pn < 8) { bf16_t* dst = Qb + (size_t)(pn >> 2) * TT * 1024 + (size_t)row * 1024 + (pn & 3) * 256 + wc * 32 + fq * 4;
          f32x4 cs = {1.f, 1.f, 1.f, 1.f}, sn = {0.f, 0.f, 0.f, 0.f};
          if (!isctx) { const int tl = (row % TPB) - CTXL; const int pos = (wc >> 1) ? (tl & 63) : (tl >> 6); const int p0 = (wc & 1) * 16 + fq * 4;
            cs = *(const f32x4*)(rc + pos * 32 + p0); sn = *(const f32x4*)(rs + pos * 32 + p0); }
#pragma unroll
          for (int bj = 0; bj < 2; ++bj) { const f32x4 v1 = acc[ai][bj][m][0], v2 = acc[ai][bj][m][1]; const f32x4 o1 = v1 * cs - v2 * sn, o2 = v2 * cs + v1 * sn;
            u32x2 w1 = {cvtpk(o1[0], o1[1]), cvtpk(o1[2], o1[3])}, w2 = {cvtpk(o2[0], o2[1]), cvtpk(o2[2], o2[3])};
            *(u32x2*)(dst + bj * 128) = w1; *(u32x2*)(dst + bj * 128 + 16) = w2; } }
        else if (pn < 12) { bf16_t* dst = Vb + (size_t)row * 1024 + (pn - 8) * 256 + wc * 32 + fq * 4;
#pragma unroll
          for (int bj = 0; bj < 2; ++bj)
#pragma unroll
            for (int n = 0; n < 2; ++n) { const f32x4 v = acc[ai][bj][m][n]; u32x2 w = {cvtpk(v[0], v[1]), cvtpk(v[2], v[3])}; *(u32x2*)(dst + bj * 128 + n * 16) = w; } }
        else { float* dst = U + (size_t)row * 512 + (pn - 12) * 256 + wc * 32 + fq * 4;
#pragma unroll
          for (int bj = 0; bj < 2; ++bj)
#pragma unroll
            for (int n = 0; n < 2; ++n) *(f32x4*)(dst + bj * 128 + n * 16) = acc[ai][bj][m][n]; } }
  }
};
struct EpiPQ {
  bf16_t *PT;
  __device__ __forceinline__ void operator()(const Acc& acc, const gm::Unit& u, int wr, int wc, int fr, int fq) const {
    const int pm = u.pm, pn = u.pn, b = pm / 17, tt = pm % 17, part = (pn - 14) >> 1; const size_t cb = (size_t)(part * NB + b) * 512 + (pn & 1) * 256;
    const size_t ld = tt == 0 ? 256 : 4096; bf16_t* dstm = PT + (tt == 0 ? (size_t)2 * NB * 512 * 4096 + cb * 256 : cb * 4096 + (size_t)(tt - 1) * 256);
#pragma unroll
    for (int ai = 0; ai < 2; ++ai)
#pragma unroll
      for (int bj = 0; bj < 2; ++bj)
#pragma unroll
        for (int m = 0; m < 4; ++m)
#pragma unroll
          for (int n = 0; n < 2; ++n) { const f32x4 v = acc[ai][bj][m][n]; u32x2 w = {cvtpk(v[0], v[1]), cvtpk(v[2], v[3])};
            *(u32x2*)(dstm + (size_t)(bj * 128 + wc * 32 + n * 16 + fr) * ld + ai * 128 + wr * 64 + m * 16 + fq * 4) = w; }
  }
};
__device__ __forceinline__ void phase_gemm_in(const Params& p, const Ctx& c, int l, LAS unsigned char* lds) {
  SchedMN S; S.A = p.ws + OFF_HN; S.B = p.ws + OFF_WIN; S.strA = (size_t)256 * DM * 2; S.strB = (size_t)256 * DM * 2; S.blk = c.blk; S.nblk = c.nblk;
  S.nM = l == 0 ? 68 : 64; S.latonly = l == 0 ? 0 : 1;
  { S.nN = 14; S.pn0 = 0; S.nextra = l == 0 ? 0 : 40;
    EpiIn E; E.Qb = (bf16_t*)(p.ws + OFF_Z1 + Z1_Q); E.Kb = (bf16_t*)(p.ws + OFF_Z1 + Z1_K); E.Vb = (bf16_t*)(p.ws + OFF_Z1 + Z1_V); E.U = (float*)(p.ws + OFF_Z1 + Z1_U);
    E.rc = (const float*)(p.ws + OFF_ROPE); E.rs = E.rc + 64 * 32;
    gm::gemm_phase<true>(lds, DM, DM, DM, S, E); }
  { S.nN = 4; S.pn0 = 14; S.nextra = 0;
    EpiPQ E; E.PT = (bf16_t*)(p.ws + OFF_Z2 + Z2_CAT);
    gm::gemm_phase<false>(lds, DM, DM, DM, S, E); }
}

template <int LAT> struct SchedFour {
  const bf16_t *DM_, *PT; int blk, nblk;
  __device__ __forceinline__ bool next(int i, gm::Unit& u) const { const int it = i * nblk + blk; if (it >= (LAT ? 256 : 16)) return false; u.pm = it; u.pn = 0; return true; }
  __device__ __forceinline__ const char* pA(const gm::Unit& u) const { const int it = u.pm;
    if (LAT) { const int kt = it & 15, part = (it >> 5) & 1; return (const char*)(DM_ + ((size_t)part * 4096 + kt * 256) * 4096); }
    const int part = (it >> 1) & 1; return (const char*)(DM_ + (size_t)part * 256 * 256); }
  __device__ __forceinline__ const char* pB(const gm::Unit& u) const { const int it = u.pm;
    if (LAT) { const int nt_ = (it >> 4) & 1, part = (it >> 5) & 1, b = it >> 6; return (const char*)(PT + ((size_t)(part * NB + b) * 512 + nt_ * 256) * 4096); }
    const int nt_ = it & 1, part = (it >> 1) & 1, b = it >> 2; return (const char*)(PT + (size_t)2 * NB * 512 * 4096 + ((size_t)(part * NB + b) * 512 + nt_ * 256) * 256); }
};
template <int LAT> struct EpiFour {
  float *FC, *FS;
  __device__ __forceinline__ void operator()(const Acc& acc, const gm::Unit& u, int wr, int wc, int fr, int fq) const { const int it = u.pm; int kt, nt_, part, b, toff;
    if (LAT) { kt = it & 15; nt_ = (it >> 4) & 1; part = (it >> 5) & 1; b = it >> 6; toff = CTXL; } else { kt = 0; nt_ = it & 1; part = (it >> 1) & 1; b = it >> 2; toff = 0; }
    float* dst = FC + (size_t)part * TT * 512 + ((size_t)b * TPB + toff + kt * 256) * 512 + nt_ * 256 + wc * 32 + fq * 4;
#pragma unroll
    for (int ai = 0; ai < 2; ++ai)
#pragma unroll
      for (int m = 0; m < 4; ++m) { float* dr = dst + (size_t)(ai * 128 + wr * 64 + m * 16 + fr) * 512;
#pragma unroll
        for (int bj = 0; bj < 2; ++bj)
#pragma unroll
          for (int n = 0; n < 2; ++n) *(f32x4*)(dr + bj * 128 + n * 16) = acc[ai][bj][m][n]; }
  }
};
__device__ __forceinline__ void phase_fourier(const Params& p, const Ctx& c, int l, LAS unsigned char* lds) {
  const bf16_t* PT = (const bf16_t*)(p.ws + OFF_Z2 + Z2_CAT);
  float* FC = (float*)(p.ws + OFF_Z2 + Z2_FC); float* FS = (float*)(p.ws + OFF_Z2 + Z2_FS);
  { const SchedFour<1> S{(const bf16_t*)(p.ws + OFF_DFTL), PT, c.blk, c.nblk}; const EpiFour<1> E{FC, FS}; gm::gemm_phase<true>(lds, 4096, 4096, 4096, S, E); }
  if (l == 0) { const SchedFour<0> S{(const bf16_t*)(p.ws + OFF_DFTC), PT, c.blk, c.nblk}; const EpiFour<0> E{FC, FS}; gm::gemm_phase<true>(lds, 256, 256, 256, S, E); }
}

struct EpiGlu {
  const bf16_t* Gg; bf16_t* Cat; const float* bg;
  __device__ __forceinline__ void operator()(const Acc& acc, const gm::Unit& u, int wr, int wc, int fr, int fq) const { const int pm = u.pm, pn = u.pn;
#pragma unroll
    for (int ai = 0; ai < 2; ++ai)
#pragma unroll
      for (int m = 0; m < 4; ++m) { const int row = pm * 256 + ai * 128 + wr * 64 + m * 16 + fr;
#pragma unroll
        for (int bj = 0; bj < 2; ++bj)
#pragma unroll
          for (int n = 0; n < 2; ++n) { const int col = pn * 256 + bj * 128 + wc * 32 + n * 16 + fq * 4; const f32x4 z = acc[ai][bj][m][n] + *(const f32x4*)(bg + col);
            const u32x2 gw = *(const u32x2*)(Gg + (size_t)row * 512 + col);
            const float g0 = __uint_as_float(gw[0] << 16), g1 = __uint_as_float(gw[0] & 0xffff0000u), g2 = __uint_as_float(gw[1] << 16), g3 = __uint_as_float(gw[1] & 0xffff0000u);
            u32x2 w = {cvtpk(g0 * sigmoidf_(z[0]), g1 * sigmoidf_(z[1])), cvtpk(g2 * sigmoidf_(z[2]), g3 * sigmoidf_(z[3]))};
            *(u32x2*)(Cat + (size_t)row * DM + 1024 + col) = w; } }
  }
};
__device__ __forceinline__ void phase_glu(const Params& p, const Ctx& c, int l, bool last, LAS unsigned char* lds) {
  SchedMN S; S.A = p.ws + OFF_Z2 + Z2_GG; S.B = p.ws + OFF_WGLU; S.strA = (size_t)256 * 512 * 2; S.strB = (size_t)256 * 512 * 2; S.blk = c.blk; S.nblk = c.nblk;
  S.nM = last ? 64 : 68; S.latonly = last ? 1 : 0; S.nN = 2; S.pn0 = 0; S.nextra = 0;
  EpiGlu E; E.Gg = (const bf16_t*)(p.ws + OFF_Z2 + Z2_GG); E.Cat = (bf16_t*)(p.ws + OFF_Z2 + Z2_CAT); E.bg = p.b_glu + (size_t)l * 512;
  gm::gemm_phase<true>(lds, 512, 512, 512, S, E);
}

struct EpiF32 {
  float* O;
  __device__ __forceinline__ void operator()(const Acc& acc, const gm::Unit& u, int wr, int wc, int fr, int fq) const {
    float* dst = O + (size_t)u.pm * 256 * DM + u.pn * 256 + wc * 32 + fq * 4;
#pragma unroll
    for (int ai = 0; ai < 2; ++ai)
#pragma unroll
      for (int m = 0; m < 4; ++m) { float* dr = dst + (size_t)(ai * 128 + wr * 64 + m * 16 + fr) * DM;
#pragma unroll
        for (int bj = 0; bj < 2; ++bj)
#pragma unroll
          for (int n = 0; n < 2; ++n) *(f32x4*)(dr + bj * 128 + n * 16) = acc[ai][bj][m][n]; }
  }
};
template <int KK>
__device__ __forceinline__ void phase_gemm_f32out(const Params& p, const Ctx& c, bool last, const char* A, const char* W, LAS unsigned char* lds) {
  SchedMN S; S.A = A; S.B = W; S.strA = (size_t)256 * KK * 2; S.strB = (size_t)256 * KK * 2; S.blk = c.blk; S.nblk = c.nblk;
  S.nM = last ? 64 : 68; S.latonly = last ? 1 : 0; S.nN = 8; S.pn0 = 0; S.nextra = 0;
  EpiF32 E; E.O = (float*)(p.ws + OFF_Z1);
  gm::gemm_phase<true>(lds, KK, KK, KK, S, E);
}

struct EpiGU {
  bf16_t* ACT;
  __device__ __forceinline__ void operator()(const Acc& acc, const gm::Unit& u, int wr, int wc, int fr, int fq) const {
    bf16_t* dst = ACT + (size_t)u.pm * 256 * DFF + u.pn * 128 + wc * 32 + fq * 4;
#pragma unroll
    for (int ai = 0; ai < 2; ++ai)
#pragma unroll
      for (int m = 0; m < 4; ++m) { bf16_t* dr = dst + (size_t)(ai * 128 + wr * 64 + m * 16 + fr) * DFF;
#pragma unroll
        for (int n = 0; n < 2; ++n) { const f32x4 g = acc[ai][0][m][n], uu = acc[ai][1][m][n];
          u32x2 w = {cvtpk(g[0] * sigmoidf_(g[0]) * uu[0], g[1] * sigmoidf_(g[1]) * uu[1]), cvtpk(g[2] * sigmoidf_(g[2]) * uu[2], g[3] * sigmoidf_(g[3]) * uu[3])};
          *(u32x2*)(dr + n * 16) = w; } }
  }
};
__device__ __forceinline__ void phase_gemm_gu(const Params& p, const Ctx& c, bool last, LAS unsigned char* lds) {
  SchedMN S; S.A = p.ws + OFF_HN; S.B = p.ws + OFF_WGU; S.strA = (size_t)256 * DM * 2; S.strB = (size_t)256 * DM * 2; S.blk = c.blk; S.nblk = c.nblk;
  S.nM = last ? 64 : 68; S.latonly = last ? 1 : 0; S.nN = 44; S.pn0 = 0; S.nextra = 0;
  EpiGU E; E.ACT = (bf16_t*)(p.ws + OFF_Z2);
  gm::gemm_phase<true>(lds, DM, DM, DM, S, E);
}

__device__ __forceinline__ void phase_attn(const Params& p, const Ctx& c, int l, char* lds) {
  const bf16_t* Qb = (const bf16_t*)(p.ws + OFF_Z1 + Z1_Q); const bf16_t* Kb = (const bf16_t*)(p.ws + OFF_Z1 + Z1_K); const bf16_t* Vb = (const bf16_t*)(p.ws + OFF_Z1 + Z1_V);
  bf16_t* O = (bf16_t*)(p.ws + OFF_HN);
  const int ntot = (l == 0) ? 1024 + 64 : 1024;
  for (int v = c.blk; v < ntot; v += c.nblk) {
    int combo, qb, seq;
    if (v < 1024) { const int rd = v >> 8, w = v & 255; combo = rd * 16 + (w & 7) * 2 + ((w >> 3) >> 4); qb = 1 + ((w >> 3) & 15); seq = TPB; }
    else { combo = v - 1024; qb = 0; seq = CTXL; }
    const int e = combo & 1, mp = (combo >> 1) & 1, h = (combo >> 2) & 3, b = combo >> 4;
    const size_t r0 = (size_t)b * TPB;
    at::body(Qb + (r0 + qb * 256) * 1024 + (h * 2 + mp) * 128, Kb + r0 * 1024 + (h * 2 + mp) * 128, Vb + r0 * 1024 + h * 256 + e * 128,
             O + (r0 + qb * 256) * DM + (h * 2 + mp) * 256 + e * 128, seq, lds);
  }
}

__device__ __forceinline__ int ssm_row(int dir, int s) { return dir == 0 ? s : (s < CTXL ? (CTXL - 1 - s) : (TPB + CTXL - 1 - s)); }
__device__ __forceinline__ void ssm_setup(const Params& p, int l, int dir, int g, int lane, float& ar, float& ai, float (&bbr)[16], float (&bbi)[16]) {
  const int idx = (l * 2 + dir) * 32 + g;
  const float lre = p.ssm_a_re[idx * 64 + lane], lim = p.ssm_a_im[idx * 64 + lane];
  const float dt = expf(p.ssm_log_dt[idx]);
  const float mag = expf(lre * dt); float sn, cs; my_sincos(lim * dt, sn, cs);
  ar = mag * cs; ai = mag * sn;
  const float nr = ar - 1.f, ni = ai, den = 1.f / (lre * lre + lim * lim);
  const float cr = (nr * lre + ni * lim) * den, ci = (ni * lre - nr * lim) * den;
  const f32x4* br = (const f32x4*)(p.ssm_b_re + ((size_t)idx * 64 + lane) * 16); const f32x4* bi = (const f32x4*)(p.ssm_b_im + ((size_t)idx * 64 + lane) * 16);
#pragma unroll
  for (int q = 0; q < 4; ++q) { const f32x4 r = br[q], i = bi[q];
#pragma unroll
    for (int j = 0; j < 4; ++j) { bbr[q * 4 + j] = cr * r[j] - ci * i[j]; bbi[q * 4 + j] = cr * i[j] + ci * r[j]; } }
}
template <int CTRL> __device__ __forceinline__ float dpp_add(float v) { return v + __uint_as_float(__builtin_amdgcn_update_dpp(0u, __float_as_uint(v), CTRL, 0xf, 0xf, false)); }

template <bool PASSC>
__device__ __forceinline__ void phase_ssm(const Params& p, const Ctx& c, int l, bool last, float* lds) {
  const float* U = (const float*)(p.ws + OFF_Z1 + Z1_U);
  float2* S = (float2*)(p.ws + OFF_Z2 + Z2_S);
  float* ul = lds + c.wid * 1024;
  const int nunits = NB * 2 * 32 * 68;
  for (int u = c.gwave; u < nunits; u += c.nwave) {
    const int ch = u % 68, g = (u / 68) & 31, dir = (u / (68 * 32)) & 1, b = u / (68 * 64);
    if (PASSC && last && ch < 4) continue;
    float ar, ai, bbr[16], bbi[16];
    ssm_setup(p, l, dir, g, c.lane, ar, ai, bbr, bbi);
    {
      const int row = b * TPB + ssm_row(dir, ch * 64 + c.lane); const f32x4* src = (const f32x4*)(U + (size_t)row * 512 + g * 16);
#pragma unroll
      for (int q = 0; q < 4; ++q) *(f32x4*)(ul + c.lane * 16 + q * 4) = src[q];
    }
    float hr = 0.f, hi = 0.f;
    if (!PASSC) {
      for (int i = 0; i < 64; ++i) { float bur = 0.f, bui = 0.f;
#pragma unroll
        for (int q = 0; q < 4; ++q) { const f32x4 uu = *(const f32x4*)(ul + i * 16 + q * 4);
#pragma unroll
          for (int j = 0; j < 4; ++j) { bur += bbr[q * 4 + j] * uu[j]; bui += bbi[q * 4 + j] * uu[j]; } }
        const float nhr = ar * hr - ai * hi + bur, nhi = ar * hi + ai * hr + bui; hr = nhr; hi = nhi; }
      S[(size_t)u * 64 + c.lane] = make_float2(hr, hi);
    } else {
      {
        float pr = ar, pi = ai;
#pragma unroll
        for (int k = 0; k < 6; ++k) { const float t = pr * pr - pi * pi; pi = 2.f * pr * pi; pr = t; }
        const float2* Sb = S + (size_t)(u - ch) * 64 + c.lane;
        for (int cc = 0; cc < ch; ++cc) { const float2 s = Sb[(size_t)cc * 64]; const float nhr = pr * hr - pi * hi + s.x, nhi = pr * hi + pi * hr + s.y; hr = nhr; hi = nhi; }
      }
      const int idx = (l * 2 + dir) * 32 + g; float cre[16], cim[16];
#pragma unroll
      for (int h = 0; h < 16; ++h) { cre[h] = p.ssm_c_re[((size_t)idx * 16 + h) * 64 + c.lane]; cim[h] = p.ssm_c_im[((size_t)idx * 16 + h) * 64 + c.lane]; }
      float* Y = (float*)(p.ws + OFF_Z2 + Z2_YF) + (size_t)dir * TT * 512;
      const int rho = c.lane >> 4, hsel = (c.lane & 3) + 4 * (rho & 1) + 8 * (rho >> 1);
      for (int i = 0; i < 64; ++i) { float bur = 0.f, bui = 0.f;
#pragma unroll
        for (int q = 0; q < 4; ++q) { const f32x4 uu = *(const f32x4*)(ul + i * 16 + q * 4);
#pragma unroll
          for (int j = 0; j < 4; ++j) { bur += bbr[q * 4 + j] * uu[j]; bui += bbi[q * 4 + j] * uu[j]; } }
        const float nhr = ar * hr - ai * hi + bur, nhi = ar * hi + ai * hr + bui; hr = nhr; hi = nhi;
        float y[16];
#pragma unroll
        for (int h = 0; h < 16; ++h) y[h] = cre[h] * hr - cim[h] * hi;
        float z[8];
#pragma unroll
        for (int k = 0; k < 8; ++k) { auto rr = __builtin_amdgcn_permlane32_swap(__float_as_uint(y[k]), __float_as_uint(y[k + 8]), false, false); z[k] = __uint_as_float(rr[0]) + __uint_as_float(rr[1]); }
        float w[4];
#pragma unroll
        for (int k = 0; k < 4; ++k) { auto rr = __builtin_amdgcn_permlane16_swap(__float_as_uint(z[k]), __float_as_uint(z[k + 4]), false, false); w[k] = __uint_as_float(rr[0]) + __uint_as_float(rr[1]); }
#pragma unroll
        for (int k = 0; k < 4; ++k) { w[k] = dpp_add<0xB1>(w[k]); w[k] = dpp_add<0x4E>(w[k]); w[k] = dpp_add<0x141>(w[k]); w[k] = dpp_add<0x140>(w[k]); }
        const int k4 = c.lane & 3; const float val = k4 == 0 ? w[0] : k4 == 1 ? w[1] : k4 == 2 ? w[2] : w[3];
        if ((c.lane & 15) < 4) { const int row = b * TPB + ssm_row(dir, ch * 64 + i); Y[(size_t)row * 512 + g * 16 + hsel] = val; }
      }
    }
  }
}

__device__ __forceinline__ void phase_combine(const Params& p, const Ctx& c, int l, bool last) {
  const bf16_t* O = (const bf16_t*)(p.ws + OFF_HN); bf16_t* Cat = (bf16_t*)(p.ws + OFF_Z2 + Z2_CAT); bf16_t* Gg = (bf16_t*)(p.ws + OFF_Z2 + Z2_GG);
  const float* U = (const float*)(p.ws + OFF_Z1 + Z1_U); const float* YF = (const float*)(p.ws + OFF_Z2 + Z2_YF); const float* YR = (const float*)(p.ws + OFF_Z2 + Z2_YR);
  const float* FC = (const float*)(p.ws + OFF_Z2 + Z2_FC); const float* FS = (const float*)(p.ws + OFF_Z2 + Z2_FS);
  const float lam_init = 0.8f - 0.6f * expf(-0.3f * (float)l);
  float lam;
  { const float a1 = p.lam_q1[l * 128 + c.lane] * p.lam_k1[l * 128 + c.lane] + p.lam_q1[l * 128 + 64 + c.lane] * p.lam_k1[l * 128 + 64 + c.lane];
    const float a2 = p.lam_q2[l * 128 + c.lane] * p.lam_k2[l * 128 + c.lane] + p.lam_q2[l * 128 + 64 + c.lane] * p.lam_k2[l * 128 + 64 + c.lane];
    lam = expf(wave_sum(a1)) - expf(wave_sum(a2)) + lam_init; }
  const f32x4 gs = *(const f32x4*)(p.g_subln + (size_t)l * 256 + c.lane * 4);
  for (int row = c.gwave; row < TT; row += c.nwave) { const int t = row % TPB; if (last && t < CTXL) continue;
    const bf16_t* orow = O + (size_t)row * DM; bf16_t* crow_ = Cat + (size_t)row * DM;
#pragma unroll
    for (int h = 0; h < 4; ++h) { const u32x2 a = *(const u32x2*)(orow + (h * 2) * 256 + c.lane * 4), bq = *(const u32x2*)(orow + (h * 2 + 1) * 256 + c.lane * 4);
      f32x4 o; o[0] = __uint_as_float(a[0] << 16) - lam * __uint_as_float(bq[0] << 16); o[1] = __uint_as_float(a[0] & 0xffff0000u) - lam * __uint_as_float(bq[0] & 0xffff0000u);
      o[2] = __uint_as_float(a[1] << 16) - lam * __uint_as_float(bq[1] << 16); o[3] = __uint_as_float(a[1] & 0xffff0000u) - lam * __uint_as_float(bq[1] & 0xffff0000u);
      const float ss = wave_sum(o[0] * o[0] + o[1] * o[1] + o[2] * o[2] + o[3] * o[3]); const float r = rsqrtf(ss * (1.f / 256.f) + 1e-5f) * (1.f - lam_init);
      o = o * r * gs; u32x2 w = {cvtpk(o[0], o[1]), cvtpk(o[2], o[3])}; *(u32x2*)(crow_ + h * 256 + c.lane * 4) = w; }
#pragma unroll
    for (int q = 0; q < 2; ++q) { const int col = q * 256 + c.lane * 4; const size_t o5 = (size_t)row * 512 + col;
      const f32x4 y = *(const f32x4*)(p.ssm_d + (size_t)l * 512 + col) * *(const f32x4*)(U + o5) + *(const f32x4*)(YF + o5) + *(const f32x4*)(YR + o5);
      u32x2 w = {cvtpk(gelu_tanh(y[0]), gelu_tanh(y[1])), cvtpk(gelu_tanh(y[2]), gelu_tanh(y[3]))}; *(u32x2*)(Gg + o5) = w;
      const f32x4 f = *(const f32x4*)(FC + o5) - *(const f32x4*)(FS + o5) + *(const f32x4*)(p.b_four + (size_t)l * 512 + col);
      u32x2 wf = {cvtpk(f[0], f[1]), cvtpk(f[2], f[3])}; *(u32x2*)(crow_ + 1536 + col) = wf; }
  }
}

__global__ void __launch_bounds__(NTHREADS) mega(Params p) {
  extern __shared__ __attribute__((aligned(16))) char shm[];
  cg::grid_group grid = cg::this_grid();
  Ctx c;
#define RECTX() do { int t_ = threadIdx.x; asm volatile("" : "+v"(t_)); int b_ = blockIdx.x; asm volatile("" : "+s"(b_)); \
    c.tid = t_; c.wid = t_ >> 6; c.lane = t_ & 63; c.blk = b_; c.nblk = gridDim.x; c.gwave = c.blk * 8 + c.wid; c.nwave = c.nblk * 8; \
    c.gtid = (long)c.blk * NTHREADS + c.tid; c.nthr = (long)c.nblk * NTHREADS; } while (0)
  RECTX();
  LAS unsigned char* gshm = (LAS unsigned char*)shm; float* fl = (float*)shm;

  phase0a(p, c, fl);
  RECTX(); convert_weights(p, c, 0, fl);
  grid.sync();
  RECTX(); reduce_mod(p, c);
  RECTX(); fold_four(p, c, 0, fl);
  grid.sync();
  RECTX(); phase_prenorm(p, c, 0);
  grid.sync();
  for (int l = 0; l < 2; ++l) {
    const bool last = (l == 1);
    RECTX(); phase_gemm_in(p, c, l, gshm);
    grid.sync();
    RECTX(); phase_fourier(p, c, l, gshm);
    RECTX(); phase_ssm<false>(p, c, l, last, fl);
    grid.sync();
    RECTX(); phase_attn(p, c, l, shm);
    RECTX(); phase_ssm<true>(p, c, l, last, fl);
    grid.sync();
    RECTX(); phase_combine(p, c, l, last);
    grid.sync();
    RECTX(); phase_glu(p, c, l, last, gshm);
    grid.sync();
    RECTX(); phase_gemm_f32out<DM>(p, c, last, p.ws + OFF_Z2 + Z2_CAT, p.ws + OFF_WOUT, gshm);
    grid.sync();
    RECTX(); phase_postmix(p, c, l, last);
    grid.sync();
    RECTX(); phase_gemm_gu(p, c, last, gshm);
    grid.sync();
    RECTX(); phase_gemm_f32out<DFF>(p, c, last, p.ws + OFF_Z2, p.ws + OFF_WD, gshm);
    grid.sync();
    RECTX(); phase_postffn(p, c, l, last);
    if (!last) { RECTX(); convert_weights(p, c, 1, fl); RECTX(); fold_four(p, c, 1, fl); grid.sync(); }
  }
}

extern "C" void kernel_launch(void* const* d_in, const int* in_sizes, int n_in, void* d_out, int out_size, void* d_ws, size_t ws_size,
                              hipStream_t stream) {
  static int grid_blocks = 0;
  if (!grid_blocks) {
    (void)hipFuncSetAttribute((const void*)mega, hipFuncAttributeMaxDynamicSharedMemorySize, SHM_BYTES);
    int dev = 0, cus = 0, per_cu = 0;
    (void)hipGetDevice(&dev);
    (void)hipDeviceGetAttribute(&cus, hipDeviceAttributeMultiprocessorCount, dev);
    (void)hipOccupancyMaxActiveBlocksPerMultiprocessor(&per_cu, mega, NTHREADS, SHM_BYTES);
    if (per_cu < 1) per_cu = 1;
    grid_blocks = cus;
  }
  if (n_in != 32 || ws_size < WS_NEED) { fprintf(stderr, "kernel_launch: bad n_in %d or ws %zu < %zu\n", n_in, ws_size, WS_NEED); return; }
  Params p{};
  const float** f = (const float**)&p;
  for (int i = 0; i < 32; ++i) f[i] = (const float*)d_in[i];
  p.out = (float*)d_out; p.ws = (char*)d_ws;
  void* args[] = {&p};
  hipError_t e = hipLaunchCooperativeKernel((void*)mega, dim3(grid_blocks), dim3(NTHREADS), args, SHM_BYTES, stream);
  if (e != hipSuccess) fprintf(stderr, "cooperative launch failed: %s (grid %d)\n", hipGetErrorString(e), grid_blocks);
}
```

```cpp
#include <hip/hip_runtime.h>
#include <hip/hip_cooperative_groups.h>
#include <cstdio>
#include <cstdint>
namespace cg = cooperative_groups;

typedef unsigned short bf16_t;
using bf16x8 = __attribute__((ext_vector_type(8))) short;
using s16x4  = __attribute__((ext_vector_type(4))) short;
using f32x4  = __attribute__((ext_vector_type(4))) float;
using f32x16 = __attribute__((ext_vector_type(16))) float;
using u32x4  = __attribute__((ext_vector_type(4))) unsigned;
using u32x2  = __attribute__((ext_vector_type(2))) unsigned;
#define LAS __attribute__((address_space(3)))

constexpr int NB = 4, SEQ = 4096, CTXL = 256, TPB = SEQ + CTXL  , TT = NB * TPB  ;
constexpr int DM = 2048, NIN = 4608, DFF = 5632, NMODC = 6 * DM  ;
constexpr int NTHREADS = 512, SHM_BYTES = 131072;

constexpr size_t al256(size_t x) { return (x + 255) / 256 * 256; }
constexpr size_t OFF_X    = 0;
constexpr size_t OFF_WIN  = OFF_X + (size_t)TT * DM * 4;
constexpr size_t OFF_WOUT = OFF_WIN + (size_t)NIN * DM * 2;
constexpr size_t OFF_WGU  = OFF_WOUT + (size_t)DM * DM * 2;
constexpr size_t OFF_WD   = OFF_WGU + (size_t)2 * DFF * DM * 2;
constexpr size_t OFF_WGLU = OFF_WD + (size_t)DM * DFF * 2;
constexpr size_t OFF_DFTL = OFF_WGLU + (size_t)512 * 512 * 2;
constexpr size_t OFF_DFTC = OFF_DFTL + (size_t)2 * 4096 * 4096 * 2;
constexpr size_t OFF_MP   = OFF_DFTC + (size_t)2 * 256 * 256 * 2;
constexpr size_t OFF_MOD  = OFF_MP + (size_t)16 * 5 * 24576 * 4;
constexpr size_t OFF_ROPE = OFF_MOD + (size_t)2 * 5 * NMODC * 4;
constexpr size_t OFF_WCS  = OFF_ROPE + (size_t)2 * 64 * 32 * 4;
constexpr size_t OFF_PW   = OFF_WCS + (size_t)2 * 2 * 4 * 128 * 128 * 4;
constexpr size_t OFF_BB   = OFF_PW + (size_t)2 * 32 * 2 * 33 * 64 * 8;
constexpr size_t OFF_MK   = OFF_BB + (size_t)2 * 32 * 2 * 64 * 16 * 8;
constexpr size_t OFF_TF   = OFF_MK + (size_t)2 * 32 * 2 * 32 * 256 * 4;
constexpr size_t OFF_EM   = OFF_TF + (size_t)32 * 512 * 768 * 2;
constexpr size_t OFF_HN   = OFF_EM + (size_t)32 * 256 * 512 * 2;
constexpr size_t OFF_Z1   = OFF_HN + (size_t)TT * DM * 2;
constexpr size_t Z1_Q = 0, Z1_K = (size_t)TT * 1024 * 2, Z1_V = 2 * Z1_K;
constexpr size_t OFF_Z2   = OFF_Z1 + (size_t)TT * DM * 4;
constexpr size_t Z2_FC = 0, Z2_FS = Z2_FC + (size_t)TT * 512 * 4;
constexpr size_t Z2_UG = Z2_FS + (size_t)TT * 512 * 4;
constexpr size_t Z2_SB = Z2_UG + (size_t)32 * 768 * 768 * 2;
constexpr size_t Z2_CAT = Z2_SB + (size_t)32 * 768 * 256 * 4;
constexpr size_t Z2_GG = Z2_CAT + (size_t)TT * DM * 2;
constexpr size_t Z2_END = Z2_GG + (size_t)TT * 512 * 2;
constexpr size_t Z2_SIZE = Z2_END > (size_t)TT * DFF * 2 ? Z2_END : (size_t)TT * DFF * 2;
constexpr size_t WS_NEED = OFF_Z2 + Z2_SIZE;
static_assert(WS_NEED <= (size_t)805306368, "workspace over 768 MiB");


struct Params {
  const float *x, *c, *ctx, *c_ctx, *w_mod, *b_mod, *g_mix_pre, *g_mix_post, *g_ffn_pre, *g_ffn_post, *w_in, *w_out;
  const float *lam_q1, *lam_k1, *lam_q2, *lam_k2, *g_subln, *ssm_a_re, *ssm_a_im, *ssm_log_dt, *ssm_b_re, *ssm_b_im;
  const float *ssm_c_re, *ssm_c_im, *ssm_d, *w_glu, *b_glu, *w_four, *b_four, *w_gate, *w_up, *w_down;
  float* out; char* ws;
};

__device__ __forceinline__ unsigned cvtpk(float lo, float hi) { unsigned r; asm volatile("v_cvt_pk_bf16_f32 %0, %1, %2" : "=v"(r) : "v"(lo), "v"(hi)); return r; }
__device__ __forceinline__ float bf2f(unsigned short b) { return __uint_as_float((unsigned)b << 16); }
__device__ __forceinline__ float wave_sum(float v) {
  v += __shfl_xor(v, 32); v += __shfl_xor(v, 16); v += __shfl_xor(v, 8); v += __shfl_xor(v, 4); v += __shfl_xor(v, 2); v += __shfl_xor(v, 1); return v;
}
__device__ __forceinline__ void my_sincos(float x, float& s, float& c) {
  const double xd = (double)x; const double kd = rint(xd * 0.63661977236758134); const double r = xd - kd * 1.5707963267948966;
  const double r2 = r * r;
  const double sn = r * (1.0 - r2 / 6.0 * (1.0 - r2 / 20.0 * (1.0 - r2 / 42.0 * (1.0 - r2 / 72.0 * (1.0 - r2 / 110.0 * (1.0 - r2 / 156.0))))));
  const double cs = 1.0 - r2 / 2.0 * (1.0 - r2 / 12.0 * (1.0 - r2 / 30.0 * (1.0 - r2 / 56.0 * (1.0 - r2 / 90.0 * (1.0 - r2 / 132.0)))));
  const int q = ((int)kd) & 3;
  const double ss = (q == 0) ? sn : (q == 1) ? cs : (q == 2) ? -sn : -cs;
  const double cc = (q == 0) ? cs : (q == 1) ? -sn : (q == 2) ? -cs : sn;
  s = (float)ss; c = (float)cc;
}
__device__ __forceinline__ float sigmoidf_(float x) { return 1.f / (1.f + __expf(-x)); }
__device__ __forceinline__ float gelu_tanh(float y) { const float u = 0.7978845608028654f * (y + 0.044715f * y * y * y); return y * sigmoidf_(2.f * u); }

namespace gm {
constexpr int BM = 256, BK = 64, HALF = 128, HTB = HALF * BK * 2, NXCD = 8, WGM = 8;
__device__ __forceinline__ int lds_byte(int r, int c) { const int st = (r >> 4) * 2 + (c >> 5), rr = r & 15, cc = c & 31, ob = rr * 64 + cc * 2; return st * 1024 + (ob ^ (((ob >> 9) & 1) << 5)); }
__device__ __forceinline__ void stage_rc(int b, int& R, int& C) { const int st = b / 1024, sb = b % 1024, swz = sb ^ (((sb >> 9) & 1) << 5); R = (st >> 1) * 16 + swz / 64; C = (st & 1) * 32 + (swz % 64) / 2; }
__device__ __forceinline__ void tile_of(int wgid, int nM, int nN, int& pm, int& pn) {
  const int nwg = nM * nN; { const int q = nwg / NXCD, r = nwg % NXCD, xcd = wgid % NXCD, off = wgid / NXCD; wgid = (xcd < r ? xcd * (q + 1) : r * (q + 1) + (xcd - r) * q) + off; }
  const int nig = WGM * nN, gid = wgid / nig, fm = gid * WGM, gsz = (nM - fm) < WGM ? (nM - fm) : WGM;
  pm = fm + ((wgid % nig) % gsz); pn = (wgid % nig) / gsz;
}
struct Unit { int pm, pn; };

template <bool SWAP, class Epi, class Sched>
__device__ __forceinline__ void gemm_phase(LAS unsigned char* lds, const int lda, const int ldb, const int K, const Sched& S, const Epi& E) {
  int tid_ = threadIdx.x; asm volatile("" : "+v"(tid_));
  const int tid = tid_, wid = __builtin_amdgcn_readfirstlane(tid >> 6), lane = tid & 63, wr = wid >> 2, wc = wid & 3, fr = lane & 15, fq = lane >> 4;
  const int nt = K / BK;
  unsigned voffA[2], voffB[2];
#pragma unroll
  for (int i = 0; i < 2; ++i) { int R, C; stage_rc(tid * 16 + i * 8192, R, C); voffA[i] = (unsigned)(R * lda + C) * 2u; voffB[i] = (unsigned)(R * ldb + C) * 2u; }
  const size_t kstep = (size_t)(BK * 2), hstepA = (size_t)HALF * lda * 2, hstepB = (size_t)HALF * ldb * 2;
  const unsigned ldsw = (unsigned)wid * 1024u;
  const int aoff = lds_byte(wr * 64 + fr, fq * 8), boff = lds_byte(wc * 32 + fr, fq * 8);
#define PG8_SA(b, h) (((b) * 2 + (h)) * HTB)
#define PG8_SB(b, h) ((4 + (b) * 2 + (h)) * HTB)
#define PG8_STAGE(bufoff, gbase, voff) do { _Pragma("unroll") for (int _i = 0; _i < 2; ++_i) \
    __builtin_amdgcn_global_load_lds((const unsigned*)((const char*)(gbase) + (voff)[_i]), (LAS unsigned*)(lds + (bufoff) + ldsw + _i * 8192), 16, 0, 0); } while (0)
#define PG8_LDA(dst, b, h) do { _Pragma("unroll") for (int m = 0; m < 4; ++m) _Pragma("unroll") for (int k = 0; k < 2; ++k) dst[m][k] = *(const LAS bf16x8*)(lds + PG8_SA(b, h) + aoff + m * 2048 + k * 1024); } while (0)
#define PG8_LDB(dst, b, h) do { _Pragma("unroll") for (int n = 0; n < 2; ++n) _Pragma("unroll") for (int k = 0; k < 2; ++k) dst[n][k] = *(const LAS bf16x8*)(lds + PG8_SB(b, h) + boff + n * 2048 + k * 1024); } while (0)
#define PG8_MMA(ai, bj, At, Bt) do { __builtin_amdgcn_s_setprio(1); _Pragma("unroll") for (int m = 0; m < 4; ++m) _Pragma("unroll") for (int n = 0; n < 2; ++n) _Pragma("unroll") for (int k = 0; k < 2; ++k) \
    acc[ai][bj][m][n] = SWAP ? __builtin_amdgcn_mfma_f32_16x16x32_bf16(Bt[n][k], At[m][k], acc[ai][bj][m][n], 0, 0, 0) \
                             : __builtin_amdgcn_mfma_f32_16x16x32_bf16(At[m][k], Bt[n][k], acc[ai][bj][m][n], 0, 0, 0); __builtin_amdgcn_s_setprio(0); } while (0)
#define PG8_WAIT_V(n) asm volatile("s_waitcnt vmcnt(" #n ")" ::: "memory")
#define PG8_WAIT_L(n) asm volatile("s_waitcnt lgkmcnt(" #n ")" ::: "memory")
#define PG8_BAR __builtin_amdgcn_s_barrier()
#define PG8_SCHED __builtin_amdgcn_sched_barrier(0)
  Unit cur, nxt; int ui = 0;
  if (!S.next(0, cur)) return;
  f32x4 acc[2][2][4][2];
#pragma unroll
  for (int a = 0; a < 2; ++a)
#pragma unroll
    for (int b = 0; b < 2; ++b)
#pragma unroll
      for (int m = 0; m < 4; ++m)
#pragma unroll
        for (int n = 0; n < 2; ++n) acc[a][b][m][n] = (f32x4){0.f, 0.f, 0.f, 0.f};
  bf16x8 At[4][2], B0[2][2], B1[2][2];
  const char* cA = S.pA(cur); const char* cB = S.pB(cur);
  PG8_STAGE(PG8_SB(0, 0), cB, voffB); PG8_STAGE(PG8_SB(0, 1), cB + hstepB, voffB); PG8_STAGE(PG8_SA(0, 0), cA, voffA); PG8_STAGE(PG8_SA(0, 1), cA + hstepA, voffA);
  if (wr == 1) PG8_BAR;
  PG8_WAIT_V(2); PG8_BAR;
  PG8_STAGE(PG8_SB(1, 0), cB + kstep, voffB); PG8_STAGE(PG8_SA(1, 0), cA + kstep, voffA); PG8_STAGE(PG8_SB(1, 1), cB + hstepB + kstep, voffB);
  PG8_WAIT_V(6); PG8_BAR;
  for (;;) {
    const bool has_next = S.next(ui + 1, nxt);
    const char* nA = has_next ? S.pA(nxt) : cA; const char* nB = has_next ? S.pB(nxt) : cB;
    for (int t = 0; t < nt; t += 2) {
      const bool last = (t == nt - 2);
      const char* a1 = cA + (size_t)(t + 1) * kstep;
      const char* a2 = last ? nA : cA + (size_t)(t + 2) * kstep; const char* b2 = last ? nB : cB + (size_t)(t + 2) * kstep;
      const char* a3 = a2 + kstep; const char* b3 = b2 + kstep;
      PG8_LDB(B0, 0, 0); PG8_LDB(B1, 0, 1); PG8_SCHED; PG8_LDA(At, 0, 0); PG8_STAGE(PG8_SA(1, 1), a1 + hstepA, voffA);
      PG8_WAIT_V(8); PG8_WAIT_L(0); PG8_BAR; PG8_MMA(0, 0, At, B0); PG8_MMA(0, 1, At, B1); PG8_BAR; PG8_SCHED;
      PG8_LDA(At, 0, 1); PG8_STAGE(PG8_SB(0, 0), b2, voffB); PG8_STAGE(PG8_SB(0, 1), b2 + hstepB, voffB); PG8_STAGE(PG8_SA(0, 0), a2, voffA);
      PG8_WAIT_V(8); PG8_WAIT_L(0); PG8_BAR; PG8_MMA(1, 0, At, B0); PG8_MMA(1, 1, At, B1); PG8_BAR; PG8_SCHED;
      PG8_LDB(B0, 1, 0); PG8_LDB(B1, 1, 1); PG8_SCHED; PG8_LDA(At, 1, 0); PG8_STAGE(PG8_SA(0, 1), a2 + hstepA, voffA);
      PG8_WAIT_V(8); PG8_WAIT_L(0); PG8_BAR; PG8_MMA(0, 0, At, B0); PG8_MMA(0, 1, At, B1); PG8_BAR; PG8_SCHED;
      PG8_LDA(At, 1, 1); PG8_STAGE(PG8_SB(1, 0), b3, voffB); PG8_STAGE(PG8_SB(1, 1), b3 + hstepB, voffB); PG8_STAGE(PG8_SA(1, 0), a3, voffA);
      PG8_WAIT_V(8); PG8_WAIT_L(0); PG8_BAR; PG8_MMA(1, 0, At, B0); PG8_MMA(1, 1, At, B1); PG8_BAR; PG8_SCHED;
    }
    if (wr == 0) PG8_BAR;
    { int fr2 = fr, fq2 = fq; asm volatile("" : "+v"(fr2), "+v"(fq2));
      E(acc, cur, wr, wc, fr2, fq2); }
    if (!has_next) break;
#pragma unroll
    for (int a = 0; a < 2; ++a)
#pragma unroll
      for (int b = 0; b < 2; ++b)
#pragma unroll
        for (int m = 0; m < 4; ++m)
#pragma unroll
          for (int n = 0; n < 2; ++n) acc[a][b][m][n] = (f32x4){0.f, 0.f, 0.f, 0.f};
    cur = nxt; cA = nA; cB = nB; ++ui;
    if (wr == 1) PG8_BAR;
  }
  PG8_WAIT_V(0);
  PG8_BAR;
#undef PG8_SA
#undef PG8_SB
#undef PG8_STAGE
#undef PG8_LDA
#undef PG8_LDB
#undef PG8_MMA
#undef PG8_WAIT_V
#undef PG8_WAIT_L
#undef PG8_BAR
#undef PG8_SCHED
}
}

namespace at {
constexpr int D = 128, NW = 8, QBLK = 32, KVBLK = 64;
constexpr float SCALE = 0.088388347648318440f;
constexpr float THR = 8.f;
constexpr int LDQ = 1024, LDK = 1024, LDV = 1024, LDO = 2048;
constexpr size_t SHM_V = KVBLK * D * 2, SHM_K = KVBLK * D * 2;
#define KSWZ(row, colB) ((row) * 256 + ((colB) ^ (((row) & 7) << 4)))
#define SBAR() __builtin_amdgcn_sched_barrier(0)
__device__ __forceinline__ int crow(int r, int hi) { return (r & 3) + 8 * (r >> 2) + 4 * hi; }
__device__ __forceinline__ void partialSM(f32x16& p0, f32x16& p1, float& m_reg, float& mn, float& alpha) {
  constexpr float C = SCALE * 1.4426950408889634f;
  float pmax = p0[0];
#pragma unroll
  for (int r = 1; r < 16; ++r) pmax = fmaxf(pmax, p0[r]);
#pragma unroll
  for (int r = 0; r < 16; ++r) pmax = fmaxf(pmax, p1[r]);
  { auto rr = __builtin_amdgcn_permlane32_swap(__float_as_uint(pmax), __float_as_uint(pmax), false, false);
    pmax = fmaxf(__uint_as_float(rr[0]), __uint_as_float(rr[1])); }
  if (__builtin_expect(__all(pmax - m_reg <= THR / SCALE), 1)) { mn = m_reg; alpha = 1.f; }
  else { mn = fmaxf(m_reg, pmax); alpha = __builtin_amdgcn_exp2f((m_reg - mn) * C); m_reg = mn; }
  float mnC = -mn * C;
#pragma unroll
  for (int r = 0; r < 16; ++r) p0[r] = fmaf(p0[r], C, mnC);
#pragma unroll
  for (int r = 0; r < 16; ++r) p1[r] = fmaf(p1[r], C, mnC);
#pragma unroll
  for (int r = 0; r < 16; ++r) p0[r] = __builtin_amdgcn_exp2f(p0[r]);
}
__device__ __forceinline__ void finishSM(f32x16& p0, f32x16& p1, float alpha, float& l_reg, bf16x8& pa0, bf16x8& pa1, bf16x8& pa2, bf16x8& pa3) {
#pragma unroll
  for (int r = 0; r < 16; ++r) p1[r] = __builtin_amdgcn_exp2f(p1[r]);
  float ps = 0;
#pragma unroll
  for (int r = 0; r < 16; ++r) ps += p0[r];
#pragma unroll
  for (int r = 0; r < 16; ++r) ps += p1[r];
  { auto rr = __builtin_amdgcn_permlane32_swap(__float_as_uint(ps), __float_as_uint(ps), false, false);
    ps = __uint_as_float(rr[0]) + __uint_as_float(rr[1]); }
  l_reg = l_reg * alpha + ps;
#define PK4(P, BASE, OUT) do { unsigned a0 = cvtpk(P[BASE + 0], P[BASE + 1]), a1 = cvtpk(P[BASE + 2], P[BASE + 3]);   \
    unsigned b0 = cvtpk(P[BASE + 4], P[BASE + 5]), b1 = cvtpk(P[BASE + 6], P[BASE + 7]);                              \
    auto r0 = __builtin_amdgcn_permlane32_swap(a0, b0, false, false); auto r1 = __builtin_amdgcn_permlane32_swap(a1, b1, false, false); \
    u32x4 w = {r0[0], r1[0], r0[1], r1[1]}; OUT = *reinterpret_cast<bf16x8*>(&w); } while (0)
  PK4(p0, 0, pa0); PK4(p0, 8, pa1); PK4(p1, 0, pa2); PK4(p1, 8, pa3);
#undef PK4
}
__device__ __forceinline__ void qkt(f32x16& p0, f32x16& p1, const char* Ks, const bf16x8* qr, int r32, int hi) {
  p0 = f32x16{}; p1 = f32x16{};
#pragma unroll
  for (int d0 = 0; d0 < 8; ++d0) { int cb = (d0 * 16 + hi * 8) * 2;
    bf16x8 b0 = *reinterpret_cast<const bf16x8*>(Ks + KSWZ(r32, cb));
    bf16x8 b1 = *reinterpret_cast<const bf16x8*>(Ks + KSWZ(32 + r32, cb));
    p0 = __builtin_amdgcn_mfma_f32_32x32x16_bf16(b0, qr[d0], p0, 0, 0, 0);
    p1 = __builtin_amdgcn_mfma_f32_32x32x16_bf16(b1, qr[d0], p1, 0, 0, 0); }
}
__device__ __forceinline__ int v_st(int k, int c) { const int kk = (k & ~0xC) | ((k & 4) << 1) | ((k & 8) >> 1); return ((kk >> 3) * 4 + (c >> 5)) * 512 + ((kk & 7) * 32 + (c & 31)) * 2; }
__device__ __forceinline__ int v_rd_base(int lane) { return ((lane & 3) << 3) | (((lane >> 2) & 3) << 6) | (((lane >> 4) & 1) << 5) | (((lane >> 5) & 1) << 8); }
constexpr int v_rd_off(int d0, int ks, int half) { return d0 * 512 + ks * 4096 + half * 2048; }
template <int OFF> __device__ __forceinline__ s16x4 tr_read(int vb) {
  s16x4 r; asm volatile("ds_read_b64_tr_b16 %0, %1 offset:%2" : "=&v"(r) : "v"(vb), "i"(OFF) : "memory"); return r;
}
template <int D0> __device__ __forceinline__ void pv_one(f32x16& od, int vb, bf16x8 pa0, bf16x8 pa1, bf16x8 pa2, bf16x8 pa3) {
  const s16x4 l0 = tr_read<v_rd_off(D0, 0, 0)>(vb), h0 = tr_read<v_rd_off(D0, 0, 1)>(vb), l1 = tr_read<v_rd_off(D0, 1, 0)>(vb), h1 = tr_read<v_rd_off(D0, 1, 1)>(vb);
  const s16x4 l2 = tr_read<v_rd_off(D0, 2, 0)>(vb), h2 = tr_read<v_rd_off(D0, 2, 1)>(vb), l3 = tr_read<v_rd_off(D0, 3, 0)>(vb), h3 = tr_read<v_rd_off(D0, 3, 1)>(vb);
  asm volatile("s_waitcnt lgkmcnt(0)" ::: "memory"); SBAR();
#define PK(L, H) (bf16x8){L[0], L[1], L[2], L[3], H[0], H[1], H[2], H[3]}
  od = __builtin_amdgcn_mfma_f32_32x32x16_bf16(pa0, PK(l0, h0), od, 0, 0, 0);
  od = __builtin_amdgcn_mfma_f32_32x32x16_bf16(pa1, PK(l1, h1), od, 0, 0, 0);
  od = __builtin_amdgcn_mfma_f32_32x32x16_bf16(pa2, PK(l2, h2), od, 0, 0, 0);
  od = __builtin_amdgcn_mfma_f32_32x32x16_bf16(pa3, PK(l3, h3), od, 0, 0, 0);
#undef PK
}
__device__ __forceinline__ void pv_d0(f32x16* o, int vb, bf16x8 pa0, bf16x8 pa1, bf16x8 pa2, bf16x8 pa3) {
  pv_one<0>(o[0], vb, pa0, pa1, pa2, pa3); pv_one<1>(o[1], vb, pa0, pa1, pa2, pa3); pv_one<2>(o[2], vb, pa0, pa1, pa2, pa3); pv_one<3>(o[3], vb, pa0, pa1, pa2, pa3);
}
__device__ __forceinline__ void body(const bf16_t* __restrict__ Qb, const bf16_t* __restrict__ Kh, const bf16_t* __restrict__ Vh, bf16_t* __restrict__ Ob, int seq, char* lds) {
  int tid_ = threadIdx.x; asm volatile("" : "+v"(tid_));
  const int tid = tid_, wid = tid >> 6, lane = tid & 63, r32 = lane & 31, hi = lane >> 5;
  char* V_lds = lds; char* K_lds = lds + 2 * SHM_V;
  float* ws = (float*)(lds + 2 * SHM_V + 2 * SHM_K) + wid * 64; float* li_l = ws; float* al_l = ws + 32;
  float m_reg = -1e30f, l_reg = 0; f32x16 o[4] = {}; bf16x8 qr[8];
  const bf16_t* Qw = Qb + (long)(wid * QBLK + r32) * LDQ + hi * 8;
#pragma unroll
  for (int d0 = 0; d0 < 8; ++d0) qr[d0] = *reinterpret_cast<const bf16x8*>(Qw + d0 * 16);
  const int sr = tid >> 4, sc = (tid & 15) * 8, vst0 = v_st(sr, sc), vst1 = v_st(32 + sr, sc);
  const int vb0 = (int)(uintptr_t)(LAS char*)V_lds + v_rd_base(lane);
  bf16x8 sA_vs0, sA_vs1, sA_ks0, sA_ks1, sB_vs0, sB_vs1, sB_ks0, sB_ks1;
#define SLOAD(S, k0) do { S##_vs0 = *reinterpret_cast<const bf16x8*>(&Vh[(long)((k0) + sr) * LDV + sc]); S##_vs1 = *reinterpret_cast<const bf16x8*>(&Vh[(long)((k0) + 32 + sr) * LDV + sc]); \
    S##_ks0 = *reinterpret_cast<const bf16x8*>(&Kh[(long)((k0) + sr) * LDK + sc]); S##_ks1 = *reinterpret_cast<const bf16x8*>(&Kh[(long)((k0) + 32 + sr) * LDK + sc]); } while (0)
#define SWRITE(b, S) do { *(bf16x8*)(V_lds + (b) * SHM_V + vst0) = S##_vs0; *(bf16x8*)(V_lds + (b) * SHM_V + vst1) = S##_vs1; int kc = sc * 2; \
    *(bf16x8*)(K_lds + (b) * SHM_K + KSWZ(sr, kc)) = S##_ks0; *(bf16x8*)(K_lds + (b) * SHM_K + KSWZ(32 + sr, kc)) = S##_ks1; } while (0)
#define SWAIT() asm volatile("s_waitcnt vmcnt(4)" ::: "memory")
#define RESC(a) do { if (__any((a) < 1.f)) { if (hi == 0) al_l[r32] = (a); asm volatile("s_waitcnt lgkmcnt(0)" ::: "memory"); \
    for (int d = 0; d < 4; ++d) for (int r = 0; r < 16; ++r) o[d][r] *= al_l[crow(r, hi)]; } } while (0)
  f32x16 pA0, pA1, pB0, pB1; float mnA, mnB, alA, alB; bf16x8 pa0, pa1, pa2, pa3; const int NT = seq / KVBLK;
  SLOAD(sA, 0); asm volatile("s_waitcnt vmcnt(0)" ::: "memory"); SWRITE(0, sA); __syncthreads();
  qkt(pA0, pA1, K_lds, qr, r32, hi); partialSM(pA0, pA1, m_reg, mnA, alA);
  SLOAD(sB, KVBLK); if (2 < NT) SLOAD(sA, 2 * KVBLK);
  SWAIT(); SWRITE(1, sB); __syncthreads();
  for (int j = 1; j + 1 < NT; j += 2) {
    SBAR(); qkt(pB0, pB1, K_lds + SHM_K, qr, r32, hi);
    finishSM(pA0, pA1, alA, l_reg, pa0, pa1, pa2, pa3); SBAR();
    SLOAD(sB, (j + 2) * KVBLK); SBAR();
    pv_d0(o, vb0, pa0, pa1, pa2, pa3); partialSM(pB0, pB1, m_reg, mnB, alB);
    __syncthreads(); SWAIT(); SWRITE(0, sA);
    RESC(alB); __syncthreads();
    SBAR(); qkt(pA0, pA1, K_lds, qr, r32, hi);
    finishSM(pB0, pB1, alB, l_reg, pa0, pa1, pa2, pa3); SBAR();
    if (j + 3 < NT) SLOAD(sA, (j + 3) * KVBLK); SBAR();
    pv_d0(o, vb0 + (int)SHM_V, pa0, pa1, pa2, pa3); partialSM(pA0, pA1, m_reg, mnA, alA);
    __syncthreads(); SWAIT(); SWRITE(1, sB);
    RESC(alA); __syncthreads();
  }
  SBAR(); qkt(pB0, pB1, K_lds + SHM_K, qr, r32, hi);
  finishSM(pA0, pA1, alA, l_reg, pa0, pa1, pa2, pa3); SBAR();
  pv_d0(o, vb0, pa0, pa1, pa2, pa3); partialSM(pB0, pB1, m_reg, mnB, alB);
  __syncthreads(); RESC(alB);
  finishSM(pB0, pB1, alB, l_reg, pa0, pa1, pa2, pa3); SBAR();
  pv_d0(o, vb0 + (int)SHM_V, pa0, pa1, pa2, pa3);
  if (hi == 0) li_l[r32] = l_reg; asm volatile("s_waitcnt lgkmcnt(0)" ::: "memory");
  float rli[16];
#pragma unroll
  for (int r = 0; r < 16; ++r) rli[r] = __builtin_amdgcn_rcpf(li_l[crow(r, hi)]);
  bf16_t* Ow = Ob + (long)(wid * QBLK) * LDO;
#pragma unroll
  for (int r = 0; r < 16; ++r) { int orow = crow(r, hi);
#pragma unroll
    for (int d0 = 0; d0 < 4; ++d0) Ow[(long)orow * LDO + d0 * 32 + r32] = (bf16_t)(cvtpk(o[d0][r] * rli[r], 0.f) & 0xffff); }
#undef SLOAD
#undef SWRITE
#undef SWAIT
#undef RESC
  __syncthreads();
}
}

struct Ctx {
  int tid, wid, lane, blk, nblk, gwave, nwave; long gtid, nthr;
};

__device__ __forceinline__ const float* modp(const Params& p, int l, int v, int j) { return (const float*)(p.ws + OFF_MOD) + ((size_t)(l * 5 + v) * NMODC + (size_t)j * DM); }

__device__ __forceinline__ void convert_weights(const Params& p, const Ctx& c, int l, float* lds) {
  constexpr int T0 = 56 * 32, T1 = 32 * 32, T2 = 176 * 32, T3 = 32 * 88, T4 = 8 * 8, TALL = T0 + T1 + T2 + T3 + T4;
  for (int it = c.blk; it < TALL; it += c.nblk) {
    int mat, ti = it;
    if (ti < T0) mat = 0; else if ((ti -= T0) < T1) mat = 1; else if ((ti -= T1) < T2) mat = 2; else if ((ti -= T2) < T3) mat = 3; else { ti -= T3; mat = 4; }
    const float* src; long ld; bf16_t* dst; long dld; int nkt;
    if (mat == 0) { src = p.w_in + (size_t)l * DM * 4096; ld = 4096; dst = (bf16_t*)(p.ws + OFF_WIN); dld = DM; nkt = 32; }
    else if (mat == 1) { src = p.w_out + (size_t)l * DM * DM; ld = DM; dst = (bf16_t*)(p.ws + OFF_WOUT); dld = DM; nkt = 32; }
    else if (mat == 2) { src = p.w_gate + (size_t)l * DM * DFF; ld = DFF; dst = (bf16_t*)(p.ws + OFF_WGU); dld = DM; nkt = 32; }
    else if (mat == 3) { src = p.w_down + (size_t)l * DFF * DM; ld = DM; dst = (bf16_t*)(p.ws + OFF_WD); dld = DFF; nkt = 88; }
    else { src = p.w_glu + (size_t)l * 512 * 512; ld = 512; dst = (bf16_t*)(p.ws + OFF_WGLU); dld = 512; nkt = 8; }
    const int n0 = (ti / nkt) * 64, k0 = (ti % nkt) * 64;
    {
      const int nn = c.tid & 63, np = n0 + nn; int scol = np;
      if (mat == 0) { if (np < 2048) scol = (np & ~0x30) | ((np & 16) << 1) | ((np & 32) >> 1); }
      else if (mat == 2) { const int pn = np >> 8, bj = (np >> 7) & 1; scol = pn * 128 + (np & 127); if (bj) src = p.w_up + (size_t)l * DM * DFF; }
#pragma unroll
      for (int i = 0; i < 8; ++i) { const int kk = (c.tid >> 6) + 8 * i; lds[kk * 65 + nn] = src[(size_t)(k0 + kk) * ld + scol]; }
    }
    __syncthreads();
    {
      const int nn = c.tid >> 3, kc = (c.tid & 7) * 8;
      float v[8];
#pragma unroll
      for (int i = 0; i < 8; ++i) v[i] = lds[(kc + i) * 65 + nn];
      u32x4 w = {cvtpk(v[0], v[1]), cvtpk(v[2], v[3]), cvtpk(v[4], v[5]), cvtpk(v[6], v[7])};
      *(u32x4*)(dst + (size_t)(n0 + nn) * dld + k0 + kc) = w;
    }
    __syncthreads();
  }
}

__device__ __forceinline__ void fold_four(const Params& p, const Ctx& c, int l, float* lds) {
  float* WlT = lds;
  float* Wc = lds + 128 * 68;
  const float* wcs = (const float*)(p.ws + OFF_WCS) + (size_t)l * 2 * 4 * 128 * 128;
  bf16_t* dstb = (bf16_t*)(p.ws + OFF_WIN);
  for (int u = c.blk; u < 256; u += c.nblk) {
    const int kt = u & 31, cs = (u >> 5) & 1, g = u >> 6, k0 = kt * 64;
    const float* src = p.w_in + (size_t)l * DM * 4096 + 3584 + g * 128;
    for (int i = c.tid; i < 64 * 128; i += NTHREADS) { const int kk = i >> 7, cc = i & 127; WlT[cc * 68 + kk] = src[(size_t)(k0 + kk) * 4096 + cc]; }
    const float* wsrc = wcs + (size_t)(cs * 4 + g) * 128 * 128;
    for (int i = c.tid; i < 128 * 128; i += NTHREADS) Wc[i] = wsrc[i];
    __syncthreads();
    const int kq = c.tid & 15, dq = c.tid >> 4;
    f32x4 acc[4] = {};
    for (int cc = 0; cc < 128; ++cc) {
      const f32x4 a = *(const f32x4*)(WlT + cc * 68 + kq * 4), w = *(const f32x4*)(Wc + cc * 128 + dq * 4);
#pragma unroll
      for (int di = 0; di < 4; ++di) acc[di] += a * w[di];
    }
#pragma unroll
    for (int di = 0; di < 4; ++di) { u32x2 o = {cvtpk(acc[di][0], acc[di][1]), cvtpk(acc[di][2], acc[di][3])};
      *(u32x2*)(dstb + (size_t)(3584 + cs * 512 + g * 128 + dq * 4 + di) * DM + k0 + kq * 4) = o; }
    __syncthreads();
  }
}


__device__ __forceinline__ void ssm_tables(const Params& p, const Ctx& c) {
  float2* PW = (float2*)(p.ws + OFF_PW); float2* BB = (float2*)(p.ws + OFF_BB);
  for (long i = c.gtid; i < 2L * 32 * 2 * 64; i += c.nthr) { const int pp = (int)(i & 63), idx = (int)(i >> 6);
    const int d = idx & 1, g = (idx >> 1) & 31, l = idx >> 6, iidx = (l * 2 + d) * 32 + g;
    const float lre = p.ssm_a_re[iidx * 64 + pp], lim = p.ssm_a_im[iidx * 64 + pp], dt = expf(p.ssm_log_dt[iidx]);
    float ar = 1.f, ai = 0.f;
    for (int j = 0; j <= 32; ++j) { const float mag = expf(lre * dt * (float)j); float sn, cs; my_sincos(lim * dt * (float)j, sn, cs);
      PW[((size_t)idx * 33 + j) * 64 + pp] = make_float2(mag * cs, mag * sn); if (j == 1) { ar = mag * cs; ai = mag * sn; } }
    const float nr = ar - 1.f, ni = ai, den = 1.f / (lre * lre + lim * lim), cr = (nr * lre + ni * lim) * den, ci = (ni * lre - nr * lim) * den;
    const float* br = p.ssm_b_re + ((size_t)iidx * 64 + pp) * 16; const float* bi = p.ssm_b_im + ((size_t)iidx * 64 + pp) * 16;
    for (int h = 0; h < 16; ++h) BB[((size_t)idx * 64 + pp) * 16 + h] = make_float2(cr * br[h] - ci * bi[h], cr * bi[h] + ci * br[h]); }
}
__device__ __forceinline__ void ssm_build_mef(const Params& p, const Ctx& c, int l) {
  const float2* PW = (const float2*)(p.ws + OFF_PW) + (size_t)l * 32 * 2 * 33 * 64; const float2* BB = (const float2*)(p.ws + OFF_BB) + (size_t)l * 32 * 2 * 64 * 16;
  float* MK = (float*)(p.ws + OFF_MK) + (size_t)l * 32 * 2 * 32 * 256; bf16_t* EM = (bf16_t*)(p.ws + OFF_EM); bf16_t* TF = (bf16_t*)(p.ws + OFF_TF);
  for (long i = c.gtid; i < 32L * 2 * 32 * 256; i += c.nthr) { const int hp = (int)(i & 15), h = (int)((i >> 4) & 15), j = (int)((i >> 8) & 31), gd = (int)(i >> 13), d = gd & 1, g = gd >> 1;
    const size_t ci = ((size_t)((l * 2 + d) * 32 + g) * 16 + h) * 64; const float2* pw = PW + ((size_t)gd * 33 + j) * 64; const float2* bb = BB + (size_t)gd * 64 * 16 + hp; float a = 0.f;
    for (int pp = 0; pp < 64; ++pp) { const float cr = p.ssm_c_re[ci + pp], cim = p.ssm_c_im[ci + pp]; const float2 b = bb[pp * 16], w = pw[pp];
      const float wr = cr * b.x - cim * b.y, wi = cr * b.y + cim * b.x; a += wr * w.x - wi * w.y; }
    MK[i] = a; }
  for (long i = c.gtid; i < 32L * 256 * 32 * 2; i += c.nthr) { const int hh = (int)(i & 1), s = (int)((i >> 1) & 31), n = (int)((i >> 6) & 255), g = (int)(i >> 14), ri = n & 1, pp = (n >> 1) & 63, d = n >> 7;
    const int gd = g * 2 + d, e = d ? s : 31 - s; const float2 w = PW[((size_t)gd * 33 + e) * 64 + pp]; const float2* bb = BB + ((size_t)gd * 64 + pp) * 16 + hh * 8; float v[8];
#pragma unroll
    for (int k = 0; k < 8; ++k) { const float2 b = bb[k]; v[k] = ri ? (w.x * b.y + w.y * b.x) : (w.x * b.x - w.y * b.y); }
    u32x4 o = {cvtpk(v[0], v[1]), cvtpk(v[2], v[3]), cvtpk(v[4], v[5]), cvtpk(v[6], v[7])}; *(u32x4*)(EM + ((size_t)g * 256 + n) * 512 + s * 16 + hh * 8) = o; }
  for (long i = c.gtid; i < 32L * 512 * 2 * 16; i += c.nthr) { const int pq = (int)(i & 15), d = (int)((i >> 4) & 1), n = (int)((i >> 5) & 511), g = (int)(i >> 14), h = n & 15, t = n >> 4;
    const int gd = g * 2 + d, f = d ? 32 - t : t + 1; const size_t ci = ((size_t)((l * 2 + d) * 32 + g) * 16 + h) * 64 + pq * 4; const float2* pw = PW + ((size_t)gd * 33 + f) * 64 + pq * 4; float v[8];
#pragma unroll
    for (int k = 0; k < 4; ++k) { const float cr = p.ssm_c_re[ci + k], cim = p.ssm_c_im[ci + k]; const float2 w = pw[k]; v[2 * k] = cr * w.x - cim * w.y; v[2 * k + 1] = -(cr * w.y + cim * w.x); }
    u32x4 o = {cvtpk(v[0], v[1]), cvtpk(v[2], v[3]), cvtpk(v[4], v[5]), cvtpk(v[6], v[7])}; *(u32x4*)(TF + ((size_t)g * 512 + n) * 768 + 512 + d * 128 + pq * 8) = o; }
}
__device__ __forceinline__ void ssm_build_t(const Params& p, const Ctx& c, int l) {
  const float* MK = (const float*)(p.ws + OFF_MK) + (size_t)l * 32 * 2 * 32 * 256; bf16_t* TF = (bf16_t*)(p.ws + OFF_TF);
  for (long i = c.gtid; i < 32L * 512 * 32 * 2; i += c.nthr) { const int hh = (int)(i & 1), s = (int)((i >> 1) & 31), n = (int)((i >> 6) & 511), g = (int)(i >> 15), h = n & 15, t = n >> 4;
    const int lag = t - s; float v[8];
    if (lag != 0) { const float* m = MK + ((size_t)((g * 2 + (lag < 0 ? 1 : 0)) * 32 + (lag < 0 ? -lag : lag)) * 16 + h) * 16 + hh * 8;
#pragma unroll
      for (int k = 0; k < 8; ++k) v[k] = m[k]; }
    else { const float* m0 = MK + ((size_t)((g * 2) * 32) * 16 + h) * 16 + hh * 8; const float* m1 = MK + ((size_t)((g * 2 + 1) * 32) * 16 + h) * 16 + hh * 8; const float dsk = p.ssm_d[(size_t)l * 512 + g * 16 + h];
#pragma unroll
      for (int k = 0; k < 8; ++k) v[k] = m0[k] + m1[k] + ((hh * 8 + k) == h ? dsk : 0.f); }
    u32x4 o = {cvtpk(v[0], v[1]), cvtpk(v[2], v[3]), cvtpk(v[4], v[5]), cvtpk(v[6], v[7])}; *(u32x4*)(TF + ((size_t)g * 512 + n) * 768 + s * 16 + hh * 8) = o; }
}
__device__ __forceinline__ void ssm_carry(const Params& p, const Ctx& c, int l) {
  if (c.wid != 0) return;
  const float2* PW = (const float2*)(p.ws + OFF_PW) + (size_t)l * 32 * 2 * 33 * 64; const float* SB = (const float*)(p.ws + OFF_Z2 + Z2_SB); bf16_t* UG = (bf16_t*)(p.ws + OFF_Z2 + Z2_UG);
  for (int i = c.blk * 64 + c.lane; i < NB * 32 * 2 * 64; i += c.nblk * 64) { const int pp = i & 63, d = (i >> 6) & 1, g = (i >> 7) & 31, b = i >> 12;
    const float2 a32 = PW[((size_t)(g * 2 + d) * 33 + 32) * 64 + pp]; float hr = 0.f, hi = 0.f;
    const size_t rbase = (size_t)g * 768 + b * 136; const int col = (d * 64 + pp) * 2;
#pragma unroll 8
    for (int k = 0; k < 136; ++k) { const int ch = d == 0 ? k : (k < 8 ? 7 - k : 143 - k);
      const float2 s = *(const float2*)(SB + (rbase + ch) * 256 + col);
      *(unsigned*)(UG + (rbase + ch) * 768 + 512 + col) = cvtpk(hr, hi);
      const float nr = a32.x * hr - a32.y * hi + s.x, ni = a32.x * hi + a32.y * hr + s.y; hr = nr; hi = ni; } }
}

__device__ __forceinline__ void phase0a(const Params& p, const Ctx& c, float* lds) {
  for (int i = c.tid; i < 5 * DM; i += NTHREADS) { const float v = i < 4 * DM ? p.c[i] : p.c_ctx[i - 4 * DM]; lds[i] = v * sigmoidf_(v); }
  __syncthreads();
  {
    float* MP = (float*)(p.ws + OFF_MP);
    for (long it = c.gtid; it < 16 * 6144; it += c.nthr) {
      const int cq = (int)(it % 6144), ks = (int)(it / 6144); const int gc = cq * 4, l = gc / NMODC, col = gc % NMODC;
      const float* wp = p.w_mod + ((size_t)l * DM + (size_t)ks * 128) * NMODC + col;
      f32x4 a[5] = {};
#pragma unroll 8
      for (int k = 0; k < 128; ++k) { const f32x4 w = *(const f32x4*)(wp + (size_t)k * NMODC);
#pragma unroll
        for (int v = 0; v < 5; ++v) a[v] += w * lds[v * DM + ks * 128 + k]; }
#pragma unroll
      for (int v = 0; v < 5; ++v) *(f32x4*)(MP + ((size_t)ks * 5 + v) * 24576 + gc) = a[v];
    }
  }
  __syncthreads();
  {
    f32x4* X = (f32x4*)(p.ws + OFF_X);
    for (long i = c.gtid; i < (long)TT * 512; i += c.nthr) { const int r = (int)(i >> 9), c4 = (int)(i & 511), b = r / TPB, t = r % TPB;
      const f32x4* src = t < CTXL ? (const f32x4*)(p.ctx + ((size_t)b * CTXL + t) * DM) : (const f32x4*)(p.x + ((size_t)b * SEQ + (t - CTXL)) * DM);
      X[i] = src[c4]; }
  }
  {
    float* rc = (float*)(p.ws + OFF_ROPE); float* rs = rc + 64 * 32;
    for (long i = c.gtid; i < 64 * 32; i += c.nthr) { const int pos = (int)(i >> 5), pp = (int)(i & 31);
      const float inv = (float)exp2(-(double)pp / 32.0 * 13.287712379549449); float s, cc; my_sincos((float)pos * inv, s, cc); rc[i] = cc; rs[i] = s; }
  }
  {
    bf16_t* DL = (bf16_t*)(p.ws + OFF_DFTL);
    for (long i = c.gtid; i < 2L * 4096 * 512; i += c.nthr) { const int part = (int)(i >> 21), k = (int)((i >> 9) & 4095), t0 = (int)(i & 511) * 8; float v[8];
#pragma unroll
      for (int j = 0; j < 8; ++j) { const float ph = (float)((k * (t0 + j)) & 4095) * (1.f / 4096.f); v[j] = (part ? __builtin_amdgcn_sinf(ph) : __builtin_amdgcn_cosf(ph)) * (1.f / 64.f); }
      u32x4 w = {cvtpk(v[0], v[1]), cvtpk(v[2], v[3]), cvtpk(v[4], v[5]), cvtpk(v[6], v[7])}; *(u32x4*)(DL + i * 8) = w; }
    bf16_t* DC = (bf16_t*)(p.ws + OFF_DFTC);
    for (long i = c.gtid; i < 2L * 256 * 32; i += c.nthr) { const int part = (int)(i >> 13), k = (int)((i >> 5) & 255), t0 = (int)(i & 31) * 8; float v[8];
#pragma unroll
      for (int j = 0; j < 8; ++j) { const float ph = (float)((k * (t0 + j)) & 255) * (1.f / 256.f); v[j] = (part ? __builtin_amdgcn_sinf(ph) : __builtin_amdgcn_cosf(ph)) * (1.f / 16.f); }
      u32x4 w = {cvtpk(v[0], v[1]), cvtpk(v[2], v[3]), cvtpk(v[4], v[5]), cvtpk(v[6], v[7])}; *(u32x4*)(DC + i * 8) = w; }
  }
  {
    float* W = (float*)(p.ws + OFF_WCS);
    for (long i = c.gtid; i < 2L * 2 * 4 * 128 * 128; i += c.nthr) { const int d = (int)(i & 127), cc = (int)((i >> 7) & 127), g = (int)((i >> 14) & 3), cs = (int)((i >> 16) & 1), l = (int)(i >> 17);
      const float* wf = p.w_four + ((size_t)(l * 4 + g) * 128) * 128 + d; float a = 0.f;
      for (int j = 0; j < 128; ++j) { const float ph = (float)((j * cc) & 127) * (1.f / 128.f); a += (cs ? __builtin_amdgcn_sinf(ph) : __builtin_amdgcn_cosf(ph)) * wf[(size_t)j * 128]; }
      W[i] = a * 0.08838834764831845f; }
  }
}

__device__ __forceinline__ void reduce_mod(const Params& p, const Ctx& c) {
  const float* MP = (const float*)(p.ws + OFF_MP); float* MOD = (float*)(p.ws + OFF_MOD);
  for (long o = c.gtid; o < 5L * 24576; o += c.nthr) { const int v = (int)(o / 24576), gc = (int)(o % 24576), l = gc / NMODC, col = gc % NMODC;
    float a = p.b_mod[gc];
#pragma unroll
    for (int ks = 0; ks < 16; ++ks) a += MP[((size_t)ks * 5 + v) * 24576 + gc];
    MOD[(size_t)(l * 5 + v) * NMODC + col] = a; }
}

__device__ __forceinline__ void prenorm_row(const f32x4 (&x)[8], float rinv, const float* g, const float* sc, const float* sh, bf16_t* dst, int lane) {
#pragma unroll
  for (int i = 0; i < 8; ++i) { const int col = (lane + 64 * i) * 4; const f32x4 gg = *(const f32x4*)(g + col), s1 = *(const f32x4*)(sc + col), s0 = *(const f32x4*)(sh + col);
    const f32x4 y = (x[i] * rinv * gg) * (s1 + 1.f) + s0; u32x2 o = {cvtpk(y[0], y[1]), cvtpk(y[2], y[3])}; *(u32x2*)(dst + col) = o; }
}
__device__ __forceinline__ float sumsq8(const f32x4 (&x)[8]) { float s = 0.f;
#pragma unroll
  for (int i = 0; i < 8; ++i) s += x[i][0] * x[i][0] + x[i][1] * x[i][1] + x[i][2] * x[i][2] + x[i][3] * x[i][3];
  return wave_sum(s); }

__device__ __forceinline__ void phase_prenorm(const Params& p, const Ctx& c, int l) {
  const float* X = (const float*)(p.ws + OFF_X); bf16_t* Hn = (bf16_t*)(p.ws + OFF_HN);
  for (int row = c.gwave; row < TT; row += c.nwave) { const int b = row / TPB, t = row % TPB, v = t < CTXL ? 4 : b;
    f32x4 x[8]; const f32x4* xr = (const f32x4*)(X + (size_t)row * DM);
#pragma unroll
    for (int i = 0; i < 8; ++i) x[i] = xr[c.lane + 64 * i];
    const float rinv = rsqrtf(sumsq8(x) * (1.f / DM) + 1e-6f);
    prenorm_row(x, rinv, p.g_mix_pre + (size_t)l * DM, modp(p, l, v, 1), modp(p, l, v, 0), Hn + (size_t)row * DM, c.lane); }
}
__device__ __forceinline__ void phase_postmix(const Params& p, const Ctx& c, int l, bool last) {
  float* X = (float*)(p.ws + OFF_X); const float* MIX = (const float*)(p.ws + OFF_Z1); bf16_t* Hn = (bf16_t*)(p.ws + OFF_HN);
  for (int row = c.gwave; row < TT; row += c.nwave) { const int b = row / TPB, t = row % TPB, v = t < CTXL ? 4 : b; if (last && t < CTXL) continue;
    f32x4 m[8], x[8]; const f32x4* mr = (const f32x4*)(MIX + (size_t)row * DM); f32x4* xr = (f32x4*)(X + (size_t)row * DM);
#pragma unroll
    for (int i = 0; i < 8; ++i) { m[i] = mr[c.lane + 64 * i]; x[i] = xr[c.lane + 64 * i]; }
    const float r1 = rsqrtf(sumsq8(m) * (1.f / DM) + 1e-6f); const float* gp = p.g_mix_post + (size_t)l * DM; const float* m2 = modp(p, l, v, 2);
#pragma unroll
    for (int i = 0; i < 8; ++i) { const int col = (c.lane + 64 * i) * 4; x[i] += *(const f32x4*)(m2 + col) * (m[i] * r1 * *(const f32x4*)(gp + col)); xr[c.lane + 64 * i] = x[i]; }
    const float r2 = rsqrtf(sumsq8(x) * (1.f / DM) + 1e-6f);
    prenorm_row(x, r2, p.g_ffn_pre + (size_t)l * DM, modp(p, l, v, 4), modp(p, l, v, 3), Hn + (size_t)row * DM, c.lane); }
}
__device__ __forceinline__ void phase_postffn(const Params& p, const Ctx& c, int l, bool last) {
  float* X = (float*)(p.ws + OFF_X); const float* F = (const float*)(p.ws + OFF_Z1); bf16_t* Hn = (bf16_t*)(p.ws + OFF_HN);
  for (int row = c.gwave; row < TT; row += c.nwave) { const int b = row / TPB, t = row % TPB, v = t < CTXL ? 4 : b; if (last && t < CTXL) continue;
    f32x4 m[8], x[8]; const f32x4* mr = (const f32x4*)(F + (size_t)row * DM); f32x4* xr = (f32x4*)(X + (size_t)row * DM);
#pragma unroll
    for (int i = 0; i < 8; ++i) { m[i] = mr[c.lane + 64 * i]; x[i] = xr[c.lane + 64 * i]; }
    const float r1 = rsqrtf(sumsq8(m) * (1.f / DM) + 1e-6f); const float* gp = p.g_ffn_post + (size_t)l * DM; const float* m5 = modp(p, l, v, 5);
#pragma unroll
    for (int i = 0; i < 8; ++i) { const int col = (c.lane + 64 * i) * 4; x[i] += *(const f32x4*)(m5 + col) * (m[i] * r1 * *(const f32x4*)(gp + col)); }
    if (last) { f32x4* o = (f32x4*)(p.out + ((size_t)b * SEQ + (t - CTXL)) * DM);
#pragma unroll
      for (int i = 0; i < 8; ++i) o[c.lane + 64 * i] = x[i]; }
    else {
#pragma unroll
      for (int i = 0; i < 8; ++i) xr[c.lane + 64 * i] = x[i];
      const float r2 = rsqrtf(sumsq8(x) * (1.f / DM) + 1e-6f);
      prenorm_row(x, r2, p.g_mix_pre + (size_t)(l + 1) * DM, modp(p, l + 1, v, 1), modp(p, l + 1, v, 0), Hn + (size_t)row * DM, c.lane); } }
}

typedef f32x4 Acc[2][2][4][2];
__device__ __forceinline__ int lat_pm(int i) { return (i >> 4) * 17 + 1 + (i & 15); }

struct SchedMN {
  const char* A; const char* B; size_t strA, strB;
  int nM, nN, pn0, latonly, nextra, blk, nblk;
  __device__ __forceinline__ bool next(int i, gm::Unit& u) const {
    const int it = i * nblk + blk, nmain = nM * nN;
    if (it < nmain) { gm::tile_of(it, nM, nN, u.pm, u.pn); if (latonly) u.pm = lat_pm(u.pm); u.pn += pn0; return true; }
    if (it < nmain + nextra) { const int j = it - nmain; u.pm = (j / 10) * 17; u.pn = 4 + (j % 10); return true; }
    return false;
  }
  __device__ __forceinline__ const char* pA(const gm::Unit& u) const { return A + (size_t)u.pm * strA; }
  __device__ __forceinline__ const char* pB(const gm::Unit& u) const { return B + (size_t)u.pn * strB; }
};

struct EpiIn {
  bf16_t *Qb, *Kb, *Vb, *UG; const float *rc, *rs;
  __device__ __forceinline__ void operator()(const Acc& acc, const gm::Unit& u, int wr, int wc, int fr, int fq) const {
    const int pm = u.pm, pn = u.pn; const bool isctx = (pm % 17) == 0; const int brow = pm * 256;
#pragma unroll
    for (int ai = 0; ai < 2; ++ai)
#pragma unroll
      for (int m = 0; m < 4; ++m) { const int row = brow + ai * 128 + wr * 64 + m * 16 + fr;
        if (pn < 8) { bf16_t* dst = Qb + (size_t)(pn >> 2) * TT * 1024 + (size_t)row * 1024 + (pn & 3) * 256 + wc * 32 + fq * 4;
          f32x4 cs = {1.f, 1.f, 1.f, 1.f}, sn = {0.f, 0.f, 0.f, 0.f};
          if (!isctx) { const int tl = (row % TPB) - CTXL; const int pos = (wc >> 1) ? (tl & 63) : (tl >> 6); const int p0 = (wc & 1) * 16 + fq * 4;
            cs = *(const f32x4*)(rc + pos * 32 + p0); sn = *(const f32x4*)(rs + pos * 32 + p0); }
#pragma unroll
          for (int bj = 0; bj < 2; ++bj) { const f32x4 v1 = acc[ai][bj][m][0], v2 = acc[ai][bj][m][1]; const f32x4 o1 = v1 * cs - v2 * sn, o2 = v2 * cs + v1 * sn;
            u32x2 w1 = {cvtpk(o1[0], o1[1]), cvtpk(o1[2], o1[3])}, w2 = {cvtpk(o2[0], o2[1]), cvtpk(o2[2], o2[3])};
            *(u32x2*)(dst + bj * 128) = w1; *(u32x2*)(dst + bj * 128 + 16) = w2; } }
        else if (pn < 12) { bf16_t* dst = Vb + (size_t)row * 1024 + (pn - 8) * 256 + wc * 32 + fq * 4;
#pragma unroll
          for (int bj = 0; bj < 2; ++bj)
#pragma unroll
            for (int n = 0; n < 2; ++n) { const f32x4 v = acc[ai][bj][m][n]; u32x2 w = {cvtpk(v[0], v[1]), cvtpk(v[2], v[3])}; *(u32x2*)(dst + bj * 128 + n * 16) = w; } }
        else { const int b = row / TPB, t = row % TPB; bf16_t* dst = UG + ((size_t)(b * 136 + (t >> 5))) * 768 + (t & 31) * 16 + ((fq * 4) & 15);
#pragma unroll
          for (int bj = 0; bj < 2; ++bj)
#pragma unroll
            for (int n = 0; n < 2; ++n) { const int g = ((pn - 12) * 256 + bj * 128 + wc * 32 + n * 16 + fq * 4) >> 4; const f32x4 v = acc[ai][bj][m][n];
              u32x2 w = {cvtpk(v[0], v[1]), cvtpk(v[2], v[3])}; *(u32x2*)(dst + (size_t)g * 768 * 768) = w; } } }
  }
};
struct EpiPQ {
  bf16_t *PT;
  __device__ __forceinline__ void operator()(const Acc& acc, const gm::Unit& u, int wr, int wc, int fr, int fq) const {
    const int pm = u.pm, pn = u.pn, b = pm / 17, tt = pm % 17, part = (pn - 14) >> 1; const size_t cb = (size_t)(part * NB + b) * 512 + (pn & 1) * 256;
    const size_t ld = tt == 0 ? 256 : 4096; bf16_t* dstm = PT + (tt == 0 ? (size_t)2 * NB * 512 * 4096 + cb * 256 : cb * 4096 + (size_t)(tt - 1) * 256);
#pragma unroll
    for (int ai = 0; ai < 2; ++ai)
#pragma unroll
      for (int bj = 0; bj < 2; ++bj)
#pragma unroll
        for (int m = 0; m < 4; ++m)
#pragma unroll
          for (int n = 0; n < 2; ++n) { const f32x4 v = acc[ai][bj][m][n]; u32x2 w = {cvtpk(v[0], v[1]), cvtpk(v[2], v[3])};
            *(u32x2*)(dstm + (size_t)(bj * 128 + wc * 32 + n * 16 + fr) * ld + ai * 128 + wr * 64 + m * 16 + fq * 4) = w; }
  }
};
__device__ __forceinline__ void phase_gemm_in(const Params& p, const Ctx& c, int l, LAS unsigned char* lds) {
  SchedMN S; S.A = p.ws + OFF_HN; S.B = p.ws + OFF_WIN; S.strA = (size_t)256 * DM * 2; S.strB = (size_t)256 * DM * 2; S.blk = c.blk; S.nblk = c.nblk;
  S.nM = l == 0 ? 68 : 64; S.latonly = l == 0 ? 0 : 1;
  { S.nN = 14; S.pn0 = 0; S.nextra = l == 0 ? 0 : 40;
    EpiIn E; E.Qb = (bf16_t*)(p.ws + OFF_Z1 + Z1_Q); E.Kb = (bf16_t*)(p.ws + OFF_Z1 + Z1_K); E.Vb = (bf16_t*)(p.ws + OFF_Z1 + Z1_V); E.UG = (bf16_t*)(p.ws + OFF_Z2 + Z2_UG);
    E.rc = (const float*)(p.ws + OFF_ROPE); E.rs = E.rc + 64 * 32;
    gm::gemm_phase<true>(lds, DM, DM, DM, S, E); }
  { S.nN = 4; S.pn0 = 14; S.nextra = 0;
    EpiPQ E; E.PT = (bf16_t*)(p.ws + OFF_Z2 + Z2_CAT);
    gm::gemm_phase<false>(lds, DM, DM, DM, S, E); }
}

template <int LAT> struct SchedFour {
  const bf16_t *DM_, *PT; int blk, nblk;
  __device__ __forceinline__ bool next(int i, gm::Unit& u) const { const int it = i * nblk + blk; if (it >= (LAT ? 256 : 16)) return false; u.pm = it; u.pn = 0; return true; }
  __device__ __forceinline__ const char* pA(const gm::Unit& u) const { const int it = u.pm;
    if (LAT) { const int kt = it & 15, part = (it >> 5) & 1; return (const char*)(DM_ + ((size_t)part * 4096 + kt * 256) * 4096); }
    const int part = (it >> 1) & 1; return (const char*)(DM_ + (size_t)part * 256 * 256); }
  __device__ __forceinline__ const char* pB(const gm::Unit& u) const { const int it = u.pm;
    if (LAT) { const int nt_ = (it >> 4) & 1, part = (it >> 5) & 1, b = it >> 6; return (const char*)(PT + ((size_t)(part * NB + b) * 512 + nt_ * 256) * 4096); }
    const int nt_ = it & 1, part = (it >> 1) & 1, b = it >> 2; return (const char*)(PT + (size_t)2 * NB * 512 * 4096 + ((size_t)(part * NB + b) * 512 + nt_ * 256) * 256); }
};
template <int LAT> struct EpiFour {
  float *FC, *FS;
  __device__ __forceinline__ void operator()(const Acc& acc, const gm::Unit& u, int wr, int wc, int fr, int fq) const { const int it = u.pm; int kt, nt_, part, b, toff;
    if (LAT) { kt = it & 15; nt_ = (it >> 4) & 1; part = (it >> 5) & 1; b = it >> 6; toff = CTXL; } else { kt = 0; nt_ = it & 1; part = (it >> 1) & 1; b = it >> 2; toff = 0; }
    float* dst = FC + (size_t)part * TT * 512 + ((size_t)b * TPB + toff + kt * 256) * 512 + nt_ * 256 + wc * 32 + fq * 4;
#pragma unroll
    for (int ai = 0; ai < 2; ++ai)
#pragma unroll
      for (int m = 0; m < 4; ++m) { float* dr = dst + (size_t)(ai * 128 + wr * 64 + m * 16 + fr) * 512;
#pragma unroll
        for (int bj = 0; bj < 2; ++bj)
#pragma unroll
          for (int n = 0; n < 2; ++n) *(f32x4*)(dr + bj * 128 + n * 16) = acc[ai][bj][m][n]; }
  }
};
__device__ __forceinline__ void phase_fourier(const Params& p, const Ctx& c, int l, LAS unsigned char* lds) {
  const bf16_t* PT = (const bf16_t*)(p.ws + OFF_Z2 + Z2_CAT);
  float* FC = (float*)(p.ws + OFF_Z2 + Z2_FC); float* FS = (float*)(p.ws + OFF_Z2 + Z2_FS);
  { const SchedFour<1> S{(const bf16_t*)(p.ws + OFF_DFTL), PT, c.blk, c.nblk}; const EpiFour<1> E{FC, FS}; gm::gemm_phase<true>(lds, 4096, 4096, 4096, S, E); }
  if (l == 0) { const SchedFour<0> S{(const bf16_t*)(p.ws + OFF_DFTC), PT, c.blk, c.nblk}; const EpiFour<0> E{FC, FS}; gm::gemm_phase<true>(lds, 256, 256, 256, S, E); }
}

struct SchedSsmS { const char *UG, *EM; int blk, nblk;
  __device__ __forceinline__ bool next(int i, gm::Unit& u) const { const int it = i * nblk + blk; if (it >= 96) return false; u.pm = it; u.pn = 0; return true; }
  __device__ __forceinline__ const char* pA(const gm::Unit& u) const { const int g = u.pm / 3, pm = u.pm % 3; return UG + ((size_t)g * 768 + pm * 256) * 768 * 2; }
  __device__ __forceinline__ const char* pB(const gm::Unit& u) const { const int g = u.pm / 3; return EM + (size_t)g * 256 * 512 * 2; } };
struct EpiSsmS { float* SB;
  __device__ __forceinline__ void operator()(const Acc& acc, const gm::Unit& u, int wr, int wc, int fr, int fq) const { const int g = u.pm / 3, pm = u.pm % 3;
#pragma unroll
    for (int ai = 0; ai < 2; ++ai)
#pragma unroll
      for (int m = 0; m < 4; ++m) { const int r = pm * 256 + ai * 128 + wr * 64 + m * 16 + fr; if (r >= 544) continue; float* dr = SB + ((size_t)g * 768 + r) * 256 + wc * 32 + fq * 4;
#pragma unroll
        for (int bj = 0; bj < 2; ++bj)
#pragma unroll
          for (int n = 0; n < 2; ++n) *(f32x4*)(dr + bj * 128 + n * 16) = acc[ai][bj][m][n]; }
  } };
__device__ __forceinline__ void phase_ssm_states(const Params& p, const Ctx& c, LAS unsigned char* lds) {
  const SchedSsmS S{p.ws + OFF_Z2 + Z2_UG, p.ws + OFF_EM, c.blk, c.nblk}; const EpiSsmS E{(float*)(p.ws + OFF_Z2 + Z2_SB)};
  gm::gemm_phase<true>(lds, 768, 512, 512, S, E);
}
struct SchedSsmY { const char *UG, *TF; int blk, nblk;
  __device__ __forceinline__ bool next(int i, gm::Unit& u) const { const int it = i * nblk + blk; if (it >= 192) return false; u.pm = it >> 1; u.pn = it & 1; return true; }
  __device__ __forceinline__ const char* pA(const gm::Unit& u) const { const int g = u.pm / 3, pm = u.pm % 3; return UG + ((size_t)g * 768 + pm * 256) * 768 * 2; }
  __device__ __forceinline__ const char* pB(const gm::Unit& u) const { const int g = u.pm / 3; return TF + ((size_t)g * 512 + u.pn * 256) * 768 * 2; } };
struct EpiSsmY { bf16_t* Gg; int last;
  __device__ __forceinline__ void operator()(const Acc& acc, const gm::Unit& u, int wr, int wc, int fr, int fq) const { const int g = u.pm / 3, pm = u.pm % 3;
#pragma unroll
    for (int ai = 0; ai < 2; ++ai)
#pragma unroll
      for (int m = 0; m < 4; ++m) { const int r = pm * 256 + ai * 128 + wr * 64 + m * 16 + fr; if (r >= 544) continue; const int b = r / 136, ch = r % 136; if (last && ch < 8) continue;
        bf16_t* dr = Gg + ((size_t)b * TPB + ch * 32) * 512 + g * 16 + ((fq * 4) & 15);
#pragma unroll
        for (int bj = 0; bj < 2; ++bj)
#pragma unroll
          for (int n = 0; n < 2; ++n) { const int t = (u.pn * 256 + bj * 128 + wc * 32 + n * 16 + fq * 4) >> 4; const f32x4 y = acc[ai][bj][m][n];
            u32x2 w = {cvtpk(gelu_tanh(y[0]), gelu_tanh(y[1])), cvtpk(gelu_tanh(y[2]), gelu_tanh(y[3]))}; *(u32x2*)(dr + (size_t)t * 512) = w; } }
  } };
__device__ __forceinline__ void phase_ssm_y(const Params& p, const Ctx& c, bool last, LAS unsigned char* lds) {
  const SchedSsmY S{p.ws + OFF_Z2 + Z2_UG, p.ws + OFF_TF, c.blk, c.nblk}; const EpiSsmY E{(bf16_t*)(p.ws + OFF_Z2 + Z2_GG), last ? 1 : 0};
  gm::gemm_phase<true>(lds, 768, 768, 768, S, E);
}

struct EpiGlu {
  const bf16_t* Gg; bf16_t* Cat; const float* bg;
  __device__ __forceinline__ void operator()(const Acc& acc, const gm::Unit& u, int wr, int wc, int fr, int fq) const { const int pm = u.pm, pn = u.pn;
#pragma unroll
    for (int ai = 0; ai < 2; ++ai)
#pragma unroll
      for (int m = 0; m < 4; ++m) { const int row = pm * 256 + ai * 128 + wr * 64 + m * 16 + fr;
#pragma unroll
        for (int bj = 0; bj < 2; ++bj)
#pragma unroll
          for (int n = 0; n < 2; ++n) { const int col = pn * 256 + bj * 128 + wc * 32 + n * 16 + fq * 4; const f32x4 z = acc[ai][bj][m][n] + *(const f32x4*)(bg + col);
            const u32x2 gw = *(const u32x2*)(Gg + (size_t)row * 512 + col);
            const float g0 = __uint_as_float(gw[0] << 16), g1 = __uint_as_float(gw[0] & 0xffff0000u), g2 = __uint_as_float(gw[1] << 16), g3 = __uint_as_float(gw[1] & 0xffff0000u);
            u32x2 w = {cvtpk(g0 * sigmoidf_(z[0]), g1 * sigmoidf_(z[1])), cvtpk(g2 * sigmoidf_(z[2]), g3 * sigmoidf_(z[3]))};
            *(u32x2*)(Cat + (size_t)row * DM + 1024 + col) = w; } }
  }
};
__device__ __forceinline__ void phase_glu(const Params& p, const Ctx& c, int l, bool last, LAS unsigned char* lds) {
  SchedMN S; S.A = p.ws + OFF_Z2 + Z2_GG; S.B = p.ws + OFF_WGLU; S.strA = (size_t)256 * 512 * 2; S.strB = (size_t)256 * 512 * 2; S.blk = c.blk; S.nblk = c.nblk;
  S.nM = last ? 64 : 68; S.latonly = last ? 1 : 0; S.nN = 2; S.pn0 = 0; S.nextra = 0;
  EpiGlu E; E.Gg = (const bf16_t*)(p.ws + OFF_Z2 + Z2_GG); E.Cat = (bf16_t*)(p.ws + OFF_Z2 + Z2_CAT); E.bg = p.b_glu + (size_t)l * 512;
  gm::gemm_phase<true>(lds, 512, 512, 512, S, E);
}

struct EpiF32 {
  float* O;
  __device__ __forceinline__ void operator()(const Acc& acc, const gm::Unit& u, int wr, int wc, int fr, int fq) const {
    float* dst = O + (size_t)u.pm * 256 * DM + u.pn * 256 + wc * 32 + fq * 4;
#pragma unroll
    for (int ai = 0; ai < 2; ++ai)
#pragma unroll
      for (int m = 0; m < 4; ++m) { float* dr = dst + (size_t)(ai * 128 + wr * 64 + m * 16 + fr) * DM;
#pragma unroll
        for (int bj = 0; bj < 2; ++bj)
#pragma unroll
          for (int n = 0; n < 2; ++n) *(f32x4*)(dr + bj * 128 + n * 16) = acc[ai][bj][m][n]; }
  }
};
template <int KK>
__device__ __forceinline__ void phase_gemm_f32out(const Params& p, const Ctx& c, bool last, const char* A, const char* W, LAS unsigned char* lds) {
  SchedMN S; S.A = A; S.B = W; S.strA = (size_t)256 * KK * 2; S.strB = (size_t)256 * KK * 2; S.blk = c.blk; S.nblk = c.nblk;
  S.nM = last ? 64 : 68; S.latonly = last ? 1 : 0; S.nN = 8; S.pn0 = 0; S.nextra = 0;
  EpiF32 E; E.O = (float*)(p.ws + OFF_Z1);
  gm::gemm_phase<true>(lds, KK, KK, KK, S, E);
}

struct EpiGU {
  bf16_t* ACT;
  __device__ __forceinline__ void operator()(const Acc& acc, const gm::Unit& u, int wr, int wc, int fr, int fq) const {
    bf16_t* dst = ACT + (size_t)u.pm * 256 * DFF + u.pn * 128 + wc * 32 + fq * 4;
#pragma unroll
    for (int ai = 0; ai < 2; ++ai)
#pragma unroll
      for (int m = 0; m < 4; ++m) { bf16_t* dr = dst + (size_t)(ai * 128 + wr * 64 + m * 16 + fr) * DFF;
#pragma unroll
        for (int n = 0; n < 2; ++n) { const f32x4 g = acc[ai][0][m][n], uu = acc[ai][1][m][n];
          u32x2 w = {cvtpk(g[0] * sigmoidf_(g[0]) * uu[0], g[1] * sigmoidf_(g[1]) * uu[1]), cvtpk(g[2] * sigmoidf_(g[2]) * uu[2], g[3] * sigmoidf_(g[3]) * uu[3])};
          *(u32x2*)(dr + n * 16) = w; } }
  }
};
__device__ __forceinline__ void phase_gemm_gu(const Params& p, const Ctx& c, bool last, LAS unsigned char* lds) {
  SchedMN S; S.A = p.ws + OFF_HN; S.B = p.ws + OFF_WGU; S.strA = (size_t)256 * DM * 2; S.strB = (size_t)256 * DM * 2; S.blk = c.blk; S.nblk = c.nblk;
  S.nM = last ? 64 : 68; S.latonly = last ? 1 : 0; S.nN = 44; S.pn0 = 0; S.nextra = 0;
  EpiGU E; E.ACT = (bf16_t*)(p.ws + OFF_Z2);
  gm::gemm_phase<true>(lds, DM, DM, DM, S, E);
}

__device__ __forceinline__ void phase_attn(const Params& p, const Ctx& c, int l, char* lds) {
  const bf16_t* Qb = (const bf16_t*)(p.ws + OFF_Z1 + Z1_Q); const bf16_t* Kb = (const bf16_t*)(p.ws + OFF_Z1 + Z1_K); const bf16_t* Vb = (const bf16_t*)(p.ws + OFF_Z1 + Z1_V);
  bf16_t* O = (bf16_t*)(p.ws + OFF_HN);
  const int ntot = (l == 0) ? 1024 + 64 : 1024;
  for (int v = c.blk; v < ntot; v += c.nblk) {
    int combo, qb, seq;
    if (v < 1024) { const int rd = v >> 8, w = v & 255; combo = rd * 16 + (w & 7) * 2 + ((w >> 3) >> 4); qb = 1 + ((w >> 3) & 15); seq = TPB; }
    else { combo = v - 1024; qb = 0; seq = CTXL; }
    const int e = combo & 1, mp = (combo >> 1) & 1, h = (combo >> 2) & 3, b = combo >> 4;
    const size_t r0 = (size_t)b * TPB;
    at::body(Qb + (r0 + qb * 256) * 1024 + (h * 2 + mp) * 128, Kb + r0 * 1024 + (h * 2 + mp) * 128, Vb + r0 * 1024 + h * 256 + e * 128,
             O + (r0 + qb * 256) * DM + (h * 2 + mp) * 256 + e * 128, seq, lds);
  }
}

__device__ __forceinline__ void phase_combine(const Params& p, const Ctx& c, int l, bool last) {
  const bf16_t* O = (const bf16_t*)(p.ws + OFF_HN); bf16_t* Cat = (bf16_t*)(p.ws + OFF_Z2 + Z2_CAT);
  const float* FC = (const float*)(p.ws + OFF_Z2 + Z2_FC); const float* FS = (const float*)(p.ws + OFF_Z2 + Z2_FS);
  const float lam_init = 0.8f - 0.6f * expf(-0.3f * (float)l);
  float lam;
  { const float a1 = p.lam_q1[l * 128 + c.lane] * p.lam_k1[l * 128 + c.lane] + p.lam_q1[l * 128 + 64 + c.lane] * p.lam_k1[l * 128 + 64 + c.lane];
    const float a2 = p.lam_q2[l * 128 + c.lane] * p.lam_k2[l * 128 + c.lane] + p.lam_q2[l * 128 + 64 + c.lane] * p.lam_k2[l * 128 + 64 + c.lane];
    lam = expf(wave_sum(a1)) - expf(wave_sum(a2)) + lam_init; }
  const f32x4 gs = *(const f32x4*)(p.g_subln + (size_t)l * 256 + c.lane * 4);
  for (int row = c.gwave; row < TT; row += c.nwave) { const int t = row % TPB; if (last && t < CTXL) continue;
    const bf16_t* orow = O + (size_t)row * DM; bf16_t* crow_ = Cat + (size_t)row * DM;
#pragma unroll
    for (int h = 0; h < 4; ++h) { const u32x2 a = *(const u32x2*)(orow + (h * 2) * 256 + c.lane * 4), bq = *(const u32x2*)(orow + (h * 2 + 1) * 256 + c.lane * 4);
      f32x4 o; o[0] = __uint_as_float(a[0] << 16) - lam * __uint_as_float(bq[0] << 16); o[1] = __uint_as_float(a[0] & 0xffff0000u) - lam * __uint_as_float(bq[0] & 0xffff0000u);
      o[2] = __uint_as_float(a[1] << 16) - lam * __uint_as_float(bq[1] << 16); o[3] = __uint_as_float(a[1] & 0xffff0000u) - lam * __uint_as_float(bq[1] & 0xffff0000u);
      const float ss = wave_sum(o[0] * o[0] + o[1] * o[1] + o[2] * o[2] + o[3] * o[3]); const float r = rsqrtf(ss * (1.f / 256.f) + 1e-5f) * (1.f - lam_init);
      o = o * r * gs; u32x2 w = {cvtpk(o[0], o[1]), cvtpk(o[2], o[3])}; *(u32x2*)(crow_ + h * 256 + c.lane * 4) = w; }
#pragma unroll
    for (int q = 0; q < 2; ++q) { const int col = q * 256 + c.lane * 4; const size_t o5 = (size_t)row * 512 + col;
      const f32x4 f = *(const f32x4*)(FC + o5) - *(const f32x4*)(FS + o5) + *(const f32x4*)(p.b_four + (size_t)l * 512 + col);
      u32x2 wf = {cvtpk(f[0], f[1]), cvtpk(f[2], f[3])}; *(u32x2*)(crow_ + 1536 + col) = wf; }
  }
}

__global__ void __launch_bounds__(NTHREADS) mega(Params p) {
  extern __shared__ __attribute__((aligned(16))) char shm[];
  cg::grid_group grid = cg::this_grid();
  Ctx c;
#define RECTX() do { int t_ = threadIdx.x; asm volatile("" : "+v"(t_)); int b_ = blockIdx.x; asm volatile("" : "+s"(b_)); \
    c.tid = t_; c.wid = t_ >> 6; c.lane = t_ & 63; c.blk = b_; c.nblk = gridDim.x; c.gwave = c.blk * 8 + c.wid; c.nwave = c.nblk * 8; \
    c.gtid = (long)c.blk * NTHREADS + c.tid; c.nthr = (long)c.nblk * NTHREADS; } while (0)
  RECTX();
  LAS unsigned char* gshm = (LAS unsigned char*)shm; float* fl = (float*)shm;

  phase0a(p, c, fl);
  RECTX(); ssm_tables(p, c);
  RECTX(); convert_weights(p, c, 0, fl);
  grid.sync();
  RECTX(); reduce_mod(p, c);
  RECTX(); fold_four(p, c, 0, fl);
  RECTX(); ssm_build_mef(p, c, 0);
  grid.sync();
  RECTX(); ssm_build_t(p, c, 0);
  RECTX(); phase_prenorm(p, c, 0);
  grid.sync();
  for (int l = 0; l < 2; ++l) {
    const bool last = (l == 1);
    RECTX(); phase_gemm_in(p, c, l, gshm);
    grid.sync();
    RECTX(); phase_fourier(p, c, l, gshm);
    RECTX(); phase_ssm_states(p, c, gshm);
    grid.sync();
    RECTX(); ssm_carry(p, c, l);
    RECTX(); phase_attn(p, c, l, shm);
    grid.sync();
    RECTX(); phase_ssm_y(p, c, last, gshm);
    RECTX(); phase_combine(p, c, l, last);
    grid.sync();
    RECTX(); phase_glu(p, c, l, last, gshm);
    grid.sync();
    RECTX(); phase_gemm_f32out<DM>(p, c, last, p.ws + OFF_Z2 + Z2_CAT, p.ws + OFF_WOUT, gshm);
    grid.sync();
    if (!last) { RECTX(); ssm_build_mef(p, c, 1); }
    RECTX(); phase_postmix(p, c, l, last);
    grid.sync();
    RECTX(); phase_gemm_gu(p, c, last, gshm);
    grid.sync();
    RECTX(); phase_gemm_f32out<DFF>(p, c, last, p.ws + OFF_Z2, p.ws + OFF_WD, gshm);
    grid.sync();
    if (!last) { RECTX(); ssm_build_t(p, c, 1); }
    RECTX(); phase_postffn(p, c, l, last);
    if (!last) { RECTX(); convert_weights(p, c, 1, fl); RECTX(); fold_four(p, c, 1, fl); grid.sync(); }
  }
}

extern "C" void kernel_launch(void* const* d_in, const int* in_sizes, int n_in, void* d_out, int out_size, void* d_ws, size_t ws_size,
                              hipStream_t stream) {
  static int grid_blocks = 0;
  if (!grid_blocks) {
    (void)hipFuncSetAttribute((const void*)mega, hipFuncAttributeMaxDynamicSharedMemorySize, SHM_BYTES);
    int dev = 0, cus = 0, per_cu = 0;
    (void)hipGetDevice(&dev);
    (void)hipDeviceGetAttribute(&cus, hipDeviceAttributeMultiprocessorCount, dev);
    (void)hipOccupancyMaxActiveBlocksPerMultiprocessor(&per_cu, mega, NTHREADS, SHM_BYTES);
    if (per_cu < 1) per_cu = 1;
    grid_blocks = cus;
  }
  if (n_in != 32 || ws_size < WS_NEED) { fprintf(stderr, "kernel_launch: bad n_in %d or ws %zu < %zu\n", n_in, ws_size, WS_NEED); return; }
  Params p{};
  const float** f = (const float**)&p;
  for (int i = 0; i < 32; ++i) f[i] = (const float*)d_in[i];
  p.out = (float*)d_out; p.ws = (char*)d_ws;
  void* args[] = {&p};
  hipError_t e = hipLaunchCooperativeKernel((void*)mega, dim3(grid_blocks), dim3(NTHREADS), args, SHM_BYTES, stream);
  if (e != hipSuccess) fprintf(stderr, "cooperative launch failed: %s (grid %d)\n", hipGetErrorString(e), grid_blocks);
}
```

```cpp
#include <hip/hip_runtime.h>
#include <hip/hip_cooperative_groups.h>
#include <cstdio>
#include <cstdint>
namespace cg = cooperative_groups;

typedef unsigned short bf16_t;
using bf16x8 = __attribute__((ext_vector_type(8))) short;
using s16x4  = __attribute__((ext_vector_type(4))) short;
using f32x4  = __attribute__((ext_vector_type(4))) float;
using f32x16 = __attribute__((ext_vector_type(16))) float;
using u32x4  = __attribute__((ext_vector_type(4))) unsigned;
using u32x2  = __attribute__((ext_vector_type(2))) unsigned;
#define LAS __attribute__((address_space(3)))

constexpr int NB = 4, SEQ = 4096, CTXL = 256, TPB = SEQ + CTXL  , TT = NB * TPB  ;
constexpr int DM = 2048, NIN = 4608, DFF = 5632, NMODC = 6 * DM  ;
constexpr int NTHREADS = 512, SHM_BYTES = 131072;

constexpr size_t al256(size_t x) { return (x + 255) / 256 * 256; }
constexpr size_t OFF_X    = 0;
constexpr size_t OFF_WIN  = OFF_X + (size_t)TT * DM * 4;
constexpr size_t OFF_WOUT = OFF_WIN + (size_t)NIN * DM * 2;
constexpr size_t OFF_WGU  = OFF_WOUT + (size_t)DM * DM * 2;
constexpr size_t OFF_WD   = OFF_WGU + (size_t)2 * DFF * DM * 2;
constexpr size_t OFF_WGLU = OFF_WD + (size_t)DM * DFF * 2;
constexpr size_t OFF_DFTL = OFF_WGLU + (size_t)512 * 512 * 2;
constexpr size_t OFF_DFTC = OFF_DFTL + (size_t)2 * 4096 * 4096 * 2;
constexpr size_t OFF_MP   = OFF_DFTC + (size_t)2 * 256 * 256 * 2;
constexpr size_t OFF_MOD  = OFF_MP + (size_t)16 * 5 * 24576 * 4;
constexpr size_t OFF_ROPE = OFF_MOD + (size_t)2 * 5 * NMODC * 4;
constexpr size_t OFF_WCS  = OFF_ROPE + (size_t)2 * 64 * 32 * 4;
constexpr size_t OFF_PW   = OFF_WCS + (size_t)2 * 2 * 4 * 128 * 128 * 4;
constexpr size_t OFF_BB   = OFF_PW + (size_t)2 * 32 * 2 * 33 * 64 * 8;
constexpr size_t OFF_MK   = OFF_BB + (size_t)2 * 32 * 2 * 64 * 16 * 8;
constexpr size_t OFF_TF   = OFF_MK + (size_t)2 * 32 * 2 * 32 * 256 * 4;
constexpr size_t OFF_EM   = OFF_TF + (size_t)32 * 512 * 768 * 2;
constexpr size_t OFF_BAR  = OFF_EM + (size_t)32 * 256 * 512 * 2;
constexpr size_t OFF_HN   = OFF_BAR + 16384;
constexpr size_t OFF_Z1   = OFF_HN + (size_t)TT * DM * 2;
constexpr size_t Z1_Q = 0, Z1_K = (size_t)TT * 1024 * 2, Z1_V = 2 * Z1_K;
constexpr size_t OFF_Z2   = OFF_Z1 + (size_t)TT * DM * 4;
constexpr size_t Z2_FC = 0, Z2_FS = Z2_FC + (size_t)TT * 512 * 4;
constexpr size_t Z2_UG = Z2_FS + (size_t)TT * 512 * 4;
constexpr size_t Z2_SB = Z2_UG + (size_t)32 * 768 * 768 * 2;
constexpr size_t Z2_CAT = Z2_SB + (size_t)32 * 768 * 256 * 4;
constexpr size_t Z2_GG = Z2_CAT + (size_t)TT * DM * 2;
constexpr size_t Z2_END = Z2_GG + (size_t)TT * 512 * 2;
constexpr size_t Z2_SIZE = Z2_END > (size_t)TT * DFF * 2 ? Z2_END : (size_t)TT * DFF * 2;
constexpr size_t WS_NEED = OFF_Z2 + Z2_SIZE;
static_assert(WS_NEED <= (size_t)805306368, "workspace over 768 MiB");


struct Params {
  const float *x, *c, *ctx, *c_ctx, *w_mod, *b_mod, *g_mix_pre, *g_mix_post, *g_ffn_pre, *g_ffn_post, *w_in, *w_out;
  const float *lam_q1, *lam_k1, *lam_q2, *lam_k2, *g_subln, *ssm_a_re, *ssm_a_im, *ssm_log_dt, *ssm_b_re, *ssm_b_im;
  const float *ssm_c_re, *ssm_c_im, *ssm_d, *w_glu, *b_glu, *w_four, *b_four, *w_gate, *w_up, *w_down;
  float* out; char* ws;
};

__device__ __forceinline__ unsigned cvtpk(float lo, float hi) { unsigned r; asm volatile("v_cvt_pk_bf16_f32 %0, %1, %2" : "=v"(r) : "v"(lo), "v"(hi)); return r; }
__device__ __forceinline__ float bf2f(unsigned short b) { return __uint_as_float((unsigned)b << 16); }
__device__ __forceinline__ float wave_sum(float v) {
  v += __shfl_xor(v, 32); v += __shfl_xor(v, 16); v += __shfl_xor(v, 8); v += __shfl_xor(v, 4); v += __shfl_xor(v, 2); v += __shfl_xor(v, 1); return v;
}
__device__ __forceinline__ void my_sincos(float x, float& s, float& c) {
  const double xd = (double)x; const double kd = rint(xd * 0.63661977236758134); const double r = xd - kd * 1.5707963267948966;
  const double r2 = r * r;
  const double sn = r * (1.0 - r2 / 6.0 * (1.0 - r2 / 20.0 * (1.0 - r2 / 42.0 * (1.0 - r2 / 72.0 * (1.0 - r2 / 110.0 * (1.0 - r2 / 156.0))))));
  const double cs = 1.0 - r2 / 2.0 * (1.0 - r2 / 12.0 * (1.0 - r2 / 30.0 * (1.0 - r2 / 56.0 * (1.0 - r2 / 90.0 * (1.0 - r2 / 132.0)))));
  const int q = ((int)kd) & 3;
  const double ss = (q == 0) ? sn : (q == 1) ? cs : (q == 2) ? -sn : -cs;
  const double cc = (q == 0) ? cs : (q == 1) ? -sn : (q == 2) ? -cs : sn;
  s = (float)ss; c = (float)cc;
}
__device__ __forceinline__ float sigmoidf_(float x) { return 1.f / (1.f + __expf(-x)); }
__device__ __forceinline__ float gelu_tanh(float y) { const float u = 0.7978845608028654f * (y + 0.044715f * y * y * y); return y * sigmoidf_(2.f * u); }

namespace gm {
constexpr int BM = 256, BK = 64, HALF = 128, HTB = HALF * BK * 2, NXCD = 8, WGM = 8;
__device__ __forceinline__ int lds_byte(int r, int c) { const int st = (r >> 4) * 2 + (c >> 5), rr = r & 15, cc = c & 31, ob = rr * 64 + cc * 2; return st * 1024 + (ob ^ (((ob >> 9) & 1) << 5)); }
__device__ __forceinline__ void stage_rc(int b, int& R, int& C) { const int st = b / 1024, sb = b % 1024, swz = sb ^ (((sb >> 9) & 1) << 5); R = (st >> 1) * 16 + swz / 64; C = (st & 1) * 32 + (swz % 64) / 2; }
__device__ __forceinline__ void tile_of(int wgid, int nM, int nN, int& pm, int& pn) {
  const int nwg = nM * nN; { const int q = nwg / NXCD, r = nwg % NXCD, xcd = wgid % NXCD, off = wgid / NXCD; wgid = (xcd < r ? xcd * (q + 1) : r * (q + 1) + (xcd - r) * q) + off; }
  const int nig = WGM * nN, gid = wgid / nig, fm = gid * WGM, gsz = (nM - fm) < WGM ? (nM - fm) : WGM;
  pm = fm + ((wgid % nig) % gsz); pn = (wgid % nig) / gsz;
}
struct Unit { int pm, pn; };

template <bool SWAP, class Epi, class Sched>
__device__ __forceinline__ void gemm_phase(LAS unsigned char* lds, const int lda, const int ldb, const int K, const Sched& S, const Epi& E) {
  int tid_ = threadIdx.x; asm volatile("" : "+v"(tid_));
  const int tid = tid_, wid = __builtin_amdgcn_readfirstlane(tid >> 6), lane = tid & 63, wr = wid >> 2, wc = wid & 3, fr = lane & 15, fq = lane >> 4;
  const int nt = K / BK;
  unsigned voffA[2], voffB[2];
#pragma unroll
  for (int i = 0; i < 2; ++i) { int R, C; stage_rc(tid * 16 + i * 8192, R, C); voffA[i] = (unsigned)(R * lda + C) * 2u; voffB[i] = (unsigned)(R * ldb + C) * 2u; }
  const size_t kstep = (size_t)(BK * 2), hstepA = (size_t)HALF * lda * 2, hstepB = (size_t)HALF * ldb * 2;
  const unsigned ldsw = (unsigned)wid * 1024u;
  const int aoff = lds_byte(wr * 64 + fr, fq * 8), boff = lds_byte(wc * 32 + fr, fq * 8);
#define PG8_SA(b, h) (((b) * 2 + (h)) * HTB)
#define PG8_SB(b, h) ((4 + (b) * 2 + (h)) * HTB)
#define PG8_STAGE(bufoff, gbase, voff) do { _Pragma("unroll") for (int _i = 0; _i < 2; ++_i) \
    __builtin_amdgcn_global_load_lds((const unsigned*)((const char*)(gbase) + (voff)[_i]), (LAS unsigned*)(lds + (bufoff) + ldsw + _i * 8192), 16, 0, 0); } while (0)
#define PG8_LDA(dst, b, h) do { _Pragma("unroll") for (int m = 0; m < 4; ++m) _Pragma("unroll") for (int k = 0; k < 2; ++k) dst[m][k] = *(const LAS bf16x8*)(lds + PG8_SA(b, h) + aoff + m * 2048 + k * 1024); } while (0)
#define PG8_LDB(dst, b, h) do { _Pragma("unroll") for (int n = 0; n < 2; ++n) _Pragma("unroll") for (int k = 0; k < 2; ++k) dst[n][k] = *(const LAS bf16x8*)(lds + PG8_SB(b, h) + boff + n * 2048 + k * 1024); } while (0)
#define PG8_MMA(ai, bj, At, Bt) do { __builtin_amdgcn_s_setprio(1); _Pragma("unroll") for (int m = 0; m < 4; ++m) _Pragma("unroll") for (int n = 0; n < 2; ++n) _Pragma("unroll") for (int k = 0; k < 2; ++k) \
    acc[ai][bj][m][n] = SWAP ? __builtin_amdgcn_mfma_f32_16x16x32_bf16(Bt[n][k], At[m][k], acc[ai][bj][m][n], 0, 0, 0) \
                             : __builtin_amdgcn_mfma_f32_16x16x32_bf16(At[m][k], Bt[n][k], acc[ai][bj][m][n], 0, 0, 0); __builtin_amdgcn_s_setprio(0); } while (0)
#define PG8_WAIT_V(n) asm volatile("s_waitcnt vmcnt(" #n ")" ::: "memory")
#define PG8_WAIT_L(n) asm volatile("s_waitcnt lgkmcnt(" #n ")" ::: "memory")
#define PG8_BAR __builtin_amdgcn_s_barrier()
#define PG8_SCHED __builtin_amdgcn_sched_barrier(0)
  Unit cur, nxt; int ui = 0;
  if (!S.next(0, cur)) return;
  f32x4 acc[2][2][4][2];
#pragma unroll
  for (int a = 0; a < 2; ++a)
#pragma unroll
    for (int b = 0; b < 2; ++b)
#pragma unroll
      for (int m = 0; m < 4; ++m)
#pragma unroll
        for (int n = 0; n < 2; ++n) acc[a][b][m][n] = (f32x4){0.f, 0.f, 0.f, 0.f};
  bf16x8 At[4][2], B0[2][2], B1[2][2];
  const char* cA = S.pA(cur); const char* cB = S.pB(cur);
  PG8_STAGE(PG8_SB(0, 0), cB, voffB); PG8_STAGE(PG8_SB(0, 1), cB + hstepB, voffB); PG8_STAGE(PG8_SA(0, 0), cA, voffA); PG8_STAGE(PG8_SA(0, 1), cA + hstepA, voffA);
  if (wr == 1) PG8_BAR;
  PG8_WAIT_V(2); PG8_BAR;
  PG8_STAGE(PG8_SB(1, 0), cB + kstep, voffB); PG8_STAGE(PG8_SA(1, 0), cA + kstep, voffA); PG8_STAGE(PG8_SB(1, 1), cB + hstepB + kstep, voffB);
  PG8_WAIT_V(6); PG8_BAR;
  for (;;) {
    const bool has_next = S.next(ui + 1, nxt);
    const char* nA = has_next ? S.pA(nxt) : cA; const char* nB = has_next ? S.pB(nxt) : cB;
    for (int t = 0; t < nt; t += 2) {
      const bool last = (t == nt - 2);
      const char* a1 = cA + (size_t)(t + 1) * kstep;
      const char* a2 = last ? nA : cA + (size_t)(t + 2) * kstep; const char* b2 = last ? nB : cB + (size_t)(t + 2) * kstep;
      const char* a3 = a2 + kstep; const char* b3 = b2 + kstep;
      PG8_LDB(B0, 0, 0); PG8_LDB(B1, 0, 1); PG8_SCHED; PG8_LDA(At, 0, 0); PG8_STAGE(PG8_SA(1, 1), a1 + hstepA, voffA);
      PG8_WAIT_V(8); PG8_WAIT_L(0); PG8_BAR; PG8_MMA(0, 0, At, B0); PG8_MMA(0, 1, At, B1); PG8_BAR; PG8_SCHED;
      PG8_LDA(At, 0, 1); PG8_STAGE(PG8_SB(0, 0), b2, voffB); PG8_STAGE(PG8_SB(0, 1), b2 + hstepB, voffB); PG8_STAGE(PG8_SA(0, 0), a2, voffA);
      PG8_WAIT_V(8); PG8_WAIT_L(0); PG8_BAR; PG8_MMA(1, 0, At, B0); PG8_MMA(1, 1, At, B1); PG8_BAR; PG8_SCHED;
      PG8_LDB(B0, 1, 0); PG8_LDB(B1, 1, 1); PG8_SCHED; PG8_LDA(At, 1, 0); PG8_STAGE(PG8_SA(0, 1), a2 + hstepA, voffA);
      PG8_WAIT_V(8); PG8_WAIT_L(0); PG8_BAR; PG8_MMA(0, 0, At, B0); PG8_MMA(0, 1, At, B1); PG8_BAR; PG8_SCHED;
      PG8_LDA(At, 1, 1); PG8_STAGE(PG8_SB(1, 0), b3, voffB); PG8_STAGE(PG8_SB(1, 1), b3 + hstepB, voffB); PG8_STAGE(PG8_SA(1, 0), a3, voffA);
      PG8_WAIT_V(8); PG8_WAIT_L(0); PG8_BAR; PG8_MMA(1, 0, At, B0); PG8_MMA(1, 1, At, B1); PG8_BAR; PG8_SCHED;
    }
    if (wr == 0) PG8_BAR;
    { int fr2 = fr, fq2 = fq; asm volatile("" : "+v"(fr2), "+v"(fq2));
      E(acc, cur, wr, wc, fr2, fq2); }
    if (!has_next) break;
#pragma unroll
    for (int a = 0; a < 2; ++a)
#pragma unroll
      for (int b = 0; b < 2; ++b)
#pragma unroll
        for (int m = 0; m < 4; ++m)
#pragma unroll
          for (int n = 0; n < 2; ++n) acc[a][b][m][n] = (f32x4){0.f, 0.f, 0.f, 0.f};
    cur = nxt; cA = nA; cB = nB; ++ui;
    if (wr == 1) PG8_BAR;
  }
  PG8_WAIT_V(0);
  PG8_BAR;
#undef PG8_SA
#undef PG8_SB
#undef PG8_STAGE
#undef PG8_LDA
#undef PG8_LDB
#undef PG8_MMA
#undef PG8_WAIT_V
#undef PG8_WAIT_L
#undef PG8_BAR
#undef PG8_SCHED
}
}

namespace at {
constexpr int D = 128, NW = 8, QBLK = 32, KVBLK = 64;
constexpr float SCALE = 0.088388347648318440f;
constexpr float THR = 8.f;
constexpr int LDQ = 1024, LDK = 1024, LDV = 1024, LDO = 2048;
constexpr size_t SHM_V = KVBLK * D * 2, SHM_K = KVBLK * D * 2;
#define KSWZ(row, colB) ((row) * 256 + ((colB) ^ (((row) & 7) << 4)))
#define SBAR() __builtin_amdgcn_sched_barrier(0)
__device__ __forceinline__ int crow(int r, int hi) { return (r & 3) + 8 * (r >> 2) + 4 * hi; }
__device__ __forceinline__ void partialSM(f32x16& p0, f32x16& p1, float& m_reg, float& mn, float& alpha) {
  constexpr float C = SCALE * 1.4426950408889634f;
  float pmax = p0[0];
#pragma unroll
  for (int r = 1; r < 16; ++r) pmax = fmaxf(pmax, p0[r]);
#pragma unroll
  for (int r = 0; r < 16; ++r) pmax = fmaxf(pmax, p1[r]);
  { auto rr = __builtin_amdgcn_permlane32_swap(__float_as_uint(pmax), __float_as_uint(pmax), false, false);
    pmax = fmaxf(__uint_as_float(rr[0]), __uint_as_float(rr[1])); }
  if (__builtin_expect(__all(pmax - m_reg <= THR / SCALE), 1)) { mn = m_reg; alpha = 1.f; }
  else { mn = fmaxf(m_reg, pmax); alpha = __builtin_amdgcn_exp2f((m_reg - mn) * C); m_reg = mn; }
  float mnC = -mn * C;
#pragma unroll
  for (int r = 0; r < 16; ++r) p0[r] = fmaf(p0[r], C, mnC);
#pragma unroll
  for (int r = 0; r < 16; ++r) p1[r] = fmaf(p1[r], C, mnC);
#pragma unroll
  for (int r = 0; r < 16; ++r) p0[r] = __builtin_amdgcn_exp2f(p0[r]);
}
__device__ __forceinline__ void finishSM(f32x16& p0, f32x16& p1, float alpha, float& l_reg, bf16x8& pa0, bf16x8& pa1, bf16x8& pa2, bf16x8& pa3) {
#pragma unroll
  for (int r = 0; r < 16; ++r) p1[r] = __builtin_amdgcn_exp2f(p1[r]);
  float ps = 0;
#pragma unroll
  for (int r = 0; r < 16; ++r) ps += p0[r];
#pragma unroll
  for (int r = 0; r < 16; ++r) ps += p1[r];
  { auto rr = __builtin_amdgcn_permlane32_swap(__float_as_uint(ps), __float_as_uint(ps), false, false);
    ps = __uint_as_float(rr[0]) + __uint_as_float(rr[1]); }
  l_reg = l_reg * alpha + ps;
#define PK4(P, BASE, OUT) do { unsigned a0 = cvtpk(P[BASE + 0], P[BASE + 1]), a1 = cvtpk(P[BASE + 2], P[BASE + 3]);   \
    unsigned b0 = cvtpk(P[BASE + 4], P[BASE + 5]), b1 = cvtpk(P[BASE + 6], P[BASE + 7]);                              \
    auto r0 = __builtin_amdgcn_permlane32_swap(a0, b0, false, false); auto r1 = __builtin_amdgcn_permlane32_swap(a1, b1, false, false); \
    u32x4 w = {r0[0], r1[0], r0[1], r1[1]}; OUT = *reinterpret_cast<bf16x8*>(&w); } while (0)
  PK4(p0, 0, pa0); PK4(p0, 8, pa1); PK4(p1, 0, pa2); PK4(p1, 8, pa3);
#undef PK4
}
__device__ __forceinline__ void qkt(f32x16& p0, f32x16& p1, const char* Ks, const bf16x8* qr, int r32, int hi) {
  p0 = f32x16{}; p1 = f32x16{};
#pragma unroll
  for (int d0 = 0; d0 < 8; ++d0) { int cb = (d0 * 16 + hi * 8) * 2;
    bf16x8 b0 = *reinterpret_cast<const bf16x8*>(Ks + KSWZ(r32, cb));
    bf16x8 b1 = *reinterpret_cast<const bf16x8*>(Ks + KSWZ(32 + r32, cb));
    p0 = __builtin_amdgcn_mfma_f32_32x32x16_bf16(b0, qr[d0], p0, 0, 0, 0);
    p1 = __builtin_amdgcn_mfma_f32_32x32x16_bf16(b1, qr[d0], p1, 0, 0, 0); }
}
__device__ __forceinline__ int v_st(int k, int c) { const int kk = (k & ~0xC) | ((k & 4) << 1) | ((k & 8) >> 1); return ((kk >> 3) * 4 + (c >> 5)) * 512 + ((kk & 7) * 32 + (c & 31)) * 2; }
__device__ __forceinline__ int v_rd_base(int lane) { return ((lane & 3) << 3) | (((lane >> 2) & 3) << 6) | (((lane >> 4) & 1) << 5) | (((lane >> 5) & 1) << 8); }
constexpr int v_rd_off(int d0, int ks, int half) { return d0 * 512 + ks * 4096 + half * 2048; }
template <int OFF> __device__ __forceinline__ s16x4 tr_read(int vb) {
  s16x4 r; asm volatile("ds_read_b64_tr_b16 %0, %1 offset:%2" : "=&v"(r) : "v"(vb), "i"(OFF) : "memory"); return r;
}
template <int D0> __device__ __forceinline__ void pv_one(f32x16& od, int vb, bf16x8 pa0, bf16x8 pa1, bf16x8 pa2, bf16x8 pa3) {
  const s16x4 l0 = tr_read<v_rd_off(D0, 0, 0)>(vb), h0 = tr_read<v_rd_off(D0, 0, 1)>(vb), l1 = tr_read<v_rd_off(D0, 1, 0)>(vb), h1 = tr_read<v_rd_off(D0, 1, 1)>(vb);
  const s16x4 l2 = tr_read<v_rd_off(D0, 2, 0)>(vb), h2 = tr_read<v_rd_off(D0, 2, 1)>(vb), l3 = tr_read<v_rd_off(D0, 3, 0)>(vb), h3 = tr_read<v_rd_off(D0, 3, 1)>(vb);
  asm volatile("s_waitcnt lgkmcnt(0)" ::: "memory"); SBAR();
#define PK(L, H) (bf16x8){L[0], L[1], L[2], L[3], H[0], H[1], H[2], H[3]}
  od = __builtin_amdgcn_mfma_f32_32x32x16_bf16(pa0, PK(l0, h0), od, 0, 0, 0);
  od = __builtin_amdgcn_mfma_f32_32x32x16_bf16(pa1, PK(l1, h1), od, 0, 0, 0);
  od = __builtin_amdgcn_mfma_f32_32x32x16_bf16(pa2, PK(l2, h2), od, 0, 0, 0);
  od = __builtin_amdgcn_mfma_f32_32x32x16_bf16(pa3, PK(l3, h3), od, 0, 0, 0);
#undef PK
}
__device__ __forceinline__ void pv_d0(f32x16* o, int vb, bf16x8 pa0, bf16x8 pa1, bf16x8 pa2, bf16x8 pa3) {
  pv_one<0>(o[0], vb, pa0, pa1, pa2, pa3); pv_one<1>(o[1], vb, pa0, pa1, pa2, pa3); pv_one<2>(o[2], vb, pa0, pa1, pa2, pa3); pv_one<3>(o[3], vb, pa0, pa1, pa2, pa3);
}
__device__ __forceinline__ void body(const bf16_t* __restrict__ Qb, const bf16_t* __restrict__ Kh, const bf16_t* __restrict__ Vh, bf16_t* __restrict__ Ob, int seq, char* lds) {
  int tid_ = threadIdx.x; asm volatile("" : "+v"(tid_));
  const int tid = tid_, wid = tid >> 6, lane = tid & 63, r32 = lane & 31, hi = lane >> 5;
  char* V_lds = lds; char* K_lds = lds + 2 * SHM_V;
  float* ws = (float*)(lds + 2 * SHM_V + 2 * SHM_K) + wid * 64; float* li_l = ws; float* al_l = ws + 32;
  float m_reg = -1e30f, l_reg = 0; f32x16 o[4] = {}; bf16x8 qr[8];
  const bf16_t* Qw = Qb + (long)(wid * QBLK + r32) * LDQ + hi * 8;
#pragma unroll
  for (int d0 = 0; d0 < 8; ++d0) qr[d0] = *reinterpret_cast<const bf16x8*>(Qw + d0 * 16);
  const int sr = tid >> 4, sc = (tid & 15) * 8, vst0 = v_st(sr, sc), vst1 = v_st(32 + sr, sc);
  const int vb0 = (int)(uintptr_t)(LAS char*)V_lds + v_rd_base(lane);
  bf16x8 sA_vs0, sA_vs1, sA_ks0, sA_ks1, sB_vs0, sB_vs1, sB_ks0, sB_ks1;
#define SLOAD(S, k0) do { S##_vs0 = *reinterpret_cast<const bf16x8*>(&Vh[(long)((k0) + sr) * LDV + sc]); S##_vs1 = *reinterpret_cast<const bf16x8*>(&Vh[(long)((k0) + 32 + sr) * LDV + sc]); \
    S##_ks0 = *reinterpret_cast<const bf16x8*>(&Kh[(long)((k0) + sr) * LDK + sc]); S##_ks1 = *reinterpret_cast<const bf16x8*>(&Kh[(long)((k0) + 32 + sr) * LDK + sc]); } while (0)
#define SWRITE(b, S) do { *(bf16x8*)(V_lds + (b) * SHM_V + vst0) = S##_vs0; *(bf16x8*)(V_lds + (b) * SHM_V + vst1) = S##_vs1; int kc = sc * 2; \
    *(bf16x8*)(K_lds + (b) * SHM_K + KSWZ(sr, kc)) = S##_ks0; *(bf16x8*)(K_lds + (b) * SHM_K + KSWZ(32 + sr, kc)) = S##_ks1; } while (0)
#define SWAIT() asm volatile("s_waitcnt vmcnt(4)" ::: "memory")
#define RESC(a) do { if (__any((a) < 1.f)) { if (hi == 0) al_l[r32] = (a); asm volatile("s_waitcnt lgkmcnt(0)" ::: "memory"); \
    for (int d = 0; d < 4; ++d) for (int r = 0; r < 16; ++r) o[d][r] *= al_l[crow(r, hi)]; } } while (0)
  f32x16 pA0, pA1, pB0, pB1; float mnA, mnB, alA, alB; bf16x8 pa0, pa1, pa2, pa3; const int NT = seq / KVBLK;
  SLOAD(sA, 0); asm volatile("s_waitcnt vmcnt(0)" ::: "memory"); SWRITE(0, sA); __syncthreads();
  qkt(pA0, pA1, K_lds, qr, r32, hi); partialSM(pA0, pA1, m_reg, mnA, alA);
  SLOAD(sB, KVBLK); if (2 < NT) SLOAD(sA, 2 * KVBLK);
  SWAIT(); SWRITE(1, sB); __syncthreads();
  for (int j = 1; j + 1 < NT; j += 2) {
    SBAR(); qkt(pB0, pB1, K_lds + SHM_K, qr, r32, hi);
    finishSM(pA0, pA1, alA, l_reg, pa0, pa1, pa2, pa3); SBAR();
    SLOAD(sB, (j + 2) * KVBLK); SBAR();
    pv_d0(o, vb0, pa0, pa1, pa2, pa3); partialSM(pB0, pB1, m_reg, mnB, alB);
    __syncthreads(); SWAIT(); SWRITE(0, sA);
    RESC(alB); __syncthreads();
    SBAR(); qkt(pA0, pA1, K_lds, qr, r32, hi);
    finishSM(pB0, pB1, alB, l_reg, pa0, pa1, pa2, pa3); SBAR();
    if (j + 3 < NT) SLOAD(sA, (j + 3) * KVBLK); SBAR();
    pv_d0(o, vb0 + (int)SHM_V, pa0, pa1, pa2, pa3); partialSM(pA0, pA1, m_reg, mnA, alA);
    __syncthreads(); SWAIT(); SWRITE(1, sB);
    RESC(alA); __syncthreads();
  }
  SBAR(); qkt(pB0, pB1, K_lds + SHM_K, qr, r32, hi);
  finishSM(pA0, pA1, alA, l_reg, pa0, pa1, pa2, pa3); SBAR();
  pv_d0(o, vb0, pa0, pa1, pa2, pa3); partialSM(pB0, pB1, m_reg, mnB, alB);
  __syncthreads(); RESC(alB);
  finishSM(pB0, pB1, alB, l_reg, pa0, pa1, pa2, pa3); SBAR();
  pv_d0(o, vb0 + (int)SHM_V, pa0, pa1, pa2, pa3);
  if (hi == 0) li_l[r32] = l_reg; asm volatile("s_waitcnt lgkmcnt(0)" ::: "memory");
  float rli[16];
#pragma unroll
  for (int r = 0; r < 16; ++r) rli[r] = __builtin_amdgcn_rcpf(li_l[crow(r, hi)]);
  bf16_t* Ow = Ob + (long)(wid * QBLK) * LDO;
#pragma unroll
  for (int r = 0; r < 16; ++r) { int orow = crow(r, hi);
#pragma unroll
    for (int d0 = 0; d0 < 4; ++d0) Ow[(long)orow * LDO + d0 * 32 + r32] = (bf16_t)(cvtpk(o[d0][r] * rli[r], 0.f) & 0xffff); }
#undef SLOAD
#undef SWRITE
#undef SWAIT
#undef RESC
  __syncthreads();
}
}

struct Ctx {
  int tid, wid, lane, blk, nblk, gwave, nwave; long gtid, nthr;
};

__device__ __forceinline__ const float* modp(const Params& p, int l, int v, int j) { return (const float*)(p.ws + OFF_MOD) + ((size_t)(l * 5 + v) * NMODC + (size_t)j * DM); }

__device__ __forceinline__ void convert_weights(const Params& p, const Ctx& c, int l, float* lds) {
  constexpr int T0 = 56 * 32, T1 = 32 * 32, T2 = 176 * 32, T3 = 32 * 88, T4 = 8 * 8, TALL = T0 + T1 + T2 + T3 + T4;
  for (int it = c.blk; it < TALL; it += c.nblk) {
    int mat, ti = it;
    if (ti < T0) mat = 0; else if ((ti -= T0) < T1) mat = 1; else if ((ti -= T1) < T2) mat = 2; else if ((ti -= T2) < T3) mat = 3; else { ti -= T3; mat = 4; }
    const float* src; long ld; bf16_t* dst; long dld; int nkt;
    if (mat == 0) { src = p.w_in + (size_t)l * DM * 4096; ld = 4096; dst = (bf16_t*)(p.ws + OFF_WIN); dld = DM; nkt = 32; }
    else if (mat == 1) { src = p.w_out + (size_t)l * DM * DM; ld = DM; dst = (bf16_t*)(p.ws + OFF_WOUT); dld = DM; nkt = 32; }
    else if (mat == 2) { src = p.w_gate + (size_t)l * DM * DFF; ld = DFF; dst = (bf16_t*)(p.ws + OFF_WGU); dld = DM; nkt = 32; }
    else if (mat == 3) { src = p.w_down + (size_t)l * DFF * DM; ld = DM; dst = (bf16_t*)(p.ws + OFF_WD); dld = DFF; nkt = 88; }
    else { src = p.w_glu + (size_t)l * 512 * 512; ld = 512; dst = (bf16_t*)(p.ws + OFF_WGLU); dld = 512; nkt = 8; }
    const int n0 = (ti / nkt) * 64, k0 = (ti % nkt) * 64;
    {
      const int nn = c.tid & 63, np = n0 + nn; int scol = np;
      if (mat == 0) { if (np < 2048) scol = (np & ~0x30) | ((np & 16) << 1) | ((np & 32) >> 1); }
      else if (mat == 2) { const int pn = np >> 8, bj = (np >> 7) & 1; scol = pn * 128 + (np & 127); if (bj) src = p.w_up + (size_t)l * DM * DFF; }
#pragma unroll
      for (int i = 0; i < 8; ++i) { const int kk = (c.tid >> 6) + 8 * i; lds[kk * 65 + nn] = src[(size_t)(k0 + kk) * ld + scol]; }
    }
    __syncthreads();
    {
      const int nn = c.tid >> 3, kc = (c.tid & 7) * 8;
      float v[8];
#pragma unroll
      for (int i = 0; i < 8; ++i) v[i] = lds[(kc + i) * 65 + nn];
      u32x4 w = {cvtpk(v[0], v[1]), cvtpk(v[2], v[3]), cvtpk(v[4], v[5]), cvtpk(v[6], v[7])};
      *(u32x4*)(dst + (size_t)(n0 + nn) * dld + k0 + kc) = w;
    }
    __syncthreads();
  }
}

__device__ __forceinline__ void fold_four(const Params& p, const Ctx& c, int l, float* lds) {
  float* WlT = lds;
  float* Wc = lds + 128 * 68;
  const float* wcs = (const float*)(p.ws + OFF_WCS) + (size_t)l * 2 * 4 * 128 * 128;
  bf16_t* dstb = (bf16_t*)(p.ws + OFF_WIN);
  for (int u = c.blk; u < 256; u += c.nblk) {
    const int kt = u & 31, cs = (u >> 5) & 1, g = u >> 6, k0 = kt * 64;
    const float* src = p.w_in + (size_t)l * DM * 4096 + 3584 + g * 128;
    for (int i = c.tid; i < 64 * 128; i += NTHREADS) { const int kk = i >> 7, cc = i & 127; WlT[cc * 68 + kk] = src[(size_t)(k0 + kk) * 4096 + cc]; }
    const float* wsrc = wcs + (size_t)(cs * 4 + g) * 128 * 128;
    for (int i = c.tid; i < 128 * 128; i += NTHREADS) Wc[i] = wsrc[i];
    __syncthreads();
    const int kq = c.tid & 15, dq = c.tid >> 4;
    f32x4 acc[4] = {};
    for (int cc = 0; cc < 128; ++cc) {
      const f32x4 a = *(const f32x4*)(WlT + cc * 68 + kq * 4), w = *(const f32x4*)(Wc + cc * 128 + dq * 4);
#pragma unroll
      for (int di = 0; di < 4; ++di) acc[di] += a * w[di];
    }
#pragma unroll
    for (int di = 0; di < 4; ++di) { u32x2 o = {cvtpk(acc[di][0], acc[di][1]), cvtpk(acc[di][2], acc[di][3])};
      *(u32x2*)(dstb + (size_t)(3584 + cs * 512 + g * 128 + dq * 4 + di) * DM + k0 + kq * 4) = o; }
    __syncthreads();
  }
}


__device__ __forceinline__ void ssm_tables(const Params& p, const Ctx& c) {
  float2* PW = (float2*)(p.ws + OFF_PW); float2* BB = (float2*)(p.ws + OFF_BB);
  for (long i = c.gtid; i < 2L * 32 * 2 * 64; i += c.nthr) { const int pp = (int)(i & 63), idx = (int)(i >> 6);
    const int d = idx & 1, g = (idx >> 1) & 31, l = idx >> 6, iidx = (l * 2 + d) * 32 + g;
    const float lre = p.ssm_a_re[iidx * 64 + pp], lim = p.ssm_a_im[iidx * 64 + pp], dt = expf(p.ssm_log_dt[iidx]);
    float ar = 1.f, ai = 0.f;
    for (int j = 0; j <= 32; ++j) { const float mag = expf(lre * dt * (float)j); float sn, cs; my_sincos(lim * dt * (float)j, sn, cs);
      PW[((size_t)idx * 33 + j) * 64 + pp] = make_float2(mag * cs, mag * sn); if (j == 1) { ar = mag * cs; ai = mag * sn; } }
    const float nr = ar - 1.f, ni = ai, den = 1.f / (lre * lre + lim * lim), cr = (nr * lre + ni * lim) * den, ci = (ni * lre - nr * lim) * den;
    const float* br = p.ssm_b_re + ((size_t)iidx * 64 + pp) * 16; const float* bi = p.ssm_b_im + ((size_t)iidx * 64 + pp) * 16;
    for (int h = 0; h < 16; ++h) BB[((size_t)idx * 64 + pp) * 16 + h] = make_float2(cr * br[h] - ci * bi[h], cr * bi[h] + ci * br[h]); }
}
__device__ __forceinline__ void ssm_build_mef(const Params& p, const Ctx& c, int l) {
  const float2* PW = (const float2*)(p.ws + OFF_PW) + (size_t)l * 32 * 2 * 33 * 64; const float2* BB = (const float2*)(p.ws + OFF_BB) + (size_t)l * 32 * 2 * 64 * 16;
  float* MK = (float*)(p.ws + OFF_MK) + (size_t)l * 32 * 2 * 32 * 256; bf16_t* EM = (bf16_t*)(p.ws + OFF_EM); bf16_t* TF = (bf16_t*)(p.ws + OFF_TF);
  for (long i = c.gtid; i < 32L * 2 * 32 * 256; i += c.nthr) { const int hp = (int)(i & 15), h = (int)((i >> 4) & 15), j = (int)((i >> 8) & 31), gd = (int)(i >> 13), d = gd & 1, g = gd >> 1;
    const size_t ci = ((size_t)((l * 2 + d) * 32 + g) * 16 + h) * 64; const float2* pw = PW + ((size_t)gd * 33 + j) * 64; const float2* bb = BB + (size_t)gd * 64 * 16 + hp; float a = 0.f;
    for (int pp = 0; pp < 64; ++pp) { const float cr = p.ssm_c_re[ci + pp], cim = p.ssm_c_im[ci + pp]; const float2 b = bb[pp * 16], w = pw[pp];
      const float wr = cr * b.x - cim * b.y, wi = cr * b.y + cim * b.x; a += wr * w.x - wi * w.y; }
    MK[i] = a; }
  for (long i = c.gtid; i < 32L * 256 * 32 * 2; i += c.nthr) { const int hh = (int)(i & 1), s = (int)((i >> 1) & 31), n = (int)((i >> 6) & 255), g = (int)(i >> 14), ri = n & 1, pp = (n >> 1) & 63, d = n >> 7;
    const int gd = g * 2 + d, e = d ? s : 31 - s; const float2 w = PW[((size_t)gd * 33 + e) * 64 + pp]; const float2* bb = BB + ((size_t)gd * 64 + pp) * 16 + hh * 8; float v[8];
#pragma unroll
    for (int k = 0; k < 8; ++k) { const float2 b = bb[k]; v[k] = ri ? (w.x * b.y + w.y * b.x) : (w.x * b.x - w.y * b.y); }
    u32x4 o = {cvtpk(v[0], v[1]), cvtpk(v[2], v[3]), cvtpk(v[4], v[5]), cvtpk(v[6], v[7])}; *(u32x4*)(EM + ((size_t)g * 256 + n) * 512 + s * 16 + hh * 8) = o; }
  for (long i = c.gtid; i < 32L * 512 * 2 * 16; i += c.nthr) { const int pq = (int)(i & 15), d = (int)((i >> 4) & 1), n = (int)((i >> 5) & 511), g = (int)(i >> 14), h = n & 15, t = n >> 4;
    const int gd = g * 2 + d, f = d ? 32 - t : t + 1; const size_t ci = ((size_t)((l * 2 + d) * 32 + g) * 16 + h) * 64 + pq * 4; const float2* pw = PW + ((size_t)gd * 33 + f) * 64 + pq * 4; float v[8];
#pragma unroll
    for (int k = 0; k < 4; ++k) { const float cr = p.ssm_c_re[ci + k], cim = p.ssm_c_im[ci + k]; const float2 w = pw[k]; v[2 * k] = cr * w.x - cim * w.y; v[2 * k + 1] = -(cr * w.y + cim * w.x); }
    u32x4 o = {cvtpk(v[0], v[1]), cvtpk(v[2], v[3]), cvtpk(v[4], v[5]), cvtpk(v[6], v[7])}; *(u32x4*)(TF + ((size_t)g * 512 + n) * 768 + 512 + d * 128 + pq * 8) = o; }
}
__device__ __forceinline__ void ssm_build_t(const Params& p, const Ctx& c, int l) {
  const float* MK = (const float*)(p.ws + OFF_MK) + (size_t)l * 32 * 2 * 32 * 256; bf16_t* TF = (bf16_t*)(p.ws + OFF_TF);
  for (long i = c.gtid; i < 32L * 512 * 32 * 2; i += c.nthr) { const int hh = (int)(i & 1), s = (int)((i >> 1) & 31), n = (int)((i >> 6) & 511), g = (int)(i >> 15), h = n & 15, t = n >> 4;
    const int lag = t - s; float v[8];
    if (lag != 0) { const float* m = MK + ((size_t)((g * 2 + (lag < 0 ? 1 : 0)) * 32 + (lag < 0 ? -lag : lag)) * 16 + h) * 16 + hh * 8;
#pragma unroll
      for (int k = 0; k < 8; ++k) v[k] = m[k]; }
    else { const float* m0 = MK + ((size_t)((g * 2) * 32) * 16 + h) * 16 + hh * 8; const float* m1 = MK + ((size_t)((g * 2 + 1) * 32) * 16 + h) * 16 + hh * 8; const float dsk = p.ssm_d[(size_t)l * 512 + g * 16 + h];
#pragma unroll
      for (int k = 0; k < 8; ++k) v[k] = m0[k] + m1[k] + ((hh * 8 + k) == h ? dsk : 0.f); }
    u32x4 o = {cvtpk(v[0], v[1]), cvtpk(v[2], v[3]), cvtpk(v[4], v[5]), cvtpk(v[6], v[7])}; *(u32x4*)(TF + ((size_t)g * 512 + n) * 768 + s * 16 + hh * 8) = o; }
}
__device__ __forceinline__ void ssm_carry(const Params& p, const Ctx& c, int l) {
  if (c.wid != 0) return;
  const float2* PW = (const float2*)(p.ws + OFF_PW) + (size_t)l * 32 * 2 * 33 * 64; const float* SB = (const float*)(p.ws + OFF_Z2 + Z2_SB); bf16_t* UG = (bf16_t*)(p.ws + OFF_Z2 + Z2_UG);
  for (int i = c.blk * 64 + c.lane; i < NB * 32 * 2 * 64; i += c.nblk * 64) { const int pp = i & 63, d = (i >> 6) & 1, g = (i >> 7) & 31, b = i >> 12;
    const float2 a32 = PW[((size_t)(g * 2 + d) * 33 + 32) * 64 + pp]; float hr = 0.f, hi = 0.f;
    const size_t rbase = (size_t)g * 768 + b * 136; const int col = (d * 64 + pp) * 2;
#pragma unroll 8
    for (int k = 0; k < 136; ++k) { const int ch = d == 0 ? k : (k < 8 ? 7 - k : 143 - k);
      const float2 s = *(const float2*)(SB + (rbase + ch) * 256 + col);
      *(unsigned*)(UG + (rbase + ch) * 768 + 512 + col) = cvtpk(hr, hi);
      const float nr = a32.x * hr - a32.y * hi + s.x, ni = a32.x * hi + a32.y * hr + s.y; hr = nr; hi = ni; } }
}

__device__ __forceinline__ void phase0a(const Params& p, const Ctx& c, float* lds) {
  for (int i = c.tid; i < 5 * DM; i += NTHREADS) { const float v = i < 4 * DM ? p.c[i] : p.c_ctx[i - 4 * DM]; lds[i] = v * sigmoidf_(v); }
  __syncthreads();
  {
    float* MP = (float*)(p.ws + OFF_MP);
    for (long it = c.gtid; it < 16 * 6144; it += c.nthr) {
      const int cq = (int)(it % 6144), ks = (int)(it / 6144); const int gc = cq * 4, l = gc / NMODC, col = gc % NMODC;
      const float* wp = p.w_mod + ((size_t)l * DM + (size_t)ks * 128) * NMODC + col;
      f32x4 a[5] = {};
#pragma unroll 8
      for (int k = 0; k < 128; ++k) { const f32x4 w = *(const f32x4*)(wp + (size_t)k * NMODC);
#pragma unroll
        for (int v = 0; v < 5; ++v) a[v] += w * lds[v * DM + ks * 128 + k]; }
#pragma unroll
      for (int v = 0; v < 5; ++v) *(f32x4*)(MP + ((size_t)ks * 5 + v) * 24576 + gc) = a[v];
    }
  }
  __syncthreads();
  {
    f32x4* X = (f32x4*)(p.ws + OFF_X);
    for (long i = c.gtid; i < (long)TT * 512; i += c.nthr) { const int r = (int)(i >> 9), c4 = (int)(i & 511), b = r / TPB, t = r % TPB;
      const f32x4* src = t < CTXL ? (const f32x4*)(p.ctx + ((size_t)b * CTXL + t) * DM) : (const f32x4*)(p.x + ((size_t)b * SEQ + (t - CTXL)) * DM);
      X[i] = src[c4]; }
  }
  {
    float* rc = (float*)(p.ws + OFF_ROPE); float* rs = rc + 64 * 32;
    for (long i = c.gtid; i < 64 * 32; i += c.nthr) { const int pos = (int)(i >> 5), pp = (int)(i & 31);
      const float inv = (float)exp2(-(double)pp / 32.0 * 13.287712379549449); float s, cc; my_sincos((float)pos * inv, s, cc); rc[i] = cc; rs[i] = s; }
  }
  {
    bf16_t* DL = (bf16_t*)(p.ws + OFF_DFTL);
    for (long i = c.gtid; i < 2L * 4096 * 512; i += c.nthr) { const int part = (int)(i >> 21), k = (int)((i >> 9) & 4095), t0 = (int)(i & 511) * 8; float v[8];
#pragma unroll
      for (int j = 0; j < 8; ++j) { const float ph = (float)((k * (t0 + j)) & 4095) * (1.f / 4096.f); v[j] = (part ? __builtin_amdgcn_sinf(ph) : __builtin_amdgcn_cosf(ph)) * (1.f / 64.f); }
      u32x4 w = {cvtpk(v[0], v[1]), cvtpk(v[2], v[3]), cvtpk(v[4], v[5]), cvtpk(v[6], v[7])}; *(u32x4*)(DL + i * 8) = w; }
    bf16_t* DC = (bf16_t*)(p.ws + OFF_DFTC);
    for (long i = c.gtid; i < 2L * 256 * 32; i += c.nthr) { const int part = (int)(i >> 13), k = (int)((i >> 5) & 255), t0 = (int)(i & 31) * 8; float v[8];
#pragma unroll
      for (int j = 0; j < 8; ++j) { const float ph = (float)((k * (t0 + j)) & 255) * (1.f / 256.f); v[j] = (part ? __builtin_amdgcn_sinf(ph) : __builtin_amdgcn_cosf(ph)) * (1.f / 16.f); }
      u32x4 w = {cvtpk(v[0], v[1]), cvtpk(v[2], v[3]), cvtpk(v[4], v[5]), cvtpk(v[6], v[7])}; *(u32x4*)(DC + i * 8) = w; }
  }
  {
    float* W = (float*)(p.ws + OFF_WCS);
    for (long i = c.gtid; i < 2L * 2 * 4 * 128 * 128; i += c.nthr) { const int d = (int)(i & 127), cc = (int)((i >> 7) & 127), g = (int)((i >> 14) & 3), cs = (int)((i >> 16) & 1), l = (int)(i >> 17);
      const float* wf = p.w_four + ((size_t)(l * 4 + g) * 128) * 128 + d; float a = 0.f;
      for (int j = 0; j < 128; ++j) { const float ph = (float)((j * cc) & 127) * (1.f / 128.f); a += (cs ? __builtin_amdgcn_sinf(ph) : __builtin_amdgcn_cosf(ph)) * wf[(size_t)j * 128]; }
      W[i] = a * 0.08838834764831845f; }
  }
}

__device__ __forceinline__ void reduce_mod(const Params& p, const Ctx& c) {
  const float* MP = (const float*)(p.ws + OFF_MP); float* MOD = (float*)(p.ws + OFF_MOD);
  for (long o = c.gtid; o < 5L * 24576; o += c.nthr) { const int v = (int)(o / 24576), gc = (int)(o % 24576), l = gc / NMODC, col = gc % NMODC;
    float a = p.b_mod[gc];
#pragma unroll
    for (int ks = 0; ks < 16; ++ks) a += MP[((size_t)ks * 5 + v) * 24576 + gc];
    MOD[(size_t)(l * 5 + v) * NMODC + col] = a; }
}

__device__ __forceinline__ void prenorm_row(const f32x4 (&x)[8], float rinv, const float* g, const float* sc, const float* sh, bf16_t* dst, int lane) {
#pragma unroll
  for (int i = 0; i < 8; ++i) { const int col = (lane + 64 * i) * 4; const f32x4 gg = *(const f32x4*)(g + col), s1 = *(const f32x4*)(sc + col), s0 = *(const f32x4*)(sh + col);
    const f32x4 y = (x[i] * rinv * gg) * (s1 + 1.f) + s0; u32x2 o = {cvtpk(y[0], y[1]), cvtpk(y[2], y[3])}; *(u32x2*)(dst + col) = o; }
}
__device__ __forceinline__ float sumsq8(const f32x4 (&x)[8]) { float s = 0.f;
#pragma unroll
  for (int i = 0; i < 8; ++i) s += x[i][0] * x[i][0] + x[i][1] * x[i][1] + x[i][2] * x[i][2] + x[i][3] * x[i][3];
  return wave_sum(s); }

__device__ __forceinline__ void phase_prenorm(const Params& p, const Ctx& c, int l) {
  const float* X = (const float*)(p.ws + OFF_X); bf16_t* Hn = (bf16_t*)(p.ws + OFF_HN);
  for (int row = c.gwave; row < TT; row += c.nwave) { const int b = row / TPB, t = row % TPB, v = t < CTXL ? 4 : b;
    f32x4 x[8]; const f32x4* xr = (const f32x4*)(X + (size_t)row * DM);
#pragma unroll
    for (int i = 0; i < 8; ++i) x[i] = xr[c.lane + 64 * i];
    const float rinv = rsqrtf(sumsq8(x) * (1.f / DM) + 1e-6f);
    prenorm_row(x, rinv, p.g_mix_pre + (size_t)l * DM, modp(p, l, v, 1), modp(p, l, v, 0), Hn + (size_t)row * DM, c.lane); }
}
__device__ __forceinline__ void phase_postmix(const Params& p, const Ctx& c, int l, bool last) {
  float* X = (float*)(p.ws + OFF_X); const float* MIX = (const float*)(p.ws + OFF_Z1); bf16_t* Hn = (bf16_t*)(p.ws + OFF_HN);
  for (int row = c.gwave; row < TT; row += c.nwave) { const int b = row / TPB, t = row % TPB, v = t < CTXL ? 4 : b; if (last && t < CTXL) continue;
    f32x4 m[8], x[8]; const f32x4* mr = (const f32x4*)(MIX + (size_t)row * DM); f32x4* xr = (f32x4*)(X + (size_t)row * DM);
#pragma unroll
    for (int i = 0; i < 8; ++i) { m[i] = mr[c.lane + 64 * i]; x[i] = xr[c.lane + 64 * i]; }
    const float r1 = rsqrtf(sumsq8(m) * (1.f / DM) + 1e-6f); const float* gp = p.g_mix_post + (size_t)l * DM; const float* m2 = modp(p, l, v, 2);
#pragma unroll
    for (int i = 0; i < 8; ++i) { const int col = (c.lane + 64 * i) * 4; x[i] += *(const f32x4*)(m2 + col) * (m[i] * r1 * *(const f32x4*)(gp + col)); xr[c.lane + 64 * i] = x[i]; }
    const float r2 = rsqrtf(sumsq8(x) * (1.f / DM) + 1e-6f);
    prenorm_row(x, r2, p.g_ffn_pre + (size_t)l * DM, modp(p, l, v, 4), modp(p, l, v, 3), Hn + (size_t)row * DM, c.lane); }
}
__device__ __forceinline__ void phase_postffn(const Params& p, const Ctx& c, int l, bool last) {
  float* X = (float*)(p.ws + OFF_X); const float* F = (const float*)(p.ws + OFF_Z1); bf16_t* Hn = (bf16_t*)(p.ws + OFF_HN);
  for (int row = c.gwave; row < TT; row += c.nwave) { const int b = row / TPB, t = row % TPB, v = t < CTXL ? 4 : b; if (last && t < CTXL) continue;
    f32x4 m[8], x[8]; const f32x4* mr = (const f32x4*)(F + (size_t)row * DM); f32x4* xr = (f32x4*)(X + (size_t)row * DM);
#pragma unroll
    for (int i = 0; i < 8; ++i) { m[i] = mr[c.lane + 64 * i]; x[i] = xr[c.lane + 64 * i]; }
    const float r1 = rsqrtf(sumsq8(m) * (1.f / DM) + 1e-6f); const float* gp = p.g_ffn_post + (size_t)l * DM; const float* m5 = modp(p, l, v, 5);
#pragma unroll
    for (int i = 0; i < 8; ++i) { const int col = (c.lane + 64 * i) * 4; x[i] += *(const f32x4*)(m5 + col) * (m[i] * r1 * *(const f32x4*)(gp + col)); }
    if (last) { f32x4* o = (f32x4*)(p.out + ((size_t)b * SEQ + (t - CTXL)) * DM);
#pragma unroll
      for (int i = 0; i < 8; ++i) o[c.lane + 64 * i] = x[i]; }
    else {
#pragma unroll
      for (int i = 0; i < 8; ++i) xr[c.lane + 64 * i] = x[i];
      const float r2 = rsqrtf(sumsq8(x) * (1.f / DM) + 1e-6f);
      prenorm_row(x, r2, p.g_mix_pre + (size_t)(l + 1) * DM, modp(p, l + 1, v, 1), modp(p, l + 1, v, 0), Hn + (size_t)row * DM, c.lane); } }
}

typedef f32x4 Acc[2][2][4][2];
__device__ __forceinline__ int lat_pm(int i) { return (i >> 4) * 17 + 1 + (i & 15); }

struct SchedMN {
  const char* A; const char* B; size_t strA, strB;
  int nM, nN, pn0, latonly, nextra, blk, nblk;
  __device__ __forceinline__ bool next(int i, gm::Unit& u) const {
    const int it = i * nblk + blk, nmain = nM * nN;
    if (it < nmain) { gm::tile_of(it, nM, nN, u.pm, u.pn); if (latonly) u.pm = lat_pm(u.pm); u.pn += pn0; return true; }
    if (it < nmain + nextra) { const int j = it - nmain; u.pm = (j / 10) * 17; u.pn = 4 + (j % 10); return true; }
    return false;
  }
  __device__ __forceinline__ const char* pA(const gm::Unit& u) const { return A + (size_t)u.pm * strA; }
  __device__ __forceinline__ const char* pB(const gm::Unit& u) const { return B + (size_t)u.pn * strB; }
};

struct EpiIn {
  bf16_t *Qb, *Kb, *Vb, *UG; const float *rc, *rs;
  __device__ __forceinline__ void operator()(const Acc& acc, const gm::Unit& u, int wr, int wc, int fr, int fq) const {
    const int pm = u.pm, pn = u.pn; const bool isctx = (pm % 17) == 0; const int brow = pm * 256;
#pragma unroll
    for (int ai = 0; ai < 2; ++ai)
#pragma unroll
      for (int m = 0; m < 4; ++m) { const int row = brow + ai * 128 + wr * 64 + m * 16 + fr;
        if (pn < 8) { bf16_t* dst = Qb + (size_t)(pn >> 2) * TT * 1024 + (size_t)row * 1024 + (pn & 3) * 256 + wc * 32 + fq * 4;
          f32x4 cs = {1.f, 1.f, 1.f, 1.f}, sn = {0.f, 0.f, 0.f, 0.f};
          if (!isctx) { const int tl = (row % TPB) - CTXL; const int pos = (wc >> 1) ? (tl & 63) : (tl >> 6); const int p0 = (wc & 1) * 16 + fq * 4;
            cs = *(const f32x4*)(rc + pos * 32 + p0); sn = *(const f32x4*)(rs + pos * 32 + p0); }
#pragma unroll
          for (int bj = 0; bj < 2; ++bj) { const f32x4 v1 = acc[ai][bj][m][0], v2 = acc[ai][bj][m][1]; const f32x4 o1 = v1 * cs - v2 * sn, o2 = v2 * cs + v1 * sn;
            u32x2 w1 = {cvtpk(o1[0], o1[1]), cvtpk(o1[2], o1[3])}, w2 = {cvtpk(o2[0], o2[1]), cvtpk(o2[2], o2[3])};
            *(u32x2*)(dst + bj * 128) = w1; *(u32x2*)(dst + bj * 128 + 16) = w2; } }
        else if (pn < 12) { bf16_t* dst = Vb + (size_t)row * 1024 + (pn - 8) * 256 + wc * 32 + fq * 4;
#pragma unroll
          for (int bj = 0; bj < 2; ++bj)
#pragma unroll
            for (int n = 0; n < 2; ++n) { const f32x4 v = acc[ai][bj][m][n]; u32x2 w = {cvtpk(v[0], v[1]), cvtpk(v[2], v[3])}; *(u32x2*)(dst + bj * 128 + n * 16) = w; } }
        else { const int b = row / TPB, t = row % TPB; bf16_t* dst = UG + ((size_t)(b * 136 + (t >> 5))) * 768 + (t & 31) * 16 + ((fq * 4) & 15);
#pragma unroll
          for (int bj = 0; bj < 2; ++bj)
#pragma unroll
            for (int n = 0; n < 2; ++n) { const int g = ((pn - 12) * 256 + bj * 128 + wc * 32 + n * 16 + fq * 4) >> 4; const f32x4 v = acc[ai][bj][m][n];
              u32x2 w = {cvtpk(v[0], v[1]), cvtpk(v[2], v[3])}; *(u32x2*)(dst + (size_t)g * 768 * 768) = w; } } }
  }
};
struct EpiPQ {
  bf16_t *PT;
  __device__ __forceinline__ void operator()(const Acc& acc, const gm::Unit& u, int wr, int wc, int fr, int fq) const {
    const int pm = u.pm, pn = u.pn, b = pm / 17, tt = pm % 17, part = (pn - 14) >> 1; const size_t cb = (size_t)(part * NB + b) * 512 + (pn & 1) * 256;
    const size_t ld = tt == 0 ? 256 : 4096; bf16_t* dstm = PT + (tt == 0 ? (size_t)2 * NB * 512 * 4096 + cb * 256 : cb * 4096 + (size_t)(tt - 1) * 256);
#pragma unroll
    for (int ai = 0; ai < 2; ++ai)
#pragma unroll
      for (int bj = 0; bj < 2; ++bj)
#pragma unroll
        for (int m = 0; m < 4; ++m)
#pragma unroll
          for (int n = 0; n < 2; ++n) { const f32x4 v = acc[ai][bj][m][n]; u32x2 w = {cvtpk(v[0], v[1]), cvtpk(v[2], v[3])};
            *(u32x2*)(dstm + (size_t)(bj * 128 + wc * 32 + n * 16 + fr) * ld + ai * 128 + wr * 64 + m * 16 + fq * 4) = w; }
  }
};
__device__ __forceinline__ void phase_gemm_in(const Params& p, const Ctx& c, int l, LAS unsigned char* lds) {
  SchedMN S; S.A = p.ws + OFF_HN; S.B = p.ws + OFF_WIN; S.strA = (size_t)256 * DM * 2; S.strB = (size_t)256 * DM * 2; S.blk = c.blk; S.nblk = c.nblk;
  S.nM = l == 0 ? 68 : 64; S.latonly = l == 0 ? 0 : 1;
  { S.nN = 14; S.pn0 = 0; S.nextra = l == 0 ? 0 : 40;
    EpiIn E; E.Qb = (bf16_t*)(p.ws + OFF_Z1 + Z1_Q); E.Kb = (bf16_t*)(p.ws + OFF_Z1 + Z1_K); E.Vb = (bf16_t*)(p.ws + OFF_Z1 + Z1_V); E.UG = (bf16_t*)(p.ws + OFF_Z2 + Z2_UG);
    E.rc = (const float*)(p.ws + OFF_ROPE); E.rs = E.rc + 64 * 32;
    gm::gemm_phase<true>(lds, DM, DM, DM, S, E); }
  { S.nN = 4; S.pn0 = 14; S.nextra = 0;
    EpiPQ E; E.PT = (bf16_t*)(p.ws + OFF_Z2 + Z2_CAT);
    gm::gemm_phase<false>(lds, DM, DM, DM, S, E); }
}

template <int LAT> struct SchedFour {
  const bf16_t *DM_, *PT; int blk, nblk;
  __device__ __forceinline__ bool next(int i, gm::Unit& u) const { const int it = i * nblk + blk; if (it >= (LAT ? 256 : 16)) return false; u.pm = it; u.pn = 0; return true; }
  __device__ __forceinline__ const char* pA(const gm::Unit& u) const { const int it = u.pm;
    if (LAT) { const int kt = it & 15, part = (it >> 5) & 1; return (const char*)(DM_ + ((size_t)part * 4096 + kt * 256) * 4096); }
    const int part = (it >> 1) & 1; return (const char*)(DM_ + (size_t)part * 256 * 256); }
  __device__ __forceinline__ const char* pB(const gm::Unit& u) const { const int it = u.pm;
    if (LAT) { const int nt_ = (it >> 4) & 1, part = (it >> 5) & 1, b = it >> 6; return (const char*)(PT + ((size_t)(part * NB + b) * 512 + nt_ * 256) * 4096); }
    const int nt_ = it & 1, part = (it >> 1) & 1, b = it >> 2; return (const char*)(PT + (size_t)2 * NB * 512 * 4096 + ((size_t)(part * NB + b) * 512 + nt_ * 256) * 256); }
};
template <int LAT> struct EpiFour {
  float *FC, *FS;
  __device__ __forceinline__ void operator()(const Acc& acc, const gm::Unit& u, int wr, int wc, int fr, int fq) const { const int it = u.pm; int kt, nt_, part, b, toff;
    if (LAT) { kt = it & 15; nt_ = (it >> 4) & 1; part = (it >> 5) & 1; b = it >> 6; toff = CTXL; } else { kt = 0; nt_ = it & 1; part = (it >> 1) & 1; b = it >> 2; toff = 0; }
    float* dst = FC + (size_t)part * TT * 512 + ((size_t)b * TPB + toff + kt * 256) * 512 + nt_ * 256 + wc * 32 + fq * 4;
#pragma unroll
    for (int ai = 0; ai < 2; ++ai)
#pragma unroll
      for (int m = 0; m < 4; ++m) { float* dr = dst + (size_t)(ai * 128 + wr * 64 + m * 16 + fr) * 512;
#pragma unroll
        for (int bj = 0; bj < 2; ++bj)
#pragma unroll
          for (int n = 0; n < 2; ++n) *(f32x4*)(dr + bj * 128 + n * 16) = acc[ai][bj][m][n]; }
  }
};
__device__ __forceinline__ void phase_fourier(const Params& p, const Ctx& c, int l, LAS unsigned char* lds) {
  const bf16_t* PT = (const bf16_t*)(p.ws + OFF_Z2 + Z2_CAT);
  float* FC = (float*)(p.ws + OFF_Z2 + Z2_FC); float* FS = (float*)(p.ws + OFF_Z2 + Z2_FS);
  { const SchedFour<1> S{(const bf16_t*)(p.ws + OFF_DFTL), PT, c.blk, c.nblk}; const EpiFour<1> E{FC, FS}; gm::gemm_phase<true>(lds, 4096, 4096, 4096, S, E); }
  if (l == 0) { const SchedFour<0> S{(const bf16_t*)(p.ws + OFF_DFTC), PT, c.blk, c.nblk}; const EpiFour<0> E{FC, FS}; gm::gemm_phase<true>(lds, 256, 256, 256, S, E); }
}

struct SchedSsmS { const char *UG, *EM; int blk, nblk;
  __device__ __forceinline__ bool next(int i, gm::Unit& u) const { const int it = i * nblk + blk; if (it >= 96) return false; u.pm = it; u.pn = 0; return true; }
  __device__ __forceinline__ const char* pA(const gm::Unit& u) const { const int g = u.pm / 3, pm = u.pm % 3; return UG + ((size_t)g * 768 + pm * 256) * 768 * 2; }
  __device__ __forceinline__ const char* pB(const gm::Unit& u) const { const int g = u.pm / 3; return EM + (size_t)g * 256 * 512 * 2; } };
struct EpiSsmS { float* SB;
  __device__ __forceinline__ void operator()(const Acc& acc, const gm::Unit& u, int wr, int wc, int fr, int fq) const { const int g = u.pm / 3, pm = u.pm % 3;
#pragma unroll
    for (int ai = 0; ai < 2; ++ai)
#pragma unroll
      for (int m = 0; m < 4; ++m) { const int r = pm * 256 + ai * 128 + wr * 64 + m * 16 + fr; if (r >= 544) continue; float* dr = SB + ((size_t)g * 768 + r) * 256 + wc * 32 + fq * 4;
#pragma unroll
        for (int bj = 0; bj < 2; ++bj)
#pragma unroll
          for (int n = 0; n < 2; ++n) *(f32x4*)(dr + bj * 128 + n * 16) = acc[ai][bj][m][n]; }
  } };
__device__ __forceinline__ void phase_ssm_states(const Params& p, const Ctx& c, LAS unsigned char* lds) {
  const SchedSsmS S{p.ws + OFF_Z2 + Z2_UG, p.ws + OFF_EM, c.blk, c.nblk}; const EpiSsmS E{(float*)(p.ws + OFF_Z2 + Z2_SB)};
  gm::gemm_phase<true>(lds, 768, 512, 512, S, E);
}
struct SchedSsmY { const char *UG, *TF; int blk, nblk;
  __device__ __forceinline__ bool next(int i, gm::Unit& u) const { const int it = i * nblk + blk; if (it >= 192) return false; u.pm = it >> 1; u.pn = it & 1; return true; }
  __device__ __forceinline__ const char* pA(const gm::Unit& u) const { const int g = u.pm / 3, pm = u.pm % 3; return UG + ((size_t)g * 768 + pm * 256) * 768 * 2; }
  __device__ __forceinline__ const char* pB(const gm::Unit& u) const { const int g = u.pm / 3; return TF + ((size_t)g * 512 + u.pn * 256) * 768 * 2; } };
struct EpiSsmY { bf16_t* Gg; int last;
  __device__ __forceinline__ void operator()(const Acc& acc, const gm::Unit& u, int wr, int wc, int fr, int fq) const { const int g = u.pm / 3, pm = u.pm % 3;
#pragma unroll
    for (int ai = 0; ai < 2; ++ai)
#pragma unroll
      for (int m = 0; m < 4; ++m) { const int r = pm * 256 + ai * 128 + wr * 64 + m * 16 + fr; if (r >= 544) continue; const int b = r / 136, ch = r % 136; if (last && ch < 8) continue;
        bf16_t* dr = Gg + ((size_t)b * TPB + ch * 32) * 512 + g * 16 + ((fq * 4) & 15);
#pragma unroll
        for (int bj = 0; bj < 2; ++bj)
#pragma unroll
          for (int n = 0; n < 2; ++n) { const int t = (u.pn * 256 + bj * 128 + wc * 32 + n * 16 + fq * 4) >> 4; const f32x4 y = acc[ai][bj][m][n];
            u32x2 w = {cvtpk(gelu_tanh(y[0]), gelu_tanh(y[1])), cvtpk(gelu_tanh(y[2]), gelu_tanh(y[3]))}; *(u32x2*)(dr + (size_t)t * 512) = w; } }
  } };
__device__ __forceinline__ void phase_ssm_y(const Params& p, const Ctx& c, bool last, LAS unsigned char* lds) {
  const SchedSsmY S{p.ws + OFF_Z2 + Z2_UG, p.ws + OFF_TF, c.blk, c.nblk}; const EpiSsmY E{(bf16_t*)(p.ws + OFF_Z2 + Z2_GG), last ? 1 : 0};
  gm::gemm_phase<true>(lds, 768, 768, 768, S, E);
}

struct EpiGlu {
  const bf16_t* Gg; bf16_t* Cat; const float* bg;
  __device__ __forceinline__ void operator()(const Acc& acc, const gm::Unit& u, int wr, int wc, int fr, int fq) const { const int pm = u.pm, pn = u.pn;
#pragma unroll
    for (int ai = 0; ai < 2; ++ai)
#pragma unroll
      for (int m = 0; m < 4; ++m) { const int row = pm * 256 + ai * 128 + wr * 64 + m * 16 + fr;
#pragma unroll
        for (int bj = 0; bj < 2; ++bj)
#pragma unroll
          for (int n = 0; n < 2; ++n) { const int col = pn * 256 + bj * 128 + wc * 32 + n * 16 + fq * 4; const f32x4 z = acc[ai][bj][m][n] + *(const f32x4*)(bg + col);
            const u32x2 gw = *(const u32x2*)(Gg + (size_t)row * 512 + col);
            const float g0 = __uint_as_float(gw[0] << 16), g1 = __uint_as_float(gw[0] & 0xffff0000u), g2 = __uint_as_float(gw[1] << 16), g3 = __uint_as_float(gw[1] & 0xffff0000u);
            u32x2 w = {cvtpk(g0 * sigmoidf_(z[0]), g1 * sigmoidf_(z[1])), cvtpk(g2 * sigmoidf_(z[2]), g3 * sigmoidf_(z[3]))};
            *(u32x2*)(Cat + (size_t)row * DM + 1024 + col) = w; } }
  }
};
__device__ __forceinline__ void phase_glu(const Params& p, const Ctx& c, int l, bool last, LAS unsigned char* lds) {
  SchedMN S; S.A = p.ws + OFF_Z2 + Z2_GG; S.B = p.ws + OFF_WGLU; S.strA = (size_t)256 * 512 * 2; S.strB = (size_t)256 * 512 * 2; S.blk = c.blk; S.nblk = c.nblk;
  S.nM = last ? 64 : 68; S.latonly = last ? 1 : 0; S.nN = 2; S.pn0 = 0; S.nextra = 0;
  EpiGlu E; E.Gg = (const bf16_t*)(p.ws + OFF_Z2 + Z2_GG); E.Cat = (bf16_t*)(p.ws + OFF_Z2 + Z2_CAT); E.bg = p.b_glu + (size_t)l * 512;
  gm::gemm_phase<true>(lds, 512, 512, 512, S, E);
}

struct EpiF32 {
  float* O;
  __device__ __forceinline__ void operator()(const Acc& acc, const gm::Unit& u, int wr, int wc, int fr, int fq) const {
    float* dst = O + (size_t)u.pm * 256 * DM + u.pn * 256 + wc * 32 + fq * 4;
#pragma unroll
    for (int ai = 0; ai < 2; ++ai)
#pragma unroll
      for (int m = 0; m < 4; ++m) { float* dr = dst + (size_t)(ai * 128 + wr * 64 + m * 16 + fr) * DM;
#pragma unroll
        for (int bj = 0; bj < 2; ++bj)
#pragma unroll
          for (int n = 0; n < 2; ++n) *(f32x4*)(dr + bj * 128 + n * 16) = acc[ai][bj][m][n]; }
  }
};
template <int KK>
__device__ __forceinline__ void phase_gemm_f32out(const Params& p, const Ctx& c, bool last, const char* A, const char* W, LAS unsigned char* lds) {
  SchedMN S; S.A = A; S.B = W; S.strA = (size_t)256 * KK * 2; S.strB = (size_t)256 * KK * 2; S.blk = c.blk; S.nblk = c.nblk;
  S.nM = last ? 64 : 68; S.latonly = last ? 1 : 0; S.nN = 8; S.pn0 = 0; S.nextra = 0;
  EpiF32 E; E.O = (float*)(p.ws + OFF_Z1);
  gm::gemm_phase<true>(lds, KK, KK, KK, S, E);
}

struct EpiGU {
  bf16_t* ACT;
  __device__ __forceinline__ void operator()(const Acc& acc, const gm::Unit& u, int wr, int wc, int fr, int fq) const {
    bf16_t* dst = ACT + (size_t)u.pm * 256 * DFF + u.pn * 128 + wc * 32 + fq * 4;
#pragma unroll
    for (int ai = 0; ai < 2; ++ai)
#pragma unroll
      for (int m = 0; m < 4; ++m) { bf16_t* dr = dst + (size_t)(ai * 128 + wr * 64 + m * 16 + fr) * DFF;
#pragma unroll
        for (int n = 0; n < 2; ++n) { const f32x4 g = acc[ai][0][m][n], uu = acc[ai][1][m][n];
          u32x2 w = {cvtpk(g[0] * sigmoidf_(g[0]) * uu[0], g[1] * sigmoidf_(g[1]) * uu[1]), cvtpk(g[2] * sigmoidf_(g[2]) * uu[2], g[3] * sigmoidf_(g[3]) * uu[3])};
          *(u32x2*)(dr + n * 16) = w; } }
  }
};
__device__ __forceinline__ void phase_gemm_gu(const Params& p, const Ctx& c, bool last, LAS unsigned char* lds) {
  SchedMN S; S.A = p.ws + OFF_HN; S.B = p.ws + OFF_WGU; S.strA = (size_t)256 * DM * 2; S.strB = (size_t)256 * DM * 2; S.blk = c.blk; S.nblk = c.nblk;
  S.nM = last ? 64 : 68; S.latonly = last ? 1 : 0; S.nN = 44; S.pn0 = 0; S.nextra = 0;
  EpiGU E; E.ACT = (bf16_t*)(p.ws + OFF_Z2);
  gm::gemm_phase<true>(lds, DM, DM, DM, S, E);
}

__device__ __forceinline__ void phase_attn(const Params& p, const Ctx& c, int l, char* lds) {
  const bf16_t* Qb = (const bf16_t*)(p.ws + OFF_Z1 + Z1_Q); const bf16_t* Kb = (const bf16_t*)(p.ws + OFF_Z1 + Z1_K); const bf16_t* Vb = (const bf16_t*)(p.ws + OFF_Z1 + Z1_V);
  bf16_t* O = (bf16_t*)(p.ws + OFF_HN);
  const int ntot = (l == 0) ? 1024 + 64 : 1024;
  for (int v = c.blk; v < ntot; v += c.nblk) {
    int combo, qb, seq;
    if (v < 1024) { const int rd = v >> 8, w = v & 255; combo = rd * 16 + (w & 7) * 2 + ((w >> 3) >> 4); qb = 1 + ((w >> 3) & 15); seq = TPB; }
    else { combo = v - 1024; qb = 0; seq = CTXL; }
    const int e = combo & 1, mp = (combo >> 1) & 1, h = (combo >> 2) & 3, b = combo >> 4;
    const size_t r0 = (size_t)b * TPB;
    at::body(Qb + (r0 + qb * 256) * 1024 + (h * 2 + mp) * 128, Kb + r0 * 1024 + (h * 2 + mp) * 128, Vb + r0 * 1024 + h * 256 + e * 128,
             O + (r0 + qb * 256) * DM + (h * 2 + mp) * 256 + e * 128, seq, lds);
  }
}

__device__ __forceinline__ void phase_combine(const Params& p, const Ctx& c, int l, bool last) {
  const bf16_t* O = (const bf16_t*)(p.ws + OFF_HN); bf16_t* Cat = (bf16_t*)(p.ws + OFF_Z2 + Z2_CAT);
  const float* FC = (const float*)(p.ws + OFF_Z2 + Z2_FC); const float* FS = (const float*)(p.ws + OFF_Z2 + Z2_FS);
  const float lam_init = 0.8f - 0.6f * expf(-0.3f * (float)l);
  float lam;
  { const float a1 = p.lam_q1[l * 128 + c.lane] * p.lam_k1[l * 128 + c.lane] + p.lam_q1[l * 128 + 64 + c.lane] * p.lam_k1[l * 128 + 64 + c.lane];
    const float a2 = p.lam_q2[l * 128 + c.lane] * p.lam_k2[l * 128 + c.lane] + p.lam_q2[l * 128 + 64 + c.lane] * p.lam_k2[l * 128 + 64 + c.lane];
    lam = expf(wave_sum(a1)) - expf(wave_sum(a2)) + lam_init; }
  const f32x4 gs = *(const f32x4*)(p.g_subln + (size_t)l * 256 + c.lane * 4);
  for (int row = c.gwave; row < TT; row += c.nwave) { const int t = row % TPB; if (last && t < CTXL) continue;
    const bf16_t* orow = O + (size_t)row * DM; bf16_t* crow_ = Cat + (size_t)row * DM;
#pragma unroll
    for (int h = 0; h < 4; ++h) { const u32x2 a = *(const u32x2*)(orow + (h * 2) * 256 + c.lane * 4), bq = *(const u32x2*)(orow + (h * 2 + 1) * 256 + c.lane * 4);
      f32x4 o; o[0] = __uint_as_float(a[0] << 16) - lam * __uint_as_float(bq[0] << 16); o[1] = __uint_as_float(a[0] & 0xffff0000u) - lam * __uint_as_float(bq[0] & 0xffff0000u);
      o[2] = __uint_as_float(a[1] << 16) - lam * __uint_as_float(bq[1] << 16); o[3] = __uint_as_float(a[1] & 0xffff0000u) - lam * __uint_as_float(bq[1] & 0xffff0000u);
      const float ss = wave_sum(o[0] * o[0] + o[1] * o[1] + o[2] * o[2] + o[3] * o[3]); const float r = rsqrtf(ss * (1.f / 256.f) + 1e-5f) * (1.f - lam_init);
      o = o * r * gs; u32x2 w = {cvtpk(o[0], o[1]), cvtpk(o[2], o[3])}; *(u32x2*)(crow_ + h * 256 + c.lane * 4) = w; }
#pragma unroll
    for (int q = 0; q < 2; ++q) { const int col = q * 256 + c.lane * 4; const size_t o5 = (size_t)row * 512 + col;
      const f32x4 f = *(const f32x4*)(FC + o5) - *(const f32x4*)(FS + o5) + *(const f32x4*)(p.b_four + (size_t)l * 512 + col);
      u32x2 wf = {cvtpk(f[0], f[1]), cvtpk(f[2], f[3])}; *(u32x2*)(crow_ + 1536 + col) = wf; }
  }
}


#define XB_TMO      128
#define XB_XCNT(j)  (256  + 64 * (j))
#define XB_XSUB(j)  (1280 + 64 * (j))
#define XB_XGEN(j)  (2304 + 64 * (j))
#define XB_TOP      3328
#define XB_TOPGEN   3392
#define XCD_BAR_WORDS 3456
#define XB_SPIN_CAP (1u << 18)
__device__ __forceinline__ unsigned xb_ld(unsigned* p)              { return __hip_atomic_load(p, __ATOMIC_RELAXED, __HIP_MEMORY_SCOPE_AGENT); }
__device__ __forceinline__ unsigned xb_add(unsigned* p, unsigned v) { return __hip_atomic_fetch_add(p, v, __ATOMIC_RELAXED, __HIP_MEMORY_SCOPE_AGENT); }
__device__ __forceinline__ unsigned xb_xcc_id() { return (unsigned)__builtin_amdgcn_s_getreg((3 << 11) | 20) & 0xFu; }
#define XB_SPIN(cond, bar) do { unsigned _sp = 0; while (cond) { __builtin_amdgcn_s_sleep(1); \
    if ((++_sp & 255u) == 0u) { if (xb_ld(&(bar)[XB_TMO])) break; if (_sp > XB_SPIN_CAP) { atomicAdd(&(bar)[XB_TMO], 1u); break; } } } } while (0)
struct XcdBarrier { unsigned* bar; unsigned x; volatile LAS unsigned* st; };
__device__ __forceinline__ XcdBarrier xcd_barrier_post(unsigned* bar, volatile LAS unsigned* st) {
  XcdBarrier b; b.bar = bar; b.x = xb_xcc_id(); b.st = st;
  if (threadIdx.x == 0) (void)xb_add(&bar[XB_XCNT(b.x)], 1u);
  return b;
}
__device__ __forceinline__ void xcd_barrier_complete(unsigned* bar, unsigned x, unsigned& nloc, unsigned& nx) {
  const unsigned G = gridDim.x * gridDim.y * gridDim.z;
  unsigned sum, cnt, mine, sp = 0u;
  for (;;) {
    sum = 0u; cnt = 0u; mine = 0u;
#pragma unroll
    for (unsigned j = 0; j < 16; ++j) { const unsigned c = xb_ld(&bar[XB_XCNT(j)]); sum += c; cnt += (c > 0u) ? 1u : 0u; mine = (j == x) ? c : mine; }
    if (sum == G) break;
    __builtin_amdgcn_s_sleep(1);
    if ((++sp & 255u) == 0u) { if (xb_ld(&bar[XB_TMO])) break; if (sp > XB_SPIN_CAP) { atomicAdd(&bar[XB_TMO], 1u); break; } }
  }
  nloc = mine > 0u ? mine : 1u; nx = cnt > 0u ? cnt : 1u;
}
__device__ __forceinline__ void xcd_barrier(const XcdBarrier& b) {
  asm volatile("s_waitcnt vmcnt(0)" ::: "memory");
  __syncthreads();
  if (threadIdx.x == 0) {
    unsigned* bar = b.bar;
    __builtin_amdgcn_s_waitcnt(0);
    unsigned nloc = b.st[0], nx = b.st[1];
    if (nloc == 0u) { xcd_barrier_complete(bar, b.x, nloc, nx); b.st[0] = nloc; b.st[1] = nx; }
    const unsigned old = xb_add(&bar[XB_XSUB(b.x)], 1u);
    const unsigned gen = old / nloc;
    if (old + 1u == (gen + 1u) * nloc) {
      __builtin_amdgcn_fence(__ATOMIC_RELEASE, "agent");
      asm volatile("s_waitcnt vmcnt(0)" ::: "memory");
      const unsigned og = xb_add(&bar[XB_TOP], 1u);
      const unsigned tg = og / nx;
      if (og + 1u == (tg + 1u) * nx) xb_add(&bar[XB_TOPGEN], 1u);
      else XB_SPIN(xb_ld(&bar[XB_TOPGEN]) == tg, bar);
      __builtin_amdgcn_fence(__ATOMIC_ACQUIRE, "agent");
      xb_add(&bar[XB_XGEN(b.x)], 1u);
      asm volatile("s_waitcnt vmcnt(0)" ::: "memory");
    } else {
      XB_SPIN(xb_ld(&bar[XB_XGEN(b.x)]) == gen, bar);
      __builtin_amdgcn_fence(__ATOMIC_ACQUIRE, "agent");
      asm volatile("s_waitcnt vmcnt(0)" ::: "memory");
    }
  }
  __syncthreads();
}

__global__ void __launch_bounds__(NTHREADS) mega(Params p_arg) {
  extern __shared__ __attribute__((aligned(16))) char shm[];
  __shared__ uint4 xb_words;
  cg::grid_group grid = cg::this_grid();
  typedef const __attribute__((address_space(4))) Params* KP;
  KP kp = (KP)__builtin_amdgcn_kernarg_segment_ptr();
  unsigned* bar = (unsigned*)(p_arg.ws + OFF_BAR);
  if (threadIdx.x == 0) xb_words = make_uint4(0u, 0u, 0u, 0u);
  if (blockIdx.x == 0) for (int i = threadIdx.x; i < XCD_BAR_WORDS; i += NTHREADS) bar[i] = 0u;
  __syncthreads();
  Ctx c;
#define RECTX() do { asm volatile("" : "+s"(kp)); int t_ = threadIdx.x; asm volatile("" : "+v"(t_)); int b_ = blockIdx.x; asm volatile("" : "+s"(b_)); \
    c.tid = t_; c.wid = t_ >> 6; c.lane = t_ & 63; c.blk = b_; c.nblk = gridDim.x; c.gwave = c.blk * 8 + c.wid; c.nwave = c.nblk * 8; \
    c.gtid = (long)c.blk * NTHREADS + c.tid; c.nthr = (long)c.nblk * NTHREADS; } while (0)
  RECTX();
  LAS unsigned char* gshm = (LAS unsigned char*)shm; float* fl = (float*)shm;

#define PP (*(const Params*)kp)
#define GSYNC() do { RECTX(); XcdBarrier xb_; xb_.bar = (unsigned*)(kp->ws + OFF_BAR); xb_.x = xb_xcc_id(); xb_.st = (volatile LAS unsigned*)&xb_words; xcd_barrier(xb_); } while (0)
  phase0a(PP, c, fl);
  RECTX(); ssm_tables(PP, c);
  RECTX(); convert_weights(PP, c, 0, fl);
  grid.sync();
  RECTX(); if (threadIdx.x == 0) (void)xb_add((unsigned*)(kp->ws + OFF_BAR) + XB_XCNT(xb_xcc_id()), 1u);
  RECTX(); reduce_mod(PP, c);
  RECTX(); fold_four(PP, c, 0, fl);
  RECTX(); ssm_build_mef(PP, c, 0);
  GSYNC();
  RECTX(); ssm_build_t(PP, c, 0);
  RECTX(); phase_prenorm(PP, c, 0);
  GSYNC();
  for (int l = 0; l < 2; ++l) {
    const bool last = (l == 1);
    RECTX(); phase_gemm_in(PP, c, l, gshm);
    GSYNC();
    RECTX(); phase_fourier(PP, c, l, gshm);
    RECTX(); phase_ssm_states(PP, c, gshm);
    GSYNC();
    RECTX(); ssm_carry(PP, c, l);
    RECTX(); phase_attn(PP, c, l, shm);
    GSYNC();
    RECTX(); phase_ssm_y(PP, c, last, gshm);
    RECTX(); phase_combine(PP, c, l, last);
    GSYNC();
    RECTX(); phase_glu(PP, c, l, last, gshm);
    GSYNC();
    RECTX(); phase_gemm_f32out<DM>(PP, c, last, kp->ws + OFF_Z2 + Z2_CAT, kp->ws + OFF_WOUT, gshm);
    GSYNC();
    if (!last) { RECTX(); ssm_build_mef(PP, c, 1); }
    RECTX(); phase_postmix(PP, c, l, last);
    GSYNC();
    RECTX(); phase_gemm_gu(PP, c, last, gshm);
    GSYNC();
    RECTX(); phase_gemm_f32out<DFF>(PP, c, last, kp->ws + OFF_Z2, kp->ws + OFF_WD, gshm);
    GSYNC();
    if (!last) { RECTX(); ssm_build_t(PP, c, 1); }
    RECTX(); phase_postffn(PP, c, l, last);
    if (!last) { RECTX(); convert_weights(PP, c, 1, fl); RECTX(); fold_four(PP, c, 1, fl); GSYNC(); }
  }
}

extern "C" void kernel_launch(void* const* d_in, const int* in_sizes, int n_in, void* d_out, int out_size, void* d_ws, size_t ws_size,
                              hipStream_t stream) {
  static int grid_blocks = 0;
  if (!grid_blocks) {
    (void)hipFuncSetAttribute((const void*)mega, hipFuncAttributeMaxDynamicSharedMemorySize, SHM_BYTES);
    int dev = 0, cus = 0, per_cu = 0;
    (void)hipGetDevice(&dev);
    (void)hipDeviceGetAttribute(&cus, hipDeviceAttributeMultiprocessorCount, dev);
    (void)hipOccupancyMaxActiveBlocksPerMultiprocessor(&per_cu, mega, NTHREADS, SHM_BYTES);
    if (per_cu < 1) per_cu = 1;
    grid_blocks = cus;
  }
  if (n_in != 32 || ws_size < WS_NEED) { fprintf(stderr, "kernel_launch: bad n_in %d or ws %zu < %zu\n", n_in, ws_size, WS_NEED); return; }
  Params p{};
  const float** f = (const float**)&p;
  for (int i = 0; i < 32; ++i) f[i] = (const float*)d_in[i];
  p.out = (float*)d_out; p.ws = (char*)d_ws;
  void* args[] = {&p};
  hipError_t e = hipLaunchCooperativeKernel((void*)mega, dim3(grid_blocks), dim3(NTHREADS), args, SHM_BYTES, stream);
  if (e != hipSuccess) fprintf(stderr, "cooperative launch failed: %s (grid %d)\n", hipGetErrorString(e), grid_blocks);
}
```

```cpp
#include <hip/hip_runtime.h>
#include <hip/hip_cooperative_groups.h>
#include <cstdio>
#include <cstdint>
namespace cg = cooperative_groups;

typedef unsigned short bf16_t;
using bf16x8 = __attribute__((ext_vector_type(8))) short;
using s16x4  = __attribute__((ext_vector_type(4))) short;
using f32x4  = __attribute__((ext_vector_type(4))) float;
using f32x16 = __attribute__((ext_vector_type(16))) float;
using u32x4  = __attribute__((ext_vector_type(4))) unsigned;
using u32x2  = __attribute__((ext_vector_type(2))) unsigned;
#define LAS __attribute__((address_space(3)))

constexpr int NB = 4, SEQ = 4096, CTXL = 256, TPB = SEQ + CTXL  , TT = NB * TPB  ;
constexpr int DM = 2048, NIN = 4608, DFF = 5632, NMODC = 6 * DM  ;
constexpr int NTHREADS = 512, SHM_BYTES = 131072;

constexpr size_t al256(size_t x) { return (x + 255) / 256 * 256; }
constexpr size_t OFF_X    = 0;
constexpr size_t OFF_WIN  = OFF_X + (size_t)TT * DM * 4;
constexpr size_t OFF_WOUT = OFF_WIN + (size_t)NIN * DM * 2;
constexpr size_t OFF_WGU  = OFF_WOUT + (size_t)DM * DM * 2;
constexpr size_t OFF_WD   = OFF_WGU + (size_t)2 * DFF * DM * 2;
constexpr size_t OFF_WGLU = OFF_WD + (size_t)DM * DFF * 2;
constexpr size_t OFF_DFTL = OFF_WGLU + (size_t)512 * 512 * 2;
constexpr size_t OFF_DFTC = OFF_DFTL + (size_t)2 * 4096 * 4096 * 2;
constexpr size_t OFF_MP   = OFF_DFTC + (size_t)2 * 256 * 256 * 2;
constexpr size_t OFF_MOD  = OFF_MP + (size_t)16 * 5 * 24576 * 4;
constexpr size_t OFF_ROPE = OFF_MOD + (size_t)2 * 5 * NMODC * 4;
constexpr size_t OFF_WCS  = OFF_ROPE + (size_t)2 * 64 * 32 * 4;
constexpr size_t OFF_PW   = OFF_WCS + (size_t)2 * 2 * 4 * 128 * 128 * 4;
constexpr size_t OFF_BB   = OFF_PW + (size_t)2 * 32 * 2 * 33 * 64 * 8;
constexpr size_t OFF_MK   = OFF_BB + (size_t)2 * 32 * 2 * 64 * 16 * 8;
constexpr size_t OFF_TF   = OFF_MK + (size_t)2 * 32 * 2 * 32 * 256 * 4;
constexpr size_t OFF_EM   = OFF_TF + (size_t)32 * 512 * 768 * 2;
constexpr size_t OFF_BAR  = OFF_EM + (size_t)32 * 256 * 512 * 2;
constexpr size_t OFF_HN   = OFF_BAR + 16384;
constexpr size_t OFF_Z1   = OFF_HN + (size_t)TT * DM * 2;
constexpr size_t Z1_Q = 0, Z1_K = (size_t)TT * 1024 * 2, Z1_V = 2 * Z1_K;
constexpr size_t OFF_Z2   = OFF_Z1 + (size_t)TT * DM * 4;
constexpr size_t Z2_FC = 0, Z2_FS = Z2_FC + (size_t)TT * 512 * 4;
constexpr size_t Z2_UG = Z2_FS + (size_t)TT * 512 * 4;
constexpr size_t Z2_SB = Z2_UG + (size_t)32 * 768 * 768 * 2;
constexpr size_t Z2_CAT = Z2_SB + (size_t)32 * 768 * 256 * 4;
constexpr size_t Z2_GG = Z2_CAT + (size_t)TT * DM * 2;
constexpr size_t Z2_END = Z2_GG + (size_t)TT * 512 * 2;
constexpr size_t Z2_SIZE = Z2_END > (size_t)TT * DFF * 2 ? Z2_END : (size_t)TT * DFF * 2;
constexpr size_t WS_NEED = OFF_Z2 + Z2_SIZE;
static_assert(WS_NEED <= (size_t)805306368, "workspace over 768 MiB");


struct Params {
  const float *x, *c, *ctx, *c_ctx, *w_mod, *b_mod, *g_mix_pre, *g_mix_post, *g_ffn_pre, *g_ffn_post, *w_in, *w_out;
  const float *lam_q1, *lam_k1, *lam_q2, *lam_k2, *g_subln, *ssm_a_re, *ssm_a_im, *ssm_log_dt, *ssm_b_re, *ssm_b_im;
  const float *ssm_c_re, *ssm_c_im, *ssm_d, *w_glu, *b_glu, *w_four, *b_four, *w_gate, *w_up, *w_down;
  float* out; char* ws;
};

__device__ __forceinline__ unsigned cvtpk(float lo, float hi) { unsigned r; asm volatile("v_cvt_pk_bf16_f32 %0, %1, %2" : "=v"(r) : "v"(lo), "v"(hi)); return r; }
__device__ __forceinline__ float bf2f(unsigned short b) { return __uint_as_float((unsigned)b << 16); }
__device__ __forceinline__ float wave_sum(float v) {
  v += __shfl_xor(v, 32); v += __shfl_xor(v, 16); v += __shfl_xor(v, 8); v += __shfl_xor(v, 4); v += __shfl_xor(v, 2); v += __shfl_xor(v, 1); return v;
}
__device__ __forceinline__ void my_sincos(float x, float& s, float& c) {
  const double xd = (double)x; const double kd = rint(xd * 0.63661977236758134); const double r = xd - kd * 1.5707963267948966;
  const double r2 = r * r;
  const double sn = r * (1.0 - r2 / 6.0 * (1.0 - r2 / 20.0 * (1.0 - r2 / 42.0 * (1.0 - r2 / 72.0 * (1.0 - r2 / 110.0 * (1.0 - r2 / 156.0))))));
  const double cs = 1.0 - r2 / 2.0 * (1.0 - r2 / 12.0 * (1.0 - r2 / 30.0 * (1.0 - r2 / 56.0 * (1.0 - r2 / 90.0 * (1.0 - r2 / 132.0)))));
  const int q = ((int)kd) & 3;
  const double ss = (q == 0) ? sn : (q == 1) ? cs : (q == 2) ? -sn : -cs;
  const double cc = (q == 0) ? cs : (q == 1) ? -sn : (q == 2) ? -cs : sn;
  s = (float)ss; c = (float)cc;
}
__device__ __forceinline__ float sigmoidf_(float x) { return 1.f / (1.f + __expf(-x)); }
__device__ __forceinline__ float gelu_tanh(float y) { const float u = 0.7978845608028654f * (y + 0.044715f * y * y * y); return y * sigmoidf_(2.f * u); }

namespace gm {
constexpr int BM = 256, BK = 64, HALF = 128, HTB = HALF * BK * 2, NXCD = 8, WGM = 8;
__device__ __forceinline__ int lds_byte(int r, int c) { const int st = (r >> 4) * 2 + (c >> 5), rr = r & 15, cc = c & 31, ob = rr * 64 + cc * 2; return st * 1024 + (ob ^ (((ob >> 9) & 1) << 5)); }
__device__ __forceinline__ void stage_rc(int b, int& R, int& C) { const int st = b / 1024, sb = b % 1024, swz = sb ^ (((sb >> 9) & 1) << 5); R = (st >> 1) * 16 + swz / 64; C = (st & 1) * 32 + (swz % 64) / 2; }
__device__ __forceinline__ void tile_of(int wgid, int nM, int nN, int& pm, int& pn) {
  const int nwg = nM * nN; { const int q = nwg / NXCD, r = nwg % NXCD, xcd = wgid % NXCD, off = wgid / NXCD; wgid = (xcd < r ? xcd * (q + 1) : r * (q + 1) + (xcd - r) * q) + off; }
  const int nig = WGM * nN, gid = wgid / nig, fm = gid * WGM, gsz = (nM - fm) < WGM ? (nM - fm) : WGM;
  pm = fm + ((wgid % nig) % gsz); pn = (wgid % nig) / gsz;
}
struct Unit { int pm, pn; };

template <bool SWAP, class Epi, class Sched>
__device__ __forceinline__ void gemm_phase(LAS unsigned char* lds, const int lda, const int ldb, const int K, const Sched& S, const Epi& E) {
  int tid_ = threadIdx.x; asm volatile("" : "+v"(tid_));
  const int tid = tid_, wid = __builtin_amdgcn_readfirstlane(tid >> 6), lane = tid & 63, wr = wid >> 2, wc = wid & 3, fr = lane & 15, fq = lane >> 4;
  const int nt = K / BK;
  unsigned voffA[2], voffB[2];
#pragma unroll
  for (int i = 0; i < 2; ++i) { int R, C; stage_rc(tid * 16 + i * 8192, R, C); voffA[i] = (unsigned)(R * lda + C) * 2u; voffB[i] = (unsigned)(R * ldb + C) * 2u; }
  const size_t kstep = (size_t)(BK * 2), hstepA = (size_t)HALF * lda * 2, hstepB = (size_t)HALF * ldb * 2;
  const unsigned ldsw = (unsigned)wid * 1024u;
  const int aoff = lds_byte(wr * 64 + fr, fq * 8), boff = lds_byte(wc * 32 + fr, fq * 8);
#define PG8_SA(b, h) (((b) * 2 + (h)) * HTB)
#define PG8_SB(b, h) ((4 + (b) * 2 + (h)) * HTB)
#define PG8_STAGE(bufoff, gbase, voff) do { _Pragma("unroll") for (int _i = 0; _i < 2; ++_i) \
    __builtin_amdgcn_global_load_lds((const unsigned*)((const char*)(gbase) + (voff)[_i]), (LAS unsigned*)(lds + (bufoff) + ldsw + _i * 8192), 16, 0, 0); } while (0)
#define PG8_LDA(dst, b, h) do { _Pragma("unroll") for (int m = 0; m < 4; ++m) _Pragma("unroll") for (int k = 0; k < 2; ++k) dst[m][k] = *(const LAS bf16x8*)(lds + PG8_SA(b, h) + aoff + m * 2048 + k * 1024); } while (0)
#define PG8_LDB(dst, b, h) do { _Pragma("unroll") for (int n = 0; n < 2; ++n) _Pragma("unroll") for (int k = 0; k < 2; ++k) dst[n][k] = *(const LAS bf16x8*)(lds + PG8_SB(b, h) + boff + n * 2048 + k * 1024); } while (0)
#define PG8_MMA(ai, bj, At, Bt) do { __builtin_amdgcn_s_setprio(1); _Pragma("unroll") for (int m = 0; m < 4; ++m) _Pragma("unroll") for (int n = 0; n < 2; ++n) _Pragma("unroll") for (int k = 0; k < 2; ++k) \
    acc[ai][bj][m][n] = SWAP ? __builtin_amdgcn_mfma_f32_16x16x32_bf16(Bt[n][k], At[m][k], acc[ai][bj][m][n], 0, 0, 0) \
                             : __builtin_amdgcn_mfma_f32_16x16x32_bf16(At[m][k], Bt[n][k], acc[ai][bj][m][n], 0, 0, 0); __builtin_amdgcn_s_setprio(0); } while (0)
#define PG8_WAIT_V(n) asm volatile("s_waitcnt vmcnt(" #n ")" ::: "memory")
#define PG8_WAIT_L(n) asm volatile("s_waitcnt lgkmcnt(" #n ")" ::: "memory")
#define PG8_BAR __builtin_amdgcn_s_barrier()
#define PG8_SCHED __builtin_amdgcn_sched_barrier(0)
  Unit cur, nxt; int ui = 0;
  if (!S.next(0, cur)) return;
  f32x4 acc[2][2][4][2];
#pragma unroll
  for (int a = 0; a < 2; ++a)
#pragma unroll
    for (int b = 0; b < 2; ++b)
#pragma unroll
      for (int m = 0; m < 4; ++m)
#pragma unroll
        for (int n = 0; n < 2; ++n) acc[a][b][m][n] = (f32x4){0.f, 0.f, 0.f, 0.f};
  bf16x8 At[4][2], B0[2][2], B1[2][2];
  const char* cA = S.pA(cur); const char* cB = S.pB(cur);
  PG8_STAGE(PG8_SB(0, 0), cB, voffB); PG8_STAGE(PG8_SB(0, 1), cB + hstepB, voffB); PG8_STAGE(PG8_SA(0, 0), cA, voffA); PG8_STAGE(PG8_SA(0, 1), cA + hstepA, voffA);
  if (wr == 1) PG8_BAR;
  PG8_WAIT_V(2); PG8_BAR;
  PG8_STAGE(PG8_SB(1, 0), cB + kstep, voffB); PG8_STAGE(PG8_SA(1, 0), cA + kstep, voffA); PG8_STAGE(PG8_SB(1, 1), cB + hstepB + kstep, voffB);
  PG8_WAIT_V(6); PG8_BAR;
  for (;;) {
    const bool has_next = S.next(ui + 1, nxt);
    const char* nA = has_next ? S.pA(nxt) : cA; const char* nB = has_next ? S.pB(nxt) : cB;
    for (int t = 0; t < nt; t += 2) {
      const bool last = (t == nt - 2);
      const char* a1 = cA + (size_t)(t + 1) * kstep;
      const char* a2 = last ? nA : cA + (size_t)(t + 2) * kstep; const char* b2 = last ? nB : cB + (size_t)(t + 2) * kstep;
      const char* a3 = a2 + kstep; const char* b3 = b2 + kstep;
      PG8_LDB(B0, 0, 0); PG8_LDB(B1, 0, 1); PG8_SCHED; PG8_LDA(At, 0, 0); PG8_STAGE(PG8_SA(1, 1), a1 + hstepA, voffA);
      PG8_WAIT_V(8); PG8_WAIT_L(0); PG8_BAR; PG8_MMA(0, 0, At, B0); PG8_MMA(0, 1, At, B1); PG8_BAR; PG8_SCHED;
      PG8_LDA(At, 0, 1); PG8_STAGE(PG8_SB(0, 0), b2, voffB); PG8_STAGE(PG8_SB(0, 1), b2 + hstepB, voffB); PG8_STAGE(PG8_SA(0, 0), a2, voffA);
      PG8_WAIT_V(8); PG8_WAIT_L(0); PG8_BAR; PG8_MMA(1, 0, At, B0); PG8_MMA(1, 1, At, B1); PG8_BAR; PG8_SCHED;
      PG8_LDB(B0, 1, 0); PG8_LDB(B1, 1, 1); PG8_SCHED; PG8_LDA(At, 1, 0); PG8_STAGE(PG8_SA(0, 1), a2 + hstepA, voffA);
      PG8_WAIT_V(8); PG8_WAIT_L(0); PG8_BAR; PG8_MMA(0, 0, At, B0); PG8_MMA(0, 1, At, B1); PG8_BAR; PG8_SCHED;
      PG8_LDA(At, 1, 1); PG8_STAGE(PG8_SB(1, 0), b3, voffB); PG8_STAGE(PG8_SB(1, 1), b3 + hstepB, voffB); PG8_STAGE(PG8_SA(1, 0), a3, voffA);
      PG8_WAIT_V(8); PG8_WAIT_L(0); PG8_BAR; PG8_MMA(1, 0, At, B0); PG8_MMA(1, 1, At, B1); PG8_BAR; PG8_SCHED;
    }
    if (wr == 0) PG8_BAR;
    { int fr2 = fr, fq2 = fq; asm volatile("" : "+v"(fr2), "+v"(fq2));
      E(acc, cur, wr, wc, fr2, fq2); }
    if (!has_next) break;
#pragma unroll
    for (int a = 0; a < 2; ++a)
#pragma unroll
      for (int b = 0; b < 2; ++b)
#pragma unroll
        for (int m = 0; m < 4; ++m)
#pragma unroll
          for (int n = 0; n < 2; ++n) acc[a][b][m][n] = (f32x4){0.f, 0.f, 0.f, 0.f};
    cur = nxt; cA = nA; cB = nB; ++ui;
    if (wr == 1) PG8_BAR;
  }
  PG8_WAIT_V(0);
  PG8_BAR;
#undef PG8_SA
#undef PG8_SB
#undef PG8_STAGE
#undef PG8_LDA
#undef PG8_LDB
#undef PG8_MMA
#undef PG8_WAIT_V
#undef PG8_WAIT_L
#undef PG8_BAR
#undef PG8_SCHED
}
}

namespace at {
constexpr int D = 128, NW = 8, QBLK = 32, KVBLK = 64;
constexpr float SCALE = 0.088388347648318440f;
constexpr float THR = 8.f;
constexpr int LDQ = 1024, LDK = 1024, LDV = 1024, LDO = 2048;
constexpr size_t SHM_V = KVBLK * D * 2, SHM_K = KVBLK * D * 2;
#define KSWZ(row, colB) ((row) * 256 + ((colB) ^ (((row) & 7) << 4)))
#define SBAR() __builtin_amdgcn_sched_barrier(0)
__device__ __forceinline__ int crow(int r, int hi) { return (r & 3) + 8 * (r >> 2) + 4 * hi; }
__device__ __forceinline__ void partialSM(f32x16& p0, f32x16& p1, float& m_reg, float& mn, float& alpha) {
  constexpr float C = SCALE * 1.4426950408889634f;
  float pmax = p0[0];
#pragma unroll
  for (int r = 1; r < 16; ++r) pmax = fmaxf(pmax, p0[r]);
#pragma unroll
  for (int r = 0; r < 16; ++r) pmax = fmaxf(pmax, p1[r]);
  { auto rr = __builtin_amdgcn_permlane32_swap(__float_as_uint(pmax), __float_as_uint(pmax), false, false);
    pmax = fmaxf(__uint_as_float(rr[0]), __uint_as_float(rr[1])); }
  if (__builtin_expect(__all(pmax - m_reg <= THR / SCALE), 1)) { mn = m_reg; alpha = 1.f; }
  else { mn = fmaxf(m_reg, pmax); alpha = __builtin_amdgcn_exp2f((m_reg - mn) * C); m_reg = mn; }
  float mnC = -mn * C;
#pragma unroll
  for (int r = 0; r < 16; ++r) p0[r] = fmaf(p0[r], C, mnC);
#pragma unroll
  for (int r = 0; r < 16; ++r) p1[r] = fmaf(p1[r], C, mnC);
#pragma unroll
  for (int r = 0; r < 16; ++r) p0[r] = __builtin_amdgcn_exp2f(p0[r]);
}
__device__ __forceinline__ void finishSM(f32x16& p0, f32x16& p1, float alpha, float& l_reg, bf16x8& pa0, bf16x8& pa1, bf16x8& pa2, bf16x8& pa3) {
#pragma unroll
  for (int r = 0; r < 16; ++r) p1[r] = __builtin_amdgcn_exp2f(p1[r]);
  float ps = 0;
#pragma unroll
  for (int r = 0; r < 16; ++r) ps += p0[r];
#pragma unroll
  for (int r = 0; r < 16; ++r) ps += p1[r];
  { auto rr = __builtin_amdgcn_permlane32_swap(__float_as_uint(ps), __float_as_uint(ps), false, false);
    ps = __uint_as_float(rr[0]) + __uint_as_float(rr[1]); }
  l_reg = l_reg * alpha + ps;
#define PK4(P, BASE, OUT) do { unsigned a0 = cvtpk(P[BASE + 0], P[BASE + 1]), a1 = cvtpk(P[BASE + 2], P[BASE + 3]);   \
    unsigned b0 = cvtpk(P[BASE + 4], P[BASE + 5]), b1 = cvtpk(P[BASE + 6], P[BASE + 7]);                              \
    auto r0 = __builtin_amdgcn_permlane32_swap(a0, b0, false, false); auto r1 = __builtin_amdgcn_permlane32_swap(a1, b1, false, false); \
    u32x4 w = {r0[0], r1[0], r0[1], r1[1]}; OUT = *reinterpret_cast<bf16x8*>(&w); } while (0)
  PK4(p0, 0, pa0); PK4(p0, 8, pa1); PK4(p1, 0, pa2); PK4(p1, 8, pa3);
#undef PK4
}
__device__ __forceinline__ void qkt(f32x16& p0, f32x16& p1, const char* Ks, const bf16x8* qr, int r32, int hi) {
  p0 = f32x16{}; p1 = f32x16{};
#pragma unroll
  for (int d0 = 0; d0 < 8; ++d0) { int cb = (d0 * 16 + hi * 8) * 2;
    bf16x8 b0 = *reinterpret_cast<const bf16x8*>(Ks + KSWZ(r32, cb));
    bf16x8 b1 = *reinterpret_cast<const bf16x8*>(Ks + KSWZ(32 + r32, cb));
    p0 = __builtin_amdgcn_mfma_f32_32x32x16_bf16(b0, qr[d0], p0, 0, 0, 0);
    p1 = __builtin_amdgcn_mfma_f32_32x32x16_bf16(b1, qr[d0], p1, 0, 0, 0); }
}
__device__ __forceinline__ int v_st(int k, int c) { const int kk = (k & ~0xC) | ((k & 4) << 1) | ((k & 8) >> 1); return ((kk >> 3) * 4 + (c >> 5)) * 512 + ((kk & 7) * 32 + (c & 31)) * 2; }
__device__ __forceinline__ int v_rd_base(int lane) { return ((lane & 3) << 3) | (((lane >> 2) & 3) << 6) | (((lane >> 4) & 1) << 5) | (((lane >> 5) & 1) << 8); }
constexpr int v_rd_off(int d0, int ks, int half) { return d0 * 512 + ks * 4096 + half * 2048; }
template <int OFF> __device__ __forceinline__ s16x4 tr_read(int vb) {
  s16x4 r; asm volatile("ds_read_b64_tr_b16 %0, %1 offset:%2" : "=&v"(r) : "v"(vb), "i"(OFF) : "memory"); return r;
}
template <int D0> __device__ __forceinline__ void pv_one(f32x16& od, int vb, bf16x8 pa0, bf16x8 pa1, bf16x8 pa2, bf16x8 pa3) {
  const s16x4 l0 = tr_read<v_rd_off(D0, 0, 0)>(vb), h0 = tr_read<v_rd_off(D0, 0, 1)>(vb), l1 = tr_read<v_rd_off(D0, 1, 0)>(vb), h1 = tr_read<v_rd_off(D0, 1, 1)>(vb);
  const s16x4 l2 = tr_read<v_rd_off(D0, 2, 0)>(vb), h2 = tr_read<v_rd_off(D0, 2, 1)>(vb), l3 = tr_read<v_rd_off(D0, 3, 0)>(vb), h3 = tr_read<v_rd_off(D0, 3, 1)>(vb);
  asm volatile("s_waitcnt lgkmcnt(0)" ::: "memory"); SBAR();
#define PK(L, H) (bf16x8){L[0], L[1], L[2], L[3], H[0], H[1], H[2], H[3]}
  od = __builtin_amdgcn_mfma_f32_32x32x16_bf16(pa0, PK(l0, h0), od, 0, 0, 0);
  od = __builtin_amdgcn_mfma_f32_32x32x16_bf16(pa1, PK(l1, h1), od, 0, 0, 0);
  od = __builtin_amdgcn_mfma_f32_32x32x16_bf16(pa2, PK(l2, h2), od, 0, 0, 0);
  od = __builtin_amdgcn_mfma_f32_32x32x16_bf16(pa3, PK(l3, h3), od, 0, 0, 0);
#undef PK
}
__device__ __forceinline__ void pv_d0(f32x16* o, int vb, bf16x8 pa0, bf16x8 pa1, bf16x8 pa2, bf16x8 pa3) {
  pv_one<0>(o[0], vb, pa0, pa1, pa2, pa3); pv_one<1>(o[1], vb, pa0, pa1, pa2, pa3); pv_one<2>(o[2], vb, pa0, pa1, pa2, pa3); pv_one<3>(o[3], vb, pa0, pa1, pa2, pa3);
}
__device__ __forceinline__ void body(const bf16_t* __restrict__ Qb, const bf16_t* __restrict__ Kh, const bf16_t* __restrict__ Vh, bf16_t* __restrict__ Ob, int seq, char* lds) {
  int tid_ = threadIdx.x; asm volatile("" : "+v"(tid_));
  const int tid = tid_, wid = tid >> 6, lane = tid & 63, r32 = lane & 31, hi = lane >> 5;
  char* V_lds = lds; char* K_lds = lds + 2 * SHM_V;
  float* ws = (float*)(lds + 2 * SHM_V + 2 * SHM_K) + wid * 64; float* li_l = ws; float* al_l = ws + 32;
  float m_reg = -1e30f, l_reg = 0; f32x16 o[4] = {}; bf16x8 qr[8];
  const bf16_t* Qw = Qb + (long)(wid * QBLK + r32) * LDQ + hi * 8;
#pragma unroll
  for (int d0 = 0; d0 < 8; ++d0) qr[d0] = *reinterpret_cast<const bf16x8*>(Qw + d0 * 16);
  const int sr = tid >> 4, sc = (tid & 15) * 8, vst0 = v_st(sr, sc), vst1 = v_st(32 + sr, sc);
  const int vb0 = (int)(uintptr_t)(LAS char*)V_lds + v_rd_base(lane);
  bf16x8 sA_vs0, sA_vs1, sA_ks0, sA_ks1, sB_vs0, sB_vs1, sB_ks0, sB_ks1;
#define SLOAD(S, k0) do { S##_vs0 = *reinterpret_cast<const bf16x8*>(&Vh[(long)((k0) + sr) * LDV + sc]); S##_vs1 = *reinterpret_cast<const bf16x8*>(&Vh[(long)((k0) + 32 + sr) * LDV + sc]); \
    S##_ks0 = *reinterpret_cast<const bf16x8*>(&Kh[(long)((k0) + sr) * LDK + sc]); S##_ks1 = *reinterpret_cast<const bf16x8*>(&Kh[(long)((k0) + 32 + sr) * LDK + sc]); } while (0)
#define SWRITE(b, S) do { *(bf16x8*)(V_lds + (b) * SHM_V + vst0) = S##_vs0; *(bf16x8*)(V_lds + (b) * SHM_V + vst1) = S##_vs1; int kc = sc * 2; \
    *(bf16x8*)(K_lds + (b) * SHM_K + KSWZ(sr, kc)) = S##_ks0; *(bf16x8*)(K_lds + (b) * SHM_K + KSWZ(32 + sr, kc)) = S##_ks1; } while (0)
#define SWAIT() asm volatile("s_waitcnt vmcnt(4)" ::: "memory")
#define RESC(a) do { if (__any((a) < 1.f)) { if (hi == 0) al_l[r32] = (a); asm volatile("s_waitcnt lgkmcnt(0)" ::: "memory"); \
    for (int d = 0; d < 4; ++d) for (int r = 0; r < 16; ++r) o[d][r] *= al_l[crow(r, hi)]; } } while (0)
  f32x16 pA0, pA1, pB0, pB1; float mnA, mnB, alA, alB; bf16x8 pa0, pa1, pa2, pa3; const int NT = seq / KVBLK;
  SLOAD(sA, 0); asm volatile("s_waitcnt vmcnt(0)" ::: "memory"); SWRITE(0, sA); __syncthreads();
  qkt(pA0, pA1, K_lds, qr, r32, hi); partialSM(pA0, pA1, m_reg, mnA, alA);
  SLOAD(sB, KVBLK); if (2 < NT) SLOAD(sA, 2 * KVBLK);
  SWAIT(); SWRITE(1, sB); __syncthreads();
  for (int j = 1; j + 1 < NT; j += 2) {
    SBAR(); qkt(pB0, pB1, K_lds + SHM_K, qr, r32, hi);
    finishSM(pA0, pA1, alA, l_reg, pa0, pa1, pa2, pa3); SBAR();
    SLOAD(sB, (j + 2) * KVBLK); SBAR();
    pv_d0(o, vb0, pa0, pa1, pa2, pa3); partialSM(pB0, pB1, m_reg, mnB, alB);
    __syncthreads(); SWAIT(); SWRITE(0, sA);
    RESC(alB); __syncthreads();
    SBAR(); qkt(pA0, pA1, K_lds, qr, r32, hi);
    finishSM(pB0, pB1, alB, l_reg, pa0, pa1, pa2, pa3); SBAR();
    if (j + 3 < NT) SLOAD(sA, (j + 3) * KVBLK); SBAR();
    pv_d0(o, vb0 + (int)SHM_V, pa0, pa1, pa2, pa3); partialSM(pA0, pA1, m_reg, mnA, alA);
    __syncthreads(); SWAIT(); SWRITE(1, sB);
    RESC(alA); __syncthreads();
  }
  SBAR(); qkt(pB0, pB1, K_lds + SHM_K, qr, r32, hi);
  finishSM(pA0, pA1, alA, l_reg, pa0, pa1, pa2, pa3); SBAR();
  pv_d0(o, vb0, pa0, pa1, pa2, pa3); partialSM(pB0, pB1, m_reg, mnB, alB);
  __syncthreads(); RESC(alB);
  finishSM(pB0, pB1, alB, l_reg, pa0, pa1, pa2, pa3); SBAR();
  pv_d0(o, vb0 + (int)SHM_V, pa0, pa1, pa2, pa3);
  if (hi == 0) li_l[r32] = l_reg; asm volatile("s_waitcnt lgkmcnt(0)" ::: "memory");
  float rli[16];
#pragma unroll
  for (int r = 0; r < 16; ++r) rli[r] = __builtin_amdgcn_rcpf(li_l[crow(r, hi)]);
  bf16_t* Ow = Ob + (long)(wid * QBLK) * LDO;
#pragma unroll
  for (int r = 0; r < 16; ++r) { int orow = crow(r, hi);
#pragma unroll
    for (int d0 = 0; d0 < 4; ++d0) Ow[(long)orow * LDO + d0 * 32 + r32] = (bf16_t)(cvtpk(o[d0][r] * rli[r], 0.f) & 0xffff); }
#undef SLOAD
#undef SWRITE
#undef SWAIT
#undef RESC
  __syncthreads();
}
}

struct Ctx {
  int tid, wid, lane, blk, nblk, gwave, nwave; long gtid, nthr;
};

__device__ __forceinline__ const float* modp(const Params& p, int l, int v, int j) { return (const float*)(p.ws + OFF_MOD) + ((size_t)(l * 5 + v) * NMODC + (size_t)j * DM); }

__device__ __forceinline__ void convert_weights(const Params& p, const Ctx& c, int l, float* lds) {
  constexpr int T0 = 14 * 32, T1 = 8 * 32, T2 = 44 * 32, T3 = 8 * 88, T4 = 2 * 8, TALL = T0 + T1 + T2 + T3 + T4;
  for (int it = c.blk; it < TALL; it += c.nblk) {
    int mat, ti = it;
    if (ti < T0) mat = 0; else if ((ti -= T0) < T1) mat = 1; else if ((ti -= T1) < T2) mat = 2; else if ((ti -= T2) < T3) mat = 3; else { ti -= T3; mat = 4; }
    const float* src; long ld; bf16_t* dst; long dld; int nkt;
    if (mat == 0) { src = p.w_in + (size_t)l * DM * 4096; ld = 4096; dst = (bf16_t*)(p.ws + OFF_WIN); dld = DM; nkt = 32; }
    else if (mat == 1) { src = p.w_out + (size_t)l * DM * DM; ld = DM; dst = (bf16_t*)(p.ws + OFF_WOUT); dld = DM; nkt = 32; }
    else if (mat == 2) { src = p.w_gate + (size_t)l * DM * DFF; ld = DFF; dst = (bf16_t*)(p.ws + OFF_WGU); dld = DM; nkt = 32; }
    else if (mat == 3) { src = p.w_down + (size_t)l * DFF * DM; ld = DM; dst = (bf16_t*)(p.ws + OFF_WD); dld = DFF; nkt = 88; }
    else { src = p.w_glu + (size_t)l * 512 * 512; ld = 512; dst = (bf16_t*)(p.ws + OFF_WGLU); dld = 512; nkt = 8; }
    const int n0 = (ti / nkt) * 256, k0 = (ti % nkt) * 64;
    {
      const int nn = c.tid & 255, kk0 = c.tid >> 8, np = n0 + nn; int scol = np;
      if (mat == 0) { if (np < 2048) scol = (np & ~0x30) | ((np & 16) << 1) | ((np & 32) >> 1); }
      else if (mat == 2) { const int pn = np >> 8, bj = (np >> 7) & 1; scol = pn * 128 + (np & 127); if (bj) src = p.w_up + (size_t)l * DM * DFF; }
      const float* sp = src + (size_t)(k0 + kk0) * ld + scol; float v[32];
#pragma unroll
      for (int i = 0; i < 32; ++i) v[i] = sp[(size_t)(2 * i) * ld];
#pragma unroll
      for (int i = 0; i < 32; ++i) lds[(kk0 + 2 * i) * 257 + nn] = v[i];
    }
    __syncthreads();
    {
      const int kc = (c.tid & 7) * 8;
#pragma unroll
      for (int j = 0; j < 4; ++j) { const int nn = (c.tid >> 3) + 64 * j; float v[8];
#pragma unroll
        for (int i = 0; i < 8; ++i) v[i] = lds[(kc + i) * 257 + nn];
        u32x4 w = {cvtpk(v[0], v[1]), cvtpk(v[2], v[3]), cvtpk(v[4], v[5]), cvtpk(v[6], v[7])};
        *(u32x4*)(dst + (size_t)(n0 + nn) * dld + k0 + kc) = w; }
    }
    __syncthreads();
  }
}

__device__ __forceinline__ void fold_four(const Params& p, const Ctx& c, int l, float* lds) {
  float* WlT = lds;
  float* Wc = lds + 128 * 68;
  const float* wcs = (const float*)(p.ws + OFF_WCS) + (size_t)l * 2 * 4 * 128 * 128;
  bf16_t* dstb = (bf16_t*)(p.ws + OFF_WIN);
  for (int u = c.blk; u < 256; u += c.nblk) {
    const int kt = u & 31, cs = (u >> 5) & 1, g = u >> 6, k0 = kt * 64;
    const float* src = p.w_in + (size_t)l * DM * 4096 + 3584 + g * 128;
    for (int i = c.tid; i < 64 * 128; i += NTHREADS) { const int kk = i >> 7, cc = i & 127; WlT[cc * 68 + kk] = src[(size_t)(k0 + kk) * 4096 + cc]; }
    const float* wsrc = wcs + (size_t)(cs * 4 + g) * 128 * 128;
    for (int i = c.tid; i < 128 * 128; i += NTHREADS) Wc[i] = wsrc[i];
    __syncthreads();
    const int kq = c.tid & 15, dq = c.tid >> 4;
    f32x4 acc[4] = {};
    for (int cc = 0; cc < 128; ++cc) {
      const f32x4 a = *(const f32x4*)(WlT + cc * 68 + kq * 4), w = *(const f32x4*)(Wc + cc * 128 + dq * 4);
#pragma unroll
      for (int di = 0; di < 4; ++di) acc[di] += a * w[di];
    }
#pragma unroll
    for (int di = 0; di < 4; ++di) { u32x2 o = {cvtpk(acc[di][0], acc[di][1]), cvtpk(acc[di][2], acc[di][3])};
      *(u32x2*)(dstb + (size_t)(3584 + cs * 512 + g * 128 + dq * 4 + di) * DM + k0 + kq * 4) = o; }
    __syncthreads();
  }
}


__device__ __forceinline__ void ssm_tables(const Params& p, const Ctx& c) {
  float2* PW = (float2*)(p.ws + OFF_PW); float2* BB = (float2*)(p.ws + OFF_BB);
  for (long i = c.gtid; i < 2L * 32 * 2 * 64; i += c.nthr) { const int pp = (int)(i & 63), idx = (int)(i >> 6);
    const int d = idx & 1, g = (idx >> 1) & 31, l = idx >> 6, iidx = (l * 2 + d) * 32 + g;
    const float lre = p.ssm_a_re[iidx * 64 + pp], lim = p.ssm_a_im[iidx * 64 + pp], dt = expf(p.ssm_log_dt[iidx]);
    float ar = 1.f, ai = 0.f;
    for (int j = 0; j <= 32; ++j) { const float mag = expf(lre * dt * (float)j); float sn, cs; my_sincos(lim * dt * (float)j, sn, cs);
      PW[((size_t)idx * 33 + j) * 64 + pp] = make_float2(mag * cs, mag * sn); if (j == 1) { ar = mag * cs; ai = mag * sn; } }
    const float nr = ar - 1.f, ni = ai, den = 1.f / (lre * lre + lim * lim), cr = (nr * lre + ni * lim) * den, ci = (ni * lre - nr * lim) * den;
    const float* br = p.ssm_b_re + ((size_t)iidx * 64 + pp) * 16; const float* bi = p.ssm_b_im + ((size_t)iidx * 64 + pp) * 16;
    for (int h = 0; h < 16; ++h) BB[((size_t)idx * 64 + pp) * 16 + h] = make_float2(cr * br[h] - ci * bi[h], cr * bi[h] + ci * br[h]); }
}
__device__ __forceinline__ void ssm_build_mef(const Params& p, const Ctx& c, int l) {
  const float2* PW = (const float2*)(p.ws + OFF_PW) + (size_t)l * 32 * 2 * 33 * 64; const float2* BB = (const float2*)(p.ws + OFF_BB) + (size_t)l * 32 * 2 * 64 * 16;
  float* MK = (float*)(p.ws + OFF_MK) + (size_t)l * 32 * 2 * 32 * 256; bf16_t* EM = (bf16_t*)(p.ws + OFF_EM); bf16_t* TF = (bf16_t*)(p.ws + OFF_TF);
  for (long i = c.gtid; i < 32L * 2 * 32 * 256; i += c.nthr) { const int hp = (int)(i & 15), h = (int)((i >> 4) & 15), j = (int)((i >> 8) & 31), gd = (int)(i >> 13), d = gd & 1, g = gd >> 1;
    const size_t ci = ((size_t)((l * 2 + d) * 32 + g) * 16 + h) * 64; const float2* pw = PW + ((size_t)gd * 33 + j) * 64; const float2* bb = BB + (size_t)gd * 64 * 16 + hp; float a = 0.f;
    for (int pp = 0; pp < 64; ++pp) { const float cr = p.ssm_c_re[ci + pp], cim = p.ssm_c_im[ci + pp]; const float2 b = bb[pp * 16], w = pw[pp];
      const float wr = cr * b.x - cim * b.y, wi = cr * b.y + cim * b.x; a += wr * w.x - wi * w.y; }
    MK[i] = a; }
  for (long i = c.gtid; i < 32L * 256 * 32 * 2; i += c.nthr) { const int hh = (int)(i & 1), s = (int)((i >> 1) & 31), n = (int)((i >> 6) & 255), g = (int)(i >> 14), ri = n & 1, pp = (n >> 1) & 63, d = n >> 7;
    const int gd = g * 2 + d, e = d ? s : 31 - s; const float2 w = PW[((size_t)gd * 33 + e) * 64 + pp]; const float2* bb = BB + ((size_t)gd * 64 + pp) * 16 + hh * 8; float v[8];
#pragma unroll
    for (int k = 0; k < 8; ++k) { const float2 b = bb[k]; v[k] = ri ? (w.x * b.y + w.y * b.x) : (w.x * b.x - w.y * b.y); }
    u32x4 o = {cvtpk(v[0], v[1]), cvtpk(v[2], v[3]), cvtpk(v[4], v[5]), cvtpk(v[6], v[7])}; *(u32x4*)(EM + ((size_t)g * 256 + n) * 512 + s * 16 + hh * 8) = o; }
  for (long i = c.gtid; i < 32L * 512 * 2 * 16; i += c.nthr) { const int pq = (int)(i & 15), d = (int)((i >> 4) & 1), n = (int)((i >> 5) & 511), g = (int)(i >> 14), h = n & 15, t = n >> 4;
    const int gd = g * 2 + d, f = d ? 32 - t : t + 1; const size_t ci = ((size_t)((l * 2 + d) * 32 + g) * 16 + h) * 64 + pq * 4; const float2* pw = PW + ((size_t)gd * 33 + f) * 64 + pq * 4; float v[8];
#pragma unroll
    for (int k = 0; k < 4; ++k) { const float cr = p.ssm_c_re[ci + k], cim = p.ssm_c_im[ci + k]; const float2 w = pw[k]; v[2 * k] = cr * w.x - cim * w.y; v[2 * k + 1] = -(cr * w.y + cim * w.x); }
    u32x4 o = {cvtpk(v[0], v[1]), cvtpk(v[2], v[3]), cvtpk(v[4], v[5]), cvtpk(v[6], v[7])}; *(u32x4*)(TF + ((size_t)g * 512 + n) * 768 + 512 + d * 128 + pq * 8) = o; }
}
__device__ __forceinline__ void ssm_build_t(const Params& p, const Ctx& c, int l) {
  const float* MK = (const float*)(p.ws + OFF_MK) + (size_t)l * 32 * 2 * 32 * 256; bf16_t* TF = (bf16_t*)(p.ws + OFF_TF);
  for (long i = c.gtid; i < 32L * 512 * 32 * 2; i += c.nthr) { const int hh = (int)(i & 1), s = (int)((i >> 1) & 31), n = (int)((i >> 6) & 511), g = (int)(i >> 15), h = n & 15, t = n >> 4;
    const int lag = t - s; float v[8];
    if (lag != 0) { const float* m = MK + ((size_t)((g * 2 + (lag < 0 ? 1 : 0)) * 32 + (lag < 0 ? -lag : lag)) * 16 + h) * 16 + hh * 8;
#pragma unroll
      for (int k = 0; k < 8; ++k) v[k] = m[k]; }
    else { const float* m0 = MK + ((size_t)((g * 2) * 32) * 16 + h) * 16 + hh * 8; const float* m1 = MK + ((size_t)((g * 2 + 1) * 32) * 16 + h) * 16 + hh * 8; const float dsk = p.ssm_d[(size_t)l * 512 + g * 16 + h];
#pragma unroll
      for (int k = 0; k < 8; ++k) v[k] = m0[k] + m1[k] + ((hh * 8 + k) == h ? dsk : 0.f); }
    u32x4 o = {cvtpk(v[0], v[1]), cvtpk(v[2], v[3]), cvtpk(v[4], v[5]), cvtpk(v[6], v[7])}; *(u32x4*)(TF + ((size_t)g * 512 + n) * 768 + s * 16 + hh * 8) = o; }
}
__device__ __forceinline__ void ssm_carry(const Params& p, const Ctx& c, int l) {
  if (c.wid != 0) return;
  const float2* PW = (const float2*)(p.ws + OFF_PW) + (size_t)l * 32 * 2 * 33 * 64; const float* SB = (const float*)(p.ws + OFF_Z2 + Z2_SB); bf16_t* UG = (bf16_t*)(p.ws + OFF_Z2 + Z2_UG);
  for (int i = c.blk * 64 + c.lane; i < NB * 32 * 2 * 64; i += c.nblk * 64) { const int pp = i & 63, d = (i >> 6) & 1, g = (i >> 7) & 31, b = i >> 12;
    const float2 a32 = PW[((size_t)(g * 2 + d) * 33 + 32) * 64 + pp]; float hr = 0.f, hi = 0.f;
    const size_t rbase = (size_t)g * 768 + b * 136; const int col = (d * 64 + pp) * 2;
#pragma unroll 8
    for (int k = 0; k < 136; ++k) { const int ch = d == 0 ? k : (k < 8 ? 7 - k : 143 - k);
      const float2 s = *(const float2*)(SB + (rbase + ch) * 256 + col);
      *(unsigned*)(UG + (rbase + ch) * 768 + 512 + col) = cvtpk(hr, hi);
      const float nr = a32.x * hr - a32.y * hi + s.x, ni = a32.x * hi + a32.y * hr + s.y; hr = nr; hi = ni; } }
}

__device__ __forceinline__ void phase0a(const Params& p, const Ctx& c, float* lds) {
  for (int i = c.tid; i < 5 * DM; i += NTHREADS) { const float v = i < 4 * DM ? p.c[i] : p.c_ctx[i - 4 * DM]; lds[i] = v * sigmoidf_(v); }
  __syncthreads();
  {
    float* MP = (float*)(p.ws + OFF_MP);
    for (long it = c.gtid; it < 16 * 6144; it += c.nthr) {
      const int cq = (int)(it % 6144), ks = (int)(it / 6144); const int gc = cq * 4, l = gc / NMODC, col = gc % NMODC;
      const float* wp = p.w_mod + ((size_t)l * DM + (size_t)ks * 128) * NMODC + col;
      f32x4 a[5] = {};
#pragma unroll 8
      for (int k = 0; k < 128; ++k) { const f32x4 w = *(const f32x4*)(wp + (size_t)k * NMODC);
#pragma unroll
        for (int v = 0; v < 5; ++v) a[v] += w * lds[v * DM + ks * 128 + k]; }
#pragma unroll
      for (int v = 0; v < 5; ++v) *(f32x4*)(MP + ((size_t)ks * 5 + v) * 24576 + gc) = a[v];
    }
  }
  __syncthreads();
  {
    float* rc = (float*)(p.ws + OFF_ROPE); float* rs = rc + 64 * 32;
    for (long i = c.gtid; i < 64 * 32; i += c.nthr) { const int pos = (int)(i >> 5), pp = (int)(i & 31);
      const float inv = (float)exp2(-(double)pp / 32.0 * 13.287712379549449); float s, cc; my_sincos((float)pos * inv, s, cc); rc[i] = cc; rs[i] = s; }
  }
  {
    bf16_t* DL = (bf16_t*)(p.ws + OFF_DFTL);
    for (long i = c.gtid; i < 2L * 4096 * 512; i += c.nthr) { const int part = (int)(i >> 21), k = (int)((i >> 9) & 4095), t0 = (int)(i & 511) * 8; float v[8];
#pragma unroll
      for (int j = 0; j < 8; ++j) { const float ph = (float)((k * (t0 + j)) & 4095) * (1.f / 4096.f); v[j] = (part ? __builtin_amdgcn_sinf(ph) : __builtin_amdgcn_cosf(ph)) * (1.f / 64.f); }
      u32x4 w = {cvtpk(v[0], v[1]), cvtpk(v[2], v[3]), cvtpk(v[4], v[5]), cvtpk(v[6], v[7])}; *(u32x4*)(DL + i * 8) = w; }
    bf16_t* DC = (bf16_t*)(p.ws + OFF_DFTC);
    for (long i = c.gtid; i < 2L * 256 * 32; i += c.nthr) { const int part = (int)(i >> 13), k = (int)((i >> 5) & 255), t0 = (int)(i & 31) * 8; float v[8];
#pragma unroll
      for (int j = 0; j < 8; ++j) { const float ph = (float)((k * (t0 + j)) & 255) * (1.f / 256.f); v[j] = (part ? __builtin_amdgcn_sinf(ph) : __builtin_amdgcn_cosf(ph)) * (1.f / 16.f); }
      u32x4 w = {cvtpk(v[0], v[1]), cvtpk(v[2], v[3]), cvtpk(v[4], v[5]), cvtpk(v[6], v[7])}; *(u32x4*)(DC + i * 8) = w; }
  }
  {
    float* W = (float*)(p.ws + OFF_WCS);
    for (long i = c.gtid; i < 2L * 2 * 4 * 128 * 128; i += c.nthr) { const int d = (int)(i & 127), cc = (int)((i >> 7) & 127), g = (int)((i >> 14) & 3), cs = (int)((i >> 16) & 1), l = (int)(i >> 17);
      const float* wf = p.w_four + ((size_t)(l * 4 + g) * 128) * 128 + d; float a = 0.f;
      for (int j = 0; j < 128; ++j) { const float ph = (float)((j * cc) & 127) * (1.f / 128.f); a += (cs ? __builtin_amdgcn_sinf(ph) : __builtin_amdgcn_cosf(ph)) * wf[(size_t)j * 128]; }
      W[i] = a * 0.08838834764831845f; }
  }
}

__device__ __forceinline__ void reduce_mod(const Params& p, const Ctx& c) {
  const float* MP = (const float*)(p.ws + OFF_MP); float* MOD = (float*)(p.ws + OFF_MOD);
  for (long o = c.gtid; o < 5L * 24576; o += c.nthr) { const int v = (int)(o / 24576), gc = (int)(o % 24576), l = gc / NMODC, col = gc % NMODC;
    float a = p.b_mod[gc];
#pragma unroll
    for (int ks = 0; ks < 16; ++ks) a += MP[((size_t)ks * 5 + v) * 24576 + gc];
    MOD[(size_t)(l * 5 + v) * NMODC + col] = a; }
}

__device__ __forceinline__ void prenorm_row(const f32x4 (&x)[8], float rinv, const float* g, const float* sc, const float* sh, bf16_t* dst, int lane) {
#pragma unroll
  for (int i = 0; i < 8; ++i) { const int col = (lane + 64 * i) * 4; const f32x4 gg = *(const f32x4*)(g + col), s1 = *(const f32x4*)(sc + col), s0 = *(const f32x4*)(sh + col);
    const f32x4 y = (x[i] * rinv * gg) * (s1 + 1.f) + s0; u32x2 o = {cvtpk(y[0], y[1]), cvtpk(y[2], y[3])}; *(u32x2*)(dst + col) = o; }
}
__device__ __forceinline__ float sumsq8(const f32x4 (&x)[8]) { float s = 0.f;
#pragma unroll
  for (int i = 0; i < 8; ++i) s += x[i][0] * x[i][0] + x[i][1] * x[i][1] + x[i][2] * x[i][2] + x[i][3] * x[i][3];
  return wave_sum(s); }

__device__ __forceinline__ const float* xrow_src(const Params& p, int l, int b, int t, int row) {
  if (l != 0) return (const float*)(p.ws + OFF_X) + (size_t)row * DM;
  const float* base = t < CTXL ? p.ctx : p.x; const size_t off = t < CTXL ? ((size_t)b * CTXL + t) * DM : ((size_t)b * SEQ + (t - CTXL)) * DM; return base + off;
}
__device__ __forceinline__ void phase_prenorm(const Params& p, const Ctx& c, int l) {
  bf16_t* Hn = (bf16_t*)(p.ws + OFF_HN);
  for (int row = c.gwave; row < TT; row += c.nwave) { const int b = row / TPB, t = row % TPB, v = t < CTXL ? 4 : b;
    f32x4 x[8]; const f32x4* xr = (const f32x4*)xrow_src(p, l, b, t, row);
#pragma unroll
    for (int i = 0; i < 8; ++i) x[i] = xr[c.lane + 64 * i];
    const float rinv = rsqrtf(sumsq8(x) * (1.f / DM) + 1e-6f);
    prenorm_row(x, rinv, p.g_mix_pre + (size_t)l * DM, modp(p, l, v, 1), modp(p, l, v, 0), Hn + (size_t)row * DM, c.lane); }
}
__device__ __forceinline__ void phase_postmix(const Params& p, const Ctx& c, int l, bool last) {
  float* X = (float*)(p.ws + OFF_X); const bf16_t* MIX = (const bf16_t*)(p.ws + OFF_Z1); bf16_t* Hn = (bf16_t*)(p.ws + OFF_HN);
  for (int row = c.gwave; row < TT; row += c.nwave) { const int b = row / TPB, t = row % TPB, v = t < CTXL ? 4 : b; if (last && t < CTXL) continue;
    f32x4 m[8], x[8]; const u32x2* mr = (const u32x2*)(MIX + (size_t)row * DM); f32x4* xr = (f32x4*)(X + (size_t)row * DM); const f32x4* xs = (const f32x4*)xrow_src(p, l, b, t, row);
#pragma unroll
    for (int i = 0; i < 8; ++i) { const u32x2 w = mr[c.lane + 64 * i]; m[i] = (f32x4){__uint_as_float(w[0] << 16), __uint_as_float(w[0] & 0xffff0000u), __uint_as_float(w[1] << 16), __uint_as_float(w[1] & 0xffff0000u)}; x[i] = xs[c.lane + 64 * i]; }
    const float r1 = rsqrtf(sumsq8(m) * (1.f / DM) + 1e-6f); const float* gp = p.g_mix_post + (size_t)l * DM; const float* m2 = modp(p, l, v, 2);
#pragma unroll
    for (int i = 0; i < 8; ++i) { const int col = (c.lane + 64 * i) * 4; x[i] += *(const f32x4*)(m2 + col) * (m[i] * r1 * *(const f32x4*)(gp + col)); xr[c.lane + 64 * i] = x[i]; }
    const float r2 = rsqrtf(sumsq8(x) * (1.f / DM) + 1e-6f);
    prenorm_row(x, r2, p.g_ffn_pre + (size_t)l * DM, modp(p, l, v, 4), modp(p, l, v, 3), Hn + (size_t)row * DM, c.lane); }
}
__device__ __forceinline__ void phase_postffn(const Params& p, const Ctx& c, int l, bool last) {
  float* X = (float*)(p.ws + OFF_X); const bf16_t* F = (const bf16_t*)(p.ws + OFF_Z1); bf16_t* Hn = (bf16_t*)(p.ws + OFF_HN);
  for (int row = c.gwave; row < TT; row += c.nwave) { const int b = row / TPB, t = row % TPB, v = t < CTXL ? 4 : b; if (last && t < CTXL) continue;
    f32x4 m[8], x[8]; const u32x2* mr = (const u32x2*)(F + (size_t)row * DM); f32x4* xr = (f32x4*)(X + (size_t)row * DM);
#pragma unroll
    for (int i = 0; i < 8; ++i) { const u32x2 w = mr[c.lane + 64 * i]; m[i] = (f32x4){__uint_as_float(w[0] << 16), __uint_as_float(w[0] & 0xffff0000u), __uint_as_float(w[1] << 16), __uint_as_float(w[1] & 0xffff0000u)}; x[i] = xr[c.lane + 64 * i]; }
    const float r1 = rsqrtf(sumsq8(m) * (1.f / DM) + 1e-6f); const float* gp = p.g_ffn_post + (size_t)l * DM; const float* m5 = modp(p, l, v, 5);
#pragma unroll
    for (int i = 0; i < 8; ++i) { const int col = (c.lane + 64 * i) * 4; x[i] += *(const f32x4*)(m5 + col) * (m[i] * r1 * *(const f32x4*)(gp + col)); }
    if (last) { f32x4* o = (f32x4*)(p.out + ((size_t)b * SEQ + (t - CTXL)) * DM);
#pragma unroll
      for (int i = 0; i < 8; ++i) o[c.lane + 64 * i] = x[i]; }
    else {
#pragma unroll
      for (int i = 0; i < 8; ++i) xr[c.lane + 64 * i] = x[i];
      const float r2 = rsqrtf(sumsq8(x) * (1.f / DM) + 1e-6f);
      prenorm_row(x, r2, p.g_mix_pre + (size_t)(l + 1) * DM, modp(p, l + 1, v, 1), modp(p, l + 1, v, 0), Hn + (size_t)row * DM, c.lane); } }
}

typedef f32x4 Acc[2][2][4][2];
__device__ __forceinline__ int lat_pm(int i) { return (i >> 4) * 17 + 1 + (i & 15); }

struct SchedMN {
  const char* A; const char* B; size_t strA, strB;
  int nM, nN, pn0, latonly, nextra, blk, nblk;
  __device__ __forceinline__ bool next(int i, gm::Unit& u) const {
    const int it = i * nblk + blk, nmain = nM * nN;
    if (it < nmain) { gm::tile_of(it, nM, nN, u.pm, u.pn); if (latonly) u.pm = lat_pm(u.pm); u.pn += pn0; return true; }
    if (it < nmain + nextra) { const int j = it - nmain; u.pm = (j / 10) * 17; u.pn = 4 + (j % 10); return true; }
    return false;
  }
  __device__ __forceinline__ const char* pA(const gm::Unit& u) const { return A + (size_t)u.pm * strA; }
  __device__ __forceinline__ const char* pB(const gm::Unit& u) const { return B + (size_t)u.pn * strB; }
};

struct EpiIn {
  bf16_t *Qb, *Kb, *Vb, *UG; const float *rc, *rs;
  __device__ __forceinline__ void operator()(const Acc& acc, const gm::Unit& u, int wr, int wc, int fr, int fq) const {
    const int pm = u.pm, pn = u.pn; const bool isctx = (pm % 17) == 0; const int brow = pm * 256;
#pragma unroll
    for (int ai = 0; ai < 2; ++ai)
#pragma unroll
      for (int m = 0; m < 4; ++m) { const int row = brow + ai * 128 + wr * 64 + m * 16 + fr;
        if (pn < 8) { bf16_t* dst = Qb + (size_t)(pn >> 2) * TT * 1024 + (size_t)row * 1024 + (pn & 3) * 256 + wc * 32 + fq * 4;
          f32x4 cs = {1.f, 1.f, 1.f, 1.f}, sn = {0.f, 0.f, 0.f, 0.f};
          if (!isctx) { const int tl = (row % TPB) - CTXL; const int pos = (wc >> 1) ? (tl & 63) : (tl >> 6); const int p0 = (wc & 1) * 16 + fq * 4;
            cs = *(const f32x4*)(rc + pos * 32 + p0); sn = *(const f32x4*)(rs + pos * 32 + p0); }
#pragma unroll
          for (int bj = 0; bj < 2; ++bj) { const f32x4 v1 = acc[ai][bj][m][0], v2 = acc[ai][bj][m][1]; const f32x4 o1 = v1 * cs - v2 * sn, o2 = v2 * cs + v1 * sn;
            u32x2 w1 = {cvtpk(o1[0], o1[1]), cvtpk(o1[2], o1[3])}, w2 = {cvtpk(o2[0], o2[1]), cvtpk(o2[2], o2[3])};
            *(u32x2*)(dst + bj * 128) = w1; *(u32x2*)(dst + bj * 128 + 16) = w2; } }
        else if (pn < 12) { bf16_t* dst = Vb + (size_t)row * 1024 + (pn - 8) * 256 + wc * 32 + fq * 4;
#pragma unroll
          for (int bj = 0; bj < 2; ++bj)
#pragma unroll
            for (int n = 0; n < 2; ++n) { const f32x4 v = acc[ai][bj][m][n]; u32x2 w = {cvtpk(v[0], v[1]), cvtpk(v[2], v[3])}; *(u32x2*)(dst + bj * 128 + n * 16) = w; } }
        else { const int b = row / TPB, t = row % TPB; bf16_t* dst = UG + ((size_t)(b * 136 + (t >> 5))) * 768 + (t & 31) * 16 + ((fq * 4) & 15);
#pragma unroll
          for (int bj = 0; bj < 2; ++bj)
#pragma unroll
            for (int n = 0; n < 2; ++n) { const int g = ((pn - 12) * 256 + bj * 128 + wc * 32 + n * 16 + fq * 4) >> 4; const f32x4 v = acc[ai][bj][m][n];
              u32x2 w = {cvtpk(v[0], v[1]), cvtpk(v[2], v[3])}; *(u32x2*)(dst + (size_t)g * 768 * 768) = w; } } }
  }
};
struct EpiPQ {
  bf16_t *PT;
  __device__ __forceinline__ void operator()(const Acc& acc, const gm::Unit& u, int wr, int wc, int fr, int fq) const {
    const int pm = u.pm, pn = u.pn, b = pm / 17, tt = pm % 17, part = (pn - 14) >> 1; const size_t cb = (size_t)(part * NB + b) * 512 + (pn & 1) * 256;
    const size_t ld = tt == 0 ? 256 : 4096; bf16_t* dstm = PT + (tt == 0 ? (size_t)2 * NB * 512 * 4096 + cb * 256 : cb * 4096 + (size_t)(tt - 1) * 256);
#pragma unroll
    for (int ai = 0; ai < 2; ++ai)
#pragma unroll
      for (int bj = 0; bj < 2; ++bj)
#pragma unroll
        for (int m = 0; m < 4; ++m)
#pragma unroll
          for (int n = 0; n < 2; ++n) { const f32x4 v = acc[ai][bj][m][n]; u32x2 w = {cvtpk(v[0], v[1]), cvtpk(v[2], v[3])};
            *(u32x2*)(dstm + (size_t)(bj * 128 + wc * 32 + n * 16 + fr) * ld + ai * 128 + wr * 64 + m * 16 + fq * 4) = w; }
  }
};
__device__ __forceinline__ void phase_gemm_in(const Params& p, const Ctx& c, int l, LAS unsigned char* lds) {
  SchedMN S; S.A = p.ws + OFF_HN; S.B = p.ws + OFF_WIN; S.strA = (size_t)256 * DM * 2; S.strB = (size_t)256 * DM * 2; S.blk = c.blk; S.nblk = c.nblk;
  S.nM = l == 0 ? 68 : 64; S.latonly = l == 0 ? 0 : 1;
  { S.nN = 14; S.pn0 = 0; S.nextra = l == 0 ? 0 : 40;
    EpiIn E; E.Qb = (bf16_t*)(p.ws + OFF_Z1 + Z1_Q); E.Kb = (bf16_t*)(p.ws + OFF_Z1 + Z1_K); E.Vb = (bf16_t*)(p.ws + OFF_Z1 + Z1_V); E.UG = (bf16_t*)(p.ws + OFF_Z2 + Z2_UG);
    E.rc = (const float*)(p.ws + OFF_ROPE); E.rs = E.rc + 64 * 32;
    gm::gemm_phase<true>(lds, DM, DM, DM, S, E); }
  { S.nN = 4; S.pn0 = 14; S.nextra = 0;
    EpiPQ E; E.PT = (bf16_t*)(p.ws + OFF_Z2 + Z2_CAT);
    gm::gemm_phase<false>(lds, DM, DM, DM, S, E); }
}

template <int LAT> struct SchedFour {
  const bf16_t *DM_, *PT; int blk, nblk;
  __device__ __forceinline__ bool next(int i, gm::Unit& u) const { const int it = i * nblk + blk; if (it >= (LAT ? 256 : 16)) return false; u.pm = it; u.pn = 0; return true; }
  __device__ __forceinline__ const char* pA(const gm::Unit& u) const { const int it = u.pm;
    if (LAT) { const int kt = it & 15, part = (it >> 5) & 1; return (const char*)(DM_ + ((size_t)part * 4096 + kt * 256) * 4096); }
    const int part = (it >> 1) & 1; return (const char*)(DM_ + (size_t)part * 256 * 256); }
  __device__ __forceinline__ const char* pB(const gm::Unit& u) const { const int it = u.pm;
    if (LAT) { const int nt_ = (it >> 4) & 1, part = (it >> 5) & 1, b = it >> 6; return (const char*)(PT + ((size_t)(part * NB + b) * 512 + nt_ * 256) * 4096); }
    const int nt_ = it & 1, part = (it >> 1) & 1, b = it >> 2; return (const char*)(PT + (size_t)2 * NB * 512 * 4096 + ((size_t)(part * NB + b) * 512 + nt_ * 256) * 256); }
};
template <int LAT> struct EpiFour {
  float *FC, *FS;
  __device__ __forceinline__ void operator()(const Acc& acc, const gm::Unit& u, int wr, int wc, int fr, int fq) const { const int it = u.pm; int kt, nt_, part, b, toff;
    if (LAT) { kt = it & 15; nt_ = (it >> 4) & 1; part = (it >> 5) & 1; b = it >> 6; toff = CTXL; } else { kt = 0; nt_ = it & 1; part = (it >> 1) & 1; b = it >> 2; toff = 0; }
    float* dst = FC + (size_t)part * TT * 512 + ((size_t)b * TPB + toff + kt * 256) * 512 + nt_ * 256 + wc * 32 + fq * 4;
#pragma unroll
    for (int ai = 0; ai < 2; ++ai)
#pragma unroll
      for (int m = 0; m < 4; ++m) { float* dr = dst + (size_t)(ai * 128 + wr * 64 + m * 16 + fr) * 512;
#pragma unroll
        for (int bj = 0; bj < 2; ++bj)
#pragma unroll
          for (int n = 0; n < 2; ++n) *(f32x4*)(dr + bj * 128 + n * 16) = acc[ai][bj][m][n]; }
  }
};
__device__ __forceinline__ void phase_fourier(const Params& p, const Ctx& c, int l, LAS unsigned char* lds) {
  const bf16_t* PT = (const bf16_t*)(p.ws + OFF_Z2 + Z2_CAT);
  float* FC = (float*)(p.ws + OFF_Z2 + Z2_FC); float* FS = (float*)(p.ws + OFF_Z2 + Z2_FS);
  { const SchedFour<1> S{(const bf16_t*)(p.ws + OFF_DFTL), PT, c.blk, c.nblk}; const EpiFour<1> E{FC, FS}; gm::gemm_phase<true>(lds, 4096, 4096, 4096, S, E); }
  if (l == 0) { const SchedFour<0> S{(const bf16_t*)(p.ws + OFF_DFTC), PT, c.blk, c.nblk}; const EpiFour<0> E{FC, FS}; gm::gemm_phase<true>(lds, 256, 256, 256, S, E); }
}

struct SchedSsmS { const char *UG, *EM; int blk, nblk;
  __device__ __forceinline__ bool next(int i, gm::Unit& u) const { const int it = i * nblk + blk; if (it >= 96) return false; u.pm = it; u.pn = 0; return true; }
  __device__ __forceinline__ const char* pA(const gm::Unit& u) const { const int g = u.pm / 3, pm = u.pm % 3; return UG + ((size_t)g * 768 + pm * 256) * 768 * 2; }
  __device__ __forceinline__ const char* pB(const gm::Unit& u) const { const int g = u.pm / 3; return EM + (size_t)g * 256 * 512 * 2; } };
struct EpiSsmS { float* SB;
  __device__ __forceinline__ void operator()(const Acc& acc, const gm::Unit& u, int wr, int wc, int fr, int fq) const { const int g = u.pm / 3, pm = u.pm % 3;
#pragma unroll
    for (int ai = 0; ai < 2; ++ai)
#pragma unroll
      for (int m = 0; m < 4; ++m) { const int r = pm * 256 + ai * 128 + wr * 64 + m * 16 + fr; if (r >= 544) continue; float* dr = SB + ((size_t)g * 768 + r) * 256 + wc * 32 + fq * 4;
#pragma unroll
        for (int bj = 0; bj < 2; ++bj)
#pragma unroll
          for (int n = 0; n < 2; ++n) *(f32x4*)(dr + bj * 128 + n * 16) = acc[ai][bj][m][n]; }
  } };
__device__ __forceinline__ void phase_ssm_states(const Params& p, const Ctx& c, LAS unsigned char* lds) {
  const SchedSsmS S{p.ws + OFF_Z2 + Z2_UG, p.ws + OFF_EM, c.blk, c.nblk}; const EpiSsmS E{(float*)(p.ws + OFF_Z2 + Z2_SB)};
  gm::gemm_phase<true>(lds, 768, 512, 512, S, E);
}
struct SchedSsmY { const char *UG, *TF; int blk, nblk;
  __device__ __forceinline__ bool next(int i, gm::Unit& u) const { const int it = i * nblk + blk; if (it >= 192) return false; u.pm = it >> 1; u.pn = it & 1; return true; }
  __device__ __forceinline__ const char* pA(const gm::Unit& u) const { const int g = u.pm / 3, pm = u.pm % 3; return UG + ((size_t)g * 768 + pm * 256) * 768 * 2; }
  __device__ __forceinline__ const char* pB(const gm::Unit& u) const { const int g = u.pm / 3; return TF + ((size_t)g * 512 + u.pn * 256) * 768 * 2; } };
struct EpiSsmY { bf16_t* Gg; int last;
  __device__ __forceinline__ void operator()(const Acc& acc, const gm::Unit& u, int wr, int wc, int fr, int fq) const { const int g = u.pm / 3, pm = u.pm % 3;
#pragma unroll
    for (int ai = 0; ai < 2; ++ai)
#pragma unroll
      for (int m = 0; m < 4; ++m) { const int r = pm * 256 + ai * 128 + wr * 64 + m * 16 + fr; if (r >= 544) continue; const int b = r / 136, ch = r % 136; if (last && ch < 8) continue;
        bf16_t* dr = Gg + ((size_t)b * TPB + ch * 32) * 512 + g * 16 + ((fq * 4) & 15);
#pragma unroll
        for (int bj = 0; bj < 2; ++bj)
#pragma unroll
          for (int n = 0; n < 2; ++n) { const int t = (u.pn * 256 + bj * 128 + wc * 32 + n * 16 + fq * 4) >> 4; const f32x4 y = acc[ai][bj][m][n];
            u32x2 w = {cvtpk(gelu_tanh(y[0]), gelu_tanh(y[1])), cvtpk(gelu_tanh(y[2]), gelu_tanh(y[3]))}; *(u32x2*)(dr + (size_t)t * 512) = w; } }
  } };
__device__ __forceinline__ void phase_ssm_y(const Params& p, const Ctx& c, bool last, LAS unsigned char* lds) {
  const SchedSsmY S{p.ws + OFF_Z2 + Z2_UG, p.ws + OFF_TF, c.blk, c.nblk}; const EpiSsmY E{(bf16_t*)(p.ws + OFF_Z2 + Z2_GG), last ? 1 : 0};
  gm::gemm_phase<true>(lds, 768, 768, 768, S, E);
}

struct EpiGlu {
  const bf16_t* Gg; bf16_t* Cat; const float* bg;
  __device__ __forceinline__ void operator()(const Acc& acc, const gm::Unit& u, int wr, int wc, int fr, int fq) const { const int pm = u.pm, pn = u.pn;
#pragma unroll
    for (int ai = 0; ai < 2; ++ai)
#pragma unroll
      for (int m = 0; m < 4; ++m) { const int row = pm * 256 + ai * 128 + wr * 64 + m * 16 + fr;
#pragma unroll
        for (int bj = 0; bj < 2; ++bj)
#pragma unroll
          for (int n = 0; n < 2; ++n) { const int col = pn * 256 + bj * 128 + wc * 32 + n * 16 + fq * 4; const f32x4 z = acc[ai][bj][m][n] + *(const f32x4*)(bg + col);
            const u32x2 gw = *(const u32x2*)(Gg + (size_t)row * 512 + col);
            const float g0 = __uint_as_float(gw[0] << 16), g1 = __uint_as_float(gw[0] & 0xffff0000u), g2 = __uint_as_float(gw[1] << 16), g3 = __uint_as_float(gw[1] & 0xffff0000u);
            u32x2 w = {cvtpk(g0 * sigmoidf_(z[0]), g1 * sigmoidf_(z[1])), cvtpk(g2 * sigmoidf_(z[2]), g3 * sigmoidf_(z[3]))};
            *(u32x2*)(Cat + (size_t)row * DM + 1024 + col) = w; } }
  }
};
__device__ __forceinline__ void phase_glu(const Params& p, const Ctx& c, int l, bool last, LAS unsigned char* lds) {
  SchedMN S; S.A = p.ws + OFF_Z2 + Z2_GG; S.B = p.ws + OFF_WGLU; S.strA = (size_t)256 * 512 * 2; S.strB = (size_t)256 * 512 * 2; S.blk = c.blk; S.nblk = c.nblk;
  S.nM = last ? 64 : 68; S.latonly = last ? 1 : 0; S.nN = 2; S.pn0 = 0; S.nextra = 0;
  EpiGlu E; E.Gg = (const bf16_t*)(p.ws + OFF_Z2 + Z2_GG); E.Cat = (bf16_t*)(p.ws + OFF_Z2 + Z2_CAT); E.bg = p.b_glu + (size_t)l * 512;
  gm::gemm_phase<true>(lds, 512, 512, 512, S, E);
}

struct EpiF32 {
  bf16_t* O;
  __device__ __forceinline__ void operator()(const Acc& acc, const gm::Unit& u, int wr, int wc, int fr, int fq) const {
    bf16_t* dst = O + (size_t)u.pm * 256 * DM + u.pn * 256 + wc * 32 + fq * 4;
#pragma unroll
    for (int ai = 0; ai < 2; ++ai)
#pragma unroll
      for (int m = 0; m < 4; ++m) { bf16_t* dr = dst + (size_t)(ai * 128 + wr * 64 + m * 16 + fr) * DM;
#pragma unroll
        for (int bj = 0; bj < 2; ++bj)
#pragma unroll
          for (int n = 0; n < 2; ++n) { const f32x4 v = acc[ai][bj][m][n]; u32x2 w = {cvtpk(v[0], v[1]), cvtpk(v[2], v[3])}; *(u32x2*)(dr + bj * 128 + n * 16) = w; } }
  }
};
template <int KK>
__device__ __forceinline__ void phase_gemm_f32out(const Params& p, const Ctx& c, bool last, const char* A, const char* W, LAS unsigned char* lds) {
  SchedMN S; S.A = A; S.B = W; S.strA = (size_t)256 * KK * 2; S.strB = (size_t)256 * KK * 2; S.blk = c.blk; S.nblk = c.nblk;
  S.nM = last ? 64 : 68; S.latonly = last ? 1 : 0; S.nN = 8; S.pn0 = 0; S.nextra = 0;
  EpiF32 E; E.O = (bf16_t*)(p.ws + OFF_Z1);
  gm::gemm_phase<true>(lds, KK, KK, KK, S, E);
}

struct EpiGU {
  bf16_t* ACT;
  __device__ __forceinline__ void operator()(const Acc& acc, const gm::Unit& u, int wr, int wc, int fr, int fq) const {
    bf16_t* dst = ACT + (size_t)u.pm * 256 * DFF + u.pn * 128 + wc * 32 + fq * 4;
#pragma unroll
    for (int ai = 0; ai < 2; ++ai)
#pragma unroll
      for (int m = 0; m < 4; ++m) { bf16_t* dr = dst + (size_t)(ai * 128 + wr * 64 + m * 16 + fr) * DFF;
#pragma unroll
        for (int n = 0; n < 2; ++n) { const f32x4 g = acc[ai][0][m][n], uu = acc[ai][1][m][n];
          u32x2 w = {cvtpk(g[0] * sigmoidf_(g[0]) * uu[0], g[1] * sigmoidf_(g[1]) * uu[1]), cvtpk(g[2] * sigmoidf_(g[2]) * uu[2], g[3] * sigmoidf_(g[3]) * uu[3])};
          *(u32x2*)(dr + n * 16) = w; } }
  }
};
__device__ __forceinline__ void phase_gemm_gu(const Params& p, const Ctx& c, bool last, LAS unsigned char* lds) {
  SchedMN S; S.A = p.ws + OFF_HN; S.B = p.ws + OFF_WGU; S.strA = (size_t)256 * DM * 2; S.strB = (size_t)256 * DM * 2; S.blk = c.blk; S.nblk = c.nblk;
  S.nM = last ? 64 : 68; S.latonly = last ? 1 : 0; S.nN = 44; S.pn0 = 0; S.nextra = 0;
  EpiGU E; E.ACT = (bf16_t*)(p.ws + OFF_Z2);
  gm::gemm_phase<true>(lds, DM, DM, DM, S, E);
}

__device__ __forceinline__ void phase_attn(const Params& p, const Ctx& c, int l, char* lds) {
  const bf16_t* Qb = (const bf16_t*)(p.ws + OFF_Z1 + Z1_Q); const bf16_t* Kb = (const bf16_t*)(p.ws + OFF_Z1 + Z1_K); const bf16_t* Vb = (const bf16_t*)(p.ws + OFF_Z1 + Z1_V);
  bf16_t* O = (bf16_t*)(p.ws + OFF_HN);
  const int ntot = (l == 0) ? 1024 + 64 : 1024;
  for (int v = c.blk; v < ntot; v += c.nblk) {
    int combo, qb, seq;
    if (v < 1024) { const int rd = v >> 8, w = v & 255; combo = rd * 16 + (w & 7) * 2 + ((w >> 3) >> 4); qb = 1 + ((w >> 3) & 15); seq = TPB; }
    else { combo = v - 1024; qb = 0; seq = CTXL; }
    const int e = combo & 1, mp = (combo >> 1) & 1, h = (combo >> 2) & 3, b = combo >> 4;
    const size_t r0 = (size_t)b * TPB;
    at::body(Qb + (r0 + qb * 256) * 1024 + (h * 2 + mp) * 128, Kb + r0 * 1024 + (h * 2 + mp) * 128, Vb + r0 * 1024 + h * 256 + e * 128,
             O + (r0 + qb * 256) * DM + (h * 2 + mp) * 256 + e * 128, seq, lds);
  }
}

__device__ __forceinline__ void phase_combine(const Params& p, const Ctx& c, int l, bool last) {
  const bf16_t* O = (const bf16_t*)(p.ws + OFF_HN); bf16_t* Cat = (bf16_t*)(p.ws + OFF_Z2 + Z2_CAT);
  const float* FC = (const float*)(p.ws + OFF_Z2 + Z2_FC); const float* FS = (const float*)(p.ws + OFF_Z2 + Z2_FS);
  const float lam_init = 0.8f - 0.6f * expf(-0.3f * (float)l);
  float lam;
  { const float a1 = p.lam_q1[l * 128 + c.lane] * p.lam_k1[l * 128 + c.lane] + p.lam_q1[l * 128 + 64 + c.lane] * p.lam_k1[l * 128 + 64 + c.lane];
    const float a2 = p.lam_q2[l * 128 + c.lane] * p.lam_k2[l * 128 + c.lane] + p.lam_q2[l * 128 + 64 + c.lane] * p.lam_k2[l * 128 + 64 + c.lane];
    lam = expf(wave_sum(a1)) - expf(wave_sum(a2)) + lam_init; }
  const f32x4 gs = *(const f32x4*)(p.g_subln + (size_t)l * 256 + c.lane * 4);
  for (int row = c.gwave; row < TT; row += c.nwave) { const int t = row % TPB; if (last && t < CTXL) continue;
    const bf16_t* orow = O + (size_t)row * DM; bf16_t* crow_ = Cat + (size_t)row * DM;
#pragma unroll
    for (int h = 0; h < 4; ++h) { const u32x2 a = *(const u32x2*)(orow + (h * 2) * 256 + c.lane * 4), bq = *(const u32x2*)(orow + (h * 2 + 1) * 256 + c.lane * 4);
      f32x4 o; o[0] = __uint_as_float(a[0] << 16) - lam * __uint_as_float(bq[0] << 16); o[1] = __uint_as_float(a[0] & 0xffff0000u) - lam * __uint_as_float(bq[0] & 0xffff0000u);
      o[2] = __uint_as_float(a[1] << 16) - lam * __uint_as_float(bq[1] << 16); o[3] = __uint_as_float(a[1] & 0xffff0000u) - lam * __uint_as_float(bq[1] & 0xffff0000u);
      const float ss = wave_sum(o[0] * o[0] + o[1] * o[1] + o[2] * o[2] + o[3] * o[3]); const float r = rsqrtf(ss * (1.f / 256.f) + 1e-5f) * (1.f - lam_init);
      o = o * r * gs; u32x2 w = {cvtpk(o[0], o[1]), cvtpk(o[2], o[3])}; *(u32x2*)(crow_ + h * 256 + c.lane * 4) = w; }
#pragma unroll
    for (int q = 0; q < 2; ++q) { const int col = q * 256 + c.lane * 4; const size_t o5 = (size_t)row * 512 + col;
      const f32x4 f = *(const f32x4*)(FC + o5) - *(const f32x4*)(FS + o5) + *(const f32x4*)(p.b_four + (size_t)l * 512 + col);
      u32x2 wf = {cvtpk(f[0], f[1]), cvtpk(f[2], f[3])}; *(u32x2*)(crow_ + 1536 + col) = wf; }
  }
}


#define XB_TMO      128
#define XB_XCNT(j)  (256  + 64 * (j))
#define XB_XSUB(j)  (1280 + 64 * (j))
#define XB_XGEN(j)  (2304 + 64 * (j))
#define XB_TOP      3328
#define XB_TOPGEN   3392
#define XCD_BAR_WORDS 3456
#define XB_SPIN_CAP (1u << 18)
__device__ __forceinline__ unsigned xb_ld(unsigned* p)              { return __hip_atomic_load(p, __ATOMIC_RELAXED, __HIP_MEMORY_SCOPE_AGENT); }
__device__ __forceinline__ unsigned xb_add(unsigned* p, unsigned v) { return __hip_atomic_fetch_add(p, v, __ATOMIC_RELAXED, __HIP_MEMORY_SCOPE_AGENT); }
__device__ __forceinline__ unsigned xb_xcc_id() { return (unsigned)__builtin_amdgcn_s_getreg((3 << 11) | 20) & 0xFu; }
#define XB_SPIN(cond, bar) do { unsigned _sp = 0; while (cond) { __builtin_amdgcn_s_sleep(1); \
    if ((++_sp & 255u) == 0u) { if (xb_ld(&(bar)[XB_TMO])) break; if (_sp > XB_SPIN_CAP) { atomicAdd(&(bar)[XB_TMO], 1u); break; } } } } while (0)
struct XcdBarrier { unsigned* bar; unsigned x; volatile LAS unsigned* st; };
__device__ __forceinline__ XcdBarrier xcd_barrier_post(unsigned* bar, volatile LAS unsigned* st) {
  XcdBarrier b; b.bar = bar; b.x = xb_xcc_id(); b.st = st;
  if (threadIdx.x == 0) (void)xb_add(&bar[XB_XCNT(b.x)], 1u);
  return b;
}
__device__ __forceinline__ void xcd_barrier_complete(unsigned* bar, unsigned x, unsigned& nloc, unsigned& nx) {
  const unsigned G = gridDim.x * gridDim.y * gridDim.z;
  unsigned sum, cnt, mine, sp = 0u;
  for (;;) {
    sum = 0u; cnt = 0u; mine = 0u;
#pragma unroll
    for (unsigned j = 0; j < 16; ++j) { const unsigned c = xb_ld(&bar[XB_XCNT(j)]); sum += c; cnt += (c > 0u) ? 1u : 0u; mine = (j == x) ? c : mine; }
    if (sum == G) break;
    __builtin_amdgcn_s_sleep(1);
    if ((++sp & 255u) == 0u) { if (xb_ld(&bar[XB_TMO])) break; if (sp > XB_SPIN_CAP) { atomicAdd(&bar[XB_TMO], 1u); break; } }
  }
  nloc = mine > 0u ? mine : 1u; nx = cnt > 0u ? cnt : 1u;
}
__device__ __forceinline__ void xcd_barrier(const XcdBarrier& b) {
  asm volatile("s_waitcnt vmcnt(0)" ::: "memory");
  __syncthreads();
  if (threadIdx.x == 0) {
    unsigned* bar = b.bar;
    __builtin_amdgcn_s_waitcnt(0);
    unsigned nloc = b.st[0], nx = b.st[1];
    if (nloc == 0u) { xcd_barrier_complete(bar, b.x, nloc, nx); b.st[0] = nloc; b.st[1] = nx; }
    const unsigned old = xb_add(&bar[XB_XSUB(b.x)], 1u);
    const unsigned gen = old / nloc;
    if (old + 1u == (gen + 1u) * nloc) {
      __builtin_amdgcn_fence(__ATOMIC_RELEASE, "agent");
      asm volatile("s_waitcnt vmcnt(0)" ::: "memory");
      const unsigned og = xb_add(&bar[XB_TOP], 1u);
      const unsigned tg = og / nx;
      if (og + 1u == (tg + 1u) * nx) xb_add(&bar[XB_TOPGEN], 1u);
      else XB_SPIN(xb_ld(&bar[XB_TOPGEN]) == tg, bar);
      __builtin_amdgcn_fence(__ATOMIC_ACQUIRE, "agent");
      xb_add(&bar[XB_XGEN(b.x)], 1u);
      asm volatile("s_waitcnt vmcnt(0)" ::: "memory");
    } else {
      XB_SPIN(xb_ld(&bar[XB_XGEN(b.x)]) == gen, bar);
      __builtin_amdgcn_fence(__ATOMIC_ACQUIRE, "agent");
      asm volatile("s_waitcnt vmcnt(0)" ::: "memory");
    }
  }
  __syncthreads();
}

__global__ void __launch_bounds__(NTHREADS) mega(Params p_arg) {
  extern __shared__ __attribute__((aligned(16))) char shm[];
  __shared__ uint4 xb_words;
  cg::grid_group grid = cg::this_grid();
  typedef const __attribute__((address_space(4))) Params* KP;
  KP kp = (KP)__builtin_amdgcn_kernarg_segment_ptr();
  unsigned* bar = (unsigned*)(p_arg.ws + OFF_BAR);
  if (threadIdx.x == 0) xb_words = make_uint4(0u, 0u, 0u, 0u);
  if (blockIdx.x == 0) for (int i = threadIdx.x; i < XCD_BAR_WORDS; i += NTHREADS) bar[i] = 0u;
  __syncthreads();
  Ctx c;
#define RECTX() do { asm volatile("" : "+s"(kp)); int t_ = threadIdx.x; asm volatile("" : "+v"(t_)); int b_ = blockIdx.x; asm volatile("" : "+s"(b_)); \
    c.tid = t_; c.wid = t_ >> 6; c.lane = t_ & 63; c.blk = b_; c.nblk = gridDim.x; c.gwave = c.blk * 8 + c.wid; c.nwave = c.nblk * 8; \
    c.gtid = (long)c.blk * NTHREADS + c.tid; c.nthr = (long)c.nblk * NTHREADS; } while (0)
  RECTX();
  LAS unsigned char* gshm = (LAS unsigned char*)shm; float* fl = (float*)shm;

#define PP (*(const Params*)kp)
#define GSYNC() do { RECTX(); XcdBarrier xb_; xb_.bar = (unsigned*)(kp->ws + OFF_BAR); xb_.x = xb_xcc_id(); xb_.st = (volatile LAS unsigned*)&xb_words; xcd_barrier(xb_); } while (0)
  phase0a(PP, c, fl);
  RECTX(); ssm_tables(PP, c);
  RECTX(); convert_weights(PP, c, 0, fl);
  grid.sync();
  RECTX(); if (threadIdx.x == 0) (void)xb_add((unsigned*)(kp->ws + OFF_BAR) + XB_XCNT(xb_xcc_id()), 1u);
  RECTX(); reduce_mod(PP, c);
  RECTX(); fold_four(PP, c, 0, fl);
  RECTX(); ssm_build_mef(PP, c, 0);
  GSYNC();
  RECTX(); ssm_build_t(PP, c, 0);
  RECTX(); phase_prenorm(PP, c, 0);
  GSYNC();
  for (int l = 0; l < 2; ++l) {
    const bool last = (l == 1);
    RECTX(); phase_gemm_in(PP, c, l, gshm);
    GSYNC();
    RECTX(); phase_fourier(PP, c, l, gshm);
    RECTX(); phase_ssm_states(PP, c, gshm);
    GSYNC();
    RECTX(); ssm_carry(PP, c, l);
    RECTX(); phase_attn(PP, c, l, shm);
    GSYNC();
    RECTX(); phase_ssm_y(PP, c, last, gshm);
    RECTX(); phase_combine(PP, c, l, last);
    GSYNC();
    RECTX(); phase_glu(PP, c, l, last, gshm);
    GSYNC();
    RECTX(); phase_gemm_f32out<DM>(PP, c, last, kp->ws + OFF_Z2 + Z2_CAT, kp->ws + OFF_WOUT, gshm);
    GSYNC();
    if (!last) { RECTX(); ssm_build_mef(PP, c, 1); }
    RECTX(); phase_postmix(PP, c, l, last);
    GSYNC();
    RECTX(); phase_gemm_gu(PP, c, last, gshm);
    GSYNC();
    RECTX(); phase_gemm_f32out<DFF>(PP, c, last, kp->ws + OFF_Z2, kp->ws + OFF_WD, gshm);
    GSYNC();
    if (!last) { RECTX(); ssm_build_t(PP, c, 1); }
    RECTX(); phase_postffn(PP, c, l, last);
    if (!last) { RECTX(); convert_weights(PP, c, 1, fl); RECTX(); fold_four(PP, c, 1, fl); GSYNC(); }
  }
}

extern "C" void kernel_launch(void* const* d_in, const int* in_sizes, int n_in, void* d_out, int out_size, void* d_ws, size_t ws_size,
                              hipStream_t stream) {
  static int grid_blocks = 0;
  if (!grid_blocks) {
    (void)hipFuncSetAttribute((const void*)mega, hipFuncAttributeMaxDynamicSharedMemorySize, SHM_BYTES);
    int dev = 0, cus = 0, per_cu = 0;
    (void)hipGetDevice(&dev);
    (void)hipDeviceGetAttribute(&cus, hipDeviceAttributeMultiprocessorCount, dev);
    (void)hipOccupancyMaxActiveBlocksPerMultiprocessor(&per_cu, mega, NTHREADS, SHM_BYTES);
    if (per_cu < 1) per_cu = 1;
    grid_blocks = cus;
  }
  if (n_in != 32 || ws_size < WS_NEED) { fprintf(stderr, "kernel_launch: bad n_in %d or ws %zu < %zu\n", n_in, ws_size, WS_NEED); return; }
  Params p{};
  const float** f = (const float**)&p;
  for (int i = 0; i < 32; ++i) f[i] = (const float*)d_in[i];
  p.out = (float*)d_out; p.ws = (char*)d_ws;
  void* args[] = {&p};
  hipError_t e = hipLaunchCooperativeKernel((void*)mega, dim3(grid_blocks), dim3(NTHREADS), args, SHM_BYTES, stream);
  if (e != hipSuccess) fprintf(stderr, "cooperative launch failed: %s (grid %d)\n", hipGetErrorString(e), grid_blocks);
}
```

```cpp
#include <hip/hip_runtime.h>
#include <hip/hip_cooperative_groups.h>
#include <cstdio>
#include <cstdint>
namespace cg = cooperative_groups;

typedef unsigned short bf16_t;
using bf16x8 = __attribute__((ext_vector_type(8))) short;
using s16x4  = __attribute__((ext_vector_type(4))) short;
using f32x4  = __attribute__((ext_vector_type(4))) float;
using f32x16 = __attribute__((ext_vector_type(16))) float;
using u32x4  = __attribute__((ext_vector_type(4))) unsigned;
using u32x2  = __attribute__((ext_vector_type(2))) unsigned;
#define LAS __attribute__((address_space(3)))

constexpr int NB = 4, SEQ = 4096, CTXL = 256, TPB = SEQ + CTXL  , TT = NB * TPB  ;
constexpr int DM = 2048, NIN = 4608, DFF = 5632, NMODC = 6 * DM  ;
constexpr int NTHREADS = 512, SHM_BYTES = 131072;

constexpr size_t al256(size_t x) { return (x + 255) / 256 * 256; }
constexpr size_t OFF_X    = 0;
constexpr size_t OFF_WIN  = OFF_X + (size_t)TT * DM * 4;
constexpr size_t OFF_WOUT = OFF_WIN + (size_t)NIN * DM * 2;
constexpr size_t OFF_WGU  = OFF_WOUT + (size_t)DM * DM * 2;
constexpr size_t OFF_WD   = OFF_WGU + (size_t)2 * DFF * DM * 2;
constexpr size_t OFF_WGLU = OFF_WD + (size_t)DM * DFF * 2;
constexpr size_t OFF_DFTL = OFF_WGLU + (size_t)512 * 512 * 2;
constexpr size_t OFF_DFTC = OFF_DFTL + (size_t)2 * 4096 * 4096 * 2;
constexpr size_t OFF_MP   = OFF_DFTC + (size_t)2 * 256 * 256 * 2;
constexpr size_t OFF_MOD  = OFF_MP + (size_t)16 * 5 * 24576 * 4;
constexpr size_t OFF_ROPE = OFF_MOD + (size_t)2 * 5 * NMODC * 4;
constexpr size_t OFF_WCS  = OFF_ROPE + (size_t)2 * 64 * 32 * 4;
constexpr size_t OFF_PW   = OFF_WCS + (size_t)2 * 2 * 4 * 128 * 128 * 4;
constexpr size_t OFF_BB   = OFF_PW + (size_t)2 * 32 * 2 * 33 * 64 * 8;
constexpr size_t OFF_MK   = OFF_BB + (size_t)2 * 32 * 2 * 64 * 16 * 8;
constexpr size_t OFF_TF   = OFF_MK + (size_t)2 * 32 * 2 * 32 * 256 * 4;
constexpr size_t OFF_EM   = OFF_TF + (size_t)32 * 512 * 768 * 2;
constexpr size_t OFF_BAR  = OFF_EM + (size_t)32 * 256 * 512 * 2;
constexpr size_t OFF_HN   = OFF_BAR + 16384;
constexpr size_t OFF_Z1   = OFF_HN + (size_t)TT * DM * 2;
constexpr size_t Z1_Q = 0, Z1_K = (size_t)TT * 1024 * 2, Z1_V = 2 * Z1_K;
constexpr size_t OFF_Z2   = OFF_Z1 + (size_t)TT * DM * 4;
constexpr size_t Z2_FC = 0, Z2_FS = Z2_FC + (size_t)TT * 512 * 4;
constexpr size_t Z2_UG = Z2_FS + (size_t)TT * 512 * 4;
constexpr size_t Z2_SB = Z2_UG + (size_t)32 * 768 * 768 * 2;
constexpr size_t Z2_CAT = Z2_SB + (size_t)32 * 768 * 256 * 4;
constexpr size_t Z2_GG = Z2_CAT + (size_t)TT * DM * 2;
constexpr size_t Z2_END = Z2_GG + (size_t)TT * 512 * 2;
constexpr size_t Z2_SIZE = Z2_END > (size_t)TT * DFF * 2 ? Z2_END : (size_t)TT * DFF * 2;
constexpr size_t WS_NEED = OFF_Z2 + Z2_SIZE;
static_assert(WS_NEED <= (size_t)805306368, "workspace over 768 MiB");


struct Params {
  const float *x, *c, *ctx, *c_ctx, *w_mod, *b_mod, *g_mix_pre, *g_mix_post, *g_ffn_pre, *g_ffn_post, *w_in, *w_out;
  const float *lam_q1, *lam_k1, *lam_q2, *lam_k2, *g_subln, *ssm_a_re, *ssm_a_im, *ssm_log_dt, *ssm_b_re, *ssm_b_im;
  const float *ssm_c_re, *ssm_c_im, *ssm_d, *w_glu, *b_glu, *w_four, *b_four, *w_gate, *w_up, *w_down;
  float* out; char* ws;
};

__device__ __forceinline__ unsigned cvtpk(float lo, float hi) { unsigned r; asm volatile("v_cvt_pk_bf16_f32 %0, %1, %2" : "=v"(r) : "v"(lo), "v"(hi)); return r; }
__device__ __forceinline__ float bf2f(unsigned short b) { return __uint_as_float((unsigned)b << 16); }
__device__ __forceinline__ float wave_sum(float v) {
  v += __shfl_xor(v, 32); v += __shfl_xor(v, 16); v += __shfl_xor(v, 8); v += __shfl_xor(v, 4); v += __shfl_xor(v, 2); v += __shfl_xor(v, 1); return v;
}
__device__ __forceinline__ void my_sincos(float x, float& s, float& c) {
  const double xd = (double)x; const double kd = rint(xd * 0.63661977236758134); const double r = xd - kd * 1.5707963267948966;
  const double r2 = r * r;
  const double sn = r * (1.0 - r2 / 6.0 * (1.0 - r2 / 20.0 * (1.0 - r2 / 42.0 * (1.0 - r2 / 72.0 * (1.0 - r2 / 110.0 * (1.0 - r2 / 156.0))))));
  const double cs = 1.0 - r2 / 2.0 * (1.0 - r2 / 12.0 * (1.0 - r2 / 30.0 * (1.0 - r2 / 56.0 * (1.0 - r2 / 90.0 * (1.0 - r2 / 132.0)))));
  const int q = ((int)kd) & 3;
  const double ss = (q == 0) ? sn : (q == 1) ? cs : (q == 2) ? -sn : -cs;
  const double cc = (q == 0) ? cs : (q == 1) ? -sn : (q == 2) ? -cs : sn;
  s = (float)ss; c = (float)cc;
}
__device__ __forceinline__ float sigmoidf_(float x) { return 1.f / (1.f + __expf(-x)); }
__device__ __forceinline__ float gelu_tanh(float y) { const float u = 0.7978845608028654f * (y + 0.044715f * y * y * y); return y * sigmoidf_(2.f * u); }

namespace gm {
constexpr int BM = 256, BK = 64, HALF = 128, HTB = HALF * BK * 2, NXCD = 8, WGM = 8;
__device__ __forceinline__ int lds_byte(int r, int c) { const int st = (r >> 4) * 2 + (c >> 5), rr = r & 15, cc = c & 31, ob = rr * 64 + cc * 2; return st * 1024 + (ob ^ (((ob >> 9) & 1) << 5)); }
__device__ __forceinline__ void stage_rc(int b, int& R, int& C) { const int st = b / 1024, sb = b % 1024, swz = sb ^ (((sb >> 9) & 1) << 5); R = (st >> 1) * 16 + swz / 64; C = (st & 1) * 32 + (swz % 64) / 2; }
__device__ __forceinline__ void tile_of(int wgid, int nM, int nN, int& pm, int& pn) {
  const int nwg = nM * nN; { const int q = nwg / NXCD, r = nwg % NXCD, xcd = wgid % NXCD, off = wgid / NXCD; wgid = (xcd < r ? xcd * (q + 1) : r * (q + 1) + (xcd - r) * q) + off; }
  const int nig = WGM * nN, gid = wgid / nig, fm = gid * WGM, gsz = (nM - fm) < WGM ? (nM - fm) : WGM;
  pm = fm + ((wgid % nig) % gsz); pn = (wgid % nig) / gsz;
}
struct Unit { int pm, pn; };

template <bool SWAP, class Epi, class Sched>
__device__ __forceinline__ void gemm_phase(LAS unsigned char* lds, const int lda, const int ldb, const int K, const Sched& S, const Epi& E) {
  int tid_ = threadIdx.x; asm volatile("" : "+v"(tid_));
  const int tid = tid_, wid = __builtin_amdgcn_readfirstlane(tid >> 6), lane = tid & 63, wr = wid >> 2, wc = wid & 3, fr = lane & 15, fq = lane >> 4;
  const int nt = K / BK;
  unsigned voffA[2], voffB[2];
#pragma unroll
  for (int i = 0; i < 2; ++i) { int R, C; stage_rc(tid * 16 + i * 8192, R, C); voffA[i] = (unsigned)(R * lda + C) * 2u; voffB[i] = (unsigned)(R * ldb + C) * 2u; }
  const size_t kstep = (size_t)(BK * 2), hstepA = (size_t)HALF * lda * 2, hstepB = (size_t)HALF * ldb * 2;
  const unsigned ldsw = (unsigned)wid * 1024u;
  const int aoff = lds_byte(wr * 64 + fr, fq * 8), boff = lds_byte(wc * 32 + fr, fq * 8);
#define PG8_SA(b, h) (((b) * 2 + (h)) * HTB)
#define PG8_SB(b, h) ((4 + (b) * 2 + (h)) * HTB)
#define PG8_STAGE(bufoff, gbase, voff) do { _Pragma("unroll") for (int _i = 0; _i < 2; ++_i) \
    __builtin_amdgcn_global_load_lds((const unsigned*)((const char*)(gbase) + (voff)[_i]), (LAS unsigned*)(lds + (bufoff) + ldsw + _i * 8192), 16, 0, 0); } while (0)
#define PG8_LDA(dst, b, h) do { _Pragma("unroll") for (int m = 0; m < 4; ++m) _Pragma("unroll") for (int k = 0; k < 2; ++k) dst[m][k] = *(const LAS bf16x8*)(lds + PG8_SA(b, h) + aoff + m * 2048 + k * 1024); } while (0)
#define PG8_LDB(dst, b, h) do { _Pragma("unroll") for (int n = 0; n < 2; ++n) _Pragma("unroll") for (int k = 0; k < 2; ++k) dst[n][k] = *(const LAS bf16x8*)(lds + PG8_SB(b, h) + boff + n * 2048 + k * 1024); } while (0)
#define PG8_MMA(ai, bj, At, Bt) do { __builtin_amdgcn_s_setprio(1); _Pragma("unroll") for (int m = 0; m < 4; ++m) _Pragma("unroll") for (int n = 0; n < 2; ++n) _Pragma("unroll") for (int k = 0; k < 2; ++k) \
    acc[ai][bj][m][n] = SWAP ? __builtin_amdgcn_mfma_f32_16x16x32_bf16(Bt[n][k], At[m][k], acc[ai][bj][m][n], 0, 0, 0) \
                             : __builtin_amdgcn_mfma_f32_16x16x32_bf16(At[m][k], Bt[n][k], acc[ai][bj][m][n], 0, 0, 0); __builtin_amdgcn_s_setprio(0); } while (0)
#define PG8_WAIT_V(n) asm volatile("s_waitcnt vmcnt(" #n ")" ::: "memory")
#define PG8_WAIT_L(n) asm volatile("s_waitcnt lgkmcnt(" #n ")" ::: "memory")
#define PG8_BAR __builtin_amdgcn_s_barrier()
#define PG8_SCHED __builtin_amdgcn_sched_barrier(0)
  Unit cur, nxt; int ui = 0;
  if (!S.next(0, cur)) return;
  f32x4 acc[2][2][4][2];
#pragma unroll
  for (int a = 0; a < 2; ++a)
#pragma unroll
    for (int b = 0; b < 2; ++b)
#pragma unroll
      for (int m = 0; m < 4; ++m)
#pragma unroll
        for (int n = 0; n < 2; ++n) acc[a][b][m][n] = (f32x4){0.f, 0.f, 0.f, 0.f};
  bf16x8 At[4][2], B0[2][2], B1[2][2];
  const char* cA = S.pA(cur); const char* cB = S.pB(cur);
  PG8_STAGE(PG8_SB(0, 0), cB, voffB); PG8_STAGE(PG8_SB(0, 1), cB + hstepB, voffB); PG8_STAGE(PG8_SA(0, 0), cA, voffA); PG8_STAGE(PG8_SA(0, 1), cA + hstepA, voffA);
  if (wr == 1) PG8_BAR;
  PG8_WAIT_V(2); PG8_BAR;
  PG8_STAGE(PG8_SB(1, 0), cB + kstep, voffB); PG8_STAGE(PG8_SA(1, 0), cA + kstep, voffA); PG8_STAGE(PG8_SB(1, 1), cB + hstepB + kstep, voffB);
  PG8_WAIT_V(6); PG8_BAR;
  for (;;) {
    const bool has_next = S.next(ui + 1, nxt);
    const char* nA = has_next ? S.pA(nxt) : cA; const char* nB = has_next ? S.pB(nxt) : cB;
    for (int t = 0; t < nt; t += 2) {
      const bool last = (t == nt - 2);
      const char* a1 = cA + (size_t)(t + 1) * kstep;
      const char* a2 = last ? nA : cA + (size_t)(t + 2) * kstep; const char* b2 = last ? nB : cB + (size_t)(t + 2) * kstep;
      const char* a3 = a2 + kstep; const char* b3 = b2 + kstep;
      PG8_LDB(B0, 0, 0); PG8_LDB(B1, 0, 1); PG8_SCHED; PG8_LDA(At, 0, 0); PG8_STAGE(PG8_SA(1, 1), a1 + hstepA, voffA);
      PG8_WAIT_V(8); PG8_WAIT_L(0); PG8_BAR; PG8_MMA(0, 0, At, B0); PG8_MMA(0, 1, At, B1); PG8_BAR; PG8_SCHED;
      PG8_LDA(At, 0, 1); PG8_STAGE(PG8_SB(0, 0), b2, voffB); PG8_STAGE(PG8_SB(0, 1), b2 + hstepB, voffB); PG8_STAGE(PG8_SA(0, 0), a2, voffA);
      PG8_WAIT_V(8); PG8_WAIT_L(0); PG8_BAR; PG8_MMA(1, 0, At, B0); PG8_MMA(1, 1, At, B1); PG8_BAR; PG8_SCHED;
      PG8_LDB(B0, 1, 0); PG8_LDB(B1, 1, 1); PG8_SCHED; PG8_LDA(At, 1, 0); PG8_STAGE(PG8_SA(0, 1), a2 + hstepA, voffA);
      PG8_WAIT_V(8); PG8_WAIT_L(0); PG8_BAR; PG8_MMA(0, 0, At, B0); PG8_MMA(0, 1, At, B1); PG8_BAR; PG8_SCHED;
      PG8_LDA(At, 1, 1); PG8_STAGE(PG8_SB(1, 0), b3, voffB); PG8_STAGE(PG8_SB(1, 1), b3 + hstepB, voffB); PG8_STAGE(PG8_SA(1, 0), a3, voffA);
      PG8_WAIT_V(8); PG8_WAIT_L(0); PG8_BAR; PG8_MMA(1, 0, At, B0); PG8_MMA(1, 1, At, B1); PG8_BAR; PG8_SCHED;
    }
    if (wr == 0) PG8_BAR;
    { int fr2 = fr, fq2 = fq; asm volatile("" : "+v"(fr2), "+v"(fq2));
      E(acc, cur, wr, wc, fr2, fq2); }
    if (!has_next) break;
#pragma unroll
    for (int a = 0; a < 2; ++a)
#pragma unroll
      for (int b = 0; b < 2; ++b)
#pragma unroll
        for (int m = 0; m < 4; ++m)
#pragma unroll
          for (int n = 0; n < 2; ++n) acc[a][b][m][n] = (f32x4){0.f, 0.f, 0.f, 0.f};
    cur = nxt; cA = nA; cB = nB; ++ui;
    if (wr == 1) PG8_BAR;
  }
  PG8_WAIT_V(0);
  PG8_BAR;
#undef PG8_SA
#undef PG8_SB
#undef PG8_STAGE
#undef PG8_LDA
#undef PG8_LDB
#undef PG8_MMA
#undef PG8_WAIT_V
#undef PG8_WAIT_L
#undef PG8_BAR
#undef PG8_SCHED
}
}

namespace at {
constexpr int D = 128, NW = 8, QBLK = 32, KVBLK = 64;
constexpr float SCALE = 0.088388347648318440f;
constexpr float THR = 8.f;
constexpr int LDQ = 1024, LDK = 1024, LDV = 1024, LDO = 2048;
constexpr size_t SHM_V = KVBLK * D * 2, SHM_K = KVBLK * D * 2;
#define KSWZ(row, colB) ((row) * 256 + ((colB) ^ (((row) & 7) << 4)))
#define SBAR() __builtin_amdgcn_sched_barrier(0)
__device__ __forceinline__ int crow(int r, int hi) { return (r & 3) + 8 * (r >> 2) + 4 * hi; }
__device__ __forceinline__ void partialSM(f32x16& p0, f32x16& p1, float& m_reg, float& mn, float& alpha) {
  constexpr float C = SCALE * 1.4426950408889634f;
  float pmax = p0[0];
#pragma unroll
  for (int r = 1; r < 16; ++r) pmax = fmaxf(pmax, p0[r]);
#pragma unroll
  for (int r = 0; r < 16; ++r) pmax = fmaxf(pmax, p1[r]);
  { auto rr = __builtin_amdgcn_permlane32_swap(__float_as_uint(pmax), __float_as_uint(pmax), false, false);
    pmax = fmaxf(__uint_as_float(rr[0]), __uint_as_float(rr[1])); }
  if (__builtin_expect(__all(pmax - m_reg <= THR / SCALE), 1)) { mn = m_reg; alpha = 1.f; }
  else { mn = fmaxf(m_reg, pmax); alpha = __builtin_amdgcn_exp2f((m_reg - mn) * C); m_reg = mn; }
  float mnC = -mn * C;
#pragma unroll
  for (int r = 0; r < 16; ++r) p0[r] = fmaf(p0[r], C, mnC);
#pragma unroll
  for (int r = 0; r < 16; ++r) p1[r] = fmaf(p1[r], C, mnC);
#pragma unroll
  for (int r = 0; r < 16; ++r) p0[r] = __builtin_amdgcn_exp2f(p0[r]);
}
__device__ __forceinline__ void finishSM(f32x16& p0, f32x16& p1, float alpha, float& l_reg, bf16x8& pa0, bf16x8& pa1, bf16x8& pa2, bf16x8& pa3) {
#pragma unroll
  for (int r = 0; r < 16; ++r) p1[r] = __builtin_amdgcn_exp2f(p1[r]);
  float ps = 0;
#pragma unroll
  for (int r = 0; r < 16; ++r) ps += p0[r];
#pragma unroll
  for (int r = 0; r < 16; ++r) ps += p1[r];
  { auto rr = __builtin_amdgcn_permlane32_swap(__float_as_uint(ps), __float_as_uint(ps), false, false);
    ps = __uint_as_float(rr[0]) + __uint_as_float(rr[1]); }
  l_reg = l_reg * alpha + ps;
#define PK4(P, BASE, OUT) do { unsigned a0 = cvtpk(P[BASE + 0], P[BASE + 1]), a1 = cvtpk(P[BASE + 2], P[BASE + 3]);   \
    unsigned b0 = cvtpk(P[BASE + 4], P[BASE + 5]), b1 = cvtpk(P[BASE + 6], P[BASE + 7]);                              \
    auto r0 = __builtin_amdgcn_permlane32_swap(a0, b0, false, false); auto r1 = __builtin_amdgcn_permlane32_swap(a1, b1, false, false); \
    u32x4 w = {r0[0], r1[0], r0[1], r1[1]}; OUT = *reinterpret_cast<bf16x8*>(&w); } while (0)
  PK4(p0, 0, pa0); PK4(p0, 8, pa1); PK4(p1, 0, pa2); PK4(p1, 8, pa3);
#undef PK4
}
__device__ __forceinline__ void qkt(f32x16& p0, f32x16& p1, const char* Ks, const bf16x8* qr, int r32, int hi) {
  p0 = f32x16{}; p1 = f32x16{};
#pragma unroll
  for (int d0 = 0; d0 < 8; ++d0) { int cb = (d0 * 16 + hi * 8) * 2;
    bf16x8 b0 = *reinterpret_cast<const bf16x8*>(Ks + KSWZ(r32, cb));
    bf16x8 b1 = *reinterpret_cast<const bf16x8*>(Ks + KSWZ(32 + r32, cb));
    p0 = __builtin_amdgcn_mfma_f32_32x32x16_bf16(b0, qr[d0], p0, 0, 0, 0);
    p1 = __builtin_amdgcn_mfma_f32_32x32x16_bf16(b1, qr[d0], p1, 0, 0, 0); }
}
__device__ __forceinline__ int v_st(int k, int c) { const int kk = (k & ~0xC) | ((k & 4) << 1) | ((k & 8) >> 1); return ((kk >> 3) * 4 + (c >> 5)) * 512 + ((kk & 7) * 32 + (c & 31)) * 2; }
__device__ __forceinline__ int v_rd_base(int lane) { return ((lane & 3) << 3) | (((lane >> 2) & 3) << 6) | (((lane >> 4) & 1) << 5) | (((lane >> 5) & 1) << 8); }
constexpr int v_rd_off(int d0, int ks, int half) { return d0 * 512 + ks * 4096 + half * 2048; }
template <int OFF> __device__ __forceinline__ s16x4 tr_read(int vb) {
  s16x4 r; asm volatile("ds_read_b64_tr_b16 %0, %1 offset:%2" : "=&v"(r) : "v"(vb), "i"(OFF) : "memory"); return r;
}
template <int D0> __device__ __forceinline__ void pv_one(f32x16& od, int vb, bf16x8 pa0, bf16x8 pa1, bf16x8 pa2, bf16x8 pa3) {
  const s16x4 l0 = tr_read<v_rd_off(D0, 0, 0)>(vb), h0 = tr_read<v_rd_off(D0, 0, 1)>(vb), l1 = tr_read<v_rd_off(D0, 1, 0)>(vb), h1 = tr_read<v_rd_off(D0, 1, 1)>(vb);
  const s16x4 l2 = tr_read<v_rd_off(D0, 2, 0)>(vb), h2 = tr_read<v_rd_off(D0, 2, 1)>(vb), l3 = tr_read<v_rd_off(D0, 3, 0)>(vb), h3 = tr_read<v_rd_off(D0, 3, 1)>(vb);
  asm volatile("s_waitcnt lgkmcnt(0)" ::: "memory"); SBAR();
#define PK(L, H) (bf16x8){L[0], L[1], L[2], L[3], H[0], H[1], H[2], H[3]}
  od = __builtin_amdgcn_mfma_f32_32x32x16_bf16(pa0, PK(l0, h0), od, 0, 0, 0);
  od = __builtin_amdgcn_mfma_f32_32x32x16_bf16(pa1, PK(l1, h1), od, 0, 0, 0);
  od = __builtin_amdgcn_mfma_f32_32x32x16_bf16(pa2, PK(l2, h2), od, 0, 0, 0);
  od = __builtin_amdgcn_mfma_f32_32x32x16_bf16(pa3, PK(l3, h3), od, 0, 0, 0);
#undef PK
}
__device__ __forceinline__ void pv_d0(f32x16* o, int vb, bf16x8 pa0, bf16x8 pa1, bf16x8 pa2, bf16x8 pa3) {
  pv_one<0>(o[0], vb, pa0, pa1, pa2, pa3); pv_one<1>(o[1], vb, pa0, pa1, pa2, pa3); pv_one<2>(o[2], vb, pa0, pa1, pa2, pa3); pv_one<3>(o[3], vb, pa0, pa1, pa2, pa3);
}
__device__ __forceinline__ void body(const bf16_t* __restrict__ Qb, const bf16_t* __restrict__ Kh, const bf16_t* __restrict__ Vh, bf16_t* __restrict__ Ob, int seq, char* lds) {
  int tid_ = threadIdx.x; asm volatile("" : "+v"(tid_));
  const int tid = tid_, wid = tid >> 6, lane = tid & 63, r32 = lane & 31, hi = lane >> 5;
  char* V_lds = lds; char* K_lds = lds + 2 * SHM_V;
  float* ws = (float*)(lds + 2 * SHM_V + 2 * SHM_K) + wid * 64; float* li_l = ws; float* al_l = ws + 32;
  float m_reg = -1e30f, l_reg = 0; f32x16 o[4] = {}; bf16x8 qr[8];
  const bf16_t* Qw = Qb + (long)(wid * QBLK + r32) * LDQ + hi * 8;
#pragma unroll
  for (int d0 = 0; d0 < 8; ++d0) qr[d0] = *reinterpret_cast<const bf16x8*>(Qw + d0 * 16);
  const int sr = tid >> 4, sc = (tid & 15) * 8, vst0 = v_st(sr, sc), vst1 = v_st(32 + sr, sc);
  const int vb0 = (int)(uintptr_t)(LAS char*)V_lds + v_rd_base(lane);
  bf16x8 sA_vs0, sA_vs1, sA_ks0, sA_ks1, sB_vs0, sB_vs1, sB_ks0, sB_ks1;
#define SLOAD(S, k0) do { S##_vs0 = *reinterpret_cast<const bf16x8*>(&Vh[(long)((k0) + sr) * LDV + sc]); S##_vs1 = *reinterpret_cast<const bf16x8*>(&Vh[(long)((k0) + 32 + sr) * LDV + sc]); \
    S##_ks0 = *reinterpret_cast<const bf16x8*>(&Kh[(long)((k0) + sr) * LDK + sc]); S##_ks1 = *reinterpret_cast<const bf16x8*>(&Kh[(long)((k0) + 32 + sr) * LDK + sc]); } while (0)
#define SWRITE(b, S) do { *(bf16x8*)(V_lds + (b) * SHM_V + vst0) = S##_vs0; *(bf16x8*)(V_lds + (b) * SHM_V + vst1) = S##_vs1; int kc = sc * 2; \
    *(bf16x8*)(K_lds + (b) * SHM_K + KSWZ(sr, kc)) = S##_ks0; *(bf16x8*)(K_lds + (b) * SHM_K + KSWZ(32 + sr, kc)) = S##_ks1; } while (0)
#define SWAIT() asm volatile("s_waitcnt vmcnt(4)" ::: "memory")
#define RESC(a) do { if (__any((a) < 1.f)) { if (hi == 0) al_l[r32] = (a); asm volatile("s_waitcnt lgkmcnt(0)" ::: "memory"); \
    for (int d = 0; d < 4; ++d) for (int r = 0; r < 16; ++r) o[d][r] *= al_l[crow(r, hi)]; } } while (0)
  f32x16 pA0, pA1, pB0, pB1; float mnA, mnB, alA, alB; bf16x8 pa0, pa1, pa2, pa3; const int NT = seq / KVBLK;
  SLOAD(sA, 0); asm volatile("s_waitcnt vmcnt(0)" ::: "memory"); SWRITE(0, sA); __syncthreads();
  qkt(pA0, pA1, K_lds, qr, r32, hi); partialSM(pA0, pA1, m_reg, mnA, alA);
  SLOAD(sB, KVBLK); if (2 < NT) SLOAD(sA, 2 * KVBLK);
  SWAIT(); SWRITE(1, sB); __syncthreads();
  for (int j = 1; j + 1 < NT; j += 2) {
    SBAR(); qkt(pB0, pB1, K_lds + SHM_K, qr, r32, hi);
    finishSM(pA0, pA1, alA, l_reg, pa0, pa1, pa2, pa3); SBAR();
    SLOAD(sB, (j + 2) * KVBLK); SBAR();
    pv_d0(o, vb0, pa0, pa1, pa2, pa3); partialSM(pB0, pB1, m_reg, mnB, alB);
    __syncthreads(); SWAIT(); SWRITE(0, sA);
    RESC(alB); __syncthreads();
    SBAR(); qkt(pA0, pA1, K_lds, qr, r32, hi);
    finishSM(pB0, pB1, alB, l_reg, pa0, pa1, pa2, pa3); SBAR();
    if (j + 3 < NT) SLOAD(sA, (j + 3) * KVBLK); SBAR();
    pv_d0(o, vb0 + (int)SHM_V, pa0, pa1, pa2, pa3); partialSM(pA0, pA1, m_reg, mnA, alA);
    __syncthreads(); SWAIT(); SWRITE(1, sB);
    RESC(alA); __syncthreads();
  }
  SBAR(); qkt(pB0, pB1, K_lds + SHM_K, qr, r32, hi);
  finishSM(pA0, pA1, alA, l_reg, pa0, pa1, pa2, pa3); SBAR();
  pv_d0(o, vb0, pa0, pa1, pa2, pa3); partialSM(pB0, pB1, m_reg, mnB, alB);
  __syncthreads(); RESC(alB);
  finishSM(pB0, pB1, alB, l_reg, pa0, pa1, pa2, pa3); SBAR();
  pv_d0(o, vb0 + (int)SHM_V, pa0, pa1, pa2, pa3);
  if (hi == 0) li_l[r32] = l_reg; asm volatile("s_waitcnt lgkmcnt(0)" ::: "memory");
  float rli[16];
#pragma unroll
  for (int r = 0; r < 16; ++r) rli[r] = __builtin_amdgcn_rcpf(li_l[crow(r, hi)]);
  bf16_t* Ow = Ob + (long)(wid * QBLK) * LDO;
#pragma unroll
  for (int r = 0; r < 16; ++r) { int orow = crow(r, hi);
#pragma unroll
    for (int d0 = 0; d0 < 4; ++d0) Ow[(long)orow * LDO + d0 * 32 + r32] = (bf16_t)(cvtpk(o[d0][r] * rli[r], 0.f) & 0xffff); }
#undef SLOAD
#undef SWRITE
#undef SWAIT
#undef RESC
  __syncthreads();
}
}

struct Ctx {
  int tid, wid, lane, blk, nblk, gwave, nwave; long gtid, nthr;
};

__device__ __forceinline__ const float* modp(const Params& p, int l, int v, int j) { return (const float*)(p.ws + OFF_MOD) + ((size_t)(l * 5 + v) * NMODC + (size_t)j * DM); }

__device__ __forceinline__ void convert_weights(const Params& p, const Ctx& c, int l, float* lds) {
  constexpr int T0 = 14 * 32, T1 = 8 * 32, T2 = 44 * 32, T3 = 8 * 88, T4 = 2 * 8, TALL = T0 + T1 + T2 + T3 + T4;
  for (int it = c.blk; it < TALL; it += c.nblk) {
    int mat, ti = it;
    if (ti < T0) mat = 0; else if ((ti -= T0) < T1) mat = 1; else if ((ti -= T1) < T2) mat = 2; else if ((ti -= T2) < T3) mat = 3; else { ti -= T3; mat = 4; }
    const float* src; long ld; bf16_t* dst; long dld; int nkt;
    if (mat == 0) { src = p.w_in + (size_t)l * DM * 4096; ld = 4096; dst = (bf16_t*)(p.ws + OFF_WIN); dld = DM; nkt = 32; }
    else if (mat == 1) { src = p.w_out + (size_t)l * DM * DM; ld = DM; dst = (bf16_t*)(p.ws + OFF_WOUT); dld = DM; nkt = 32; }
    else if (mat == 2) { src = p.w_gate + (size_t)l * DM * DFF; ld = DFF; dst = (bf16_t*)(p.ws + OFF_WGU); dld = DM; nkt = 32; }
    else if (mat == 3) { src = p.w_down + (size_t)l * DFF * DM; ld = DM; dst = (bf16_t*)(p.ws + OFF_WD); dld = DFF; nkt = 88; }
    else { src = p.w_glu + (size_t)l * 512 * 512; ld = 512; dst = (bf16_t*)(p.ws + OFF_WGLU); dld = 512; nkt = 8; }
    const int n0 = (ti / nkt) * 256, k0 = (ti % nkt) * 64;
    {
      const int nn = c.tid & 255, kk0 = c.tid >> 8, np = n0 + nn; int scol = np;
      if (mat == 0) { if (np < 2048) scol = (np & ~0x30) | ((np & 16) << 1) | ((np & 32) >> 1); }
      else if (mat == 2) { const int pn = np >> 8, bj = (np >> 7) & 1; scol = pn * 128 + (np & 127); if (bj) src = p.w_up + (size_t)l * DM * DFF; }
      const float* sp = src + (size_t)(k0 + kk0) * ld + scol; float v[32];
#pragma unroll
      for (int i = 0; i < 32; ++i) v[i] = sp[(size_t)(2 * i) * ld];
#pragma unroll
      for (int i = 0; i < 32; ++i) lds[(kk0 + 2 * i) * 257 + nn] = v[i];
    }
    __syncthreads();
    {
      const int kc = (c.tid & 7) * 8;
#pragma unroll
      for (int j = 0; j < 4; ++j) { const int nn = (c.tid >> 3) + 64 * j; float v[8];
#pragma unroll
        for (int i = 0; i < 8; ++i) v[i] = lds[(kc + i) * 257 + nn];
        u32x4 w = {cvtpk(v[0], v[1]), cvtpk(v[2], v[3]), cvtpk(v[4], v[5]), cvtpk(v[6], v[7])};
        *(u32x4*)(dst + (size_t)(n0 + nn) * dld + k0 + kc) = w; }
    }
    __syncthreads();
  }
}

__device__ __forceinline__ void fold_four(const Params& p, const Ctx& c, int l, float* lds) {
  float* WlT = lds;
  float* Wc = lds + 128 * 68;
  const float* wcs = (const float*)(p.ws + OFF_WCS) + (size_t)l * 2 * 4 * 128 * 128;
  bf16_t* dstb = (bf16_t*)(p.ws + OFF_WIN);
  for (int u = c.blk; u < 256; u += c.nblk) {
    const int kt = u & 31, cs = (u >> 5) & 1, g = u >> 6, k0 = kt * 64;
    const float* src = p.w_in + (size_t)l * DM * 4096 + 3584 + g * 128;
    for (int i = c.tid; i < 64 * 128; i += NTHREADS) { const int kk = i >> 7, cc = i & 127; WlT[cc * 68 + kk] = src[(size_t)(k0 + kk) * 4096 + cc]; }
    const float* wsrc = wcs + (size_t)(cs * 4 + g) * 128 * 128;
    for (int i = c.tid; i < 128 * 128; i += NTHREADS) Wc[i] = wsrc[i];
    __syncthreads();
    const int kq = c.tid & 15, dq = c.tid >> 4;
    f32x4 acc[4] = {};
    for (int cc = 0; cc < 128; ++cc) {
      const f32x4 a = *(const f32x4*)(WlT + cc * 68 + kq * 4), w = *(const f32x4*)(Wc + cc * 128 + dq * 4);
#pragma unroll
      for (int di = 0; di < 4; ++di) acc[di] += a * w[di];
    }
#pragma unroll
    for (int di = 0; di < 4; ++di) { u32x2 o = {cvtpk(acc[di][0], acc[di][1]), cvtpk(acc[di][2], acc[di][3])};
      *(u32x2*)(dstb + (size_t)(3584 + cs * 512 + g * 128 + dq * 4 + di) * DM + k0 + kq * 4) = o; }
    __syncthreads();
  }
}


__device__ __forceinline__ void ssm_tables(const Params& p, const Ctx& c) {
  float2* PW = (float2*)(p.ws + OFF_PW); float2* BB = (float2*)(p.ws + OFF_BB);
  for (long i = c.gtid; i < 2L * 32 * 2 * 64; i += c.nthr) { const int pp = (int)(i & 63), idx = (int)(i >> 6);
    const int d = idx & 1, g = (idx >> 1) & 31, l = idx >> 6, iidx = (l * 2 + d) * 32 + g;
    const float lre = p.ssm_a_re[iidx * 64 + pp], lim = p.ssm_a_im[iidx * 64 + pp], dt = expf(p.ssm_log_dt[iidx]);
    float ar = 1.f, ai = 0.f;
    for (int j = 0; j <= 32; ++j) { const float mag = expf(lre * dt * (float)j); float sn, cs; my_sincos(lim * dt * (float)j, sn, cs);
      PW[((size_t)idx * 33 + j) * 64 + pp] = make_float2(mag * cs, mag * sn); if (j == 1) { ar = mag * cs; ai = mag * sn; } }
    const float nr = ar - 1.f, ni = ai, den = 1.f / (lre * lre + lim * lim), cr = (nr * lre + ni * lim) * den, ci = (ni * lre - nr * lim) * den;
    const float* br = p.ssm_b_re + ((size_t)iidx * 64 + pp) * 16; const float* bi = p.ssm_b_im + ((size_t)iidx * 64 + pp) * 16;
    for (int h = 0; h < 16; ++h) BB[((size_t)idx * 64 + pp) * 16 + h] = make_float2(cr * br[h] - ci * bi[h], cr * bi[h] + ci * br[h]); }
}
__device__ __forceinline__ void ssm_build_mef(const Params& p, const Ctx& c, int l) {
  const float2* PW = (const float2*)(p.ws + OFF_PW) + (size_t)l * 32 * 2 * 33 * 64; const float2* BB = (const float2*)(p.ws + OFF_BB) + (size_t)l * 32 * 2 * 64 * 16;
  float* MK = (float*)(p.ws + OFF_MK) + (size_t)l * 32 * 2 * 32 * 256; bf16_t* EM = (bf16_t*)(p.ws + OFF_EM); bf16_t* TF = (bf16_t*)(p.ws + OFF_TF);
  for (long i = c.gtid; i < 32L * 2 * 32 * 256; i += c.nthr) { const int hp = (int)(i & 15), h = (int)((i >> 4) & 15), j = (int)((i >> 8) & 31), gd = (int)(i >> 13), d = gd & 1, g = gd >> 1;
    const size_t ci = ((size_t)((l * 2 + d) * 32 + g) * 16 + h) * 64; const float2* pw = PW + ((size_t)gd * 33 + j) * 64; const float2* bb = BB + (size_t)gd * 64 * 16 + hp; float a = 0.f;
    for (int pp = 0; pp < 64; ++pp) { const float cr = p.ssm_c_re[ci + pp], cim = p.ssm_c_im[ci + pp]; const float2 b = bb[pp * 16], w = pw[pp];
      const float wr = cr * b.x - cim * b.y, wi = cr * b.y + cim * b.x; a += wr * w.x - wi * w.y; }
    MK[i] = a; }
  for (long i = c.gtid; i < 32L * 256 * 32 * 2; i += c.nthr) { const int hh = (int)(i & 1), s = (int)((i >> 1) & 31), n = (int)((i >> 6) & 255), g = (int)(i >> 14), ri = n & 1, pp = (n >> 1) & 63, d = n >> 7;
    const int gd = g * 2 + d, e = d ? s : 31 - s; const float2 w = PW[((size_t)gd * 33 + e) * 64 + pp]; const float2* bb = BB + ((size_t)gd * 64 + pp) * 16 + hh * 8; float v[8];
#pragma unroll
    for (int k = 0; k < 8; ++k) { const float2 b = bb[k]; v[k] = ri ? (w.x * b.y + w.y * b.x) : (w.x * b.x - w.y * b.y); }
    u32x4 o = {cvtpk(v[0], v[1]), cvtpk(v[2], v[3]), cvtpk(v[4], v[5]), cvtpk(v[6], v[7])}; *(u32x4*)(EM + ((size_t)g * 256 + n) * 512 + s * 16 + hh * 8) = o; }
  for (long i = c.gtid; i < 32L * 512 * 2 * 16; i += c.nthr) { const int pq = (int)(i & 15), d = (int)((i >> 4) & 1), n = (int)((i >> 5) & 511), g = (int)(i >> 14), h = n & 15, t = n >> 4;
    const int gd = g * 2 + d, f = d ? 32 - t : t + 1; const size_t ci = ((size_t)((l * 2 + d) * 32 + g) * 16 + h) * 64 + pq * 4; const float2* pw = PW + ((size_t)gd * 33 + f) * 64 + pq * 4; float v[8];
#pragma unroll
    for (int k = 0; k < 4; ++k) { const float cr = p.ssm_c_re[ci + k], cim = p.ssm_c_im[ci + k]; const float2 w = pw[k]; v[2 * k] = cr * w.x - cim * w.y; v[2 * k + 1] = -(cr * w.y + cim * w.x); }
    u32x4 o = {cvtpk(v[0], v[1]), cvtpk(v[2], v[3]), cvtpk(v[4], v[5]), cvtpk(v[6], v[7])}; *(u32x4*)(TF + ((size_t)g * 512 + n) * 768 + 512 + d * 128 + pq * 8) = o; }
}
__device__ __forceinline__ void ssm_build_t(const Params& p, const Ctx& c, int l) {
  const float* MK = (const float*)(p.ws + OFF_MK) + (size_t)l * 32 * 2 * 32 * 256; bf16_t* TF = (bf16_t*)(p.ws + OFF_TF);
  for (long i = c.gtid; i < 32L * 512 * 32 * 2; i += c.nthr) { const int hh = (int)(i & 1), s = (int)((i >> 1) & 31), n = (int)((i >> 6) & 511), g = (int)(i >> 15), h = n & 15, t = n >> 4;
    const int lag = t - s; float v[8];
    if (lag != 0) { const float* m = MK + ((size_t)((g * 2 + (lag < 0 ? 1 : 0)) * 32 + (lag < 0 ? -lag : lag)) * 16 + h) * 16 + hh * 8;
#pragma unroll
      for (int k = 0; k < 8; ++k) v[k] = m[k]; }
    else { const float* m0 = MK + ((size_t)((g * 2) * 32) * 16 + h) * 16 + hh * 8; const float* m1 = MK + ((size_t)((g * 2 + 1) * 32) * 16 + h) * 16 + hh * 8; const float dsk = p.ssm_d[(size_t)l * 512 + g * 16 + h];
#pragma unroll
      for (int k = 0; k < 8; ++k) v[k] = m0[k] + m1[k] + ((hh * 8 + k) == h ? dsk : 0.f); }
    u32x4 o = {cvtpk(v[0], v[1]), cvtpk(v[2], v[3]), cvtpk(v[4], v[5]), cvtpk(v[6], v[7])}; *(u32x4*)(TF + ((size_t)g * 512 + n) * 768 + s * 16 + hh * 8) = o; }
}
__device__ __forceinline__ void ssm_carry(const Params& p, const Ctx& c, int l) {
  if (c.wid != 0) return;
  const float2* PW = (const float2*)(p.ws + OFF_PW) + (size_t)l * 32 * 2 * 33 * 64; const float* SB = (const float*)(p.ws + OFF_Z2 + Z2_SB); bf16_t* UG = (bf16_t*)(p.ws + OFF_Z2 + Z2_UG);
  for (int i = c.blk * 64 + c.lane; i < NB * 32 * 2 * 64; i += c.nblk * 64) { const int pp = i & 63, d = (i >> 6) & 1, g = (i >> 7) & 31, b = i >> 12;
    const float2 a32 = PW[((size_t)(g * 2 + d) * 33 + 32) * 64 + pp]; float hr = 0.f, hi = 0.f;
    const size_t rbase = (size_t)g * 768 + b * 136; const int col = (d * 64 + pp) * 2;
#pragma unroll 8
    for (int k = 0; k < 136; ++k) { const int ch = d == 0 ? k : (k < 8 ? 7 - k : 143 - k);
      const float2 s = *(const float2*)(SB + (rbase + ch) * 256 + col);
      *(unsigned*)(UG + (rbase + ch) * 768 + 512 + col) = cvtpk(hr, hi);
      const float nr = a32.x * hr - a32.y * hi + s.x, ni = a32.x * hi + a32.y * hr + s.y; hr = nr; hi = ni; } }
}

__device__ __forceinline__ void phase0a(const Params& p, const Ctx& c, float* lds) {
  for (int i = c.tid; i < 5 * DM; i += NTHREADS) { const float v = i < 4 * DM ? p.c[i] : p.c_ctx[i - 4 * DM]; lds[i] = v * sigmoidf_(v); }
  __syncthreads();
  {
    float* MP = (float*)(p.ws + OFF_MP);
    for (long it = c.gtid; it < 16 * 6144; it += c.nthr) {
      const int cq = (int)(it % 6144), ks = (int)(it / 6144); const int gc = cq * 4, l = gc / NMODC, col = gc % NMODC;
      const float* wp = p.w_mod + ((size_t)l * DM + (size_t)ks * 128) * NMODC + col;
      f32x4 a[5] = {};
#pragma unroll 8
      for (int k = 0; k < 128; ++k) { const f32x4 w = *(const f32x4*)(wp + (size_t)k * NMODC);
#pragma unroll
        for (int v = 0; v < 5; ++v) a[v] += w * lds[v * DM + ks * 128 + k]; }
#pragma unroll
      for (int v = 0; v < 5; ++v) *(f32x4*)(MP + ((size_t)ks * 5 + v) * 24576 + gc) = a[v];
    }
  }
  __syncthreads();
  {
    float* rc = (float*)(p.ws + OFF_ROPE); float* rs = rc + 64 * 32;
    for (long i = c.gtid; i < 64 * 32; i += c.nthr) { const int pos = (int)(i >> 5), pp = (int)(i & 31);
      const float inv = (float)exp2(-(double)pp / 32.0 * 13.287712379549449); float s, cc; my_sincos((float)pos * inv, s, cc); rc[i] = cc; rs[i] = s; }
  }
  {
    bf16_t* DL = (bf16_t*)(p.ws + OFF_DFTL);
    for (long i = c.gtid; i < 2L * 4096 * 512; i += c.nthr) { const int part = (int)(i >> 21), k = (int)((i >> 9) & 4095), t0 = (int)(i & 511) * 8; float v[8];
#pragma unroll
      for (int j = 0; j < 8; ++j) { const float ph = (float)((k * (t0 + j)) & 4095) * (1.f / 4096.f); v[j] = (part ? __builtin_amdgcn_sinf(ph) : __builtin_amdgcn_cosf(ph)) * (1.f / 64.f); }
      u32x4 w = {cvtpk(v[0], v[1]), cvtpk(v[2], v[3]), cvtpk(v[4], v[5]), cvtpk(v[6], v[7])}; *(u32x4*)(DL + i * 8) = w; }
    bf16_t* DC = (bf16_t*)(p.ws + OFF_DFTC);
    for (long i = c.gtid; i < 2L * 256 * 32; i += c.nthr) { const int part = (int)(i >> 13), k = (int)((i >> 5) & 255), t0 = (int)(i & 31) * 8; float v[8];
#pragma unroll
      for (int j = 0; j < 8; ++j) { const float ph = (float)((k * (t0 + j)) & 255) * (1.f / 256.f); v[j] = (part ? __builtin_amdgcn_sinf(ph) : __builtin_amdgcn_cosf(ph)) * (1.f / 16.f); }
      u32x4 w = {cvtpk(v[0], v[1]), cvtpk(v[2], v[3]), cvtpk(v[4], v[5]), cvtpk(v[6], v[7])}; *(u32x4*)(DC + i * 8) = w; }
  }
  {
    float* W = (float*)(p.ws + OFF_WCS);
    for (long i = c.gtid; i < 2L * 2 * 4 * 128 * 128; i += c.nthr) { const int d = (int)(i & 127), cc = (int)((i >> 7) & 127), g = (int)((i >> 14) & 3), cs = (int)((i >> 16) & 1), l = (int)(i >> 17);
      const float* wf = p.w_four + ((size_t)(l * 4 + g) * 128) * 128 + d; float a = 0.f;
      for (int j = 0; j < 128; ++j) { const float ph = (float)((j * cc) & 127) * (1.f / 128.f); a += (cs ? __builtin_amdgcn_sinf(ph) : __builtin_amdgcn_cosf(ph)) * wf[(size_t)j * 128]; }
      W[i] = a * 0.08838834764831845f; }
  }
}

__device__ __forceinline__ void reduce_mod(const Params& p, const Ctx& c) {
  const float* MP = (const float*)(p.ws + OFF_MP); float* MOD = (float*)(p.ws + OFF_MOD);
  for (long o = c.gtid; o < 5L * 24576; o += c.nthr) { const int v = (int)(o / 24576), gc = (int)(o % 24576), l = gc / NMODC, col = gc % NMODC;
    float a = p.b_mod[gc];
#pragma unroll
    for (int ks = 0; ks < 16; ++ks) a += MP[((size_t)ks * 5 + v) * 24576 + gc];
    MOD[(size_t)(l * 5 + v) * NMODC + col] = a; }
}

__device__ __forceinline__ void prenorm_row(const f32x4 (&x)[8], float rinv, const float* g, const float* sc, const float* sh, bf16_t* dst, int lane) {
#pragma unroll
  for (int i = 0; i < 8; ++i) { const int col = (lane + 64 * i) * 4; const f32x4 gg = *(const f32x4*)(g + col), s1 = *(const f32x4*)(sc + col), s0 = *(const f32x4*)(sh + col);
    const f32x4 y = (x[i] * rinv * gg) * (s1 + 1.f) + s0; u32x2 o = {cvtpk(y[0], y[1]), cvtpk(y[2], y[3])}; *(u32x2*)(dst + col) = o; }
}
__device__ __forceinline__ float sumsq8(const f32x4 (&x)[8]) { float s = 0.f;
#pragma unroll
  for (int i = 0; i < 8; ++i) s += x[i][0] * x[i][0] + x[i][1] * x[i][1] + x[i][2] * x[i][2] + x[i][3] * x[i][3];
  return wave_sum(s); }

__device__ __forceinline__ const float* xrow_src(const Params& p, int l, int b, int t, int row) {
  if (l != 0) return (const float*)(p.ws + OFF_X) + (size_t)row * DM;
  const float* base = t < CTXL ? p.ctx : p.x; const size_t off = t < CTXL ? ((size_t)b * CTXL + t) * DM : ((size_t)b * SEQ + (t - CTXL)) * DM; return base + off;
}
__device__ __forceinline__ void phase_prenorm(const Params& p, const Ctx& c, int l) {
  bf16_t* Hn = (bf16_t*)(p.ws + OFF_HN);
  for (int row = c.gwave; row < TT; row += c.nwave) { const int b = row / TPB, t = row % TPB, v = t < CTXL ? 4 : b;
    f32x4 x[8]; const f32x4* xr = (const f32x4*)xrow_src(p, l, b, t, row);
#pragma unroll
    for (int i = 0; i < 8; ++i) x[i] = xr[c.lane + 64 * i];
    const float rinv = rsqrtf(sumsq8(x) * (1.f / DM) + 1e-6f);
    prenorm_row(x, rinv, p.g_mix_pre + (size_t)l * DM, modp(p, l, v, 1), modp(p, l, v, 0), Hn + (size_t)row * DM, c.lane); }
}
__device__ __forceinline__ void phase_postmix(const Params& p, const Ctx& c, int l, bool last) {
  float* X = (float*)(p.ws + OFF_X); const bf16_t* MIX = (const bf16_t*)(p.ws + OFF_Z1); bf16_t* Hn = (bf16_t*)(p.ws + OFF_HN);
  for (int row = c.gwave; row < TT; row += c.nwave) { const int b = row / TPB, t = row % TPB, v = t < CTXL ? 4 : b; if (last && t < CTXL) continue;
    f32x4 m[8], x[8]; const u32x2* mr = (const u32x2*)(MIX + (size_t)row * DM); f32x4* xr = (f32x4*)(X + (size_t)row * DM); const f32x4* xs = (const f32x4*)xrow_src(p, l, b, t, row);
    if (t < CTXL) { const u32x2* sl = (const u32x2*)(p.ws + OFF_Z2) + ((size_t)b * CTXL + t) * (DM / 4);
#pragma unroll
      for (int i = 0; i < 8; ++i) { m[i] = (f32x4){0.f, 0.f, 0.f, 0.f}; x[i] = xs[c.lane + 64 * i]; }
      for (int s = 0; s < 8; ++s) {
#pragma unroll
        for (int i = 0; i < 8; ++i) { const u32x2 w = sl[(size_t)s * NB * CTXL * (DM / 4) + c.lane + 64 * i]; m[i] += (f32x4){__uint_as_float(w[0] << 16), __uint_as_float(w[0] & 0xffff0000u), __uint_as_float(w[1] << 16), __uint_as_float(w[1] & 0xffff0000u)}; } } }
    else {
#pragma unroll
    for (int i = 0; i < 8; ++i) { const u32x2 w = mr[c.lane + 64 * i]; m[i] = (f32x4){__uint_as_float(w[0] << 16), __uint_as_float(w[0] & 0xffff0000u), __uint_as_float(w[1] << 16), __uint_as_float(w[1] & 0xffff0000u)}; x[i] = xs[c.lane + 64 * i]; } }
    const float r1 = rsqrtf(sumsq8(m) * (1.f / DM) + 1e-6f); const float* gp = p.g_mix_post + (size_t)l * DM; const float* m2 = modp(p, l, v, 2);
#pragma unroll
    for (int i = 0; i < 8; ++i) { const int col = (c.lane + 64 * i) * 4; x[i] += *(const f32x4*)(m2 + col) * (m[i] * r1 * *(const f32x4*)(gp + col)); xr[c.lane + 64 * i] = x[i]; }
    const float r2 = rsqrtf(sumsq8(x) * (1.f / DM) + 1e-6f);
    prenorm_row(x, r2, p.g_ffn_pre + (size_t)l * DM, modp(p, l, v, 4), modp(p, l, v, 3), Hn + (size_t)row * DM, c.lane); }
}
__device__ __forceinline__ void phase_postffn(const Params& p, const Ctx& c, int l, bool last) {
  float* X = (float*)(p.ws + OFF_X); const bf16_t* F = (const bf16_t*)(p.ws + OFF_Z1 + (size_t)TT * DM * 2); bf16_t* Hn = (bf16_t*)(p.ws + OFF_HN);
  for (int row = c.gwave; row < TT; row += c.nwave) { const int b = row / TPB, t = row % TPB, v = t < CTXL ? 4 : b; if (last && t < CTXL) continue;
    f32x4 m[8], x[8]; const u32x2* mr = (const u32x2*)(F + (size_t)row * DM); f32x4* xr = (f32x4*)(X + (size_t)row * DM);
    if (t < CTXL) { const u32x2* sl = (const u32x2*)(p.ws + OFF_Z1) + ((size_t)b * CTXL + t) * (DM / 4);
#pragma unroll
      for (int i = 0; i < 8; ++i) { m[i] = (f32x4){0.f, 0.f, 0.f, 0.f}; x[i] = xr[c.lane + 64 * i]; }
      for (int s = 0; s < 11; ++s) {
#pragma unroll
        for (int i = 0; i < 8; ++i) { const u32x2 w = sl[(size_t)s * NB * CTXL * (DM / 4) + c.lane + 64 * i]; m[i] += (f32x4){__uint_as_float(w[0] << 16), __uint_as_float(w[0] & 0xffff0000u), __uint_as_float(w[1] << 16), __uint_as_float(w[1] & 0xffff0000u)}; } } }
    else {
#pragma unroll
    for (int i = 0; i < 8; ++i) { const u32x2 w = mr[c.lane + 64 * i]; m[i] = (f32x4){__uint_as_float(w[0] << 16), __uint_as_float(w[0] & 0xffff0000u), __uint_as_float(w[1] << 16), __uint_as_float(w[1] & 0xffff0000u)}; x[i] = xr[c.lane + 64 * i]; } }
    const float r1 = rsqrtf(sumsq8(m) * (1.f / DM) + 1e-6f); const float* gp = p.g_ffn_post + (size_t)l * DM; const float* m5 = modp(p, l, v, 5);
#pragma unroll
    for (int i = 0; i < 8; ++i) { const int col = (c.lane + 64 * i) * 4; x[i] += *(const f32x4*)(m5 + col) * (m[i] * r1 * *(const f32x4*)(gp + col)); }
    if (last) { f32x4* o = (f32x4*)(p.out + ((size_t)b * SEQ + (t - CTXL)) * DM);
#pragma unroll
      for (int i = 0; i < 8; ++i) o[c.lane + 64 * i] = x[i]; }
    else {
#pragma unroll
      for (int i = 0; i < 8; ++i) xr[c.lane + 64 * i] = x[i];
      const float r2 = rsqrtf(sumsq8(x) * (1.f / DM) + 1e-6f);
      prenorm_row(x, r2, p.g_mix_pre + (size_t)(l + 1) * DM, modp(p, l + 1, v, 1), modp(p, l + 1, v, 0), Hn + (size_t)row * DM, c.lane); } }
}

typedef f32x4 Acc[2][2][4][2];
__device__ __forceinline__ int lat_pm(int i) { return (i >> 4) * 17 + 1 + (i & 15); }

struct SchedMN {
  const char* A; const char* B; size_t strA, strB;
  int nM, nN, pn0, latonly, nextra, blk, nblk;
  __device__ __forceinline__ bool next(int i, gm::Unit& u) const {
    const int it = i * nblk + blk, nmain = nM * nN;
    if (it < nmain) { gm::tile_of(it, nM, nN, u.pm, u.pn); if (latonly) u.pm = lat_pm(u.pm); u.pn += pn0; return true; }
    if (it < nmain + nextra) { const int j = it - nmain; u.pm = (j / 10) * 17; u.pn = 4 + (j % 10); return true; }
    return false;
  }
  __device__ __forceinline__ const char* pA(const gm::Unit& u) const { return A + (size_t)u.pm * strA; }
  __device__ __forceinline__ const char* pB(const gm::Unit& u) const { return B + (size_t)u.pn * strB; }
};

struct EpiIn {
  bf16_t *Qb, *Kb, *Vb, *UG, *PT; const float *rc, *rs;
  __device__ __forceinline__ void operator()(const Acc& acc, const gm::Unit& u, int wr, int wc, int fr, int fq) const {
    const int pm = u.pm, pn = u.pn; const bool isctx = (pm % 17) == 0; const int brow = pm * 256;
#pragma unroll
    for (int ai = 0; ai < 2; ++ai)
#pragma unroll
      for (int m = 0; m < 4; ++m) { const int row = brow + ai * 128 + wr * 64 + m * 16 + fr;
        if (pn < 8) { bf16_t* dst = Qb + (size_t)(pn >> 2) * TT * 1024 + (size_t)row * 1024 + (pn & 3) * 256 + wc * 32 + fq * 4;
          f32x4 cs = {1.f, 1.f, 1.f, 1.f}, sn = {0.f, 0.f, 0.f, 0.f};
          if (!isctx) { const int tl = (row % TPB) - CTXL; const int pos = (wc >> 1) ? (tl & 63) : (tl >> 6); const int p0 = (wc & 1) * 16 + fq * 4;
            cs = *(const f32x4*)(rc + pos * 32 + p0); sn = *(const f32x4*)(rs + pos * 32 + p0); }
#pragma unroll
          for (int bj = 0; bj < 2; ++bj) { const f32x4 v1 = acc[ai][bj][m][0], v2 = acc[ai][bj][m][1]; const f32x4 o1 = v1 * cs - v2 * sn, o2 = v2 * cs + v1 * sn;
            u32x2 w1 = {cvtpk(o1[0], o1[1]), cvtpk(o1[2], o1[3])}, w2 = {cvtpk(o2[0], o2[1]), cvtpk(o2[2], o2[3])};
            *(u32x2*)(dst + bj * 128) = w1; *(u32x2*)(dst + bj * 128 + 16) = w2; } }
        else if (pn < 12) { bf16_t* dst = Vb + (size_t)row * 1024 + (pn - 8) * 256 + wc * 32 + fq * 4;
#pragma unroll
          for (int bj = 0; bj < 2; ++bj)
#pragma unroll
            for (int n = 0; n < 2; ++n) { const f32x4 v = acc[ai][bj][m][n]; u32x2 w = {cvtpk(v[0], v[1]), cvtpk(v[2], v[3])}; *(u32x2*)(dst + bj * 128 + n * 16) = w; } }
        else if (pn < 14) { const int b = row / TPB, t = row % TPB; bf16_t* dst = UG + ((size_t)(b * 136 + (t >> 5))) * 768 + (t & 31) * 16 + ((fq * 4) & 15);
#pragma unroll
          for (int bj = 0; bj < 2; ++bj)
#pragma unroll
            for (int n = 0; n < 2; ++n) { const int g = ((pn - 12) * 256 + bj * 128 + wc * 32 + n * 16 + fq * 4) >> 4; const f32x4 v = acc[ai][bj][m][n];
              u32x2 w = {cvtpk(v[0], v[1]), cvtpk(v[2], v[3])}; *(u32x2*)(dst + (size_t)g * 768 * 768) = w; } }
        else {
          const int b = pm / 17, tt = pm % 17, part = (pn - 14) >> 1; const size_t cb = (size_t)(part * NB + b) * 512 + (pn & 1) * 256; const size_t ld = tt == 0 ? 256 : 4096;
          bf16_t* dstm = PT + (tt == 0 ? (size_t)2 * NB * 512 * 4096 + cb * 256 : cb * 4096 + (size_t)(tt - 1) * 256) + ai * 128 + wr * 64 + m * 16 + fr;
#pragma unroll
          for (int bj = 0; bj < 2; ++bj)
#pragma unroll
            for (int n = 0; n < 2; ++n) { const f32x4 v = acc[ai][bj][m][n]; const unsigned w0 = cvtpk(v[0], v[1]), w1 = cvtpk(v[2], v[3]); bf16_t* d = dstm + (size_t)(bj * 128 + wc * 32 + n * 16 + fq * 4) * ld;
              d[0] = (bf16_t)(w0 & 0xffff); d[ld] = (bf16_t)(w0 >> 16); d[2 * ld] = (bf16_t)(w1 & 0xffff); d[3 * ld] = (bf16_t)(w1 >> 16); } } }
  }
};
__device__ __forceinline__ void phase_gemm_in(const Params& p, const Ctx& c, int l, LAS unsigned char* lds) {
  SchedMN S; S.A = p.ws + OFF_HN; S.B = p.ws + OFF_WIN; S.strA = (size_t)256 * DM * 2; S.strB = (size_t)256 * DM * 2; S.blk = c.blk; S.nblk = c.nblk;
  S.nM = l == 0 ? 68 : 64; S.latonly = l == 0 ? 0 : 1;
  { S.nN = 18; S.pn0 = 0; S.nextra = l == 0 ? 0 : 40;
    EpiIn E; E.PT = (bf16_t*)(p.ws + OFF_Z2 + Z2_CAT); E.Qb = (bf16_t*)(p.ws + OFF_Z1 + Z1_Q); E.Kb = (bf16_t*)(p.ws + OFF_Z1 + Z1_K); E.Vb = (bf16_t*)(p.ws + OFF_Z1 + Z1_V); E.UG = (bf16_t*)(p.ws + OFF_Z2 + Z2_UG);
    E.rc = (const float*)(p.ws + OFF_ROPE); E.rs = E.rc + 64 * 32;
    gm::gemm_phase<true>(lds, DM, DM, DM, S, E); }
}

template <int LAT> struct SchedFour {
  const bf16_t *DM_, *PT; int blk, nblk;
  __device__ __forceinline__ bool next(int i, gm::Unit& u) const { const int it = i * nblk + blk; if (it >= (LAT ? 256 : 16)) return false; u.pm = it; u.pn = 0; return true; }
  __device__ __forceinline__ const char* pA(const gm::Unit& u) const { const int it = u.pm;
    if (LAT) { const int kt = it & 15, part = (it >> 5) & 1; return (const char*)(DM_ + ((size_t)part * 4096 + kt * 256) * 4096); }
    const int part = (it >> 1) & 1; return (const char*)(DM_ + (size_t)part * 256 * 256); }
  __device__ __forceinline__ const char* pB(const gm::Unit& u) const { const int it = u.pm;
    if (LAT) { const int nt_ = (it >> 4) & 1, part = (it >> 5) & 1, b = it >> 6; return (const char*)(PT + ((size_t)(part * NB + b) * 512 + nt_ * 256) * 4096); }
    const int nt_ = it & 1, part = (it >> 1) & 1, b = it >> 2; return (const char*)(PT + (size_t)2 * NB * 512 * 4096 + ((size_t)(part * NB + b) * 512 + nt_ * 256) * 256); }
};
template <int LAT> struct EpiFour {
  float *FC, *FS;
  __device__ __forceinline__ void operator()(const Acc& acc, const gm::Unit& u, int wr, int wc, int fr, int fq) const { const int it = u.pm; int kt, nt_, part, b, toff;
    if (LAT) { kt = it & 15; nt_ = (it >> 4) & 1; part = (it >> 5) & 1; b = it >> 6; toff = CTXL; } else { kt = 0; nt_ = it & 1; part = (it >> 1) & 1; b = it >> 2; toff = 0; }
    float* dst = FC + (size_t)part * TT * 512 + ((size_t)b * TPB + toff + kt * 256) * 512 + nt_ * 256 + wc * 32 + fq * 4;
#pragma unroll
    for (int ai = 0; ai < 2; ++ai)
#pragma unroll
      for (int m = 0; m < 4; ++m) { float* dr = dst + (size_t)(ai * 128 + wr * 64 + m * 16 + fr) * 512;
#pragma unroll
        for (int bj = 0; bj < 2; ++bj)
#pragma unroll
          for (int n = 0; n < 2; ++n) *(f32x4*)(dr + bj * 128 + n * 16) = acc[ai][bj][m][n]; }
  }
};
__device__ __forceinline__ void phase_fourier(const Params& p, const Ctx& c, int l, LAS unsigned char* lds) {
  const bf16_t* PT = (const bf16_t*)(p.ws + OFF_Z2 + Z2_CAT);
  float* FC = (float*)(p.ws + OFF_Z2 + Z2_FC); float* FS = (float*)(p.ws + OFF_Z2 + Z2_FS);
  { const SchedFour<1> S{(const bf16_t*)(p.ws + OFF_DFTL), PT, c.blk, c.nblk}; const EpiFour<1> E{FC, FS}; gm::gemm_phase<true>(lds, 4096, 4096, 4096, S, E); }
  if (l == 0) { const SchedFour<0> S{(const bf16_t*)(p.ws + OFF_DFTC), PT, c.blk, c.nblk}; const EpiFour<0> E{FC, FS}; gm::gemm_phase<true>(lds, 256, 256, 256, S, E); }
}

struct SchedSsmS { const char *UG, *EM; int blk, nblk;
  __device__ __forceinline__ bool next(int i, gm::Unit& u) const { const int it = i * nblk + blk; if (it >= 96) return false; u.pm = it; u.pn = 0; return true; }
  __device__ __forceinline__ const char* pA(const gm::Unit& u) const { const int g = u.pm / 3, pm = u.pm % 3; return UG + ((size_t)g * 768 + pm * 256) * 768 * 2; }
  __device__ __forceinline__ const char* pB(const gm::Unit& u) const { const int g = u.pm / 3; return EM + (size_t)g * 256 * 512 * 2; } };
struct EpiSsmS { float* SB;
  __device__ __forceinline__ void operator()(const Acc& acc, const gm::Unit& u, int wr, int wc, int fr, int fq) const { const int g = u.pm / 3, pm = u.pm % 3;
#pragma unroll
    for (int ai = 0; ai < 2; ++ai)
#pragma unroll
      for (int m = 0; m < 4; ++m) { const int r = pm * 256 + ai * 128 + wr * 64 + m * 16 + fr; if (r >= 544) continue; float* dr = SB + ((size_t)g * 768 + r) * 256 + wc * 32 + fq * 4;
#pragma unroll
        for (int bj = 0; bj < 2; ++bj)
#pragma unroll
          for (int n = 0; n < 2; ++n) *(f32x4*)(dr + bj * 128 + n * 16) = acc[ai][bj][m][n]; }
  } };
__device__ __forceinline__ void phase_ssm_states(const Params& p, const Ctx& c, LAS unsigned char* lds) {
  const SchedSsmS S{p.ws + OFF_Z2 + Z2_UG, p.ws + OFF_EM, c.blk, c.nblk}; const EpiSsmS E{(float*)(p.ws + OFF_Z2 + Z2_SB)};
  gm::gemm_phase<true>(lds, 768, 512, 512, S, E);
}
struct SchedSsmY { const char *UG, *TF; int blk, nblk;
  __device__ __forceinline__ bool next(int i, gm::Unit& u) const { const int it = i * nblk + blk; if (it >= 192) return false; u.pm = it >> 1; u.pn = it & 1; return true; }
  __device__ __forceinline__ const char* pA(const gm::Unit& u) const { const int g = u.pm / 3, pm = u.pm % 3; return UG + ((size_t)g * 768 + pm * 256) * 768 * 2; }
  __device__ __forceinline__ const char* pB(const gm::Unit& u) const { const int g = u.pm / 3; return TF + ((size_t)g * 512 + u.pn * 256) * 768 * 2; } };
struct EpiSsmY { bf16_t* Gg; int last;
  __device__ __forceinline__ void operator()(const Acc& acc, const gm::Unit& u, int wr, int wc, int fr, int fq) const { const int g = u.pm / 3, pm = u.pm % 3;
#pragma unroll
    for (int ai = 0; ai < 2; ++ai)
#pragma unroll
      for (int m = 0; m < 4; ++m) { const int r = pm * 256 + ai * 128 + wr * 64 + m * 16 + fr; if (r >= 544) continue; const int b = r / 136, ch = r % 136; if (last && ch < 8) continue;
        bf16_t* dr = Gg + ((size_t)b * TPB + ch * 32) * 512 + g * 16 + ((fq * 4) & 15);
#pragma unroll
        for (int bj = 0; bj < 2; ++bj)
#pragma unroll
          for (int n = 0; n < 2; ++n) { const int t = (u.pn * 256 + bj * 128 + wc * 32 + n * 16 + fq * 4) >> 4; const f32x4 y = acc[ai][bj][m][n];
            u32x2 w = {cvtpk(gelu_tanh(y[0]), gelu_tanh(y[1])), cvtpk(gelu_tanh(y[2]), gelu_tanh(y[3]))}; *(u32x2*)(dr + (size_t)t * 512) = w; } }
  } };
__device__ __forceinline__ void phase_ssm_y(const Params& p, const Ctx& c, bool last, LAS unsigned char* lds) {
  const SchedSsmY S{p.ws + OFF_Z2 + Z2_UG, p.ws + OFF_TF, c.blk, c.nblk}; const EpiSsmY E{(bf16_t*)(p.ws + OFF_Z2 + Z2_GG), last ? 1 : 0};
  gm::gemm_phase<true>(lds, 768, 768, 768, S, E);
}

struct EpiGlu {
  const bf16_t* Gg; bf16_t* Cat; const float* bg;
  __device__ __forceinline__ void operator()(const Acc& acc, const gm::Unit& u, int wr, int wc, int fr, int fq) const { const int pm = u.pm, pn = u.pn;
#pragma unroll
    for (int ai = 0; ai < 2; ++ai)
#pragma unroll
      for (int m = 0; m < 4; ++m) { const int row = pm * 256 + ai * 128 + wr * 64 + m * 16 + fr;
#pragma unroll
        for (int bj = 0; bj < 2; ++bj)
#pragma unroll
          for (int n = 0; n < 2; ++n) { const int col = pn * 256 + bj * 128 + wc * 32 + n * 16 + fq * 4; const f32x4 z = acc[ai][bj][m][n] + *(const f32x4*)(bg + col);
            const u32x2 gw = *(const u32x2*)(Gg + (size_t)row * 512 + col);
            const float g0 = __uint_as_float(gw[0] << 16), g1 = __uint_as_float(gw[0] & 0xffff0000u), g2 = __uint_as_float(gw[1] << 16), g3 = __uint_as_float(gw[1] & 0xffff0000u);
            u32x2 w = {cvtpk(g0 * sigmoidf_(z[0]), g1 * sigmoidf_(z[1])), cvtpk(g2 * sigmoidf_(z[2]), g3 * sigmoidf_(z[3]))};
            *(u32x2*)(Cat + (size_t)row * DM + 1024 + col) = w; } }
  }
};
__device__ __forceinline__ void phase_glu(const Params& p, const Ctx& c, int l, bool last, LAS unsigned char* lds) {
  SchedMN S; S.A = p.ws + OFF_Z2 + Z2_GG; S.B = p.ws + OFF_WGLU; S.strA = (size_t)256 * 512 * 2; S.strB = (size_t)256 * 512 * 2; S.blk = c.blk; S.nblk = c.nblk;
  S.nM = last ? 64 : 68; S.latonly = last ? 1 : 0; S.nN = 2; S.pn0 = 0; S.nextra = 0;
  EpiGlu E; E.Gg = (const bf16_t*)(p.ws + OFF_Z2 + Z2_GG); E.Cat = (bf16_t*)(p.ws + OFF_Z2 + Z2_CAT); E.bg = p.b_glu + (size_t)l * 512;
  gm::gemm_phase<true>(lds, 512, 512, 512, S, E);
}

struct EpiF32 {
  bf16_t* O;
  __device__ __forceinline__ void operator()(const Acc& acc, const gm::Unit& u, int wr, int wc, int fr, int fq) const {
    bf16_t* dst = O + (size_t)u.pm * 256 * DM + u.pn * 256 + wc * 32 + fq * 4;
#pragma unroll
    for (int ai = 0; ai < 2; ++ai)
#pragma unroll
      for (int m = 0; m < 4; ++m) { bf16_t* dr = dst + (size_t)(ai * 128 + wr * 64 + m * 16 + fr) * DM;
#pragma unroll
        for (int bj = 0; bj < 2; ++bj)
#pragma unroll
          for (int n = 0; n < 2; ++n) { const f32x4 v = acc[ai][bj][m][n]; u32x2 w = {cvtpk(v[0], v[1]), cvtpk(v[2], v[3])}; *(u32x2*)(dr + bj * 128 + n * 16) = w; } }
  }
};
struct SchedSplit { const char *A, *B; size_t strA, strB, kbytes; int nunits, blk, nblk;
  __device__ __forceinline__ bool next(int i, gm::Unit& u) const { const int it = i * nblk + blk; if (it >= nunits) return false; u.pm = it; u.pn = 0; return true; }
  __device__ __forceinline__ const char* pA(const gm::Unit& u) const { const int tile = u.pm & 31, sp = u.pm >> 5; return A + (size_t)((tile >> 3) * 17) * strA + sp * kbytes; }
  __device__ __forceinline__ const char* pB(const gm::Unit& u) const { const int tile = u.pm & 31, sp = u.pm >> 5; return B + (size_t)(tile & 7) * strB + sp * kbytes; } };
struct EpiAcc { bf16_t* SLAB;
  __device__ __forceinline__ void operator()(const Acc& acc, const gm::Unit& u, int wr, int wc, int fr, int fq) const { const int tile = u.pm & 31, sp = u.pm >> 5;
    bf16_t* dst = SLAB + ((size_t)sp * NB * CTXL + (tile >> 3) * 256) * DM + (tile & 7) * 256 + wc * 32 + fq * 4;
#pragma unroll
    for (int ai = 0; ai < 2; ++ai)
#pragma unroll
      for (int m = 0; m < 4; ++m) { bf16_t* dr = dst + (size_t)(ai * 128 + wr * 64 + m * 16 + fr) * DM;
#pragma unroll
        for (int bj = 0; bj < 2; ++bj)
#pragma unroll
          for (int n = 0; n < 2; ++n) { const f32x4 v = acc[ai][bj][m][n]; u32x2 w = {cvtpk(v[0], v[1]), cvtpk(v[2], v[3])}; *(u32x2*)(dr + bj * 128 + n * 16) = w; } }
  } };
template <int KK, int NSPLIT>
__device__ __forceinline__ void phase_gemm_f32out(const Params& p, const Ctx& c, bool last, const char* A, const char* W, char* outp, char* slab, LAS unsigned char* lds) {
  SchedMN S; S.A = A; S.B = W; S.strA = (size_t)256 * KK * 2; S.strB = (size_t)256 * KK * 2; S.blk = c.blk; S.nblk = c.nblk;
  S.nM = 64; S.latonly = 1; S.nN = 8; S.pn0 = 0; S.nextra = 0;
  EpiF32 E; E.O = (bf16_t*)outp;
  gm::gemm_phase<true>(lds, KK, KK, KK, S, E);
  if (!last) { const SchedSplit S2{A, W, (size_t)256 * KK * 2, (size_t)256 * KK * 2, (size_t)(KK / NSPLIT) * 2, 32 * NSPLIT, c.blk, c.nblk}; const EpiAcc E2{(bf16_t*)slab};
    gm::gemm_phase<true>(lds, KK, KK, KK / NSPLIT, S2, E2); }
}

struct EpiGU {
  bf16_t* ACT;
  __device__ __forceinline__ void operator()(const Acc& acc, const gm::Unit& u, int wr, int wc, int fr, int fq) const {
    bf16_t* dst = ACT + (size_t)u.pm * 256 * DFF + u.pn * 128 + wc * 32 + fq * 4;
#pragma unroll
    for (int ai = 0; ai < 2; ++ai)
#pragma unroll
      for (int m = 0; m < 4; ++m) { bf16_t* dr = dst + (size_t)(ai * 128 + wr * 64 + m * 16 + fr) * DFF;
#pragma unroll
        for (int n = 0; n < 2; ++n) { const f32x4 g = acc[ai][0][m][n], uu = acc[ai][1][m][n];
          u32x2 w = {cvtpk(g[0] * sigmoidf_(g[0]) * uu[0], g[1] * sigmoidf_(g[1]) * uu[1]), cvtpk(g[2] * sigmoidf_(g[2]) * uu[2], g[3] * sigmoidf_(g[3]) * uu[3])};
          *(u32x2*)(dr + n * 16) = w; } }
  }
};
__device__ __forceinline__ void phase_gemm_gu(const Params& p, const Ctx& c, bool last, LAS unsigned char* lds) {
  SchedMN S; S.A = p.ws + OFF_HN; S.B = p.ws + OFF_WGU; S.strA = (size_t)256 * DM * 2; S.strB = (size_t)256 * DM * 2; S.blk = c.blk; S.nblk = c.nblk;
  S.nM = last ? 64 : 68; S.latonly = last ? 1 : 0; S.nN = 44; S.pn0 = 0; S.nextra = 0;
  EpiGU E; E.ACT = (bf16_t*)(p.ws + OFF_Z2);
  gm::gemm_phase<true>(lds, DM, DM, DM, S, E);
}

__device__ __forceinline__ void phase_attn(const Params& p, const Ctx& c, int l, char* lds) {
  const bf16_t* Qb = (const bf16_t*)(p.ws + OFF_Z1 + Z1_Q); const bf16_t* Kb = (const bf16_t*)(p.ws + OFF_Z1 + Z1_K); const bf16_t* Vb = (const bf16_t*)(p.ws + OFF_Z1 + Z1_V);
  bf16_t* O = (bf16_t*)(p.ws + OFF_HN);
  const int ntot = (l == 0) ? 1024 + 64 : 1024;
  for (int v = c.blk; v < ntot; v += c.nblk) {
    int combo, qb, seq;
    if (v < 1024) { const int rd = v >> 8, w = v & 255; combo = rd * 16 + (w & 7) * 2 + ((w >> 3) >> 4); qb = 1 + ((w >> 3) & 15); seq = TPB; }
    else { combo = v - 1024; qb = 0; seq = CTXL; }
    const int e = combo & 1, mp = (combo >> 1) & 1, h = (combo >> 2) & 3, b = combo >> 4;
    const size_t r0 = (size_t)b * TPB;
    at::body(Qb + (r0 + qb * 256) * 1024 + (h * 2 + mp) * 128, Kb + r0 * 1024 + (h * 2 + mp) * 128, Vb + r0 * 1024 + h * 256 + e * 128,
             O + (r0 + qb * 256) * DM + (h * 2 + mp) * 256 + e * 128, seq, lds);
  }
}

__device__ __forceinline__ void phase_combine(const Params& p, const Ctx& c, int l, bool last) {
  const bf16_t* O = (const bf16_t*)(p.ws + OFF_HN); bf16_t* Cat = (bf16_t*)(p.ws + OFF_Z2 + Z2_CAT);
  const float* FC = (const float*)(p.ws + OFF_Z2 + Z2_FC); const float* FS = (const float*)(p.ws + OFF_Z2 + Z2_FS);
  const float lam_init = 0.8f - 0.6f * expf(-0.3f * (float)l);
  float lam;
  { const float a1 = p.lam_q1[l * 128 + c.lane] * p.lam_k1[l * 128 + c.lane] + p.lam_q1[l * 128 + 64 + c.lane] * p.lam_k1[l * 128 + 64 + c.lane];
    const float a2 = p.lam_q2[l * 128 + c.lane] * p.lam_k2[l * 128 + c.lane] + p.lam_q2[l * 128 + 64 + c.lane] * p.lam_k2[l * 128 + 64 + c.lane];
    lam = expf(wave_sum(a1)) - expf(wave_sum(a2)) + lam_init; }
  const f32x4 gs = *(const f32x4*)(p.g_subln + (size_t)l * 256 + c.lane * 4);
  for (int row = c.gwave; row < TT; row += c.nwave) { const int t = row % TPB; if (last && t < CTXL) continue;
    const bf16_t* orow = O + (size_t)row * DM; bf16_t* crow_ = Cat + (size_t)row * DM;
#pragma unroll
    for (int h = 0; h < 4; ++h) { const u32x2 a = *(const u32x2*)(orow + (h * 2) * 256 + c.lane * 4), bq = *(const u32x2*)(orow + (h * 2 + 1) * 256 + c.lane * 4);
      f32x4 o; o[0] = __uint_as_float(a[0] << 16) - lam * __uint_as_float(bq[0] << 16); o[1] = __uint_as_float(a[0] & 0xffff0000u) - lam * __uint_as_float(bq[0] & 0xffff0000u);
      o[2] = __uint_as_float(a[1] << 16) - lam * __uint_as_float(bq[1] << 16); o[3] = __uint_as_float(a[1] & 0xffff0000u) - lam * __uint_as_float(bq[1] & 0xffff0000u);
      const float ss = wave_sum(o[0] * o[0] + o[1] * o[1] + o[2] * o[2] + o[3] * o[3]); const float r = rsqrtf(ss * (1.f / 256.f) + 1e-5f) * (1.f - lam_init);
      o = o * r * gs; u32x2 w = {cvtpk(o[0], o[1]), cvtpk(o[2], o[3])}; *(u32x2*)(crow_ + h * 256 + c.lane * 4) = w; }
#pragma unroll
    for (int q = 0; q < 2; ++q) { const int col = q * 256 + c.lane * 4; const size_t o5 = (size_t)row * 512 + col;
      const f32x4 f = *(const f32x4*)(FC + o5) - *(const f32x4*)(FS + o5) + *(const f32x4*)(p.b_four + (size_t)l * 512 + col);
      u32x2 wf = {cvtpk(f[0], f[1]), cvtpk(f[2], f[3])}; *(u32x2*)(crow_ + 1536 + col) = wf; }
  }
}


#define XB_TMO      128
#define XB_XCNT(j)  (256  + 64 * (j))
#define XB_XSUB(j)  (1280 + 64 * (j))
#define XB_XGEN(j)  (2304 + 64 * (j))
#define XB_TOP      3328
#define XB_TOPGEN   3392
#define XCD_BAR_WORDS 3456
#define XB_SPIN_CAP (1u << 18)
__device__ __forceinline__ unsigned xb_ld(unsigned* p)              { return __hip_atomic_load(p, __ATOMIC_RELAXED, __HIP_MEMORY_SCOPE_AGENT); }
__device__ __forceinline__ unsigned xb_add(unsigned* p, unsigned v) { return __hip_atomic_fetch_add(p, v, __ATOMIC_RELAXED, __HIP_MEMORY_SCOPE_AGENT); }
__device__ __forceinline__ unsigned xb_xcc_id() { return (unsigned)__builtin_amdgcn_s_getreg((3 << 11) | 20) & 0xFu; }
#define XB_SPIN(cond, bar) do { unsigned _sp = 0; while (cond) { __builtin_amdgcn_s_sleep(1); \
    if ((++_sp & 255u) == 0u) { if (xb_ld(&(bar)[XB_TMO])) break; if (_sp > XB_SPIN_CAP) { atomicAdd(&(bar)[XB_TMO], 1u); break; } } } } while (0)
struct XcdBarrier { unsigned* bar; unsigned x; volatile LAS unsigned* st; };
__device__ __forceinline__ XcdBarrier xcd_barrier_post(unsigned* bar, volatile LAS unsigned* st) {
  XcdBarrier b; b.bar = bar; b.x = xb_xcc_id(); b.st = st;
  if (threadIdx.x == 0) (void)xb_add(&bar[XB_XCNT(b.x)], 1u);
  return b;
}
__device__ __forceinline__ void xcd_barrier_complete(unsigned* bar, unsigned x, unsigned& nloc, unsigned& nx) {
  const unsigned G = gridDim.x * gridDim.y * gridDim.z;
  unsigned sum, cnt, mine, sp = 0u;
  for (;;) {
    sum = 0u; cnt = 0u; mine = 0u;
#pragma unroll
    for (unsigned j = 0; j < 16; ++j) { const unsigned c = xb_ld(&bar[XB_XCNT(j)]); sum += c; cnt += (c > 0u) ? 1u : 0u; mine = (j == x) ? c : mine; }
    if (sum == G) break;
    __builtin_amdgcn_s_sleep(1);
    if ((++sp & 255u) == 0u) { if (xb_ld(&bar[XB_TMO])) break; if (sp > XB_SPIN_CAP) { atomicAdd(&bar[XB_TMO], 1u); break; } }
  }
  nloc = mine > 0u ? mine : 1u; nx = cnt > 0u ? cnt : 1u;
}
__device__ __forceinline__ void xcd_barrier(const XcdBarrier& b) {
  asm volatile("s_waitcnt vmcnt(0)" ::: "memory");
  __syncthreads();
  if (threadIdx.x == 0) {
    unsigned* bar = b.bar;
    __builtin_amdgcn_s_waitcnt(0);
    unsigned nloc = b.st[0], nx = b.st[1];
    if (nloc == 0u) { xcd_barrier_complete(bar, b.x, nloc, nx); b.st[0] = nloc; b.st[1] = nx; }
    const unsigned old = xb_add(&bar[XB_XSUB(b.x)], 1u);
    const unsigned gen = old / nloc;
    if (old + 1u == (gen + 1u) * nloc) {
      __builtin_amdgcn_fence(__ATOMIC_RELEASE, "agent");
      asm volatile("s_waitcnt vmcnt(0)" ::: "memory");
      const unsigned og = xb_add(&bar[XB_TOP], 1u);
      const unsigned tg = og / nx;
      if (og + 1u == (tg + 1u) * nx) xb_add(&bar[XB_TOPGEN], 1u);
      else XB_SPIN(xb_ld(&bar[XB_TOPGEN]) == tg, bar);
      __builtin_amdgcn_fence(__ATOMIC_ACQUIRE, "agent");
      xb_add(&bar[XB_XGEN(b.x)], 1u);
      asm volatile("s_waitcnt vmcnt(0)" ::: "memory");
    } else {
      XB_SPIN(xb_ld(&bar[XB_XGEN(b.x)]) == gen, bar);
      __builtin_amdgcn_fence(__ATOMIC_ACQUIRE, "agent");
      asm volatile("s_waitcnt vmcnt(0)" ::: "memory");
    }
  }
  __syncthreads();
}

__global__ void __launch_bounds__(NTHREADS) mega(Params p_arg) {
  extern __shared__ __attribute__((aligned(16))) char shm[];
  __shared__ uint4 xb_words;
  cg::grid_group grid = cg::this_grid();
  typedef const __attribute__((address_space(4))) Params* KP;
  KP kp = (KP)__builtin_amdgcn_kernarg_segment_ptr();
  unsigned* bar = (unsigned*)(p_arg.ws + OFF_BAR);
  if (threadIdx.x == 0) xb_words = make_uint4(0u, 0u, 0u, 0u);
  if (blockIdx.x == 0) for (int i = threadIdx.x; i < XCD_BAR_WORDS; i += NTHREADS) bar[i] = 0u;
  __syncthreads();
  Ctx c;
#define RECTX() do { asm volatile("" : "+s"(kp)); int t_ = threadIdx.x; asm volatile("" : "+v"(t_)); int b_ = blockIdx.x; asm volatile("" : "+s"(b_)); \
    c.tid = t_; c.wid = t_ >> 6; c.lane = t_ & 63; c.blk = b_; c.nblk = gridDim.x; c.gwave = c.blk * 8 + c.wid; c.nwave = c.nblk * 8; \
    c.gtid = (long)c.blk * NTHREADS + c.tid; c.nthr = (long)c.nblk * NTHREADS; } while (0)
  RECTX();
  LAS unsigned char* gshm = (LAS unsigned char*)shm; float* fl = (float*)shm;

#define PP (*(const Params*)kp)
#define GSYNC() do { RECTX(); XcdBarrier xb_; xb_.bar = (unsigned*)(kp->ws + OFF_BAR); xb_.x = xb_xcc_id(); xb_.st = (volatile LAS unsigned*)&xb_words; xcd_barrier(xb_); } while (0)
  phase0a(PP, c, fl);
  RECTX(); ssm_tables(PP, c);
  RECTX(); convert_weights(PP, c, 0, fl);
  grid.sync();
  RECTX(); if (threadIdx.x == 0) (void)xb_add((unsigned*)(kp->ws + OFF_BAR) + XB_XCNT(xb_xcc_id()), 1u);
  RECTX(); reduce_mod(PP, c);
  RECTX(); fold_four(PP, c, 0, fl);
  RECTX(); ssm_build_mef(PP, c, 0);
  GSYNC();
  RECTX(); ssm_build_t(PP, c, 0);
  RECTX(); phase_prenorm(PP, c, 0);
  GSYNC();
  for (int l = 0; l < 2; ++l) {
    const bool last = (l == 1);
    RECTX(); phase_gemm_in(PP, c, l, gshm);
    GSYNC();
    RECTX(); phase_fourier(PP, c, l, gshm);
    RECTX(); phase_ssm_states(PP, c, gshm);
    GSYNC();
    RECTX(); ssm_carry(PP, c, l);
    RECTX(); phase_attn(PP, c, l, shm);
    GSYNC();
    RECTX(); phase_ssm_y(PP, c, last, gshm);
    RECTX(); phase_combine(PP, c, l, last);
    GSYNC();
    RECTX(); phase_glu(PP, c, l, last, gshm);
    GSYNC();
    RECTX(); phase_gemm_f32out<DM, 8>(PP, c, last, kp->ws + OFF_Z2 + Z2_CAT, kp->ws + OFF_WOUT, kp->ws + OFF_Z1, kp->ws + OFF_Z2, gshm);
    GSYNC();
    if (!last) { RECTX(); ssm_build_mef(PP, c, 1); }
    RECTX(); phase_postmix(PP, c, l, last);
    GSYNC();
    RECTX(); phase_gemm_gu(PP, c, last, gshm);
    GSYNC();
    RECTX(); phase_gemm_f32out<DFF, 11>(PP, c, last, kp->ws + OFF_Z2, kp->ws + OFF_WD, kp->ws + OFF_Z1 + (size_t)TT * DM * 2, kp->ws + OFF_Z1, gshm);
    GSYNC();
    if (!last) { RECTX(); ssm_build_t(PP, c, 1); }
    RECTX(); phase_postffn(PP, c, l, last);
    if (!last) { RECTX(); convert_weights(PP, c, 1, fl); RECTX(); fold_four(PP, c, 1, fl); GSYNC(); }
  }
}

extern "C" void kernel_launch(void* const* d_in, const int* in_sizes, int n_in, void* d_out, int out_size, void* d_ws, size_t ws_size,
                              hipStream_t stream) {
  static int grid_blocks = 0;
  if (!grid_blocks) {
    (void)hipFuncSetAttribute((const void*)mega, hipFuncAttributeMaxDynamicSharedMemorySize, SHM_BYTES);
    int dev = 0, cus = 0, per_cu = 0;
    (void)hipGetDevice(&dev);
    (void)hipDeviceGetAttribute(&cus, hipDeviceAttributeMultiprocessorCount, dev);
    (void)hipOccupancyMaxActiveBlocksPerMultiprocessor(&per_cu, mega, NTHREADS, SHM_BYTES);
    if (per_cu < 1) per_cu = 1;
    grid_blocks = cus;
  }
  if (n_in != 32 || ws_size < WS_NEED) { fprintf(stderr, "kernel_launch: bad n_in %d or ws %zu < %zu\n", n_in, ws_size, WS_NEED); return; }
  Params p{};
  const float** f = (const float**)&p;
  for (int i = 0; i < 32; ++i) f[i] = (const float*)d_in[i];
  p.out = (float*)d_out; p.ws = (char*)d_ws;
  void* args[] = {&p};
  hipError_t e = hipLaunchCooperativeKernel((void*)mega, dim3(grid_blocks), dim3(NTHREADS), args, SHM_BYTES, stream);
  if (e != hipSuccess) fprintf(stderr, "cooperative launch failed: %s (grid %d)\n", hipGetErrorString(e), grid_blocks);
}
```

```cpp
#include <hip/hip_runtime.h>
#include <hip/hip_cooperative_groups.h>
#include <cstdio>
#include <cstdint>
namespace cg = cooperative_groups;

typedef unsigned short bf16_t;
using bf16x8 = __attribute__((ext_vector_type(8))) short;
using s16x4  = __attribute__((ext_vector_type(4))) short;
using f32x4  = __attribute__((ext_vector_type(4))) float;
using f32x16 = __attribute__((ext_vector_type(16))) float;
using u32x4  = __attribute__((ext_vector_type(4))) unsigned;
using u32x2  = __attribute__((ext_vector_type(2))) unsigned;
#define LAS __attribute__((address_space(3)))

constexpr int NB = 4, SEQ = 4096, CTXL = 256, TPB = SEQ + CTXL  , TT = NB * TPB  ;
constexpr int DM = 2048, NIN = 4608, DFF = 5632, NMODC = 6 * DM  ;
constexpr int NTHREADS = 512, SHM_BYTES = 131072;

constexpr size_t al256(size_t x) { return (x + 255) / 256 * 256; }
constexpr size_t OFF_X    = 0;
constexpr size_t OFF_WIN  = OFF_X + (size_t)TT * DM * 4;
constexpr size_t OFF_WOUT = OFF_WIN + (size_t)NIN * DM * 2;
constexpr size_t OFF_WGU  = OFF_WOUT + (size_t)DM * DM * 2;
constexpr size_t OFF_WD   = OFF_WGU + (size_t)2 * DFF * DM * 2;
constexpr size_t OFF_WGLU = OFF_WD + (size_t)DM * DFF * 2;
constexpr size_t OFF_DFTL = OFF_WGLU + (size_t)512 * 512 * 2;
constexpr size_t OFF_DFTC = OFF_DFTL + (size_t)2 * 4096 * 4096 * 2;
constexpr size_t OFF_MP   = OFF_DFTC + (size_t)2 * 256 * 256 * 2;
constexpr size_t OFF_MOD  = OFF_MP + (size_t)16 * 5 * 24576 * 4;
constexpr size_t OFF_ROPE = OFF_MOD + (size_t)2 * 5 * NMODC * 4;
constexpr size_t OFF_WCS  = OFF_ROPE + (size_t)2 * 64 * 32 * 4;
constexpr size_t OFF_PW   = OFF_WCS + (size_t)2 * 2 * 4 * 128 * 128 * 4;
constexpr size_t OFF_BB   = OFF_PW + (size_t)2 * 32 * 2 * 33 * 64 * 8;
constexpr size_t OFF_MK   = OFF_BB + (size_t)2 * 32 * 2 * 64 * 16 * 8;
constexpr size_t OFF_TF   = OFF_MK + (size_t)2 * 32 * 2 * 32 * 256 * 4;
constexpr size_t OFF_EM   = OFF_TF + (size_t)32 * 512 * 768 * 2;
constexpr size_t OFF_BAR  = OFF_EM + (size_t)32 * 256 * 512 * 2;
constexpr size_t OFF_HN   = OFF_BAR + 16384;
constexpr size_t OFF_Z1   = OFF_HN + (size_t)TT * DM * 2;
constexpr size_t Z1_Q = 0, Z1_K = (size_t)TT * 1024 * 2, Z1_V = 2 * Z1_K;
constexpr size_t OFF_Z2   = OFF_Z1 + (size_t)TT * DM * 4;
constexpr size_t Z2_FC = 0, Z2_FS = Z2_FC + (size_t)TT * 512 * 4;
constexpr size_t Z2_UG = Z2_FS + (size_t)TT * 512 * 4;
constexpr size_t Z2_SB = Z2_UG + (size_t)32 * 768 * 768 * 2;
constexpr size_t Z2_CAT = Z2_SB + (size_t)32 * 768 * 256 * 4;
constexpr size_t Z2_GG = Z2_CAT + (size_t)TT * DM * 2;
constexpr size_t Z2_END = Z2_GG + (size_t)TT * 512 * 2;
constexpr size_t Z2_SIZE = Z2_END > (size_t)TT * DFF * 2 ? Z2_END : (size_t)TT * DFF * 2;
constexpr size_t WS_NEED = OFF_Z2 + Z2_SIZE;
static_assert(WS_NEED <= (size_t)805306368, "workspace over 768 MiB");


struct Params {
  const float *x, *c, *ctx, *c_ctx, *w_mod, *b_mod, *g_mix_pre, *g_mix_post, *g_ffn_pre, *g_ffn_post, *w_in, *w_out;
  const float *lam_q1, *lam_k1, *lam_q2, *lam_k2, *g_subln, *ssm_a_re, *ssm_a_im, *ssm_log_dt, *ssm_b_re, *ssm_b_im;
  const float *ssm_c_re, *ssm_c_im, *ssm_d, *w_glu, *b_glu, *w_four, *b_four, *w_gate, *w_up, *w_down;
  float* out; char* ws;
};

__device__ __forceinline__ unsigned cvtpk(float lo, float hi) { unsigned r; asm volatile("v_cvt_pk_bf16_f32 %0, %1, %2" : "=v"(r) : "v"(lo), "v"(hi)); return r; }
__device__ __forceinline__ float bf2f(unsigned short b) { return __uint_as_float((unsigned)b << 16); }
__device__ __forceinline__ float wave_sum(float v) {
  v += __shfl_xor(v, 32); v += __shfl_xor(v, 16); v += __shfl_xor(v, 8); v += __shfl_xor(v, 4); v += __shfl_xor(v, 2); v += __shfl_xor(v, 1); return v;
}
__device__ __forceinline__ void my_sincos(float x, float& s, float& c) {
  const double xd = (double)x; const double kd = rint(xd * 0.63661977236758134); const double r = xd - kd * 1.5707963267948966;
  const double r2 = r * r;
  const double sn = r * (1.0 - r2 / 6.0 * (1.0 - r2 / 20.0 * (1.0 - r2 / 42.0 * (1.0 - r2 / 72.0 * (1.0 - r2 / 110.0 * (1.0 - r2 / 156.0))))));
  const double cs = 1.0 - r2 / 2.0 * (1.0 - r2 / 12.0 * (1.0 - r2 / 30.0 * (1.0 - r2 / 56.0 * (1.0 - r2 / 90.0 * (1.0 - r2 / 132.0)))));
  const int q = ((int)kd) & 3;
  const double ss = (q == 0) ? sn : (q == 1) ? cs : (q == 2) ? -sn : -cs;
  const double cc = (q == 0) ? cs : (q == 1) ? -sn : (q == 2) ? -cs : sn;
  s = (float)ss; c = (float)cc;
}
__device__ __forceinline__ float sigmoidf_(float x) { return 1.f / (1.f + __expf(-x)); }
__device__ __forceinline__ float gelu_tanh(float y) { const float u = 0.7978845608028654f * (y + 0.044715f * y * y * y); return y * sigmoidf_(2.f * u); }

namespace gm {
constexpr int BM = 256, BK = 64, HALF = 128, HTB = HALF * BK * 2, NXCD = 8, WGM = 8;
__device__ __forceinline__ int lds_byte(int r, int c) { const int st = (r >> 4) * 2 + (c >> 5), rr = r & 15, cc = c & 31, ob = rr * 64 + cc * 2; return st * 1024 + (ob ^ (((ob >> 9) & 1) << 5)); }
__device__ __forceinline__ void stage_rc(int b, int& R, int& C) { const int st = b / 1024, sb = b % 1024, swz = sb ^ (((sb >> 9) & 1) << 5); R = (st >> 1) * 16 + swz / 64; C = (st & 1) * 32 + (swz % 64) / 2; }
__device__ __forceinline__ void tile_of(int wgid, int nM, int nN, int& pm, int& pn) {
  const int nwg = nM * nN; { const int q = nwg / NXCD, r = nwg % NXCD, xcd = wgid % NXCD, off = wgid / NXCD; wgid = (xcd < r ? xcd * (q + 1) : r * (q + 1) + (xcd - r) * q) + off; }
  const int nig = WGM * nN, gid = wgid / nig, fm = gid * WGM, gsz = (nM - fm) < WGM ? (nM - fm) : WGM;
  pm = fm + ((wgid % nig) % gsz); pn = (wgid % nig) / gsz;
}
struct Unit { int pm, pn; };

template <bool SWAP, class Epi, class Sched>
__device__ __forceinline__ void gemm_phase(LAS unsigned char* lds, const int lda, const int ldb, const int K, const Sched& S, const Epi& E) {
  int tid_ = threadIdx.x; asm volatile("" : "+v"(tid_));
  const int tid = tid_, wid = __builtin_amdgcn_readfirstlane(tid >> 6), lane = tid & 63, wr = wid >> 2, wc = wid & 3, fr = lane & 15, fq = lane >> 4;
  const int nt = K / BK;
  unsigned voffA[2], voffB[2];
#pragma unroll
  for (int i = 0; i < 2; ++i) { int R, C; stage_rc(tid * 16 + i * 8192, R, C); voffA[i] = (unsigned)(R * lda + C) * 2u; voffB[i] = (unsigned)(R * ldb + C) * 2u; }
  const size_t kstep = (size_t)(BK * 2), hstepA = (size_t)HALF * lda * 2, hstepB = (size_t)HALF * ldb * 2;
  const unsigned ldsw = (unsigned)wid * 1024u;
  const int aoff = lds_byte(wr * 64 + fr, fq * 8), boff = lds_byte(wc * 32 + fr, fq * 8);
#define PG8_SA(b, h) (((b) * 2 + (h)) * HTB)
#define PG8_SB(b, h) ((4 + (b) * 2 + (h)) * HTB)
#define PG8_STAGE(bufoff, gbase, voff) do { _Pragma("unroll") for (int _i = 0; _i < 2; ++_i) \
    __builtin_amdgcn_global_load_lds((const unsigned*)((const char*)(gbase) + (voff)[_i]), (LAS unsigned*)(lds + (bufoff) + ldsw + _i * 8192), 16, 0, 0); } while (0)
#define PG8_LDA(dst, b, h) do { _Pragma("unroll") for (int m = 0; m < 4; ++m) _Pragma("unroll") for (int k = 0; k < 2; ++k) dst[m][k] = *(const LAS bf16x8*)(lds + PG8_SA(b, h) + aoff + m * 2048 + k * 1024); } while (0)
#define PG8_LDB(dst, b, h) do { _Pragma("unroll") for (int n = 0; n < 2; ++n) _Pragma("unroll") for (int k = 0; k < 2; ++k) dst[n][k] = *(const LAS bf16x8*)(lds + PG8_SB(b, h) + boff + n * 2048 + k * 1024); } while (0)
#define PG8_MMA(ai, bj, At, Bt) do { __builtin_amdgcn_s_setprio(1); _Pragma("unroll") for (int m = 0; m < 4; ++m) _Pragma("unroll") for (int n = 0; n < 2; ++n) _Pragma("unroll") for (int k = 0; k < 2; ++k) \
    acc[ai][bj][m][n] = SWAP ? __builtin_amdgcn_mfma_f32_16x16x32_bf16(Bt[n][k], At[m][k], acc[ai][bj][m][n], 0, 0, 0) \
                             : __builtin_amdgcn_mfma_f32_16x16x32_bf16(At[m][k], Bt[n][k], acc[ai][bj][m][n], 0, 0, 0); __builtin_amdgcn_s_setprio(0); } while (0)
#define PG8_WAIT_V(n) asm volatile("s_waitcnt vmcnt(" #n ")" ::: "memory")
#define PG8_WAIT_L(n) asm volatile("s_waitcnt lgkmcnt(" #n ")" ::: "memory")
#define PG8_BAR __builtin_amdgcn_s_barrier()
#define PG8_SCHED __builtin_amdgcn_sched_barrier(0)
  Unit cur, nxt; int ui = 0;
  if (!S.next(0, cur)) return;
  f32x4 acc[2][2][4][2];
#pragma unroll
  for (int a = 0; a < 2; ++a)
#pragma unroll
    for (int b = 0; b < 2; ++b)
#pragma unroll
      for (int m = 0; m < 4; ++m)
#pragma unroll
        for (int n = 0; n < 2; ++n) acc[a][b][m][n] = (f32x4){0.f, 0.f, 0.f, 0.f};
  bf16x8 At[4][2], B0[2][2], B1[2][2];
  const char* cA = S.pA(cur); const char* cB = S.pB(cur);
  PG8_STAGE(PG8_SB(0, 0), cB, voffB); PG8_STAGE(PG8_SB(0, 1), cB + hstepB, voffB); PG8_STAGE(PG8_SA(0, 0), cA, voffA); PG8_STAGE(PG8_SA(0, 1), cA + hstepA, voffA);
  if (wr == 1) PG8_BAR;
  PG8_WAIT_V(2); PG8_BAR;
  PG8_STAGE(PG8_SB(1, 0), cB + kstep, voffB); PG8_STAGE(PG8_SA(1, 0), cA + kstep, voffA); PG8_STAGE(PG8_SB(1, 1), cB + hstepB + kstep, voffB);
  PG8_WAIT_V(6); PG8_BAR;
  for (;;) {
    const bool has_next = S.next(ui + 1, nxt);
    const char* nA = has_next ? S.pA(nxt) : cA; const char* nB = has_next ? S.pB(nxt) : cB;
    for (int t = 0; t < nt; t += 2) {
      const bool last = (t == nt - 2);
      const char* a1 = cA + (size_t)(t + 1) * kstep;
      const char* a2 = last ? nA : cA + (size_t)(t + 2) * kstep; const char* b2 = last ? nB : cB + (size_t)(t + 2) * kstep;
      const char* a3 = a2 + kstep; const char* b3 = b2 + kstep;
      PG8_LDB(B0, 0, 0); PG8_LDB(B1, 0, 1); PG8_SCHED; PG8_LDA(At, 0, 0); PG8_STAGE(PG8_SA(1, 1), a1 + hstepA, voffA);
      PG8_WAIT_V(8); PG8_WAIT_L(0); PG8_BAR; PG8_MMA(0, 0, At, B0); PG8_MMA(0, 1, At, B1); PG8_BAR; PG8_SCHED;
      PG8_LDA(At, 0, 1); PG8_STAGE(PG8_SB(0, 0), b2, voffB); PG8_STAGE(PG8_SB(0, 1), b2 + hstepB, voffB); PG8_STAGE(PG8_SA(0, 0), a2, voffA);
      PG8_WAIT_V(8); PG8_WAIT_L(0); PG8_BAR; PG8_MMA(1, 0, At, B0); PG8_MMA(1, 1, At, B1); PG8_BAR; PG8_SCHED;
      PG8_LDB(B0, 1, 0); PG8_LDB(B1, 1, 1); PG8_SCHED; PG8_LDA(At, 1, 0); PG8_STAGE(PG8_SA(0, 1), a2 + hstepA, voffA);
      PG8_WAIT_V(8); PG8_WAIT_L(0); PG8_BAR; PG8_MMA(0, 0, At, B0); PG8_MMA(0, 1, At, B1); PG8_BAR; PG8_SCHED;
      PG8_LDA(At, 1, 1); PG8_STAGE(PG8_SB(1, 0), b3, voffB); PG8_STAGE(PG8_SB(1, 1), b3 + hstepB, voffB); PG8_STAGE(PG8_SA(1, 0), a3, voffA);
      PG8_WAIT_V(8); PG8_WAIT_L(0); PG8_BAR; PG8_MMA(1, 0, At, B0); PG8_MMA(1, 1, At, B1); PG8_BAR; PG8_SCHED;
    }
    if (wr == 0) PG8_BAR;
    { int fr2 = fr, fq2 = fq; asm volatile("" : "+v"(fr2), "+v"(fq2));
      E(acc, cur, wr, wc, fr2, fq2); }
    if (!has_next) break;
#pragma unroll
    for (int a = 0; a < 2; ++a)
#pragma unroll
      for (int b = 0; b < 2; ++b)
#pragma unroll
        for (int m = 0; m < 4; ++m)
#pragma unroll
          for (int n = 0; n < 2; ++n) acc[a][b][m][n] = (f32x4){0.f, 0.f, 0.f, 0.f};
    cur = nxt; cA = nA; cB = nB; ++ui;
    if (wr == 1) PG8_BAR;
  }
  PG8_WAIT_V(0);
  PG8_BAR;
#undef PG8_SA
#undef PG8_SB
#undef PG8_STAGE
#undef PG8_LDA
#undef PG8_LDB
#undef PG8_MMA
#undef PG8_WAIT_V
#undef PG8_WAIT_L
#undef PG8_BAR
#undef PG8_SCHED
}
}

namespace at {
constexpr int D = 128, NW = 8, QBLK = 32, KVBLK = 64;
constexpr float SCALE = 0.088388347648318440f;
constexpr float THR = 8.f;
constexpr int LDQ = 1024, LDK = 1024, LDV = 1024, LDO = 2048;
constexpr size_t SHM_V = KVBLK * D * 2, SHM_K = KVBLK * D * 2;
#define KSWZ(row, colB) ((row) * 256 + ((colB) ^ (((row) & 7) << 4)))
#define SBAR() __builtin_amdgcn_sched_barrier(0)
__device__ __forceinline__ int crow(int r, int hi) { return (r & 3) + 8 * (r >> 2) + 4 * hi; }
__device__ __forceinline__ void partialSM(f32x16& p0, f32x16& p1, float& m_reg, float& mn, float& alpha) {
  constexpr float C = SCALE * 1.4426950408889634f;
  float pmax = p0[0];
#pragma unroll
  for (int r = 1; r < 16; ++r) pmax = fmaxf(pmax, p0[r]);
#pragma unroll
  for (int r = 0; r < 16; ++r) pmax = fmaxf(pmax, p1[r]);
  { auto rr = __builtin_amdgcn_permlane32_swap(__float_as_uint(pmax), __float_as_uint(pmax), false, false);
    pmax = fmaxf(__uint_as_float(rr[0]), __uint_as_float(rr[1])); }
  if (__builtin_expect(__all(pmax - m_reg <= THR / SCALE), 1)) { mn = m_reg; alpha = 1.f; }
  else { mn = fmaxf(m_reg, pmax); alpha = __builtin_amdgcn_exp2f((m_reg - mn) * C); m_reg = mn; }
  float mnC = -mn * C;
#pragma unroll
  for (int r = 0; r < 16; ++r) p0[r] = fmaf(p0[r], C, mnC);
#pragma unroll
  for (int r = 0; r < 16; ++r) p1[r] = fmaf(p1[r], C, mnC);
#pragma unroll
  for (int r = 0; r < 16; ++r) p0[r] = __builtin_amdgcn_exp2f(p0[r]);
}
__device__ __forceinline__ void finishSM(f32x16& p0, f32x16& p1, float alpha, float& l_reg, bf16x8& pa0, bf16x8& pa1, bf16x8& pa2, bf16x8& pa3) {
#pragma unroll
  for (int r = 0; r < 16; ++r) p1[r] = __builtin_amdgcn_exp2f(p1[r]);
  float ps = 0;
#pragma unroll
  for (int r = 0; r < 16; ++r) ps += p0[r];
#pragma unroll
  for (int r = 0; r < 16; ++r) ps += p1[r];
  { auto rr = __builtin_amdgcn_permlane32_swap(__float_as_uint(ps), __float_as_uint(ps), false, false);
    ps = __uint_as_float(rr[0]) + __uint_as_float(rr[1]); }
  l_reg = l_reg * alpha + ps;
#define PK4(P, BASE, OUT) do { unsigned a0 = cvtpk(P[BASE + 0], P[BASE + 1]), a1 = cvtpk(P[BASE + 2], P[BASE + 3]);   \
    unsigned b0 = cvtpk(P[BASE + 4], P[BASE + 5]), b1 = cvtpk(P[BASE + 6], P[BASE + 7]);                              \
    auto r0 = __builtin_amdgcn_permlane32_swap(a0, b0, false, false); auto r1 = __builtin_amdgcn_permlane32_swap(a1, b1, false, false); \
    u32x4 w = {r0[0], r1[0], r0[1], r1[1]}; OUT = *reinterpret_cast<bf16x8*>(&w); } while (0)
  PK4(p0, 0, pa0); PK4(p0, 8, pa1); PK4(p1, 0, pa2); PK4(p1, 8, pa3);
#undef PK4
}
__device__ __forceinline__ void qkt(f32x16& p0, f32x16& p1, const char* Ks, const bf16x8* qr, int r32, int hi) {
  p0 = f32x16{}; p1 = f32x16{};
#pragma unroll
  for (int d0 = 0; d0 < 8; ++d0) { int cb = (d0 * 16 + hi * 8) * 2;
    bf16x8 b0 = *reinterpret_cast<const bf16x8*>(Ks + KSWZ(r32, cb));
    bf16x8 b1 = *reinterpret_cast<const bf16x8*>(Ks + KSWZ(32 + r32, cb));
    p0 = __builtin_amdgcn_mfma_f32_32x32x16_bf16(b0, qr[d0], p0, 0, 0, 0);
    p1 = __builtin_amdgcn_mfma_f32_32x32x16_bf16(b1, qr[d0], p1, 0, 0, 0); }
}
__device__ __forceinline__ int v_st(int k, int c) { const int kk = (k & ~0xC) | ((k & 4) << 1) | ((k & 8) >> 1); return ((kk >> 3) * 8 + (c >> 5)) * 512 + ((kk & 7) * 32 + (c & 31)) * 2; }
__device__ __forceinline__ int v_rd_base(int lane) { return ((lane & 3) << 3) | (((lane >> 2) & 3) << 6) | (((lane >> 4) & 1) << 5) | (((lane >> 5) & 1) << 8); }
constexpr int v_rd_off(int d0, int ks, int half) { return d0 * 512 + ks * 8192 + half * 4096; }
template <int OFF> __device__ __forceinline__ s16x4 tr_read(int vb) {
  s16x4 r; asm volatile("ds_read_b64_tr_b16 %0, %1 offset:%2" : "=&v"(r) : "v"(vb), "i"(OFF) : "memory"); return r;
}
template <int D0> __device__ __forceinline__ void pv_one(f32x16& od, int vb, bf16x8 pa0, bf16x8 pa1, bf16x8 pa2, bf16x8 pa3) {
  const s16x4 l0 = tr_read<v_rd_off(D0, 0, 0)>(vb), h0 = tr_read<v_rd_off(D0, 0, 1)>(vb), l1 = tr_read<v_rd_off(D0, 1, 0)>(vb), h1 = tr_read<v_rd_off(D0, 1, 1)>(vb);
  const s16x4 l2 = tr_read<v_rd_off(D0, 2, 0)>(vb), h2 = tr_read<v_rd_off(D0, 2, 1)>(vb), l3 = tr_read<v_rd_off(D0, 3, 0)>(vb), h3 = tr_read<v_rd_off(D0, 3, 1)>(vb);
  asm volatile("s_waitcnt lgkmcnt(0)" ::: "memory"); SBAR();
#define PK(L, H) (bf16x8){L[0], L[1], L[2], L[3], H[0], H[1], H[2], H[3]}
  od = __builtin_amdgcn_mfma_f32_32x32x16_bf16(pa0, PK(l0, h0), od, 0, 0, 0);
  od = __builtin_amdgcn_mfma_f32_32x32x16_bf16(pa1, PK(l1, h1), od, 0, 0, 0);
  od = __builtin_amdgcn_mfma_f32_32x32x16_bf16(pa2, PK(l2, h2), od, 0, 0, 0);
  od = __builtin_amdgcn_mfma_f32_32x32x16_bf16(pa3, PK(l3, h3), od, 0, 0, 0);
#undef PK
}
__device__ __forceinline__ void body(const bf16_t* __restrict__ Qb, const bf16_t* __restrict__ Kh, const bf16_t* __restrict__ Vh, bf16_t* __restrict__ Ob, int seq, char* lds) {
  int tid_ = threadIdx.x; asm volatile("" : "+v"(tid_));
  const int tid = tid_, wid = tid >> 6, lane = tid & 63, r32 = lane & 31, hi = lane >> 5;
  constexpr int SV = 64 * 256 * 2, SK = 64 * 128 * 2;
  char* V_lds = lds; char* K_lds = lds + 2 * SV;
  float* ws = (float*)(lds + 2 * SV + 2 * SK) + wid * 64; float* li_l = ws; float* al_l = ws + 32;
  float m_reg = -1e30f, l_reg = 0; f32x16 o[8] = {}; bf16x8 qr[8];
  const bf16_t* Qw = Qb + (long)(wid * QBLK + r32) * LDQ + hi * 8;
#pragma unroll
  for (int d0 = 0; d0 < 8; ++d0) qr[d0] = *reinterpret_cast<const bf16x8*>(Qw + d0 * 16);
  const int wu = __builtin_amdgcn_readfirstlane(wid);
  int koff[2], voff[4];
#pragma unroll
  for (int q = 0; q < 2; ++q) { const int row = 4 * (wu * 2 + q) + (lane >> 4); koff[q] = row * LDK + ((((lane & 15) << 4) ^ ((row & 7) << 4)) >> 1); }
#pragma unroll
  for (int q = 0; q < 4; ++q) { const int s = 2 * (wu * 4 + q) + (lane >> 5), kk = (s >> 3) * 8 + ((lane & 31) >> 2), k = (kk & ~0xC) | ((kk & 4) << 1) | ((kk & 8) >> 1);
    voff[q] = k * LDV + (s & 7) * 32 + (lane & 3) * 8; }
  const int vb0 = (int)(uintptr_t)(LAS char*)V_lds + v_rd_base(lane);
  LAS char* Vl = (LAS char*)V_lds; LAS char* Kl = (LAS char*)K_lds;
#define STAGE(b, k0) do { const bf16_t* kg = Kh + (long)(k0) * LDK; const bf16_t* vg = Vh + (long)(k0) * LDV; \
    _Pragma("unroll") for (int q = 0; q < 2; ++q) __builtin_amdgcn_global_load_lds((const unsigned*)(kg + koff[q]), (LAS unsigned*)(Kl + (b) * SK + (wu * 2 + q) * 1024), 16, 0, 0); \
    _Pragma("unroll") for (int q = 0; q < 4; ++q) __builtin_amdgcn_global_load_lds((const unsigned*)(vg + voff[q]), (LAS unsigned*)(Vl + (b) * SV + (wu * 4 + q) * 1024), 16, 0, 0); } while (0)
  const int NT = seq / KVBLK;
  STAGE(0, 0);
  asm volatile("s_waitcnt vmcnt(0) lgkmcnt(0)" ::: "memory"); __builtin_amdgcn_s_barrier(); asm volatile("" ::: "memory");
  for (int j = 0; j < NT; ++j) {
    const int b = j & 1;
    f32x16 p0, p1; float mn, al; bf16x8 pa0, pa1, pa2, pa3;
    if (j + 1 < NT) STAGE(b ^ 1, (j + 1) * KVBLK);
    SBAR(); qkt(p0, p1, K_lds + b * SK, qr, r32, hi);
    partialSM(p0, p1, m_reg, mn, al);
    if (__any(al < 1.f)) { if (hi == 0) al_l[r32] = al; asm volatile("s_waitcnt lgkmcnt(0)" ::: "memory");
#pragma unroll
      for (int d = 0; d < 8; ++d)
#pragma unroll
        for (int r = 0; r < 16; ++r) o[d][r] *= al_l[crow(r, hi)]; }
    finishSM(p0, p1, al, l_reg, pa0, pa1, pa2, pa3); SBAR();
    const int vb = vb0 + b * SV;
    pv_one<0>(o[0], vb, pa0, pa1, pa2, pa3); pv_one<1>(o[1], vb, pa0, pa1, pa2, pa3); pv_one<2>(o[2], vb, pa0, pa1, pa2, pa3); pv_one<3>(o[3], vb, pa0, pa1, pa2, pa3);
    pv_one<4>(o[4], vb, pa0, pa1, pa2, pa3); pv_one<5>(o[5], vb, pa0, pa1, pa2, pa3); pv_one<6>(o[6], vb, pa0, pa1, pa2, pa3); pv_one<7>(o[7], vb, pa0, pa1, pa2, pa3);
    asm volatile("s_waitcnt vmcnt(0) lgkmcnt(0)" ::: "memory"); __builtin_amdgcn_s_barrier(); asm volatile("" ::: "memory");
  }
  if (hi == 0) li_l[r32] = l_reg; asm volatile("s_waitcnt lgkmcnt(0)" ::: "memory");
  float rli[16];
#pragma unroll
  for (int r = 0; r < 16; ++r) rli[r] = __builtin_amdgcn_rcpf(li_l[crow(r, hi)]);
  bf16_t* Ow = Ob + (long)(wid * QBLK) * LDO;
#pragma unroll
  for (int r = 0; r < 16; ++r) { int orow = crow(r, hi);
#pragma unroll
    for (int d0 = 0; d0 < 8; ++d0) Ow[(long)orow * LDO + d0 * 32 + r32] = (bf16_t)(cvtpk(o[d0][r] * rli[r], 0.f) & 0xffff); }
#undef STAGE
  __syncthreads();
}
}

struct Ctx {
  int tid, wid, lane, blk, nblk, gwave, nwave; long gtid, nthr;
};

__device__ __forceinline__ const float* modp(const Params& p, int l, int v, int j) { return (const float*)(p.ws + OFF_MOD) + ((size_t)(l * 5 + v) * NMODC + (size_t)j * DM); }

__device__ __forceinline__ void convert_weights(const Params& p, const Ctx& c, int l, float* lds) {
  constexpr int T0 = 14 * 32, T1 = 8 * 32, T2 = 44 * 32, T3 = 8 * 88, T4 = 2 * 8, TALL = T0 + T1 + T2 + T3 + T4;
  for (int it = c.blk; it < TALL; it += c.nblk) {
    int mat, ti = it;
    if (ti < T0) mat = 0; else if ((ti -= T0) < T1) mat = 1; else if ((ti -= T1) < T2) mat = 2; else if ((ti -= T2) < T3) mat = 3; else { ti -= T3; mat = 4; }
    const float* src; long ld; bf16_t* dst; long dld; int nkt;
    if (mat == 0) { src = p.w_in + (size_t)l * DM * 4096; ld = 4096; dst = (bf16_t*)(p.ws + OFF_WIN); dld = DM; nkt = 32; }
    else if (mat == 1) { src = p.w_out + (size_t)l * DM * DM; ld = DM; dst = (bf16_t*)(p.ws + OFF_WOUT); dld = DM; nkt = 32; }
    else if (mat == 2) { src = p.w_gate + (size_t)l * DM * DFF; ld = DFF; dst = (bf16_t*)(p.ws + OFF_WGU); dld = DM; nkt = 32; }
    else if (mat == 3) { src = p.w_down + (size_t)l * DFF * DM; ld = DM; dst = (bf16_t*)(p.ws + OFF_WD); dld = DFF; nkt = 88; }
    else { src = p.w_glu + (size_t)l * 512 * 512; ld = 512; dst = (bf16_t*)(p.ws + OFF_WGLU); dld = 512; nkt = 8; }
    const int n0 = (ti / nkt) * 256, k0 = (ti % nkt) * 64;
    {
      const int nn = c.tid & 255, kk0 = c.tid >> 8, np = n0 + nn; int scol = np;
      if (mat == 0) { if (np < 2048) scol = (np & ~0x30) | ((np & 16) << 1) | ((np & 32) >> 1); }
      else if (mat == 2) { const int pn = np >> 8, bj = (np >> 7) & 1; scol = pn * 128 + (np & 127); if (bj) src = p.w_up + (size_t)l * DM * DFF; }
      const float* sp = src + (size_t)(k0 + kk0) * ld + scol; float v[32];
#pragma unroll
      for (int i = 0; i < 32; ++i) v[i] = sp[(size_t)(2 * i) * ld];
#pragma unroll
      for (int i = 0; i < 32; ++i) lds[(kk0 + 2 * i) * 257 + nn] = v[i];
    }
    __syncthreads();
    {
      const int kc = (c.tid & 7) * 8;
#pragma unroll
      for (int j = 0; j < 4; ++j) { const int nn = (c.tid >> 3) + 64 * j; float v[8];
#pragma unroll
        for (int i = 0; i < 8; ++i) v[i] = lds[(kc + i) * 257 + nn];
        u32x4 w = {cvtpk(v[0], v[1]), cvtpk(v[2], v[3]), cvtpk(v[4], v[5]), cvtpk(v[6], v[7])};
        *(u32x4*)(dst + (size_t)(n0 + nn) * dld + k0 + kc) = w; }
    }
    __syncthreads();
  }
}

__device__ __forceinline__ void fold_four(const Params& p, const Ctx& c, int l, float* lds) {
  float* WlT = lds;
  float* Wc = lds + 128 * 68;
  const float* wcs = (const float*)(p.ws + OFF_WCS) + (size_t)l * 2 * 4 * 128 * 128;
  bf16_t* dstb = (bf16_t*)(p.ws + OFF_WIN);
  for (int u = c.blk; u < 256; u += c.nblk) {
    const int kt = u & 31, cs = (u >> 5) & 1, g = u >> 6, k0 = kt * 64;
    const float* src = p.w_in + (size_t)l * DM * 4096 + 3584 + g * 128;
    for (int i = c.tid; i < 64 * 128; i += NTHREADS) { const int kk = i >> 7, cc = i & 127; WlT[cc * 68 + kk] = src[(size_t)(k0 + kk) * 4096 + cc]; }
    const float* wsrc = wcs + (size_t)(cs * 4 + g) * 128 * 128;
    for (int i = c.tid; i < 128 * 128; i += NTHREADS) Wc[i] = wsrc[i];
    __syncthreads();
    const int kq = c.tid & 15, dq = c.tid >> 4;
    f32x4 acc[4] = {};
    for (int cc = 0; cc < 128; ++cc) {
      const f32x4 a = *(const f32x4*)(WlT + cc * 68 + kq * 4), w = *(const f32x4*)(Wc + cc * 128 + dq * 4);
#pragma unroll
      for (int di = 0; di < 4; ++di) acc[di] += a * w[di];
    }
#pragma unroll
    for (int di = 0; di < 4; ++di) { u32x2 o = {cvtpk(acc[di][0], acc[di][1]), cvtpk(acc[di][2], acc[di][3])};
      *(u32x2*)(dstb + (size_t)(3584 + cs * 512 + g * 128 + dq * 4 + di) * DM + k0 + kq * 4) = o; }
    __syncthreads();
  }
}


__device__ __forceinline__ void ssm_tables(const Params& p, const Ctx& c) {
  float2* PW = (float2*)(p.ws + OFF_PW); float2* BB = (float2*)(p.ws + OFF_BB);
  for (long i = c.gtid; i < 2L * 32 * 2 * 64; i += c.nthr) { const int pp = (int)(i & 63), idx = (int)(i >> 6);
    const int d = idx & 1, g = (idx >> 1) & 31, l = idx >> 6, iidx = (l * 2 + d) * 32 + g;
    const float lre = p.ssm_a_re[iidx * 64 + pp], lim = p.ssm_a_im[iidx * 64 + pp], dt = expf(p.ssm_log_dt[iidx]);
    float ar = 1.f, ai = 0.f;
    for (int j = 0; j <= 32; ++j) { const float mag = expf(lre * dt * (float)j); float sn, cs; my_sincos(lim * dt * (float)j, sn, cs);
      PW[((size_t)idx * 33 + j) * 64 + pp] = make_float2(mag * cs, mag * sn); if (j == 1) { ar = mag * cs; ai = mag * sn; } }
    const float nr = ar - 1.f, ni = ai, den = 1.f / (lre * lre + lim * lim), cr = (nr * lre + ni * lim) * den, ci = (ni * lre - nr * lim) * den;
    const float* br = p.ssm_b_re + ((size_t)iidx * 64 + pp) * 16; const float* bi = p.ssm_b_im + ((size_t)iidx * 64 + pp) * 16;
    for (int h = 0; h < 16; ++h) BB[((size_t)idx * 64 + pp) * 16 + h] = make_float2(cr * br[h] - ci * bi[h], cr * bi[h] + ci * br[h]); }
}
__device__ __forceinline__ void ssm_build_mef(const Params& p, const Ctx& c, int l) {
  const float2* PW = (const float2*)(p.ws + OFF_PW) + (size_t)l * 32 * 2 * 33 * 64; const float2* BB = (const float2*)(p.ws + OFF_BB) + (size_t)l * 32 * 2 * 64 * 16;
  float* MK = (float*)(p.ws + OFF_MK) + (size_t)l * 32 * 2 * 32 * 256; bf16_t* EM = (bf16_t*)(p.ws + OFF_EM); bf16_t* TF = (bf16_t*)(p.ws + OFF_TF);
  for (long i = c.gtid; i < 32L * 2 * 32 * 256; i += c.nthr) { const int hp = (int)(i & 15), h = (int)((i >> 4) & 15), j = (int)((i >> 8) & 31), gd = (int)(i >> 13), d = gd & 1, g = gd >> 1;
    const size_t ci = ((size_t)((l * 2 + d) * 32 + g) * 16 + h) * 64; const float2* pw = PW + ((size_t)gd * 33 + j) * 64; const float2* bb = BB + (size_t)gd * 64 * 16 + hp; float a = 0.f;
    for (int pp = 0; pp < 64; ++pp) { const float cr = p.ssm_c_re[ci + pp], cim = p.ssm_c_im[ci + pp]; const float2 b = bb[pp * 16], w = pw[pp];
      const float wr = cr * b.x - cim * b.y, wi = cr * b.y + cim * b.x; a += wr * w.x - wi * w.y; }
    MK[i] = a; }
  for (long i = c.gtid; i < 32L * 256 * 32 * 2; i += c.nthr) { const int hh = (int)(i & 1), s = (int)((i >> 1) & 31), n = (int)((i >> 6) & 255), g = (int)(i >> 14), ri = n & 1, pp = (n >> 1) & 63, d = n >> 7;
    const int gd = g * 2 + d, e = d ? s : 31 - s; const float2 w = PW[((size_t)gd * 33 + e) * 64 + pp]; const float2* bb = BB + ((size_t)gd * 64 + pp) * 16 + hh * 8; float v[8];
#pragma unroll
    for (int k = 0; k < 8; ++k) { const float2 b = bb[k]; v[k] = ri ? (w.x * b.y + w.y * b.x) : (w.x * b.x - w.y * b.y); }
    u32x4 o = {cvtpk(v[0], v[1]), cvtpk(v[2], v[3]), cvtpk(v[4], v[5]), cvtpk(v[6], v[7])}; *(u32x4*)(EM + ((size_t)g * 256 + n) * 512 + s * 16 + hh * 8) = o; }
  for (long i = c.gtid; i < 32L * 512 * 2 * 16; i += c.nthr) { const int pq = (int)(i & 15), d = (int)((i >> 4) & 1), n = (int)((i >> 5) & 511), g = (int)(i >> 14), h = n & 15, t = n >> 4;
    const int gd = g * 2 + d, f = d ? 32 - t : t + 1; const size_t ci = ((size_t)((l * 2 + d) * 32 + g) * 16 + h) * 64 + pq * 4; const float2* pw = PW + ((size_t)gd * 33 + f) * 64 + pq * 4; float v[8];
#pragma unroll
    for (int k = 0; k < 4; ++k) { const float cr = p.ssm_c_re[ci + k], cim = p.ssm_c_im[ci + k]; const float2 w = pw[k]; v[2 * k] = cr * w.x - cim * w.y; v[2 * k + 1] = -(cr * w.y + cim * w.x); }
    u32x4 o = {cvtpk(v[0], v[1]), cvtpk(v[2], v[3]), cvtpk(v[4], v[5]), cvtpk(v[6], v[7])}; *(u32x4*)(TF + ((size_t)g * 512 + n) * 768 + 512 + d * 128 + pq * 8) = o; }
}
__device__ __forceinline__ void ssm_build_t(const Params& p, const Ctx& c, int l) {
  const float* MK = (const float*)(p.ws + OFF_MK) + (size_t)l * 32 * 2 * 32 * 256; bf16_t* TF = (bf16_t*)(p.ws + OFF_TF);
  for (long i = c.gtid; i < 32L * 512 * 32 * 2; i += c.nthr) { const int hh = (int)(i & 1), s = (int)((i >> 1) & 31), n = (int)((i >> 6) & 511), g = (int)(i >> 15), h = n & 15, t = n >> 4;
    const int lag = t - s; float v[8];
    if (lag != 0) { const float* m = MK + ((size_t)((g * 2 + (lag < 0 ? 1 : 0)) * 32 + (lag < 0 ? -lag : lag)) * 16 + h) * 16 + hh * 8;
#pragma unroll
      for (int k = 0; k < 8; ++k) v[k] = m[k]; }
    else { const float* m0 = MK + ((size_t)((g * 2) * 32) * 16 + h) * 16 + hh * 8; const float* m1 = MK + ((size_t)((g * 2 + 1) * 32) * 16 + h) * 16 + hh * 8; const float dsk = p.ssm_d[(size_t)l * 512 + g * 16 + h];
#pragma unroll
      for (int k = 0; k < 8; ++k) v[k] = m0[k] + m1[k] + ((hh * 8 + k) == h ? dsk : 0.f); }
    u32x4 o = {cvtpk(v[0], v[1]), cvtpk(v[2], v[3]), cvtpk(v[4], v[5]), cvtpk(v[6], v[7])}; *(u32x4*)(TF + ((size_t)g * 512 + n) * 768 + s * 16 + hh * 8) = o; }
}
__device__ __forceinline__ void ssm_carry(const Params& p, const Ctx& c, int l) {
  if (c.wid != 0) return;
  const float2* PW = (const float2*)(p.ws + OFF_PW) + (size_t)l * 32 * 2 * 33 * 64; const float* SB = (const float*)(p.ws + OFF_Z2 + Z2_SB); bf16_t* UG = (bf16_t*)(p.ws + OFF_Z2 + Z2_UG);
  for (int i = c.blk * 64 + c.lane; i < NB * 32 * 2 * 64; i += c.nblk * 64) { const int pp = i & 63, d = (i >> 6) & 1, g = (i >> 7) & 31, b = i >> 12;
    const float2 a32 = PW[((size_t)(g * 2 + d) * 33 + 32) * 64 + pp]; float hr = 0.f, hi = 0.f;
    const size_t rbase = (size_t)g * 768 + b * 136; const int col = (d * 64 + pp) * 2;
#pragma unroll 8
    for (int k = 0; k < 136; ++k) { const int ch = d == 0 ? k : (k < 8 ? 7 - k : 143 - k);
      const float2 s = *(const float2*)(SB + (rbase + ch) * 256 + col);
      *(unsigned*)(UG + (rbase + ch) * 768 + 512 + col) = cvtpk(hr, hi);
      const float nr = a32.x * hr - a32.y * hi + s.x, ni = a32.x * hi + a32.y * hr + s.y; hr = nr; hi = ni; } }
}

__device__ __forceinline__ void phase0a(const Params& p, const Ctx& c, float* lds) {
  for (int i = c.tid; i < 5 * DM; i += NTHREADS) { const float v = i < 4 * DM ? p.c[i] : p.c_ctx[i - 4 * DM]; lds[i] = v * sigmoidf_(v); }
  __syncthreads();
  {
    float* MP = (float*)(p.ws + OFF_MP);
    for (long it = c.gtid; it < 16 * 6144; it += c.nthr) {
      const int cq = (int)(it % 6144), ks = (int)(it / 6144); const int gc = cq * 4, l = gc / NMODC, col = gc % NMODC;
      const float* wp = p.w_mod + ((size_t)l * DM + (size_t)ks * 128) * NMODC + col;
      f32x4 a[5] = {};
#pragma unroll 8
      for (int k = 0; k < 128; ++k) { const f32x4 w = *(const f32x4*)(wp + (size_t)k * NMODC);
#pragma unroll
        for (int v = 0; v < 5; ++v) a[v] += w * lds[v * DM + ks * 128 + k]; }
#pragma unroll
      for (int v = 0; v < 5; ++v) *(f32x4*)(MP + ((size_t)ks * 5 + v) * 24576 + gc) = a[v];
    }
  }
  __syncthreads();
  {
    float* rc = (float*)(p.ws + OFF_ROPE); float* rs = rc + 64 * 32;
    for (long i = c.gtid; i < 64 * 32; i += c.nthr) { const int pos = (int)(i >> 5), pp = (int)(i & 31);
      const float inv = (float)exp2(-(double)pp / 32.0 * 13.287712379549449); float s, cc; my_sincos((float)pos * inv, s, cc); rc[i] = cc; rs[i] = s; }
  }
  {
    bf16_t* DL = (bf16_t*)(p.ws + OFF_DFTL);
    for (long i = c.gtid; i < 2L * 4096 * 512; i += c.nthr) { const int part = (int)(i >> 21), k = (int)((i >> 9) & 4095), t0 = (int)(i & 511) * 8; float v[8];
#pragma unroll
      for (int j = 0; j < 8; ++j) { const float ph = (float)((k * (t0 + j)) & 4095) * (1.f / 4096.f); v[j] = (part ? __builtin_amdgcn_sinf(ph) : __builtin_amdgcn_cosf(ph)) * (1.f / 64.f); }
      u32x4 w = {cvtpk(v[0], v[1]), cvtpk(v[2], v[3]), cvtpk(v[4], v[5]), cvtpk(v[6], v[7])}; *(u32x4*)(DL + i * 8) = w; }
    bf16_t* DC = (bf16_t*)(p.ws + OFF_DFTC);
    for (long i = c.gtid; i < 2L * 256 * 32; i += c.nthr) { const int part = (int)(i >> 13), k = (int)((i >> 5) & 255), t0 = (int)(i & 31) * 8; float v[8];
#pragma unroll
      for (int j = 0; j < 8; ++j) { const float ph = (float)((k * (t0 + j)) & 255) * (1.f / 256.f); v[j] = (part ? __builtin_amdgcn_sinf(ph) : __builtin_amdgcn_cosf(ph)) * (1.f / 16.f); }
      u32x4 w = {cvtpk(v[0], v[1]), cvtpk(v[2], v[3]), cvtpk(v[4], v[5]), cvtpk(v[6], v[7])}; *(u32x4*)(DC + i * 8) = w; }
  }
  {
    float* W = (float*)(p.ws + OFF_WCS);
    for (long i = c.gtid; i < 2L * 2 * 4 * 128 * 128; i += c.nthr) { const int d = (int)(i & 127), cc = (int)((i >> 7) & 127), g = (int)((i >> 14) & 3), cs = (int)((i >> 16) & 1), l = (int)(i >> 17);
      const float* wf = p.w_four + ((size_t)(l * 4 + g) * 128) * 128 + d; float a = 0.f;
      for (int j = 0; j < 128; ++j) { const float ph = (float)((j * cc) & 127) * (1.f / 128.f); a += (cs ? __builtin_amdgcn_sinf(ph) : __builtin_amdgcn_cosf(ph)) * wf[(size_t)j * 128]; }
      W[i] = a * 0.08838834764831845f; }
  }
}

__device__ __forceinline__ void reduce_mod(const Params& p, const Ctx& c) {
  const float* MP = (const float*)(p.ws + OFF_MP); float* MOD = (float*)(p.ws + OFF_MOD);
  for (long o = c.gtid; o < 5L * 24576; o += c.nthr) { const int v = (int)(o / 24576), gc = (int)(o % 24576), l = gc / NMODC, col = gc % NMODC;
    float a = p.b_mod[gc];
#pragma unroll
    for (int ks = 0; ks < 16; ++ks) a += MP[((size_t)ks * 5 + v) * 24576 + gc];
    MOD[(size_t)(l * 5 + v) * NMODC + col] = a; }
}

__device__ __forceinline__ void prenorm_row(const f32x4 (&x)[8], float rinv, const float* g, const float* sc, const float* sh, bf16_t* dst, int lane) {
#pragma unroll
  for (int i = 0; i < 8; ++i) { const int col = (lane + 64 * i) * 4; const f32x4 gg = *(const f32x4*)(g + col), s1 = *(const f32x4*)(sc + col), s0 = *(const f32x4*)(sh + col);
    const f32x4 y = (x[i] * rinv * gg) * (s1 + 1.f) + s0; u32x2 o = {cvtpk(y[0], y[1]), cvtpk(y[2], y[3])}; *(u32x2*)(dst + col) = o; }
}
__device__ __forceinline__ float sumsq8(const f32x4 (&x)[8]) { float s = 0.f;
#pragma unroll
  for (int i = 0; i < 8; ++i) s += x[i][0] * x[i][0] + x[i][1] * x[i][1] + x[i][2] * x[i][2] + x[i][3] * x[i][3];
  return wave_sum(s); }

__device__ __forceinline__ const float* xrow_src(const Params& p, int l, int b, int t, int row) {
  if (l != 0) return (const float*)(p.ws + OFF_X) + (size_t)row * DM;
  const float* base = t < CTXL ? p.ctx : p.x; const size_t off = t < CTXL ? ((size_t)b * CTXL + t) * DM : ((size_t)b * SEQ + (t - CTXL)) * DM; return base + off;
}
__device__ __forceinline__ void phase_prenorm(const Params& p, const Ctx& c, int l) {
  bf16_t* Hn = (bf16_t*)(p.ws + OFF_HN);
  for (int row = c.gwave; row < TT; row += c.nwave) { const int b = row / TPB, t = row % TPB, v = t < CTXL ? 4 : b;
    f32x4 x[8]; const f32x4* xr = (const f32x4*)xrow_src(p, l, b, t, row);
#pragma unroll
    for (int i = 0; i < 8; ++i) x[i] = xr[c.lane + 64 * i];
    const float rinv = rsqrtf(sumsq8(x) * (1.f / DM) + 1e-6f);
    prenorm_row(x, rinv, p.g_mix_pre + (size_t)l * DM, modp(p, l, v, 1), modp(p, l, v, 0), Hn + (size_t)row * DM, c.lane); }
}
__device__ __forceinline__ void phase_postmix(const Params& p, const Ctx& c, int l, bool last) {
  float* X = (float*)(p.ws + OFF_X); const bf16_t* MIX = (const bf16_t*)(p.ws + OFF_Z1); bf16_t* Hn = (bf16_t*)(p.ws + OFF_HN);
  for (int row = c.gwave; row < TT; row += c.nwave) { const int b = row / TPB, t = row % TPB, v = t < CTXL ? 4 : b; if (last && t < CTXL) continue;
    f32x4 m[8], x[8]; const u32x2* mr = (const u32x2*)(MIX + (size_t)row * DM); f32x4* xr = (f32x4*)(X + (size_t)row * DM); const f32x4* xs = (const f32x4*)xrow_src(p, l, b, t, row);
    if (t < CTXL) { const u32x2* sl = (const u32x2*)(p.ws + OFF_Z2) + ((size_t)b * CTXL + t) * (DM / 4);
#pragma unroll
      for (int i = 0; i < 8; ++i) { m[i] = (f32x4){0.f, 0.f, 0.f, 0.f}; x[i] = xs[c.lane + 64 * i]; }
      for (int s = 0; s < 8; ++s) {
#pragma unroll
        for (int i = 0; i < 8; ++i) { const u32x2 w = sl[(size_t)s * NB * CTXL * (DM / 4) + c.lane + 64 * i]; m[i] += (f32x4){__uint_as_float(w[0] << 16), __uint_as_float(w[0] & 0xffff0000u), __uint_as_float(w[1] << 16), __uint_as_float(w[1] & 0xffff0000u)}; } } }
    else {
#pragma unroll
    for (int i = 0; i < 8; ++i) { const u32x2 w = mr[c.lane + 64 * i]; m[i] = (f32x4){__uint_as_float(w[0] << 16), __uint_as_float(w[0] & 0xffff0000u), __uint_as_float(w[1] << 16), __uint_as_float(w[1] & 0xffff0000u)}; x[i] = xs[c.lane + 64 * i]; } }
    const float r1 = rsqrtf(sumsq8(m) * (1.f / DM) + 1e-6f); const float* gp = p.g_mix_post + (size_t)l * DM; const float* m2 = modp(p, l, v, 2);
#pragma unroll
    for (int i = 0; i < 8; ++i) { const int col = (c.lane + 64 * i) * 4; x[i] += *(const f32x4*)(m2 + col) * (m[i] * r1 * *(const f32x4*)(gp + col)); xr[c.lane + 64 * i] = x[i]; }
    const float r2 = rsqrtf(sumsq8(x) * (1.f / DM) + 1e-6f);
    prenorm_row(x, r2, p.g_ffn_pre + (size_t)l * DM, modp(p, l, v, 4), modp(p, l, v, 3), Hn + (size_t)row * DM, c.lane); }
}
__device__ __forceinline__ void phase_postffn(const Params& p, const Ctx& c, int l, bool last) {
  float* X = (float*)(p.ws + OFF_X); const bf16_t* F = (const bf16_t*)(p.ws + OFF_Z1 + (size_t)TT * DM * 2); bf16_t* Hn = (bf16_t*)(p.ws + OFF_HN);
  for (int row = c.gwave; row < TT; row += c.nwave) { const int b = row / TPB, t = row % TPB, v = t < CTXL ? 4 : b; if (last && t < CTXL) continue;
    f32x4 m[8], x[8]; const u32x2* mr = (const u32x2*)(F + (size_t)row * DM); f32x4* xr = (f32x4*)(X + (size_t)row * DM);
    if (t < CTXL) { const u32x2* sl = (const u32x2*)(p.ws + OFF_Z1) + ((size_t)b * CTXL + t) * (DM / 4);
#pragma unroll
      for (int i = 0; i < 8; ++i) { m[i] = (f32x4){0.f, 0.f, 0.f, 0.f}; x[i] = xr[c.lane + 64 * i]; }
      for (int s = 0; s < 11; ++s) {
#pragma unroll
        for (int i = 0; i < 8; ++i) { const u32x2 w = sl[(size_t)s * NB * CTXL * (DM / 4) + c.lane + 64 * i]; m[i] += (f32x4){__uint_as_float(w[0] << 16), __uint_as_float(w[0] & 0xffff0000u), __uint_as_float(w[1] << 16), __uint_as_float(w[1] & 0xffff0000u)}; } } }
    else {
#pragma unroll
    for (int i = 0; i < 8; ++i) { const u32x2 w = mr[c.lane + 64 * i]; m[i] = (f32x4){__uint_as_float(w[0] << 16), __uint_as_float(w[0] & 0xffff0000u), __uint_as_float(w[1] << 16), __uint_as_float(w[1] & 0xffff0000u)}; x[i] = xr[c.lane + 64 * i]; } }
    const float r1 = rsqrtf(sumsq8(m) * (1.f / DM) + 1e-6f); const float* gp = p.g_ffn_post + (size_t)l * DM; const float* m5 = modp(p, l, v, 5);
#pragma unroll
    for (int i = 0; i < 8; ++i) { const int col = (c.lane + 64 * i) * 4; x[i] += *(const f32x4*)(m5 + col) * (m[i] * r1 * *(const f32x4*)(gp + col)); }
    if (last) { f32x4* o = (f32x4*)(p.out + ((size_t)b * SEQ + (t - CTXL)) * DM);
#pragma unroll
      for (int i = 0; i < 8; ++i) o[c.lane + 64 * i] = x[i]; }
    else {
#pragma unroll
      for (int i = 0; i < 8; ++i) xr[c.lane + 64 * i] = x[i];
      const float r2 = rsqrtf(sumsq8(x) * (1.f / DM) + 1e-6f);
      prenorm_row(x, r2, p.g_mix_pre + (size_t)(l + 1) * DM, modp(p, l + 1, v, 1), modp(p, l + 1, v, 0), Hn + (size_t)row * DM, c.lane); } }
}

typedef f32x4 Acc[2][2][4][2];
__device__ __forceinline__ int lat_pm(int i) { return (i >> 4) * 17 + 1 + (i & 15); }

struct SchedMN {
  const char* A; const char* B; size_t strA, strB;
  int nM, nN, pn0, latonly, nextra, blk, nblk;
  __device__ __forceinline__ bool next(int i, gm::Unit& u) const {
    const int it = i * nblk + blk, nmain = nM * nN;
    if (it < nmain) { gm::tile_of(it, nM, nN, u.pm, u.pn); if (latonly) u.pm = lat_pm(u.pm); u.pn += pn0; return true; }
    if (it < nmain + nextra) { const int j = it - nmain; u.pm = (j / 10) * 17; u.pn = 4 + (j % 10); return true; }
    return false;
  }
  __device__ __forceinline__ const char* pA(const gm::Unit& u) const { return A + (size_t)u.pm * strA; }
  __device__ __forceinline__ const char* pB(const gm::Unit& u) const { return B + (size_t)u.pn * strB; }
};

struct EpiIn {
  bf16_t *Qb, *Kb, *Vb, *UG, *PT; const float *rc, *rs;
  __device__ __forceinline__ void operator()(const Acc& acc, const gm::Unit& u, int wr, int wc, int fr, int fq) const {
    const int pm = u.pm, pn = u.pn; const bool isctx = (pm % 17) == 0; const int brow = pm * 256;
#pragma unroll
    for (int ai = 0; ai < 2; ++ai)
#pragma unroll
      for (int m = 0; m < 4; ++m) { const int row = brow + ai * 128 + wr * 64 + m * 16 + fr;
        if (pn < 8) { bf16_t* dst = Qb + (size_t)(pn >> 2) * TT * 1024 + (size_t)row * 1024 + (pn & 3) * 256 + wc * 32 + fq * 4;
          f32x4 cs = {1.f, 1.f, 1.f, 1.f}, sn = {0.f, 0.f, 0.f, 0.f};
          if (!isctx) { const int tl = (row % TPB) - CTXL; const int pos = (wc >> 1) ? (tl & 63) : (tl >> 6); const int p0 = (wc & 1) * 16 + fq * 4;
            cs = *(const f32x4*)(rc + pos * 32 + p0); sn = *(const f32x4*)(rs + pos * 32 + p0); }
#pragma unroll
          for (int bj = 0; bj < 2; ++bj) { const f32x4 v1 = acc[ai][bj][m][0], v2 = acc[ai][bj][m][1]; const f32x4 o1 = v1 * cs - v2 * sn, o2 = v2 * cs + v1 * sn;
            u32x2 w1 = {cvtpk(o1[0], o1[1]), cvtpk(o1[2], o1[3])}, w2 = {cvtpk(o2[0], o2[1]), cvtpk(o2[2], o2[3])};
            *(u32x2*)(dst + bj * 128) = w1; *(u32x2*)(dst + bj * 128 + 16) = w2; } }
        else if (pn < 12) { bf16_t* dst = Vb + (size_t)row * 1024 + (pn - 8) * 256 + wc * 32 + fq * 4;
#pragma unroll
          for (int bj = 0; bj < 2; ++bj)
#pragma unroll
            for (int n = 0; n < 2; ++n) { const f32x4 v = acc[ai][bj][m][n]; u32x2 w = {cvtpk(v[0], v[1]), cvtpk(v[2], v[3])}; *(u32x2*)(dst + bj * 128 + n * 16) = w; } }
        else if (pn < 14) { const int b = row / TPB, t = row % TPB; bf16_t* dst = UG + ((size_t)(b * 136 + (t >> 5))) * 768 + (t & 31) * 16 + ((fq * 4) & 15);
#pragma unroll
          for (int bj = 0; bj < 2; ++bj)
#pragma unroll
            for (int n = 0; n < 2; ++n) { const int g = ((pn - 12) * 256 + bj * 128 + wc * 32 + n * 16 + fq * 4) >> 4; const f32x4 v = acc[ai][bj][m][n];
              u32x2 w = {cvtpk(v[0], v[1]), cvtpk(v[2], v[3])}; *(u32x2*)(dst + (size_t)g * 768 * 768) = w; } }
        else {
          const int b = pm / 17, tt = pm % 17, part = (pn - 14) >> 1; const size_t cb = (size_t)(part * NB + b) * 512 + (pn & 1) * 256; const size_t ld = tt == 0 ? 256 : 4096;
          bf16_t* dstm = PT + (tt == 0 ? (size_t)2 * NB * 512 * 4096 + cb * 256 : cb * 4096 + (size_t)(tt - 1) * 256) + ai * 128 + wr * 64 + m * 16 + fr;
#pragma unroll
          for (int bj = 0; bj < 2; ++bj)
#pragma unroll
            for (int n = 0; n < 2; ++n) { const f32x4 v = acc[ai][bj][m][n]; const unsigned w0 = cvtpk(v[0], v[1]), w1 = cvtpk(v[2], v[3]); bf16_t* d = dstm + (size_t)(bj * 128 + wc * 32 + n * 16 + fq * 4) * ld;
              d[0] = (bf16_t)(w0 & 0xffff); d[ld] = (bf16_t)(w0 >> 16); d[2 * ld] = (bf16_t)(w1 & 0xffff); d[3 * ld] = (bf16_t)(w1 >> 16); } } }
  }
};
__device__ __forceinline__ void phase_gemm_in(const Params& p, const Ctx& c, int l, LAS unsigned char* lds) {
  SchedMN S; S.A = p.ws + OFF_HN; S.B = p.ws + OFF_WIN; S.strA = (size_t)256 * DM * 2; S.strB = (size_t)256 * DM * 2; S.blk = c.blk; S.nblk = c.nblk;
  S.nM = l == 0 ? 68 : 64; S.latonly = l == 0 ? 0 : 1;
  { S.nN = 18; S.pn0 = 0; S.nextra = l == 0 ? 0 : 40;
    EpiIn E; E.PT = (bf16_t*)(p.ws + OFF_Z2 + Z2_CAT); E.Qb = (bf16_t*)(p.ws + OFF_Z1 + Z1_Q); E.Kb = (bf16_t*)(p.ws + OFF_Z1 + Z1_K); E.Vb = (bf16_t*)(p.ws + OFF_Z1 + Z1_V); E.UG = (bf16_t*)(p.ws + OFF_Z2 + Z2_UG);
    E.rc = (const float*)(p.ws + OFF_ROPE); E.rs = E.rc + 64 * 32;
    gm::gemm_phase<true>(lds, DM, DM, DM, S, E); }
}

template <int LAT> struct SchedFour {
  const bf16_t *DM_, *PT; int blk, nblk;
  __device__ __forceinline__ bool next(int i, gm::Unit& u) const { const int it = i * nblk + blk; if (it >= (LAT ? 256 : 16)) return false; u.pm = it; u.pn = 0; return true; }
  __device__ __forceinline__ const char* pA(const gm::Unit& u) const { const int it = u.pm;
    if (LAT) { const int kt = it & 15, part = (it >> 5) & 1; return (const char*)(DM_ + ((size_t)part * 4096 + kt * 256) * 4096); }
    const int part = (it >> 1) & 1; return (const char*)(DM_ + (size_t)part * 256 * 256); }
  __device__ __forceinline__ const char* pB(const gm::Unit& u) const { const int it = u.pm;
    if (LAT) { const int nt_ = (it >> 4) & 1, part = (it >> 5) & 1, b = it >> 6; return (const char*)(PT + ((size_t)(part * NB + b) * 512 + nt_ * 256) * 4096); }
    const int nt_ = it & 1, part = (it >> 1) & 1, b = it >> 2; return (const char*)(PT + (size_t)2 * NB * 512 * 4096 + ((size_t)(part * NB + b) * 512 + nt_ * 256) * 256); }
};
template <int LAT> struct EpiFour {
  float *FC, *FS;
  __device__ __forceinline__ void operator()(const Acc& acc, const gm::Unit& u, int wr, int wc, int fr, int fq) const { const int it = u.pm; int kt, nt_, part, b, toff;
    if (LAT) { kt = it & 15; nt_ = (it >> 4) & 1; part = (it >> 5) & 1; b = it >> 6; toff = CTXL; } else { kt = 0; nt_ = it & 1; part = (it >> 1) & 1; b = it >> 2; toff = 0; }
    float* dst = FC + (size_t)part * TT * 512 + ((size_t)b * TPB + toff + kt * 256) * 512 + nt_ * 256 + wc * 32 + fq * 4;
#pragma unroll
    for (int ai = 0; ai < 2; ++ai)
#pragma unroll
      for (int m = 0; m < 4; ++m) { float* dr = dst + (size_t)(ai * 128 + wr * 64 + m * 16 + fr) * 512;
#pragma unroll
        for (int bj = 0; bj < 2; ++bj)
#pragma unroll
          for (int n = 0; n < 2; ++n) *(f32x4*)(dr + bj * 128 + n * 16) = acc[ai][bj][m][n]; }
  }
};
__device__ __forceinline__ void phase_fourier(const Params& p, const Ctx& c, int l, LAS unsigned char* lds) {
  const bf16_t* PT = (const bf16_t*)(p.ws + OFF_Z2 + Z2_CAT);
  float* FC = (float*)(p.ws + OFF_Z2 + Z2_FC); float* FS = (float*)(p.ws + OFF_Z2 + Z2_FS);
  { const SchedFour<1> S{(const bf16_t*)(p.ws + OFF_DFTL), PT, c.blk, c.nblk}; const EpiFour<1> E{FC, FS}; gm::gemm_phase<true>(lds, 4096, 4096, 4096, S, E); }
  if (l == 0) { const SchedFour<0> S{(const bf16_t*)(p.ws + OFF_DFTC), PT, c.blk, c.nblk}; const EpiFour<0> E{FC, FS}; gm::gemm_phase<true>(lds, 256, 256, 256, S, E); }
}

struct SchedSsmS { const char *UG, *EM; int blk, nblk;
  __device__ __forceinline__ bool next(int i, gm::Unit& u) const { const int it = i * nblk + blk; if (it >= 96) return false; u.pm = it; u.pn = 0; return true; }
  __device__ __forceinline__ const char* pA(const gm::Unit& u) const { const int g = u.pm / 3, pm = u.pm % 3; return UG + ((size_t)g * 768 + pm * 256) * 768 * 2; }
  __device__ __forceinline__ const char* pB(const gm::Unit& u) const { const int g = u.pm / 3; return EM + (size_t)g * 256 * 512 * 2; } };
struct EpiSsmS { float* SB;
  __device__ __forceinline__ void operator()(const Acc& acc, const gm::Unit& u, int wr, int wc, int fr, int fq) const { const int g = u.pm / 3, pm = u.pm % 3;
#pragma unroll
    for (int ai = 0; ai < 2; ++ai)
#pragma unroll
      for (int m = 0; m < 4; ++m) { const int r = pm * 256 + ai * 128 + wr * 64 + m * 16 + fr; if (r >= 544) continue; float* dr = SB + ((size_t)g * 768 + r) * 256 + wc * 32 + fq * 4;
#pragma unroll
        for (int bj = 0; bj < 2; ++bj)
#pragma unroll
          for (int n = 0; n < 2; ++n) *(f32x4*)(dr + bj * 128 + n * 16) = acc[ai][bj][m][n]; }
  } };
__device__ __forceinline__ void phase_ssm_states(const Params& p, const Ctx& c, LAS unsigned char* lds) {
  const SchedSsmS S{p.ws + OFF_Z2 + Z2_UG, p.ws + OFF_EM, c.blk, c.nblk}; const EpiSsmS E{(float*)(p.ws + OFF_Z2 + Z2_SB)};
  gm::gemm_phase<true>(lds, 768, 512, 512, S, E);
}
struct SchedSsmY { const char *UG, *TF; int blk, nblk;
  __device__ __forceinline__ bool next(int i, gm::Unit& u) const { const int it = i * nblk + blk; if (it >= 192) return false; u.pm = it >> 1; u.pn = it & 1; return true; }
  __device__ __forceinline__ const char* pA(const gm::Unit& u) const { const int g = u.pm / 3, pm = u.pm % 3; return UG + ((size_t)g * 768 + pm * 256) * 768 * 2; }
  __device__ __forceinline__ const char* pB(const gm::Unit& u) const { const int g = u.pm / 3; return TF + ((size_t)g * 512 + u.pn * 256) * 768 * 2; } };
struct EpiSsmY { bf16_t* Gg; int last;
  __device__ __forceinline__ void operator()(const Acc& acc, const gm::Unit& u, int wr, int wc, int fr, int fq) const { const int g = u.pm / 3, pm = u.pm % 3;
#pragma unroll
    for (int ai = 0; ai < 2; ++ai)
#pragma unroll
      for (int m = 0; m < 4; ++m) { const int r = pm * 256 + ai * 128 + wr * 64 + m * 16 + fr; if (r >= 544) continue; const int b = r / 136, ch = r % 136; if (last && ch < 8) continue;
        bf16_t* dr = Gg + ((size_t)b * TPB + ch * 32) * 512 + g * 16 + ((fq * 4) & 15);
#pragma unroll
        for (int bj = 0; bj < 2; ++bj)
#pragma unroll
          for (int n = 0; n < 2; ++n) { const int t = (u.pn * 256 + bj * 128 + wc * 32 + n * 16 + fq * 4) >> 4; const f32x4 y = acc[ai][bj][m][n];
            u32x2 w = {cvtpk(gelu_tanh(y[0]), gelu_tanh(y[1])), cvtpk(gelu_tanh(y[2]), gelu_tanh(y[3]))}; *(u32x2*)(dr + (size_t)t * 512) = w; } }
  } };
__device__ __forceinline__ void phase_ssm_y(const Params& p, const Ctx& c, bool last, LAS unsigned char* lds) {
  const SchedSsmY S{p.ws + OFF_Z2 + Z2_UG, p.ws + OFF_TF, c.blk, c.nblk}; const EpiSsmY E{(bf16_t*)(p.ws + OFF_Z2 + Z2_GG), last ? 1 : 0};
  gm::gemm_phase<true>(lds, 768, 768, 768, S, E);
}

struct EpiGlu {
  const bf16_t* Gg; bf16_t* Cat; const float* bg;
  __device__ __forceinline__ void operator()(const Acc& acc, const gm::Unit& u, int wr, int wc, int fr, int fq) const { const int pm = u.pm, pn = u.pn;
#pragma unroll
    for (int ai = 0; ai < 2; ++ai)
#pragma unroll
      for (int m = 0; m < 4; ++m) { const int row = pm * 256 + ai * 128 + wr * 64 + m * 16 + fr;
#pragma unroll
        for (int bj = 0; bj < 2; ++bj)
#pragma unroll
          for (int n = 0; n < 2; ++n) { const int col = pn * 256 + bj * 128 + wc * 32 + n * 16 + fq * 4; const f32x4 z = acc[ai][bj][m][n] + *(const f32x4*)(bg + col);
            const u32x2 gw = *(const u32x2*)(Gg + (size_t)row * 512 + col);
            const float g0 = __uint_as_float(gw[0] << 16), g1 = __uint_as_float(gw[0] & 0xffff0000u), g2 = __uint_as_float(gw[1] << 16), g3 = __uint_as_float(gw[1] & 0xffff0000u);
            u32x2 w = {cvtpk(g0 * sigmoidf_(z[0]), g1 * sigmoidf_(z[1])), cvtpk(g2 * sigmoidf_(z[2]), g3 * sigmoidf_(z[3]))};
            *(u32x2*)(Cat + (size_t)row * DM + 1024 + col) = w; } }
  }
};
__device__ __forceinline__ void phase_glu(const Params& p, const Ctx& c, int l, bool last, LAS unsigned char* lds) {
  SchedMN S; S.A = p.ws + OFF_Z2 + Z2_GG; S.B = p.ws + OFF_WGLU; S.strA = (size_t)256 * 512 * 2; S.strB = (size_t)256 * 512 * 2; S.blk = c.blk; S.nblk = c.nblk;
  S.nM = last ? 64 : 68; S.latonly = last ? 1 : 0; S.nN = 2; S.pn0 = 0; S.nextra = 0;
  EpiGlu E; E.Gg = (const bf16_t*)(p.ws + OFF_Z2 + Z2_GG); E.Cat = (bf16_t*)(p.ws + OFF_Z2 + Z2_CAT); E.bg = p.b_glu + (size_t)l * 512;
  gm::gemm_phase<true>(lds, 512, 512, 512, S, E);
}

struct EpiF32 {
  bf16_t* O;
  __device__ __forceinline__ void operator()(const Acc& acc, const gm::Unit& u, int wr, int wc, int fr, int fq) const {
    bf16_t* dst = O + (size_t)u.pm * 256 * DM + u.pn * 256 + wc * 32 + fq * 4;
#pragma unroll
    for (int ai = 0; ai < 2; ++ai)
#pragma unroll
      for (int m = 0; m < 4; ++m) { bf16_t* dr = dst + (size_t)(ai * 128 + wr * 64 + m * 16 + fr) * DM;
#pragma unroll
        for (int bj = 0; bj < 2; ++bj)
#pragma unroll
          for (int n = 0; n < 2; ++n) { const f32x4 v = acc[ai][bj][m][n]; u32x2 w = {cvtpk(v[0], v[1]), cvtpk(v[2], v[3])}; *(u32x2*)(dr + bj * 128 + n * 16) = w; } }
  }
};
struct SchedSplit { const char *A, *B; size_t strA, strB, kbytes; int nunits, blk, nblk;
  __device__ __forceinline__ bool next(int i, gm::Unit& u) const { const int it = i * nblk + blk; if (it >= nunits) return false; u.pm = it; u.pn = 0; return true; }
  __device__ __forceinline__ const char* pA(const gm::Unit& u) const { const int tile = u.pm & 31, sp = u.pm >> 5; return A + (size_t)((tile >> 3) * 17) * strA + sp * kbytes; }
  __device__ __forceinline__ const char* pB(const gm::Unit& u) const { const int tile = u.pm & 31, sp = u.pm >> 5; return B + (size_t)(tile & 7) * strB + sp * kbytes; } };
struct EpiAcc { bf16_t* SLAB;
  __device__ __forceinline__ void operator()(const Acc& acc, const gm::Unit& u, int wr, int wc, int fr, int fq) const { const int tile = u.pm & 31, sp = u.pm >> 5;
    bf16_t* dst = SLAB + ((size_t)sp * NB * CTXL + (tile >> 3) * 256) * DM + (tile & 7) * 256 + wc * 32 + fq * 4;
#pragma unroll
    for (int ai = 0; ai < 2; ++ai)
#pragma unroll
      for (int m = 0; m < 4; ++m) { bf16_t* dr = dst + (size_t)(ai * 128 + wr * 64 + m * 16 + fr) * DM;
#pragma unroll
        for (int bj = 0; bj < 2; ++bj)
#pragma unroll
          for (int n = 0; n < 2; ++n) { const f32x4 v = acc[ai][bj][m][n]; u32x2 w = {cvtpk(v[0], v[1]), cvtpk(v[2], v[3])}; *(u32x2*)(dr + bj * 128 + n * 16) = w; } }
  } };
template <int KK, int NSPLIT>
__device__ __forceinline__ void phase_gemm_f32out(const Params& p, const Ctx& c, bool last, const char* A, const char* W, char* outp, char* slab, LAS unsigned char* lds) {
  SchedMN S; S.A = A; S.B = W; S.strA = (size_t)256 * KK * 2; S.strB = (size_t)256 * KK * 2; S.blk = c.blk; S.nblk = c.nblk;
  S.nM = 64; S.latonly = 1; S.nN = 8; S.pn0 = 0; S.nextra = 0;
  EpiF32 E; E.O = (bf16_t*)outp;
  gm::gemm_phase<true>(lds, KK, KK, KK, S, E);
  if (!last) { const SchedSplit S2{A, W, (size_t)256 * KK * 2, (size_t)256 * KK * 2, (size_t)(KK / NSPLIT) * 2, 32 * NSPLIT, c.blk, c.nblk}; const EpiAcc E2{(bf16_t*)slab};
    gm::gemm_phase<true>(lds, KK, KK, KK / NSPLIT, S2, E2); }
}

struct EpiGU {
  bf16_t* ACT;
  __device__ __forceinline__ void operator()(const Acc& acc, const gm::Unit& u, int wr, int wc, int fr, int fq) const {
    bf16_t* dst = ACT + (size_t)u.pm * 256 * DFF + u.pn * 128 + wc * 32 + fq * 4;
#pragma unroll
    for (int ai = 0; ai < 2; ++ai)
#pragma unroll
      for (int m = 0; m < 4; ++m) { bf16_t* dr = dst + (size_t)(ai * 128 + wr * 64 + m * 16 + fr) * DFF;
#pragma unroll
        for (int n = 0; n < 2; ++n) { const f32x4 g = acc[ai][0][m][n], uu = acc[ai][1][m][n];
          u32x2 w = {cvtpk(g[0] * sigmoidf_(g[0]) * uu[0], g[1] * sigmoidf_(g[1]) * uu[1]), cvtpk(g[2] * sigmoidf_(g[2]) * uu[2], g[3] * sigmoidf_(g[3]) * uu[3])};
          *(u32x2*)(dr + n * 16) = w; } }
  }
};
__device__ __forceinline__ void phase_gemm_gu(const Params& p, const Ctx& c, bool last, LAS unsigned char* lds) {
  SchedMN S; S.A = p.ws + OFF_HN; S.B = p.ws + OFF_WGU; S.strA = (size_t)256 * DM * 2; S.strB = (size_t)256 * DM * 2; S.blk = c.blk; S.nblk = c.nblk;
  S.nM = last ? 64 : 68; S.latonly = last ? 1 : 0; S.nN = 44; S.pn0 = 0; S.nextra = 0;
  EpiGU E; E.ACT = (bf16_t*)(p.ws + OFF_Z2);
  gm::gemm_phase<true>(lds, DM, DM, DM, S, E);
}

__device__ __forceinline__ void phase_attn(const Params& p, const Ctx& c, int l, char* lds) {
  const bf16_t* Qb = (const bf16_t*)(p.ws + OFF_Z1 + Z1_Q); const bf16_t* Kb = (const bf16_t*)(p.ws + OFF_Z1 + Z1_K); const bf16_t* Vb = (const bf16_t*)(p.ws + OFF_Z1 + Z1_V);
  bf16_t* O = (bf16_t*)(p.ws + OFF_HN);
  const int ntot = (l == 0) ? 512 + 32 : 512;
  for (int v = c.blk; v < ntot; v += c.nblk) {
    int combo, qb, seq;
    if (v < 512) { const int rd = v >> 8, w = v & 255; combo = rd * 16 + (w & 7) * 2 + ((w >> 3) >> 4); qb = 1 + ((w >> 3) & 15); seq = TPB; }
    else { combo = v - 512; qb = 0; seq = CTXL; }
    const int mp = combo & 1, h = (combo >> 1) & 3, b = combo >> 3;
    const size_t r0 = (size_t)b * TPB;
    at::body(Qb + (r0 + qb * 256) * 1024 + (h * 2 + mp) * 128, Kb + r0 * 1024 + (h * 2 + mp) * 128, Vb + r0 * 1024 + h * 256,
             O + (r0 + qb * 256) * DM + (h * 2 + mp) * 256, seq, lds);
  }
}

__device__ __forceinline__ void phase_combine(const Params& p, const Ctx& c, int l, bool last) {
  const bf16_t* O = (const bf16_t*)(p.ws + OFF_HN); bf16_t* Cat = (bf16_t*)(p.ws + OFF_Z2 + Z2_CAT);
  const float* FC = (const float*)(p.ws + OFF_Z2 + Z2_FC); const float* FS = (const float*)(p.ws + OFF_Z2 + Z2_FS);
  const float lam_init = 0.8f - 0.6f * expf(-0.3f * (float)l);
  float lam;
  { const float a1 = p.lam_q1[l * 128 + c.lane] * p.lam_k1[l * 128 + c.lane] + p.lam_q1[l * 128 + 64 + c.lane] * p.lam_k1[l * 128 + 64 + c.lane];
    const float a2 = p.lam_q2[l * 128 + c.lane] * p.lam_k2[l * 128 + c.lane] + p.lam_q2[l * 128 + 64 + c.lane] * p.lam_k2[l * 128 + 64 + c.lane];
    lam = expf(wave_sum(a1)) - expf(wave_sum(a2)) + lam_init; }
  const f32x4 gs = *(const f32x4*)(p.g_subln + (size_t)l * 256 + c.lane * 4);
  for (int row = c.gwave; row < TT; row += c.nwave) { const int t = row % TPB; if (last && t < CTXL) continue;
    const bf16_t* orow = O + (size_t)row * DM; bf16_t* crow_ = Cat + (size_t)row * DM;
#pragma unroll
    for (int h = 0; h < 4; ++h) { const u32x2 a = *(const u32x2*)(orow + (h * 2) * 256 + c.lane * 4), bq = *(const u32x2*)(orow + (h * 2 + 1) * 256 + c.lane * 4);
      f32x4 o; o[0] = __uint_as_float(a[0] << 16) - lam * __uint_as_float(bq[0] << 16); o[1] = __uint_as_float(a[0] & 0xffff0000u) - lam * __uint_as_float(bq[0] & 0xffff0000u);
      o[2] = __uint_as_float(a[1] << 16) - lam * __uint_as_float(bq[1] << 16); o[3] = __uint_as_float(a[1] & 0xffff0000u) - lam * __uint_as_float(bq[1] & 0xffff0000u);
      const float ss = wave_sum(o[0] * o[0] + o[1] * o[1] + o[2] * o[2] + o[3] * o[3]); const float r = rsqrtf(ss * (1.f / 256.f) + 1e-5f) * (1.f - lam_init);
      o = o * r * gs; u32x2 w = {cvtpk(o[0], o[1]), cvtpk(o[2], o[3])}; *(u32x2*)(crow_ + h * 256 + c.lane * 4) = w; }
#pragma unroll
    for (int q = 0; q < 2; ++q) { const int col = q * 256 + c.lane * 4; const size_t o5 = (size_t)row * 512 + col;
      const f32x4 f = *(const f32x4*)(FC + o5) - *(const f32x4*)(FS + o5) + *(const f32x4*)(p.b_four + (size_t)l * 512 + col);
      u32x2 wf = {cvtpk(f[0], f[1]), cvtpk(f[2], f[3])}; *(u32x2*)(crow_ + 1536 + col) = wf; }
  }
}


#define XB_TMO      128
#define XB_XCNT(j)  (256  + 64 * (j))
#define XB_XSUB(j)  (1280 + 64 * (j))
#define XB_XGEN(j)  (2304 + 64 * (j))
#define XB_TOP      3328
#define XB_TOPGEN   3392
#define XCD_BAR_WORDS 3456
#define XB_SPIN_CAP (1u << 18)
__device__ __forceinline__ unsigned xb_ld(unsigned* p)              { return __hip_atomic_load(p, __ATOMIC_RELAXED, __HIP_MEMORY_SCOPE_AGENT); }
__device__ __forceinline__ unsigned xb_add(unsigned* p, unsigned v) { return __hip_atomic_fetch_add(p, v, __ATOMIC_RELAXED, __HIP_MEMORY_SCOPE_AGENT); }
__device__ __forceinline__ unsigned xb_xcc_id() { return (unsigned)__builtin_amdgcn_s_getreg((3 << 11) | 20) & 0xFu; }
#define XB_SPIN(cond, bar) do { unsigned _sp = 0; while (cond) { __builtin_amdgcn_s_sleep(1); \
    if ((++_sp & 255u) == 0u) { if (xb_ld(&(bar)[XB_TMO])) break; if (_sp > XB_SPIN_CAP) { atomicAdd(&(bar)[XB_TMO], 1u); break; } } } } while (0)
struct XcdBarrier { unsigned* bar; unsigned x; volatile LAS unsigned* st; };
__device__ __forceinline__ XcdBarrier xcd_barrier_post(unsigned* bar, volatile LAS unsigned* st) {
  XcdBarrier b; b.bar = bar; b.x = xb_xcc_id(); b.st = st;
  if (threadIdx.x == 0) (void)xb_add(&bar[XB_XCNT(b.x)], 1u);
  return b;
}
__device__ __forceinline__ void xcd_barrier_complete(unsigned* bar, unsigned x, unsigned& nloc, unsigned& nx) {
  const unsigned G = gridDim.x * gridDim.y * gridDim.z;
  unsigned sum, cnt, mine, sp = 0u;
  for (;;) {
    sum = 0u; cnt = 0u; mine = 0u;
#pragma unroll
    for (unsigned j = 0; j < 16; ++j) { const unsigned c = xb_ld(&bar[XB_XCNT(j)]); sum += c; cnt += (c > 0u) ? 1u : 0u; mine = (j == x) ? c : mine; }
    if (sum == G) break;
    __builtin_amdgcn_s_sleep(1);
    if ((++sp & 255u) == 0u) { if (xb_ld(&bar[XB_TMO])) break; if (sp > XB_SPIN_CAP) { atomicAdd(&bar[XB_TMO], 1u); break; } }
  }
  nloc = mine > 0u ? mine : 1u; nx = cnt > 0u ? cnt : 1u;
}
__device__ __forceinline__ void xcd_barrier(const XcdBarrier& b) {
  asm volatile("s_waitcnt vmcnt(0)" ::: "memory");
  __syncthreads();
  if (threadIdx.x == 0) {
    unsigned* bar = b.bar;
    __builtin_amdgcn_s_waitcnt(0);
    unsigned nloc = b.st[0], nx = b.st[1];
    if (nloc == 0u) { xcd_barrier_complete(bar, b.x, nloc, nx); b.st[0] = nloc; b.st[1] = nx; }
    const unsigned old = xb_add(&bar[XB_XSUB(b.x)], 1u);
    const unsigned gen = old / nloc;
    if (old + 1u == (gen + 1u) * nloc) {
      __builtin_amdgcn_fence(__ATOMIC_RELEASE, "agent");
      asm volatile("s_waitcnt vmcnt(0)" ::: "memory");
      const unsigned og = xb_add(&bar[XB_TOP], 1u);
      const unsigned tg = og / nx;
      if (og + 1u == (tg + 1u) * nx) xb_add(&bar[XB_TOPGEN], 1u);
      else XB_SPIN(xb_ld(&bar[XB_TOPGEN]) == tg, bar);
      __builtin_amdgcn_fence(__ATOMIC_ACQUIRE, "agent");
      xb_add(&bar[XB_XGEN(b.x)], 1u);
      asm volatile("s_waitcnt vmcnt(0)" ::: "memory");
    } else {
      XB_SPIN(xb_ld(&bar[XB_XGEN(b.x)]) == gen, bar);
      __builtin_amdgcn_fence(__ATOMIC_ACQUIRE, "agent");
      asm volatile("s_waitcnt vmcnt(0)" ::: "memory");
    }
  }
  __syncthreads();
}

__global__ void __launch_bounds__(NTHREADS) mega(Params p_arg) {
  extern __shared__ __attribute__((aligned(16))) char shm[];
  __shared__ uint4 xb_words;
  cg::grid_group grid = cg::this_grid();
  typedef const __attribute__((address_space(4))) Params* KP;
  KP kp = (KP)__builtin_amdgcn_kernarg_segment_ptr();
  unsigned* bar = (unsigned*)(p_arg.ws + OFF_BAR);
  if (threadIdx.x == 0) xb_words = make_uint4(0u, 0u, 0u, 0u);
  if (blockIdx.x == 0) for (int i = threadIdx.x; i < XCD_BAR_WORDS; i += NTHREADS) bar[i] = 0u;
  __syncthreads();
  Ctx c;
#define RECTX() do { asm volatile("" : "+s"(kp)); int t_ = threadIdx.x; asm volatile("" : "+v"(t_)); int b_ = blockIdx.x; asm volatile("" : "+s"(b_)); \
    c.tid = t_; c.wid = t_ >> 6; c.lane = t_ & 63; c.blk = b_; c.nblk = gridDim.x; c.gwave = c.blk * 8 + c.wid; c.nwave = c.nblk * 8; \
    c.gtid = (long)c.blk * NTHREADS + c.tid; c.nthr = (long)c.nblk * NTHREADS; } while (0)
  RECTX();
  LAS unsigned char* gshm = (LAS unsigned char*)shm; float* fl = (float*)shm;

#define PP (*(const Params*)kp)
#define GSYNC() do { RECTX(); XcdBarrier xb_; xb_.bar = (unsigned*)(kp->ws + OFF_BAR); xb_.x = xb_xcc_id(); xb_.st = (volatile LAS unsigned*)&xb_words; xcd_barrier(xb_); } while (0)
  phase0a(PP, c, fl);
  RECTX(); ssm_tables(PP, c);
  RECTX(); convert_weights(PP, c, 0, fl);
  grid.sync();
  RECTX(); if (threadIdx.x == 0) (void)xb_add((unsigned*)(kp->ws + OFF_BAR) + XB_XCNT(xb_xcc_id()), 1u);
  RECTX(); reduce_mod(PP, c);
  RECTX(); fold_four(PP, c, 0, fl);
  RECTX(); ssm_build_mef(PP, c, 0);
  GSYNC();
  RECTX(); ssm_build_t(PP, c, 0);
  RECTX(); phase_prenorm(PP, c, 0);
  GSYNC();
  for (int l = 0; l < 2; ++l) {
    const bool last = (l == 1);
    RECTX(); phase_gemm_in(PP, c, l, gshm);
    GSYNC();
    RECTX(); phase_fourier(PP, c, l, gshm);
    RECTX(); phase_ssm_states(PP, c, gshm);
    GSYNC();
    RECTX(); ssm_carry(PP, c, l);
    RECTX(); phase_attn(PP, c, l, shm);
    GSYNC();
    RECTX(); phase_ssm_y(PP, c, last, gshm);
    RECTX(); phase_combine(PP, c, l, last);
    GSYNC();
    RECTX(); phase_glu(PP, c, l, last, gshm);
    GSYNC();
    RECTX(); phase_gemm_f32out<DM, 8>(PP, c, last, kp->ws + OFF_Z2 + Z2_CAT, kp->ws + OFF_WOUT, kp->ws + OFF_Z1, kp->ws + OFF_Z2, gshm);
    GSYNC();
    if (!last) { RECTX(); ssm_build_mef(PP, c, 1); }
    RECTX(); phase_postmix(PP, c, l, last);
    GSYNC();
    RECTX(); phase_gemm_gu(PP, c, last, gshm);
    GSYNC();
    RECTX(); phase_gemm_f32out<DFF, 11>(PP, c, last, kp->ws + OFF_Z2, kp->ws + OFF_WD, kp->ws + OFF_Z1 + (size_t)TT * DM * 2, kp->ws + OFF_Z1, gshm);
    GSYNC();
    if (!last) { RECTX(); ssm_build_t(PP, c, 1); }
    RECTX(); phase_postffn(PP, c, l, last);
    if (!last) { RECTX(); convert_weights(PP, c, 1, fl); RECTX(); fold_four(PP, c, 1, fl); GSYNC(); }
  }
}

extern "C" void kernel_launch(void* const* d_in, const int* in_sizes, int n_in, void* d_out, int out_size, void* d_ws, size_t ws_size,
                              hipStream_t stream) {
  static int grid_blocks = 0;
  if (!grid_blocks) {
    (void)hipFuncSetAttribute((const void*)mega, hipFuncAttributeMaxDynamicSharedMemorySize, SHM_BYTES);
    int dev = 0, cus = 0, per_cu = 0;
    (void)hipGetDevice(&dev);
    (void)hipDeviceGetAttribute(&cus, hipDeviceAttributeMultiprocessorCount, dev);
    (void)hipOccupancyMaxActiveBlocksPerMultiprocessor(&per_cu, mega, NTHREADS, SHM_BYTES);
    if (per_cu < 1) per_cu = 1;
    grid_blocks = cus;
  }
  if (n_in != 32 || ws_size < WS_NEED) { fprintf(stderr, "kernel_launch: bad n_in %d or ws %zu < %zu\n", n_in, ws_size, WS_NEED); return; }
  Params p{};
  const float** f = (const float**)&p;
  for (int i = 0; i < 32; ++i) f[i] = (const float*)d_in[i];
  p.out = (float*)d_out; p.ws = (char*)d_ws;
  void* args[] = {&p};
  hipError_t e = hipLaunchCooperativeKernel((void*)mega, dim3(grid_blocks), dim3(NTHREADS), args, SHM_BYTES, stream);
  if (e != hipSuccess) fprintf(stderr, "cooperative launch failed: %s (grid %d)\n", hipGetErrorString(e), grid_blocks);
}
```

```cpp
#include <hip/hip_runtime.h>
#include <hip/hip_cooperative_groups.h>
#include <cstdio>
#include <cstdint>
namespace cg = cooperative_groups;

typedef unsigned short bf16_t;
using bf16x8 = __attribute__((ext_vector_type(8))) short;
using s16x4  = __attribute__((ext_vector_type(4))) short;
using f32x4  = __attribute__((ext_vector_type(4))) float;
using f32x16 = __attribute__((ext_vector_type(16))) float;
using u32x4  = __attribute__((ext_vector_type(4))) unsigned;
using u32x2  = __attribute__((ext_vector_type(2))) unsigned;
#define LAS __attribute__((address_space(3)))

constexpr int NB = 4, SEQ = 4096, CTXL = 256, TPB = SEQ + CTXL  , TT = NB * TPB  ;
constexpr int DM = 2048, NIN = 4608, DFF = 5632, NMODC = 6 * DM  ;
constexpr int NTHREADS = 512, SHM_BYTES = 131072;

constexpr size_t al256(size_t x) { return (x + 255) / 256 * 256; }
constexpr size_t OFF_X    = 0;
constexpr size_t OFF_WIN  = OFF_X + (size_t)TT * DM * 2;
constexpr size_t OFF_WOUT = OFF_WIN + (size_t)NIN * DM * 2;
constexpr size_t OFF_WGU  = OFF_WOUT + (size_t)DM * DM * 2;
constexpr size_t OFF_WD   = OFF_WGU + (size_t)2 * DFF * DM * 2;
constexpr size_t OFF_WGLU = OFF_WD + (size_t)DM * DFF * 2;
constexpr size_t OFF_DFTL = OFF_WGLU + (size_t)512 * 512 * 2;
constexpr size_t OFF_DFTC = OFF_DFTL + (size_t)2 * 4096 * 4096 * 2;
constexpr size_t OFF_MP   = OFF_DFTC + (size_t)2 * 256 * 256 * 2;
constexpr size_t OFF_MOD  = OFF_MP + (size_t)16 * 5 * 24576 * 4;
constexpr size_t OFF_ROPE = OFF_MOD + (size_t)2 * 5 * NMODC * 4;
constexpr size_t OFF_WCS  = OFF_ROPE + (size_t)2 * 64 * 32 * 4;
constexpr size_t OFF_PW   = OFF_WCS + (size_t)2 * 2 * 4 * 128 * 128 * 4;
constexpr size_t OFF_BB   = OFF_PW + (size_t)2 * 32 * 2 * 33 * 64 * 8;
constexpr size_t OFF_MK   = OFF_BB + (size_t)2 * 32 * 2 * 64 * 16 * 8;
constexpr size_t OFF_TF   = OFF_MK + (size_t)2 * 32 * 2 * 32 * 256 * 4;
constexpr size_t OFF_EM   = OFF_TF + (size_t)32 * 512 * 768 * 2;
constexpr size_t OFF_BAR  = OFF_EM + (size_t)32 * 256 * 512 * 2;
constexpr size_t OFF_HN   = OFF_BAR + 16384;
constexpr size_t OFF_Z1   = OFF_HN + (size_t)TT * DM * 2;
constexpr size_t Z1_Q = 0, Z1_K = (size_t)TT * 1024 * 2, Z1_V = 2 * Z1_K;
constexpr size_t OFF_Z2   = OFF_Z1 + (size_t)TT * DM * 4;
constexpr size_t Z2_FC = 0, Z2_FS = Z2_FC + (size_t)TT * 512 * 4;
constexpr size_t Z2_UG = Z2_FS + (size_t)TT * 512 * 4;
constexpr size_t Z2_SB = Z2_UG + (size_t)32 * 768 * 768 * 2;
constexpr size_t Z2_CAT = Z2_SB + (size_t)32 * 768 * 256 * 4;
constexpr size_t Z2_GG = Z2_CAT + (size_t)TT * DM * 2;
constexpr size_t Z2_END = Z2_GG + (size_t)TT * 512 * 2;
constexpr size_t Z2_SIZE = Z2_END > (size_t)TT * DFF * 2 ? Z2_END : (size_t)TT * DFF * 2;
constexpr size_t WS_NEED = OFF_Z2 + Z2_SIZE;
static_assert(WS_NEED <= (size_t)805306368, "workspace over 768 MiB");


struct Params {
  const float *x, *c, *ctx, *c_ctx, *w_mod, *b_mod, *g_mix_pre, *g_mix_post, *g_ffn_pre, *g_ffn_post, *w_in, *w_out;
  const float *lam_q1, *lam_k1, *lam_q2, *lam_k2, *g_subln, *ssm_a_re, *ssm_a_im, *ssm_log_dt, *ssm_b_re, *ssm_b_im;
  const float *ssm_c_re, *ssm_c_im, *ssm_d, *w_glu, *b_glu, *w_four, *b_four, *w_gate, *w_up, *w_down;
  float* out; char* ws;
};

__device__ __forceinline__ unsigned cvtpk(float lo, float hi) { unsigned r; asm volatile("v_cvt_pk_bf16_f32 %0, %1, %2" : "=v"(r) : "v"(lo), "v"(hi)); return r; }
__device__ __forceinline__ float bf2f(unsigned short b) { return __uint_as_float((unsigned)b << 16); }
template <int CTRL> __device__ __forceinline__ float dpp_add(float v) { return v + __uint_as_float(__builtin_amdgcn_update_dpp(0u, __float_as_uint(v), CTRL, 0xf, 0xf, false)); }
__device__ __forceinline__ float wave_sum(float v) {
  v = dpp_add<0xB1>(v); v = dpp_add<0x4E>(v); v = dpp_add<0x141>(v); v = dpp_add<0x140>(v);
  const int vi = (int)__float_as_uint(v);
  return (__uint_as_float((unsigned)__builtin_amdgcn_readlane(vi, 0)) + __uint_as_float((unsigned)__builtin_amdgcn_readlane(vi, 16))) + (__uint_as_float((unsigned)__builtin_amdgcn_readlane(vi, 32)) + __uint_as_float((unsigned)__builtin_amdgcn_readlane(vi, 48)));
}
__device__ __forceinline__ void my_sincos(float x, float& s, float& c) {
  const double xd = (double)x; const double kd = rint(xd * 0.63661977236758134); const double r = xd - kd * 1.5707963267948966;
  const double r2 = r * r;
  const double sn = r * (1.0 - r2 / 6.0 * (1.0 - r2 / 20.0 * (1.0 - r2 / 42.0 * (1.0 - r2 / 72.0 * (1.0 - r2 / 110.0 * (1.0 - r2 / 156.0))))));
  const double cs = 1.0 - r2 / 2.0 * (1.0 - r2 / 12.0 * (1.0 - r2 / 30.0 * (1.0 - r2 / 56.0 * (1.0 - r2 / 90.0 * (1.0 - r2 / 132.0)))));
  const int q = ((int)kd) & 3;
  const double ss = (q == 0) ? sn : (q == 1) ? cs : (q == 2) ? -sn : -cs;
  const double cc = (q == 0) ? cs : (q == 1) ? -sn : (q == 2) ? -cs : sn;
  s = (float)ss; c = (float)cc;
}
__device__ __forceinline__ float sigmoidf_(float x) { return 1.f / (1.f + __expf(-x)); }
__device__ __forceinline__ float gelu_tanh(float y) { const float u = 0.7978845608028654f * (y + 0.044715f * y * y * y); return y * sigmoidf_(2.f * u); }

namespace gm {
constexpr int BM = 256, BK = 64, HALF = 128, HTB = HALF * BK * 2, NXCD = 8, WGM = 8;
__device__ __forceinline__ int lds_byte(int r, int c) { const int st = (r >> 4) * 2 + (c >> 5), rr = r & 15, cc = c & 31, ob = rr * 64 + cc * 2; return st * 1024 + (ob ^ (((ob >> 9) & 1) << 5)); }
__device__ __forceinline__ void stage_rc(int b, int& R, int& C) { const int st = b / 1024, sb = b % 1024, swz = sb ^ (((sb >> 9) & 1) << 5); R = (st >> 1) * 16 + swz / 64; C = (st & 1) * 32 + (swz % 64) / 2; }
__device__ __forceinline__ void tile_of(int wgid, int nM, int nN, int& pm, int& pn) {
  const int nwg = nM * nN; { const int q = nwg / NXCD, r = nwg % NXCD, xcd = wgid % NXCD, off = wgid / NXCD; wgid = (xcd < r ? xcd * (q + 1) : r * (q + 1) + (xcd - r) * q) + off; }
  const int nig = WGM * nN, gid = wgid / nig, fm = gid * WGM, gsz = (nM - fm) < WGM ? (nM - fm) : WGM;
  pm = fm + ((wgid % nig) % gsz); pn = (wgid % nig) / gsz;
}
struct Unit { int pm, pn; };

template <bool SWAP, class Epi, class Sched>
__device__ __forceinline__ void gemm_phase(LAS unsigned char* lds, const int lda, const int ldb, const int K, const Sched& S, const Epi& E) {
  int tid_ = threadIdx.x; asm volatile("" : "+v"(tid_));
  const int tid = tid_, wid = __builtin_amdgcn_readfirstlane(tid >> 6), lane = tid & 63, wr = wid >> 2, wc = wid & 3, fr = lane & 15, fq = lane >> 4;
  const int nt = K / BK;
  unsigned voffA[2], voffB[2];
#pragma unroll
  for (int i = 0; i < 2; ++i) { int R, C; stage_rc(tid * 16 + i * 8192, R, C); voffA[i] = (unsigned)(R * lda + C) * 2u; voffB[i] = (unsigned)(R * ldb + C) * 2u; }
  const size_t kstep = (size_t)(BK * 2), hstepA = (size_t)HALF * lda * 2, hstepB = (size_t)HALF * ldb * 2;
  const unsigned ldsw = (unsigned)wid * 1024u;
  const int aoff = lds_byte(wr * 64 + fr, fq * 8), boff = lds_byte(wc * 32 + fr, fq * 8);
#define PG8_SA(b, h) (((b) * 2 + (h)) * HTB)
#define PG8_SB(b, h) ((4 + (b) * 2 + (h)) * HTB)
#define PG8_STAGE(bufoff, gbase, voff) do { _Pragma("unroll") for (int _i = 0; _i < 2; ++_i) \
    __builtin_amdgcn_global_load_lds((const unsigned*)((const char*)(gbase) + (voff)[_i]), (LAS unsigned*)(lds + (bufoff) + ldsw + _i * 8192), 16, 0, 0); } while (0)
#define PG8_LDA(dst, b, h) do { _Pragma("unroll") for (int m = 0; m < 4; ++m) _Pragma("unroll") for (int k = 0; k < 2; ++k) dst[m][k] = *(const LAS bf16x8*)(lds + PG8_SA(b, h) + aoff + m * 2048 + k * 1024); } while (0)
#define PG8_LDB(dst, b, h) do { _Pragma("unroll") for (int n = 0; n < 2; ++n) _Pragma("unroll") for (int k = 0; k < 2; ++k) dst[n][k] = *(const LAS bf16x8*)(lds + PG8_SB(b, h) + boff + n * 2048 + k * 1024); } while (0)
#define PG8_MMA(ai, bj, At, Bt) do { __builtin_amdgcn_s_setprio(1); _Pragma("unroll") for (int m = 0; m < 4; ++m) _Pragma("unroll") for (int n = 0; n < 2; ++n) _Pragma("unroll") for (int k = 0; k < 2; ++k) \
    acc[ai][bj][m][n] = SWAP ? __builtin_amdgcn_mfma_f32_16x16x32_bf16(Bt[n][k], At[m][k], acc[ai][bj][m][n], 0, 0, 0) \
                             : __builtin_amdgcn_mfma_f32_16x16x32_bf16(At[m][k], Bt[n][k], acc[ai][bj][m][n], 0, 0, 0); __builtin_amdgcn_s_setprio(0); } while (0)
#define PG8_WAIT_V(n) asm volatile("s_waitcnt vmcnt(" #n ")" ::: "memory")
#define PG8_WAIT_L(n) asm volatile("s_waitcnt lgkmcnt(" #n ")" ::: "memory")
#define PG8_BAR __builtin_amdgcn_s_barrier()
#define PG8_SCHED __builtin_amdgcn_sched_barrier(0)
  Unit cur, nxt; int ui = 0;
  if (!S.next(0, cur)) return;
  f32x4 acc[2][2][4][2];
#pragma unroll
  for (int a = 0; a < 2; ++a)
#pragma unroll
    for (int b = 0; b < 2; ++b)
#pragma unroll
      for (int m = 0; m < 4; ++m)
#pragma unroll
        for (int n = 0; n < 2; ++n) acc[a][b][m][n] = (f32x4){0.f, 0.f, 0.f, 0.f};
  bf16x8 At[4][2], B0[2][2], B1[2][2];
  const char* cA = S.pA(cur); const char* cB = S.pB(cur);
  PG8_STAGE(PG8_SB(0, 0), cB, voffB); PG8_STAGE(PG8_SB(0, 1), cB + hstepB, voffB); PG8_STAGE(PG8_SA(0, 0), cA, voffA); PG8_STAGE(PG8_SA(0, 1), cA + hstepA, voffA);
  if (wr == 1) PG8_BAR;
  PG8_WAIT_V(2); PG8_BAR;
  PG8_STAGE(PG8_SB(1, 0), cB + kstep, voffB); PG8_STAGE(PG8_SA(1, 0), cA + kstep, voffA); PG8_STAGE(PG8_SB(1, 1), cB + hstepB + kstep, voffB);
  PG8_WAIT_V(6); PG8_BAR;
  for (;;) {
    const bool has_next = S.next(ui + 1, nxt);
    const char* nA = has_next ? S.pA(nxt) : cA; const char* nB = has_next ? S.pB(nxt) : cB;
    for (int t = 0; t < nt; t += 2) {
      const bool last = (t == nt - 2);
      const char* a1 = cA + (size_t)(t + 1) * kstep;
      const char* a2 = last ? nA : cA + (size_t)(t + 2) * kstep; const char* b2 = last ? nB : cB + (size_t)(t + 2) * kstep;
      const char* a3 = a2 + kstep; const char* b3 = b2 + kstep;
      PG8_LDB(B0, 0, 0); PG8_LDB(B1, 0, 1); PG8_SCHED; PG8_LDA(At, 0, 0); PG8_STAGE(PG8_SA(1, 1), a1 + hstepA, voffA);
      PG8_WAIT_V(8); PG8_WAIT_L(0); PG8_BAR; PG8_MMA(0, 0, At, B0); PG8_MMA(0, 1, At, B1); PG8_BAR; PG8_SCHED;
      PG8_LDA(At, 0, 1); PG8_STAGE(PG8_SB(0, 0), b2, voffB); PG8_STAGE(PG8_SB(0, 1), b2 + hstepB, voffB); PG8_STAGE(PG8_SA(0, 0), a2, voffA);
      PG8_WAIT_V(8); PG8_WAIT_L(0); PG8_BAR; PG8_MMA(1, 0, At, B0); PG8_MMA(1, 1, At, B1); PG8_BAR; PG8_SCHED;
      PG8_LDB(B0, 1, 0); PG8_LDB(B1, 1, 1); PG8_SCHED; PG8_LDA(At, 1, 0); PG8_STAGE(PG8_SA(0, 1), a2 + hstepA, voffA);
      PG8_WAIT_V(8); PG8_WAIT_L(0); PG8_BAR; PG8_MMA(0, 0, At, B0); PG8_MMA(0, 1, At, B1); PG8_BAR; PG8_SCHED;
      PG8_LDA(At, 1, 1); PG8_STAGE(PG8_SB(1, 0), b3, voffB); PG8_STAGE(PG8_SB(1, 1), b3 + hstepB, voffB); PG8_STAGE(PG8_SA(1, 0), a3, voffA);
      PG8_WAIT_V(8); PG8_WAIT_L(0); PG8_BAR; PG8_MMA(1, 0, At, B0); PG8_MMA(1, 1, At, B1); PG8_BAR; PG8_SCHED;
    }
    if (wr == 0) PG8_BAR;
    { int fr2 = fr, fq2 = fq; asm volatile("" : "+v"(fr2), "+v"(fq2));
      E(acc, cur, wr, wc, fr2, fq2); }
    if (!has_next) break;
#pragma unroll
    for (int a = 0; a < 2; ++a)
#pragma unroll
      for (int b = 0; b < 2; ++b)
#pragma unroll
        for (int m = 0; m < 4; ++m)
#pragma unroll
          for (int n = 0; n < 2; ++n) acc[a][b][m][n] = (f32x4){0.f, 0.f, 0.f, 0.f};
    cur = nxt; cA = nA; cB = nB; ++ui;
    if (wr == 1) PG8_BAR;
  }
  PG8_WAIT_V(0);
  PG8_BAR;
#undef PG8_SA
#undef PG8_SB
#undef PG8_STAGE
#undef PG8_LDA
#undef PG8_LDB
#undef PG8_MMA
#undef PG8_WAIT_V
#undef PG8_WAIT_L
#undef PG8_BAR
#undef PG8_SCHED
}
}

namespace at {
constexpr int D = 128, NW = 8, QBLK = 32, KVBLK = 64;
constexpr float SCALE = 0.088388347648318440f;
constexpr float THR = 8.f;
constexpr int LDQ = 1024, LDK = 1024, LDV = 1024, LDO = 2048;
constexpr size_t SHM_V = KVBLK * D * 2, SHM_K = KVBLK * D * 2;
#define KSWZ(row, colB) ((row) * 256 + ((colB) ^ (((row) & 7) << 4)))
#define SBAR() __builtin_amdgcn_sched_barrier(0)
__device__ __forceinline__ int crow(int r, int hi) { return (r & 3) + 8 * (r >> 2) + 4 * hi; }
__device__ __forceinline__ void partialSM(f32x16& p0, f32x16& p1, float& m_reg, float& mn, float& alpha) {
  constexpr float C = SCALE * 1.4426950408889634f;
  float pmax = p0[0];
#pragma unroll
  for (int r = 1; r < 16; ++r) pmax = fmaxf(pmax, p0[r]);
#pragma unroll
  for (int r = 0; r < 16; ++r) pmax = fmaxf(pmax, p1[r]);
  { auto rr = __builtin_amdgcn_permlane32_swap(__float_as_uint(pmax), __float_as_uint(pmax), false, false);
    pmax = fmaxf(__uint_as_float(rr[0]), __uint_as_float(rr[1])); }
  if (__builtin_expect(__all(pmax - m_reg <= THR / SCALE), 1)) { mn = m_reg; alpha = 1.f; }
  else { mn = fmaxf(m_reg, pmax); alpha = __builtin_amdgcn_exp2f((m_reg - mn) * C); m_reg = mn; }
  float mnC = -mn * C;
#pragma unroll
  for (int r = 0; r < 16; ++r) p0[r] = fmaf(p0[r], C, mnC);
#pragma unroll
  for (int r = 0; r < 16; ++r) p1[r] = fmaf(p1[r], C, mnC);
#pragma unroll
  for (int r = 0; r < 16; ++r) p0[r] = __builtin_amdgcn_exp2f(p0[r]);
}
__device__ __forceinline__ void finishSM(f32x16& p0, f32x16& p1, float alpha, float& l_reg, bf16x8& pa0, bf16x8& pa1, bf16x8& pa2, bf16x8& pa3) {
#pragma unroll
  for (int r = 0; r < 16; ++r) p1[r] = __builtin_amdgcn_exp2f(p1[r]);
  float ps = 0;
#pragma unroll
  for (int r = 0; r < 16; ++r) ps += p0[r];
#pragma unroll
  for (int r = 0; r < 16; ++r) ps += p1[r];
  { auto rr = __builtin_amdgcn_permlane32_swap(__float_as_uint(ps), __float_as_uint(ps), false, false);
    ps = __uint_as_float(rr[0]) + __uint_as_float(rr[1]); }
  l_reg = l_reg * alpha + ps;
#define PK4(P, BASE, OUT) do { unsigned a0 = cvtpk(P[BASE + 0], P[BASE + 1]), a1 = cvtpk(P[BASE + 2], P[BASE + 3]);   \
    unsigned b0 = cvtpk(P[BASE + 4], P[BASE + 5]), b1 = cvtpk(P[BASE + 6], P[BASE + 7]);                              \
    auto r0 = __builtin_amdgcn_permlane32_swap(a0, b0, false, false); auto r1 = __builtin_amdgcn_permlane32_swap(a1, b1, false, false); \
    u32x4 w = {r0[0], r1[0], r0[1], r1[1]}; OUT = *reinterpret_cast<bf16x8*>(&w); } while (0)
  PK4(p0, 0, pa0); PK4(p0, 8, pa1); PK4(p1, 0, pa2); PK4(p1, 8, pa3);
#undef PK4
}
__device__ __forceinline__ void qkt(f32x16& p0, f32x16& p1, const char* Ks, const bf16x8* qr, int r32, int hi) {
  p0 = f32x16{}; p1 = f32x16{};
#pragma unroll
  for (int d0 = 0; d0 < 8; ++d0) { int cb = (d0 * 16 + hi * 8) * 2;
    bf16x8 b0 = *reinterpret_cast<const bf16x8*>(Ks + KSWZ(r32, cb));
    bf16x8 b1 = *reinterpret_cast<const bf16x8*>(Ks + KSWZ(32 + r32, cb));
    p0 = __builtin_amdgcn_mfma_f32_32x32x16_bf16(b0, qr[d0], p0, 0, 0, 0);
    p1 = __builtin_amdgcn_mfma_f32_32x32x16_bf16(b1, qr[d0], p1, 0, 0, 0); }
}
__device__ __forceinline__ int v_st(int k, int c) { const int kk = (k & ~0xC) | ((k & 4) << 1) | ((k & 8) >> 1); return ((kk >> 3) * 8 + (c >> 5)) * 512 + ((kk & 7) * 32 + (c & 31)) * 2; }
__device__ __forceinline__ int v_rd_base(int lane) { return ((lane & 3) << 3) | (((lane >> 2) & 3) << 6) | (((lane >> 4) & 1) << 5) | (((lane >> 5) & 1) << 8); }
constexpr int v_rd_off(int d0, int ks, int half) { return d0 * 512 + ks * 8192 + half * 4096; }
template <int OFF> __device__ __forceinline__ s16x4 tr_read(int vb) {
  s16x4 r; asm volatile("ds_read_b64_tr_b16 %0, %1 offset:%2" : "=&v"(r) : "v"(vb), "i"(OFF) : "memory"); return r;
}
template <int D0> __device__ __forceinline__ void pv_one(f32x16& od, int vb, bf16x8 pa0, bf16x8 pa1, bf16x8 pa2, bf16x8 pa3) {
  const s16x4 l0 = tr_read<v_rd_off(D0, 0, 0)>(vb), h0 = tr_read<v_rd_off(D0, 0, 1)>(vb), l1 = tr_read<v_rd_off(D0, 1, 0)>(vb), h1 = tr_read<v_rd_off(D0, 1, 1)>(vb);
  const s16x4 l2 = tr_read<v_rd_off(D0, 2, 0)>(vb), h2 = tr_read<v_rd_off(D0, 2, 1)>(vb), l3 = tr_read<v_rd_off(D0, 3, 0)>(vb), h3 = tr_read<v_rd_off(D0, 3, 1)>(vb);
  asm volatile("s_waitcnt lgkmcnt(0)" ::: "memory"); SBAR();
#define PK(L, H) (bf16x8){L[0], L[1], L[2], L[3], H[0], H[1], H[2], H[3]}
  od = __builtin_amdgcn_mfma_f32_32x32x16_bf16(pa0, PK(l0, h0), od, 0, 0, 0);
  od = __builtin_amdgcn_mfma_f32_32x32x16_bf16(pa1, PK(l1, h1), od, 0, 0, 0);
  od = __builtin_amdgcn_mfma_f32_32x32x16_bf16(pa2, PK(l2, h2), od, 0, 0, 0);
  od = __builtin_amdgcn_mfma_f32_32x32x16_bf16(pa3, PK(l3, h3), od, 0, 0, 0);
#undef PK
}
__device__ __forceinline__ void body(const bf16_t* __restrict__ Qb, const bf16_t* __restrict__ Kh, const bf16_t* __restrict__ Vh, bf16_t* __restrict__ Ob, int seq, char* lds) {
  int tid_ = threadIdx.x; asm volatile("" : "+v"(tid_));
  const int tid = tid_, wid = tid >> 6, lane = tid & 63, r32 = lane & 31, hi = lane >> 5;
  constexpr int SV = 64 * 256 * 2, SK = 64 * 128 * 2;
  char* V_lds = lds; char* K_lds = lds + 2 * SV;
  float* ws = (float*)(lds + 2 * SV + 2 * SK) + wid * 64; float* li_l = ws; float* al_l = ws + 32;
  float m_reg = -1e30f, l_reg = 0; f32x16 o[8] = {}; bf16x8 qr[8];
  const bf16_t* Qw = Qb + (long)(wid * QBLK + r32) * LDQ + hi * 8;
#pragma unroll
  for (int d0 = 0; d0 < 8; ++d0) qr[d0] = *reinterpret_cast<const bf16x8*>(Qw + d0 * 16);
  const int wu = __builtin_amdgcn_readfirstlane(wid);
  int koff[2], voff[4];
#pragma unroll
  for (int q = 0; q < 2; ++q) { const int row = 4 * (wu * 2 + q) + (lane >> 4); koff[q] = row * LDK + ((((lane & 15) << 4) ^ ((row & 7) << 4)) >> 1); }
#pragma unroll
  for (int q = 0; q < 4; ++q) { const int s = 2 * (wu * 4 + q) + (lane >> 5), kk = (s >> 3) * 8 + ((lane & 31) >> 2), k = (kk & ~0xC) | ((kk & 4) << 1) | ((kk & 8) >> 1);
    voff[q] = k * LDV + (s & 7) * 32 + (lane & 3) * 8; }
  const int vb0 = (int)(uintptr_t)(LAS char*)V_lds + v_rd_base(lane);
  LAS char* Vl = (LAS char*)V_lds; LAS char* Kl = (LAS char*)K_lds;
#define STAGE(b, k0) do { const bf16_t* kg = Kh + (long)(k0) * LDK; const bf16_t* vg = Vh + (long)(k0) * LDV; \
    _Pragma("unroll") for (int q = 0; q < 2; ++q) __builtin_amdgcn_global_load_lds((const unsigned*)(kg + koff[q]), (LAS unsigned*)(Kl + (b) * SK + (wu * 2 + q) * 1024), 16, 0, 0); \
    _Pragma("unroll") for (int q = 0; q < 4; ++q) __builtin_amdgcn_global_load_lds((const unsigned*)(vg + voff[q]), (LAS unsigned*)(Vl + (b) * SV + (wu * 4 + q) * 1024), 16, 0, 0); } while (0)
  const int NT = seq / KVBLK;
  STAGE(0, 0);
  asm volatile("s_waitcnt vmcnt(0) lgkmcnt(0)" ::: "memory"); __builtin_amdgcn_s_barrier(); asm volatile("" ::: "memory");
  for (int j = 0; j < NT; ++j) {
    const int b = j & 1;
    f32x16 p0, p1; float mn, al; bf16x8 pa0, pa1, pa2, pa3;
    if (j + 1 < NT) STAGE(b ^ 1, (j + 1) * KVBLK);
    SBAR(); qkt(p0, p1, K_lds + b * SK, qr, r32, hi);
    partialSM(p0, p1, m_reg, mn, al);
    if (__any(al < 1.f)) { if (hi == 0) al_l[r32] = al; asm volatile("s_waitcnt lgkmcnt(0)" ::: "memory");
#pragma unroll
      for (int d = 0; d < 8; ++d)
#pragma unroll
        for (int r = 0; r < 16; ++r) o[d][r] *= al_l[crow(r, hi)]; }
    finishSM(p0, p1, al, l_reg, pa0, pa1, pa2, pa3); SBAR();
    const int vb = vb0 + b * SV;
    pv_one<0>(o[0], vb, pa0, pa1, pa2, pa3); pv_one<1>(o[1], vb, pa0, pa1, pa2, pa3); pv_one<2>(o[2], vb, pa0, pa1, pa2, pa3); pv_one<3>(o[3], vb, pa0, pa1, pa2, pa3);
    pv_one<4>(o[4], vb, pa0, pa1, pa2, pa3); pv_one<5>(o[5], vb, pa0, pa1, pa2, pa3); pv_one<6>(o[6], vb, pa0, pa1, pa2, pa3); pv_one<7>(o[7], vb, pa0, pa1, pa2, pa3);
    asm volatile("s_waitcnt vmcnt(0) lgkmcnt(0)" ::: "memory"); __builtin_amdgcn_s_barrier(); asm volatile("" ::: "memory");
  }
  if (hi == 0) li_l[r32] = l_reg; asm volatile("s_waitcnt lgkmcnt(0)" ::: "memory");
  float rli[16];
#pragma unroll
  for (int r = 0; r < 16; ++r) rli[r] = __builtin_amdgcn_rcpf(li_l[crow(r, hi)]);
  bf16_t* Ow = Ob + (long)(wid * QBLK) * LDO;
#pragma unroll
  for (int r = 0; r < 16; ++r) { int orow = crow(r, hi);
#pragma unroll
    for (int d0 = 0; d0 < 8; ++d0) Ow[(long)orow * LDO + d0 * 32 + r32] = (bf16_t)(cvtpk(o[d0][r] * rli[r], 0.f) & 0xffff); }
#undef STAGE
  __syncthreads();
}
}

struct Ctx {
  int tid, wid, lane, blk, nblk, gwave, nwave; long gtid, nthr;
};

__device__ __forceinline__ const float* modp(const Params& p, int l, int v, int j) { return (const float*)(p.ws + OFF_MOD) + ((size_t)(l * 5 + v) * NMODC + (size_t)j * DM); }

__device__ __forceinline__ void convert_weights(const Params& p, const Ctx& c, int l, float* lds) {
  constexpr int T0 = 14 * 32, T1 = 8 * 32, T2 = 44 * 32, T3 = 8 * 88, T4 = 2 * 8, TALL = T0 + T1 + T2 + T3 + T4;
  for (int it = c.blk; it < TALL; it += c.nblk) {
    int mat, ti = it;
    if (ti < T0) mat = 0; else if ((ti -= T0) < T1) mat = 1; else if ((ti -= T1) < T2) mat = 2; else if ((ti -= T2) < T3) mat = 3; else { ti -= T3; mat = 4; }
    const float* src; long ld; bf16_t* dst; long dld; int nkt;
    if (mat == 0) { src = p.w_in + (size_t)l * DM * 4096; ld = 4096; dst = (bf16_t*)(p.ws + OFF_WIN); dld = DM; nkt = 32; }
    else if (mat == 1) { src = p.w_out + (size_t)l * DM * DM; ld = DM; dst = (bf16_t*)(p.ws + OFF_WOUT); dld = DM; nkt = 32; }
    else if (mat == 2) { src = p.w_gate + (size_t)l * DM * DFF; ld = DFF; dst = (bf16_t*)(p.ws + OFF_WGU); dld = DM; nkt = 32; }
    else if (mat == 3) { src = p.w_down + (size_t)l * DFF * DM; ld = DM; dst = (bf16_t*)(p.ws + OFF_WD); dld = DFF; nkt = 88; }
    else { src = p.w_glu + (size_t)l * 512 * 512; ld = 512; dst = (bf16_t*)(p.ws + OFF_WGLU); dld = 512; nkt = 8; }
    const int n0 = (ti / nkt) * 256, k0 = (ti % nkt) * 64;
    {
      const int nn = c.tid & 255, kk0 = c.tid >> 8, np = n0 + nn; int scol = np;
      if (mat == 0) { if (np < 2048) scol = (np & ~0x30) | ((np & 16) << 1) | ((np & 32) >> 1); }
      else if (mat == 2) { const int pn = np >> 8, bj = (np >> 7) & 1; scol = pn * 128 + (np & 127); if (bj) src = p.w_up + (size_t)l * DM * DFF; }
      const float* sp = src + (size_t)(k0 + kk0) * ld + scol; float v[32];
#pragma unroll
      for (int i = 0; i < 32; ++i) v[i] = sp[(size_t)(2 * i) * ld];
#pragma unroll
      for (int i = 0; i < 32; ++i) lds[(kk0 + 2 * i) * 257 + nn] = v[i];
    }
    __syncthreads();
    {
      const int kc = (c.tid & 7) * 8;
#pragma unroll
      for (int j = 0; j < 4; ++j) { const int nn = (c.tid >> 3) + 64 * j; float v[8];
#pragma unroll
        for (int i = 0; i < 8; ++i) v[i] = lds[(kc + i) * 257 + nn];
        u32x4 w = {cvtpk(v[0], v[1]), cvtpk(v[2], v[3]), cvtpk(v[4], v[5]), cvtpk(v[6], v[7])};
        *(u32x4*)(dst + (size_t)(n0 + nn) * dld + k0 + kc) = w; }
    }
    __syncthreads();
  }
}

__device__ __forceinline__ void fold_four(const Params& p, const Ctx& c, int l, float* lds) {
  float* WlT = lds;
  float* Wc = lds + 128 * 68;
  const float* wcs = (const float*)(p.ws + OFF_WCS) + (size_t)l * 2 * 4 * 128 * 128;
  bf16_t* dstb = (bf16_t*)(p.ws + OFF_WIN);
  for (int u = c.blk; u < 256; u += c.nblk) {
    const int kt = u & 31, cs = (u >> 5) & 1, g = u >> 6, k0 = kt * 64;
    const float* src = p.w_in + (size_t)l * DM * 4096 + 3584 + g * 128;
    for (int i = c.tid; i < 64 * 128; i += NTHREADS) { const int kk = i >> 7, cc = i & 127; WlT[cc * 68 + kk] = src[(size_t)(k0 + kk) * 4096 + cc]; }
    const float* wsrc = wcs + (size_t)(cs * 4 + g) * 128 * 128;
    for (int i = c.tid; i < 128 * 128; i += NTHREADS) Wc[i] = wsrc[i];
    __syncthreads();
    const int kq = c.tid & 15, dq = c.tid >> 4;
    f32x4 acc[4] = {};
    for (int cc = 0; cc < 128; ++cc) {
      const f32x4 a = *(const f32x4*)(WlT + cc * 68 + kq * 4), w = *(const f32x4*)(Wc + cc * 128 + dq * 4);
#pragma unroll
      for (int di = 0; di < 4; ++di) acc[di] += a * w[di];
    }
#pragma unroll
    for (int di = 0; di < 4; ++di) { u32x2 o = {cvtpk(acc[di][0], acc[di][1]), cvtpk(acc[di][2], acc[di][3])};
      *(u32x2*)(dstb + (size_t)(3584 + cs * 512 + g * 128 + dq * 4 + di) * DM + k0 + kq * 4) = o; }
    __syncthreads();
  }
}


__device__ __forceinline__ void ssm_tables(const Params& p, const Ctx& c) {
  float2* PW = (float2*)(p.ws + OFF_PW); float2* BB = (float2*)(p.ws + OFF_BB);
  for (long i = c.gtid; i < 2L * 32 * 2 * 64; i += c.nthr) { const int pp = (int)(i & 63), idx = (int)(i >> 6);
    const int d = idx & 1, g = (idx >> 1) & 31, l = idx >> 6, iidx = (l * 2 + d) * 32 + g;
    const float lre = p.ssm_a_re[iidx * 64 + pp], lim = p.ssm_a_im[iidx * 64 + pp], dt = expf(p.ssm_log_dt[iidx]);
    float ar = 1.f, ai = 0.f;
    for (int j = 0; j <= 32; ++j) { const float mag = expf(lre * dt * (float)j); float sn, cs; my_sincos(lim * dt * (float)j, sn, cs);
      PW[((size_t)idx * 33 + j) * 64 + pp] = make_float2(mag * cs, mag * sn); if (j == 1) { ar = mag * cs; ai = mag * sn; } }
    const float nr = ar - 1.f, ni = ai, den = 1.f / (lre * lre + lim * lim), cr = (nr * lre + ni * lim) * den, ci = (ni * lre - nr * lim) * den;
    const float* br = p.ssm_b_re + ((size_t)iidx * 64 + pp) * 16; const float* bi = p.ssm_b_im + ((size_t)iidx * 64 + pp) * 16;
    for (int h = 0; h < 16; ++h) BB[((size_t)idx * 64 + pp) * 16 + h] = make_float2(cr * br[h] - ci * bi[h], cr * bi[h] + ci * br[h]); }
}
__device__ __forceinline__ void ssm_build_mef(const Params& p, const Ctx& c, int l) {
  const float2* PW = (const float2*)(p.ws + OFF_PW) + (size_t)l * 32 * 2 * 33 * 64; const float2* BB = (const float2*)(p.ws + OFF_BB) + (size_t)l * 32 * 2 * 64 * 16;
  float* MK = (float*)(p.ws + OFF_MK) + (size_t)l * 32 * 2 * 32 * 256; bf16_t* EM = (bf16_t*)(p.ws + OFF_EM); bf16_t* TF = (bf16_t*)(p.ws + OFF_TF);
  for (long i = c.gtid; i < 32L * 2 * 32 * 256; i += c.nthr) { const int hp = (int)(i & 15), h = (int)((i >> 4) & 15), j = (int)((i >> 8) & 31), gd = (int)(i >> 13), d = gd & 1, g = gd >> 1;
    const size_t ci = ((size_t)((l * 2 + d) * 32 + g) * 16 + h) * 64; const float2* pw = PW + ((size_t)gd * 33 + j) * 64; const float2* bb = BB + (size_t)gd * 64 * 16 + hp; float a = 0.f;
    for (int pp = 0; pp < 64; ++pp) { const float cr = p.ssm_c_re[ci + pp], cim = p.ssm_c_im[ci + pp]; const float2 b = bb[pp * 16], w = pw[pp];
      const float wr = cr * b.x - cim * b.y, wi = cr * b.y + cim * b.x; a += wr * w.x - wi * w.y; }
    MK[i] = a; }
  for (long i = c.gtid; i < 32L * 256 * 32 * 2; i += c.nthr) { const int hh = (int)(i & 1), s = (int)((i >> 1) & 31), n = (int)((i >> 6) & 255), g = (int)(i >> 14), ri = n & 1, pp = (n >> 1) & 63, d = n >> 7;
    const int gd = g * 2 + d, e = d ? s : 31 - s; const float2 w = PW[((size_t)gd * 33 + e) * 64 + pp]; const float2* bb = BB + ((size_t)gd * 64 + pp) * 16 + hh * 8; float v[8];
#pragma unroll
    for (int k = 0; k < 8; ++k) { const float2 b = bb[k]; v[k] = ri ? (w.x * b.y + w.y * b.x) : (w.x * b.x - w.y * b.y); }
    u32x4 o = {cvtpk(v[0], v[1]), cvtpk(v[2], v[3]), cvtpk(v[4], v[5]), cvtpk(v[6], v[7])}; *(u32x4*)(EM + ((size_t)g * 256 + n) * 512 + s * 16 + hh * 8) = o; }
  for (long i = c.gtid; i < 32L * 512 * 2 * 16; i += c.nthr) { const int pq = (int)(i & 15), d = (int)((i >> 4) & 1), n = (int)((i >> 5) & 511), g = (int)(i >> 14), h = n & 15, t = n >> 4;
    const int gd = g * 2 + d, f = d ? 32 - t : t + 1; const size_t ci = ((size_t)((l * 2 + d) * 32 + g) * 16 + h) * 64 + pq * 4; const float2* pw = PW + ((size_t)gd * 33 + f) * 64 + pq * 4; float v[8];
#pragma unroll
    for (int k = 0; k < 4; ++k) { const float cr = p.ssm_c_re[ci + k], cim = p.ssm_c_im[ci + k]; const float2 w = pw[k]; v[2 * k] = cr * w.x - cim * w.y; v[2 * k + 1] = -(cr * w.y + cim * w.x); }
    u32x4 o = {cvtpk(v[0], v[1]), cvtpk(v[2], v[3]), cvtpk(v[4], v[5]), cvtpk(v[6], v[7])}; *(u32x4*)(TF + ((size_t)g * 512 + n) * 768 + 512 + d * 128 + pq * 8) = o; }
}
__device__ __forceinline__ void ssm_build_t(const Params& p, const Ctx& c, int l) {
  const float* MK = (const float*)(p.ws + OFF_MK) + (size_t)l * 32 * 2 * 32 * 256; bf16_t* TF = (bf16_t*)(p.ws + OFF_TF);
  for (long i = c.gtid; i < 32L * 512 * 32 * 2; i += c.nthr) { const int hh = (int)(i & 1), s = (int)((i >> 1) & 31), n = (int)((i >> 6) & 511), g = (int)(i >> 15), h = n & 15, t = n >> 4;
    const int lag = t - s; float v[8];
    if (lag != 0) { const float* m = MK + ((size_t)((g * 2 + (lag < 0 ? 1 : 0)) * 32 + (lag < 0 ? -lag : lag)) * 16 + h) * 16 + hh * 8;
#pragma unroll
      for (int k = 0; k < 8; ++k) v[k] = m[k]; }
    else { const float* m0 = MK + ((size_t)((g * 2) * 32) * 16 + h) * 16 + hh * 8; const float* m1 = MK + ((size_t)((g * 2 + 1) * 32) * 16 + h) * 16 + hh * 8; const float dsk = p.ssm_d[(size_t)l * 512 + g * 16 + h];
#pragma unroll
      for (int k = 0; k < 8; ++k) v[k] = m0[k] + m1[k] + ((hh * 8 + k) == h ? dsk : 0.f); }
    u32x4 o = {cvtpk(v[0], v[1]), cvtpk(v[2], v[3]), cvtpk(v[4], v[5]), cvtpk(v[6], v[7])}; *(u32x4*)(TF + ((size_t)g * 512 + n) * 768 + s * 16 + hh * 8) = o; }
}
__device__ __forceinline__ void ssm_carry(const Params& p, const Ctx& c, int l) {
  if (c.wid != 0) return;
  const float2* PW = (const float2*)(p.ws + OFF_PW) + (size_t)l * 32 * 2 * 33 * 64; const float* SB = (const float*)(p.ws + OFF_Z2 + Z2_SB); bf16_t* UG = (bf16_t*)(p.ws + OFF_Z2 + Z2_UG);
  for (int i = c.blk * 64 + c.lane; i < NB * 32 * 2 * 64; i += c.nblk * 64) { const int pp = i & 63, d = (i >> 6) & 1, g = (i >> 7) & 31, b = i >> 12;
    const float2 a32 = PW[((size_t)(g * 2 + d) * 33 + 32) * 64 + pp]; float hr = 0.f, hi = 0.f;
    const size_t rbase = (size_t)g * 768 + b * 136; const int col = (d * 64 + pp) * 2;
#pragma unroll 8
    for (int k = 0; k < 136; ++k) { const int ch = d == 0 ? k : (k < 8 ? 7 - k : 143 - k);
      const float2 s = *(const float2*)(SB + (rbase + ch) * 256 + col);
      *(unsigned*)(UG + (rbase + ch) * 768 + 512 + col) = cvtpk(hr, hi);
      const float nr = a32.x * hr - a32.y * hi + s.x, ni = a32.x * hi + a32.y * hr + s.y; hr = nr; hi = ni; } }
}

__device__ __forceinline__ void phase0a(const Params& p, const Ctx& c, float* lds) {
  for (int i = c.tid; i < 5 * DM; i += NTHREADS) { const float v = i < 4 * DM ? p.c[i] : p.c_ctx[i - 4 * DM]; lds[i] = v * sigmoidf_(v); }
  __syncthreads();
  {
    float* MP = (float*)(p.ws + OFF_MP);
    for (long it = c.gtid; it < 16 * 6144; it += c.nthr) {
      const int cq = (int)(it % 6144), ks = (int)(it / 6144); const int gc = cq * 4, l = gc / NMODC, col = gc % NMODC;
      const float* wp = p.w_mod + ((size_t)l * DM + (size_t)ks * 128) * NMODC + col;
      f32x4 a[5] = {};
#pragma unroll 8
      for (int k = 0; k < 128; ++k) { const f32x4 w = *(const f32x4*)(wp + (size_t)k * NMODC);
#pragma unroll
        for (int v = 0; v < 5; ++v) a[v] += w * lds[v * DM + ks * 128 + k]; }
#pragma unroll
      for (int v = 0; v < 5; ++v) *(f32x4*)(MP + ((size_t)ks * 5 + v) * 24576 + gc) = a[v];
    }
  }
  __syncthreads();
  {
    float* rc = (float*)(p.ws + OFF_ROPE); float* rs = rc + 64 * 32;
    for (long i = c.gtid; i < 64 * 32; i += c.nthr) { const int pos = (int)(i >> 5), pp = (int)(i & 31);
      const float inv = (float)exp2(-(double)pp / 32.0 * 13.287712379549449); float s, cc; my_sincos((float)pos * inv, s, cc); rc[i] = cc; rs[i] = s; }
  }
  {
    bf16_t* DL = (bf16_t*)(p.ws + OFF_DFTL);
    for (long i = c.gtid; i < 2L * 4096 * 512; i += c.nthr) { const int part = (int)(i >> 21), k = (int)((i >> 9) & 4095), t0 = (int)(i & 511) * 8; float v[8];
#pragma unroll
      for (int j = 0; j < 8; ++j) { const float ph = (float)((k * (t0 + j)) & 4095) * (1.f / 4096.f); v[j] = (part ? __builtin_amdgcn_sinf(ph) : __builtin_amdgcn_cosf(ph)) * (1.f / 64.f); }
      u32x4 w = {cvtpk(v[0], v[1]), cvtpk(v[2], v[3]), cvtpk(v[4], v[5]), cvtpk(v[6], v[7])}; *(u32x4*)(DL + i * 8) = w; }
    bf16_t* DC = (bf16_t*)(p.ws + OFF_DFTC);
    for (long i = c.gtid; i < 2L * 256 * 32; i += c.nthr) { const int part = (int)(i >> 13), k = (int)((i >> 5) & 255), t0 = (int)(i & 31) * 8; float v[8];
#pragma unroll
      for (int j = 0; j < 8; ++j) { const float ph = (float)((k * (t0 + j)) & 255) * (1.f / 256.f); v[j] = (part ? __builtin_amdgcn_sinf(ph) : __builtin_amdgcn_cosf(ph)) * (1.f / 16.f); }
      u32x4 w = {cvtpk(v[0], v[1]), cvtpk(v[2], v[3]), cvtpk(v[4], v[5]), cvtpk(v[6], v[7])}; *(u32x4*)(DC + i * 8) = w; }
  }
  {
    float* W = (float*)(p.ws + OFF_WCS);
    for (long i = c.gtid; i < 2L * 2 * 4 * 128 * 128; i += c.nthr) { const int d = (int)(i & 127), cc = (int)((i >> 7) & 127), g = (int)((i >> 14) & 3), cs = (int)((i >> 16) & 1), l = (int)(i >> 17);
      const float* wf = p.w_four + ((size_t)(l * 4 + g) * 128) * 128 + d; float a = 0.f;
      for (int j = 0; j < 128; ++j) { const float ph = (float)((j * cc) & 127) * (1.f / 128.f); a += (cs ? __builtin_amdgcn_sinf(ph) : __builtin_amdgcn_cosf(ph)) * wf[(size_t)j * 128]; }
      W[i] = a * 0.08838834764831845f; }
  }
}

__device__ __forceinline__ void reduce_mod(const Params& p, const Ctx& c) {
  const float* MP = (const float*)(p.ws + OFF_MP); float* MOD = (float*)(p.ws + OFF_MOD);
  for (long o = c.gtid; o < 5L * 24576; o += c.nthr) { const int v = (int)(o / 24576), gc = (int)(o % 24576), l = gc / NMODC, col = gc % NMODC;
    float a = p.b_mod[gc];
#pragma unroll
    for (int ks = 0; ks < 16; ++ks) a += MP[((size_t)ks * 5 + v) * 24576 + gc];
    MOD[(size_t)(l * 5 + v) * NMODC + col] = a; }
}

__device__ __forceinline__ void prenorm_row(const f32x4 (&x)[8], float rinv, const float* g, const float* sc, const float* sh, bf16_t* dst, int lane) {
#pragma unroll
  for (int i = 0; i < 8; ++i) { const int col = (lane + 64 * i) * 4; const f32x4 gg = *(const f32x4*)(g + col), s1 = *(const f32x4*)(sc + col), s0 = *(const f32x4*)(sh + col);
    const f32x4 y = (x[i] * rinv * gg) * (s1 + 1.f) + s0; u32x2 o = {cvtpk(y[0], y[1]), cvtpk(y[2], y[3])}; *(u32x2*)(dst + col) = o; }
}
__device__ __forceinline__ float sumsq8(const f32x4 (&x)[8]) { float s = 0.f;
#pragma unroll
  for (int i = 0; i < 8; ++i) s += x[i][0] * x[i][0] + x[i][1] * x[i][1] + x[i][2] * x[i][2] + x[i][3] * x[i][3];
  return wave_sum(s); }

typedef _Float16 h16x4 __attribute__((ext_vector_type(4)));
__device__ __forceinline__ f32x4 ldx(const _Float16* p) { const h16x4 h = *(const h16x4*)p; return __builtin_convertvector(h, f32x4); }
__device__ __forceinline__ void stx(_Float16* p, f32x4 v) { *(h16x4*)p = __builtin_convertvector(v, h16x4); }
__device__ __forceinline__ const float* xrow_src(const Params& p, int l, int b, int t, int row) {
  const float* base = t < CTXL ? p.ctx : p.x; const size_t off = t < CTXL ? ((size_t)b * CTXL + t) * DM : ((size_t)b * SEQ + (t - CTXL)) * DM; return base + off;
}
__device__ __forceinline__ void phase_prenorm(const Params& p, const Ctx& c, int l) {
  bf16_t* Hn = (bf16_t*)(p.ws + OFF_HN);
  for (int row = c.gwave; row < TT; row += c.nwave) { const int b = row / TPB, t = row % TPB, v = t < CTXL ? 4 : b;
    f32x4 x[8]; const f32x4* xr = (const f32x4*)xrow_src(p, l, b, t, row);
#pragma unroll
    for (int i = 0; i < 8; ++i) x[i] = xr[c.lane + 64 * i];
    const float rinv = rsqrtf(sumsq8(x) * (1.f / DM) + 1e-6f);
    prenorm_row(x, rinv, p.g_mix_pre + (size_t)l * DM, modp(p, l, v, 1), modp(p, l, v, 0), Hn + (size_t)row * DM, c.lane); }
}
__device__ __forceinline__ void phase_postmix(const Params& p, const Ctx& c, int l, bool last) {
  _Float16* X = (_Float16*)(p.ws + OFF_X); const bf16_t* MIX = (const bf16_t*)(p.ws + OFF_Z1); bf16_t* Hn = (bf16_t*)(p.ws + OFF_HN);
  for (int row = c.gwave; row < TT; row += c.nwave) { const int b = row / TPB, t = row % TPB, v = t < CTXL ? 4 : b; if (last && t < CTXL) continue;
    f32x4 m[8], x[8]; const u32x2* mr = (const u32x2*)(MIX + (size_t)row * DM); _Float16* xr = X + (size_t)row * DM; const f32x4* xs = (const f32x4*)xrow_src(p, 0, b, t, row);
    if (t < CTXL) { const u32x2* sl = (const u32x2*)(p.ws + OFF_Z2) + ((size_t)b * CTXL + t) * (DM / 4);
#pragma unroll
      for (int i = 0; i < 8; ++i) { m[i] = (f32x4){0.f, 0.f, 0.f, 0.f}; x[i] = xs[c.lane + 64 * i]; }
      for (int s = 0; s < 8; ++s) {
#pragma unroll
        for (int i = 0; i < 8; ++i) { const u32x2 w = sl[(size_t)s * NB * CTXL * (DM / 4) + c.lane + 64 * i]; m[i] += (f32x4){__uint_as_float(w[0] << 16), __uint_as_float(w[0] & 0xffff0000u), __uint_as_float(w[1] << 16), __uint_as_float(w[1] & 0xffff0000u)}; } } }
    else {
#pragma unroll
    for (int i = 0; i < 8; ++i) { const u32x2 w = mr[c.lane + 64 * i]; m[i] = (f32x4){__uint_as_float(w[0] << 16), __uint_as_float(w[0] & 0xffff0000u), __uint_as_float(w[1] << 16), __uint_as_float(w[1] & 0xffff0000u)}; x[i] = (l == 0) ? xs[c.lane + 64 * i] : ldx(xr + (c.lane + 64 * i) * 4); } }
    const float r1 = rsqrtf(sumsq8(m) * (1.f / DM) + 1e-6f); const float* gp = p.g_mix_post + (size_t)l * DM; const float* m2 = modp(p, l, v, 2);
#pragma unroll
    for (int i = 0; i < 8; ++i) { const int col = (c.lane + 64 * i) * 4; x[i] += *(const f32x4*)(m2 + col) * (m[i] * r1 * *(const f32x4*)(gp + col)); stx(xr + col, x[i]); }
    const float r2 = rsqrtf(sumsq8(x) * (1.f / DM) + 1e-6f);
    prenorm_row(x, r2, p.g_ffn_pre + (size_t)l * DM, modp(p, l, v, 4), modp(p, l, v, 3), Hn + (size_t)row * DM, c.lane); }
}
__device__ __forceinline__ void phase_postffn(const Params& p, const Ctx& c, int l, bool last) {
  _Float16* X = (_Float16*)(p.ws + OFF_X); const bf16_t* F = (const bf16_t*)(p.ws + OFF_Z1 + (size_t)TT * DM * 2); bf16_t* Hn = (bf16_t*)(p.ws + OFF_HN);
  for (int row = c.gwave; row < TT; row += c.nwave) { const int b = row / TPB, t = row % TPB, v = t < CTXL ? 4 : b; if (last && t < CTXL) continue;
    f32x4 m[8], x[8]; const u32x2* mr = (const u32x2*)(F + (size_t)row * DM); _Float16* xr = X + (size_t)row * DM;
    if (t < CTXL) { const u32x2* sl = (const u32x2*)(p.ws + OFF_Z1) + ((size_t)b * CTXL + t) * (DM / 4);
#pragma unroll
      for (int i = 0; i < 8; ++i) { m[i] = (f32x4){0.f, 0.f, 0.f, 0.f}; x[i] = ldx(xr + (c.lane + 64 * i) * 4); }
      for (int s = 0; s < 11; ++s) {
#pragma unroll
        for (int i = 0; i < 8; ++i) { const u32x2 w = sl[(size_t)s * NB * CTXL * (DM / 4) + c.lane + 64 * i]; m[i] += (f32x4){__uint_as_float(w[0] << 16), __uint_as_float(w[0] & 0xffff0000u), __uint_as_float(w[1] << 16), __uint_as_float(w[1] & 0xffff0000u)}; } } }
    else {
#pragma unroll
    for (int i = 0; i < 8; ++i) { const u32x2 w = mr[c.lane + 64 * i]; m[i] = (f32x4){__uint_as_float(w[0] << 16), __uint_as_float(w[0] & 0xffff0000u), __uint_as_float(w[1] << 16), __uint_as_float(w[1] & 0xffff0000u)}; x[i] = ldx(xr + (c.lane + 64 * i) * 4); } }
    const float r1 = rsqrtf(sumsq8(m) * (1.f / DM) + 1e-6f); const float* gp = p.g_ffn_post + (size_t)l * DM; const float* m5 = modp(p, l, v, 5);
#pragma unroll
    for (int i = 0; i < 8; ++i) { const int col = (c.lane + 64 * i) * 4; x[i] += *(const f32x4*)(m5 + col) * (m[i] * r1 * *(const f32x4*)(gp + col)); }
    if (last) { f32x4* o = (f32x4*)(p.out + ((size_t)b * SEQ + (t - CTXL)) * DM);
#pragma unroll
      for (int i = 0; i < 8; ++i) o[c.lane + 64 * i] = x[i]; }
    else {
#pragma unroll
      for (int i = 0; i < 8; ++i) stx(xr + (c.lane + 64 * i) * 4, x[i]);
      const float r2 = rsqrtf(sumsq8(x) * (1.f / DM) + 1e-6f);
      prenorm_row(x, r2, p.g_mix_pre + (size_t)(l + 1) * DM, modp(p, l + 1, v, 1), modp(p, l + 1, v, 0), Hn + (size_t)row * DM, c.lane); } }
}

typedef f32x4 Acc[2][2][4][2];
__device__ __forceinline__ int lat_pm(int i) { return (i >> 4) * 17 + 1 + (i & 15); }

struct SchedMN {
  const char* A; const char* B; size_t strA, strB;
  int nM, nN, pn0, latonly, nextra, blk, nblk;
  __device__ __forceinline__ bool next(int i, gm::Unit& u) const {
    const int it = i * nblk + blk, nmain = nM * nN;
    if (it < nmain) { gm::tile_of(it, nM, nN, u.pm, u.pn); if (latonly) u.pm = lat_pm(u.pm); u.pn += pn0; return true; }
    if (it < nmain + nextra) { const int j = it - nmain; u.pm = (j / 10) * 17; u.pn = 4 + (j % 10); return true; }
    return false;
  }
  __device__ __forceinline__ const char* pA(const gm::Unit& u) const { return A + (size_t)u.pm * strA; }
  __device__ __forceinline__ const char* pB(const gm::Unit& u) const { return B + (size_t)u.pn * strB; }
};

struct EpiIn {
  bf16_t *Qb, *Kb, *Vb, *UG, *PT; const float *rc, *rs;
  __device__ __forceinline__ void operator()(const Acc& acc, const gm::Unit& u, int wr, int wc, int fr, int fq) const {
    const int pm = u.pm, pn = u.pn; const bool isctx = (pm % 17) == 0; const int brow = pm * 256;
#pragma unroll
    for (int ai = 0; ai < 2; ++ai)
#pragma unroll
      for (int m = 0; m < 4; ++m) { const int row = brow + ai * 128 + wr * 64 + m * 16 + fr;
        if (pn < 8) { bf16_t* dst = Qb + (size_t)(pn >> 2) * TT * 1024 + (size_t)row * 1024 + (pn & 3) * 256 + wc * 32 + fq * 4;
          f32x4 cs = {1.f, 1.f, 1.f, 1.f}, sn = {0.f, 0.f, 0.f, 0.f};
          if (!isctx) { const int tl = (row % TPB) - CTXL; const int pos = (wc >> 1) ? (tl & 63) : (tl >> 6); const int p0 = (wc & 1) * 16 + fq * 4;
            cs = *(const f32x4*)(rc + pos * 32 + p0); sn = *(const f32x4*)(rs + pos * 32 + p0); }
#pragma unroll
          for (int bj = 0; bj < 2; ++bj) { const f32x4 v1 = acc[ai][bj][m][0], v2 = acc[ai][bj][m][1]; const f32x4 o1 = v1 * cs - v2 * sn, o2 = v2 * cs + v1 * sn;
            u32x2 w1 = {cvtpk(o1[0], o1[1]), cvtpk(o1[2], o1[3])}, w2 = {cvtpk(o2[0], o2[1]), cvtpk(o2[2], o2[3])};
            *(u32x2*)(dst + bj * 128) = w1; *(u32x2*)(dst + bj * 128 + 16) = w2; } }
        else if (pn < 12) { bf16_t* dst = Vb + (size_t)row * 1024 + (pn - 8) * 256 + wc * 32 + fq * 4;
#pragma unroll
          for (int bj = 0; bj < 2; ++bj)
#pragma unroll
            for (int n = 0; n < 2; ++n) { const f32x4 v = acc[ai][bj][m][n]; u32x2 w = {cvtpk(v[0], v[1]), cvtpk(v[2], v[3])}; *(u32x2*)(dst + bj * 128 + n * 16) = w; } }
        else if (pn < 14) { const int b = row / TPB, t = row % TPB; bf16_t* dst = UG + ((size_t)(b * 136 + (t >> 5))) * 768 + (t & 31) * 16 + ((fq * 4) & 15);
#pragma unroll
          for (int bj = 0; bj < 2; ++bj)
#pragma unroll
            for (int n = 0; n < 2; ++n) { const int g = ((pn - 12) * 256 + bj * 128 + wc * 32 + n * 16 + fq * 4) >> 4; const f32x4 v = acc[ai][bj][m][n];
              u32x2 w = {cvtpk(v[0], v[1]), cvtpk(v[2], v[3])}; *(u32x2*)(dst + (size_t)g * 768 * 768) = w; } }
        else {
          const int b = pm / 17, tt = pm % 17, part = (pn - 14) >> 1; const size_t cb = (size_t)(part * NB + b) * 512 + (pn & 1) * 256; const size_t ld = tt == 0 ? 256 : 4096;
          bf16_t* dstm = PT + (tt == 0 ? (size_t)2 * NB * 512 * 4096 + cb * 256 : cb * 4096 + (size_t)(tt - 1) * 256) + ai * 128 + wr * 64 + m * 16 + fr;
#pragma unroll
          for (int bj = 0; bj < 2; ++bj)
#pragma unroll
            for (int n = 0; n < 2; ++n) { const f32x4 v = acc[ai][bj][m][n]; const unsigned w0 = cvtpk(v[0], v[1]), w1 = cvtpk(v[2], v[3]); bf16_t* d = dstm + (size_t)(bj * 128 + wc * 32 + n * 16 + fq * 4) * ld;
              d[0] = (bf16_t)(w0 & 0xffff); d[ld] = (bf16_t)(w0 >> 16); d[2 * ld] = (bf16_t)(w1 & 0xffff); d[3 * ld] = (bf16_t)(w1 >> 16); } } }
  }
};
__device__ __forceinline__ void phase_gemm_in(const Params& p, const Ctx& c, int l, LAS unsigned char* lds) {
  SchedMN S; S.A = p.ws + OFF_HN; S.B = p.ws + OFF_WIN; S.strA = (size_t)256 * DM * 2; S.strB = (size_t)256 * DM * 2; S.blk = c.blk; S.nblk = c.nblk;
  S.nM = l == 0 ? 68 : 64; S.latonly = l == 0 ? 0 : 1;
  { S.nN = 18; S.pn0 = 0; S.nextra = l == 0 ? 0 : 40;
    EpiIn E; E.PT = (bf16_t*)(p.ws + OFF_Z2 + Z2_CAT); E.Qb = (bf16_t*)(p.ws + OFF_Z1 + Z1_Q); E.Kb = (bf16_t*)(p.ws + OFF_Z1 + Z1_K); E.Vb = (bf16_t*)(p.ws + OFF_Z1 + Z1_V); E.UG = (bf16_t*)(p.ws + OFF_Z2 + Z2_UG);
    E.rc = (const float*)(p.ws + OFF_ROPE); E.rs = E.rc + 64 * 32;
    gm::gemm_phase<true>(lds, DM, DM, DM, S, E); }
}

template <int LAT> struct SchedFour {
  const bf16_t *DM_, *PT; int blk, nblk;
  __device__ __forceinline__ bool next(int i, gm::Unit& u) const { const int it = i * nblk + blk; if (it >= (LAT ? 256 : 16)) return false; u.pm = it; u.pn = 0; return true; }
  __device__ __forceinline__ const char* pA(const gm::Unit& u) const { const int it = u.pm;
    if (LAT) { const int kt = it & 15, part = (it >> 5) & 1; return (const char*)(DM_ + ((size_t)part * 4096 + kt * 256) * 4096); }
    const int part = (it >> 1) & 1; return (const char*)(DM_ + (size_t)part * 256 * 256); }
  __device__ __forceinline__ const char* pB(const gm::Unit& u) const { const int it = u.pm;
    if (LAT) { const int nt_ = (it >> 4) & 1, part = (it >> 5) & 1, b = it >> 6; return (const char*)(PT + ((size_t)(part * NB + b) * 512 + nt_ * 256) * 4096); }
    const int nt_ = it & 1, part = (it >> 1) & 1, b = it >> 2; return (const char*)(PT + (size_t)2 * NB * 512 * 4096 + ((size_t)(part * NB + b) * 512 + nt_ * 256) * 256); }
};
template <int LAT> struct EpiFour {
  float *FC, *FS;
  __device__ __forceinline__ void operator()(const Acc& acc, const gm::Unit& u, int wr, int wc, int fr, int fq) const { const int it = u.pm; int kt, nt_, part, b, toff;
    if (LAT) { kt = it & 15; nt_ = (it >> 4) & 1; part = (it >> 5) & 1; b = it >> 6; toff = CTXL; } else { kt = 0; nt_ = it & 1; part = (it >> 1) & 1; b = it >> 2; toff = 0; }
    float* dst = FC + (size_t)part * TT * 512 + ((size_t)b * TPB + toff + kt * 256) * 512 + nt_ * 256 + wc * 32 + fq * 4;
#pragma unroll
    for (int ai = 0; ai < 2; ++ai)
#pragma unroll
      for (int m = 0; m < 4; ++m) { float* dr = dst + (size_t)(ai * 128 + wr * 64 + m * 16 + fr) * 512;
#pragma unroll
        for (int bj = 0; bj < 2; ++bj)
#pragma unroll
          for (int n = 0; n < 2; ++n) *(f32x4*)(dr + bj * 128 + n * 16) = acc[ai][bj][m][n]; }
  }
};
__device__ __forceinline__ void phase_fourier(const Params& p, const Ctx& c, int l, LAS unsigned char* lds) {
  const bf16_t* PT = (const bf16_t*)(p.ws + OFF_Z2 + Z2_CAT);
  float* FC = (float*)(p.ws + OFF_Z2 + Z2_FC); float* FS = (float*)(p.ws + OFF_Z2 + Z2_FS);
  { const SchedFour<1> S{(const bf16_t*)(p.ws + OFF_DFTL), PT, c.blk, c.nblk}; const EpiFour<1> E{FC, FS}; gm::gemm_phase<true>(lds, 4096, 4096, 4096, S, E); }
  if (l == 0) { const SchedFour<0> S{(const bf16_t*)(p.ws + OFF_DFTC), PT, c.blk, c.nblk}; const EpiFour<0> E{FC, FS}; gm::gemm_phase<true>(lds, 256, 256, 256, S, E); }
}

struct SchedSsmS { const char *UG, *EM; int blk, nblk;
  __device__ __forceinline__ bool next(int i, gm::Unit& u) const { const int it = i * nblk + blk; if (it >= 96) return false; u.pm = it; u.pn = 0; return true; }
  __device__ __forceinline__ const char* pA(const gm::Unit& u) const { const int g = u.pm / 3, pm = u.pm % 3; return UG + ((size_t)g * 768 + pm * 256) * 768 * 2; }
  __device__ __forceinline__ const char* pB(const gm::Unit& u) const { const int g = u.pm / 3; return EM + (size_t)g * 256 * 512 * 2; } };
struct EpiSsmS { float* SB;
  __device__ __forceinline__ void operator()(const Acc& acc, const gm::Unit& u, int wr, int wc, int fr, int fq) const { const int g = u.pm / 3, pm = u.pm % 3;
#pragma unroll
    for (int ai = 0; ai < 2; ++ai)
#pragma unroll
      for (int m = 0; m < 4; ++m) { const int r = pm * 256 + ai * 128 + wr * 64 + m * 16 + fr; if (r >= 544) continue; float* dr = SB + ((size_t)g * 768 + r) * 256 + wc * 32 + fq * 4;
#pragma unroll
        for (int bj = 0; bj < 2; ++bj)
#pragma unroll
          for (int n = 0; n < 2; ++n) *(f32x4*)(dr + bj * 128 + n * 16) = acc[ai][bj][m][n]; }
  } };
__device__ __forceinline__ void phase_ssm_states(const Params& p, const Ctx& c, LAS unsigned char* lds) {
  const SchedSsmS S{p.ws + OFF_Z2 + Z2_UG, p.ws + OFF_EM, c.blk, c.nblk}; const EpiSsmS E{(float*)(p.ws + OFF_Z2 + Z2_SB)};
  gm::gemm_phase<true>(lds, 768, 512, 512, S, E);
}
struct SchedSsmY { const char *UG, *TF; int blk, nblk;
  __device__ __forceinline__ bool next(int i, gm::Unit& u) const { const int it = i * nblk + blk; if (it >= 192) return false; u.pm = it >> 1; u.pn = it & 1; return true; }
  __device__ __forceinline__ const char* pA(const gm::Unit& u) const { const int g = u.pm / 3, pm = u.pm % 3; return UG + ((size_t)g * 768 + pm * 256) * 768 * 2; }
  __device__ __forceinline__ const char* pB(const gm::Unit& u) const { const int g = u.pm / 3; return TF + ((size_t)g * 512 + u.pn * 256) * 768 * 2; } };
struct EpiSsmY { bf16_t* Gg; int last;
  __device__ __forceinline__ void operator()(const Acc& acc, const gm::Unit& u, int wr, int wc, int fr, int fq) const { const int g = u.pm / 3, pm = u.pm % 3;
#pragma unroll
    for (int ai = 0; ai < 2; ++ai)
#pragma unroll
      for (int m = 0; m < 4; ++m) { const int r = pm * 256 + ai * 128 + wr * 64 + m * 16 + fr; if (r >= 544) continue; const int b = r / 136, ch = r % 136; if (last && ch < 8) continue;
        bf16_t* dr = Gg + ((size_t)b * TPB + ch * 32) * 512 + g * 16 + ((fq * 4) & 15);
#pragma unroll
        for (int bj = 0; bj < 2; ++bj)
#pragma unroll
          for (int n = 0; n < 2; ++n) { const int t = (u.pn * 256 + bj * 128 + wc * 32 + n * 16 + fq * 4) >> 4; const f32x4 y = acc[ai][bj][m][n];
            u32x2 w = {cvtpk(gelu_tanh(y[0]), gelu_tanh(y[1])), cvtpk(gelu_tanh(y[2]), gelu_tanh(y[3]))}; *(u32x2*)(dr + (size_t)t * 512) = w; } }
  } };
__device__ __forceinline__ void phase_ssm_y(const Params& p, const Ctx& c, bool last, LAS unsigned char* lds) {
  const SchedSsmY S{p.ws + OFF_Z2 + Z2_UG, p.ws + OFF_TF, c.blk, c.nblk}; const EpiSsmY E{(bf16_t*)(p.ws + OFF_Z2 + Z2_GG), last ? 1 : 0};
  gm::gemm_phase<true>(lds, 768, 768, 768, S, E);
}

struct EpiGlu {
  const bf16_t* Gg; bf16_t* Cat; const float* bg;
  __device__ __forceinline__ void operator()(const Acc& acc, const gm::Unit& u, int wr, int wc, int fr, int fq) const { const int pm = u.pm, pn = u.pn;
#pragma unroll
    for (int ai = 0; ai < 2; ++ai)
#pragma unroll
      for (int m = 0; m < 4; ++m) { const int row = pm * 256 + ai * 128 + wr * 64 + m * 16 + fr;
#pragma unroll
        for (int bj = 0; bj < 2; ++bj)
#pragma unroll
          for (int n = 0; n < 2; ++n) { const int col = pn * 256 + bj * 128 + wc * 32 + n * 16 + fq * 4; const f32x4 z = acc[ai][bj][m][n] + *(const f32x4*)(bg + col);
            const u32x2 gw = *(const u32x2*)(Gg + (size_t)row * 512 + col);
            const float g0 = __uint_as_float(gw[0] << 16), g1 = __uint_as_float(gw[0] & 0xffff0000u), g2 = __uint_as_float(gw[1] << 16), g3 = __uint_as_float(gw[1] & 0xffff0000u);
            u32x2 w = {cvtpk(g0 * sigmoidf_(z[0]), g1 * sigmoidf_(z[1])), cvtpk(g2 * sigmoidf_(z[2]), g3 * sigmoidf_(z[3]))};
            *(u32x2*)(Cat + (size_t)row * DM + 1024 + col) = w; } }
  }
};
__device__ __forceinline__ void phase_glu(const Params& p, const Ctx& c, int l, bool last, LAS unsigned char* lds) {
  SchedMN S; S.A = p.ws + OFF_Z2 + Z2_GG; S.B = p.ws + OFF_WGLU; S.strA = (size_t)256 * 512 * 2; S.strB = (size_t)256 * 512 * 2; S.blk = c.blk; S.nblk = c.nblk;
  S.nM = last ? 64 : 68; S.latonly = last ? 1 : 0; S.nN = 2; S.pn0 = 0; S.nextra = 0;
  EpiGlu E; E.Gg = (const bf16_t*)(p.ws + OFF_Z2 + Z2_GG); E.Cat = (bf16_t*)(p.ws + OFF_Z2 + Z2_CAT); E.bg = p.b_glu + (size_t)l * 512;
  gm::gemm_phase<true>(lds, 512, 512, 512, S, E);
}

struct EpiF32 {
  bf16_t* O;
  __device__ __forceinline__ void operator()(const Acc& acc, const gm::Unit& u, int wr, int wc, int fr, int fq) const {
    bf16_t* dst = O + (size_t)u.pm * 256 * DM + u.pn * 256 + wc * 32 + fq * 4;
#pragma unroll
    for (int ai = 0; ai < 2; ++ai)
#pragma unroll
      for (int m = 0; m < 4; ++m) { bf16_t* dr = dst + (size_t)(ai * 128 + wr * 64 + m * 16 + fr) * DM;
#pragma unroll
        for (int bj = 0; bj < 2; ++bj)
#pragma unroll
          for (int n = 0; n < 2; ++n) { const f32x4 v = acc[ai][bj][m][n]; u32x2 w = {cvtpk(v[0], v[1]), cvtpk(v[2], v[3])}; *(u32x2*)(dr + bj * 128 + n * 16) = w; } }
  }
};
struct SchedSplit { const char *A, *B; size_t strA, strB, kbytes; int nunits, blk, nblk;
  __device__ __forceinline__ bool next(int i, gm::Unit& u) const { const int it = i * nblk + blk; if (it >= nunits) return false; u.pm = it; u.pn = 0; return true; }
  __device__ __forceinline__ const char* pA(const gm::Unit& u) const { const int tile = u.pm & 31, sp = u.pm >> 5; return A + (size_t)((tile >> 3) * 17) * strA + sp * kbytes; }
  __device__ __forceinline__ const char* pB(const gm::Unit& u) const { const int tile = u.pm & 31, sp = u.pm >> 5; return B + (size_t)(tile & 7) * strB + sp * kbytes; } };
struct EpiAcc { bf16_t* SLAB;
  __device__ __forceinline__ void operator()(const Acc& acc, const gm::Unit& u, int wr, int wc, int fr, int fq) const { const int tile = u.pm & 31, sp = u.pm >> 5;
    bf16_t* dst = SLAB + ((size_t)sp * NB * CTXL + (tile >> 3) * 256) * DM + (tile & 7) * 256 + wc * 32 + fq * 4;
#pragma unroll
    for (int ai = 0; ai < 2; ++ai)
#pragma unroll
      for (int m = 0; m < 4; ++m) { bf16_t* dr = dst + (size_t)(ai * 128 + wr * 64 + m * 16 + fr) * DM;
#pragma unroll
        for (int bj = 0; bj < 2; ++bj)
#pragma unroll
          for (int n = 0; n < 2; ++n) { const f32x4 v = acc[ai][bj][m][n]; u32x2 w = {cvtpk(v[0], v[1]), cvtpk(v[2], v[3])}; *(u32x2*)(dr + bj * 128 + n * 16) = w; } }
  } };
template <int KK, int NSPLIT>
__device__ __forceinline__ void phase_gemm_f32out(const Params& p, const Ctx& c, bool last, const char* A, const char* W, char* outp, char* slab, LAS unsigned char* lds) {
  SchedMN S; S.A = A; S.B = W; S.strA = (size_t)256 * KK * 2; S.strB = (size_t)256 * KK * 2; S.blk = c.blk; S.nblk = c.nblk;
  S.nM = 64; S.latonly = 1; S.nN = 8; S.pn0 = 0; S.nextra = 0;
  EpiF32 E; E.O = (bf16_t*)outp;
  gm::gemm_phase<true>(lds, KK, KK, KK, S, E);
  if (!last) { const SchedSplit S2{A, W, (size_t)256 * KK * 2, (size_t)256 * KK * 2, (size_t)(KK / NSPLIT) * 2, 32 * NSPLIT, c.blk, c.nblk}; const EpiAcc E2{(bf16_t*)slab};
    gm::gemm_phase<true>(lds, KK, KK, KK / NSPLIT, S2, E2); }
}

struct EpiGU {
  bf16_t* ACT;
  __device__ __forceinline__ void operator()(const Acc& acc, const gm::Unit& u, int wr, int wc, int fr, int fq) const {
    bf16_t* dst = ACT + (size_t)u.pm * 256 * DFF + u.pn * 128 + wc * 32 + fq * 4;
#pragma unroll
    for (int ai = 0; ai < 2; ++ai)
#pragma unroll
      for (int m = 0; m < 4; ++m) { bf16_t* dr = dst + (size_t)(ai * 128 + wr * 64 + m * 16 + fr) * DFF;
#pragma unroll
        for (int n = 0; n < 2; ++n) { const f32x4 g = acc[ai][0][m][n], uu = acc[ai][1][m][n];
          u32x2 w = {cvtpk(g[0] * sigmoidf_(g[0]) * uu[0], g[1] * sigmoidf_(g[1]) * uu[1]), cvtpk(g[2] * sigmoidf_(g[2]) * uu[2], g[3] * sigmoidf_(g[3]) * uu[3])};
          *(u32x2*)(dr + n * 16) = w; } }
  }
};
__device__ __forceinline__ void phase_gemm_gu(const Params& p, const Ctx& c, bool last, LAS unsigned char* lds) {
  SchedMN S; S.A = p.ws + OFF_HN; S.B = p.ws + OFF_WGU; S.strA = (size_t)256 * DM * 2; S.strB = (size_t)256 * DM * 2; S.blk = c.blk; S.nblk = c.nblk;
  S.nM = last ? 64 : 68; S.latonly = last ? 1 : 0; S.nN = 44; S.pn0 = 0; S.nextra = 0;
  EpiGU E; E.ACT = (bf16_t*)(p.ws + OFF_Z2);
  gm::gemm_phase<true>(lds, DM, DM, DM, S, E);
}

__device__ __forceinline__ void phase_attn(const Params& p, const Ctx& c, int l, char* lds) {
  const bf16_t* Qb = (const bf16_t*)(p.ws + OFF_Z1 + Z1_Q); const bf16_t* Kb = (const bf16_t*)(p.ws + OFF_Z1 + Z1_K); const bf16_t* Vb = (const bf16_t*)(p.ws + OFF_Z1 + Z1_V);
  bf16_t* O = (bf16_t*)(p.ws + OFF_HN);
  const int ntot = (l == 0) ? 512 + 32 : 512;
  for (int v = c.blk; v < ntot; v += c.nblk) {
    int combo, qb, seq;
    if (v < 512) { const int rd = v >> 8, w = v & 255; combo = rd * 16 + (w & 7) * 2 + ((w >> 3) >> 4); qb = 1 + ((w >> 3) & 15); seq = TPB; }
    else { combo = v - 512; qb = 0; seq = CTXL; }
    const int mp = combo & 1, h = (combo >> 1) & 3, b = combo >> 3;
    const size_t r0 = (size_t)b * TPB;
    at::body(Qb + (r0 + qb * 256) * 1024 + (h * 2 + mp) * 128, Kb + r0 * 1024 + (h * 2 + mp) * 128, Vb + r0 * 1024 + h * 256,
             O + (r0 + qb * 256) * DM + (h * 2 + mp) * 256, seq, lds);
  }
}

__device__ __forceinline__ void phase_combine(const Params& p, const Ctx& c, int l, bool last) {
  const bf16_t* O = (const bf16_t*)(p.ws + OFF_HN); bf16_t* Cat = (bf16_t*)(p.ws + OFF_Z2 + Z2_CAT);
  const float* FC = (const float*)(p.ws + OFF_Z2 + Z2_FC); const float* FS = (const float*)(p.ws + OFF_Z2 + Z2_FS);
  const float lam_init = 0.8f - 0.6f * expf(-0.3f * (float)l);
  float lam;
  { const float a1 = p.lam_q1[l * 128 + c.lane] * p.lam_k1[l * 128 + c.lane] + p.lam_q1[l * 128 + 64 + c.lane] * p.lam_k1[l * 128 + 64 + c.lane];
    const float a2 = p.lam_q2[l * 128 + c.lane] * p.lam_k2[l * 128 + c.lane] + p.lam_q2[l * 128 + 64 + c.lane] * p.lam_k2[l * 128 + 64 + c.lane];
    lam = expf(wave_sum(a1)) - expf(wave_sum(a2)) + lam_init; }
  const f32x4 gs = *(const f32x4*)(p.g_subln + (size_t)l * 256 + c.lane * 4);
  for (int row = c.gwave; row < TT; row += c.nwave) { const int t = row % TPB; if (last && t < CTXL) continue;
    const bf16_t* orow = O + (size_t)row * DM; bf16_t* crow_ = Cat + (size_t)row * DM;
#pragma unroll
    for (int h = 0; h < 4; ++h) { const u32x2 a = *(const u32x2*)(orow + (h * 2) * 256 + c.lane * 4), bq = *(const u32x2*)(orow + (h * 2 + 1) * 256 + c.lane * 4);
      f32x4 o; o[0] = __uint_as_float(a[0] << 16) - lam * __uint_as_float(bq[0] << 16); o[1] = __uint_as_float(a[0] & 0xffff0000u) - lam * __uint_as_float(bq[0] & 0xffff0000u);
      o[2] = __uint_as_float(a[1] << 16) - lam * __uint_as_float(bq[1] << 16); o[3] = __uint_as_float(a[1] & 0xffff0000u) - lam * __uint_as_float(bq[1] & 0xffff0000u);
      const float ss = wave_sum(o[0] * o[0] + o[1] * o[1] + o[2] * o[2] + o[3] * o[3]); const float r = rsqrtf(ss * (1.f / 256.f) + 1e-5f) * (1.f - lam_init);
      o = o * r * gs; u32x2 w = {cvtpk(o[0], o[1]), cvtpk(o[2], o[3])}; *(u32x2*)(crow_ + h * 256 + c.lane * 4) = w; }
#pragma unroll
    for (int q = 0; q < 2; ++q) { const int col = q * 256 + c.lane * 4; const size_t o5 = (size_t)row * 512 + col;
      const f32x4 f = *(const f32x4*)(FC + o5) - *(const f32x4*)(FS + o5) + *(const f32x4*)(p.b_four + (size_t)l * 512 + col);
      u32x2 wf = {cvtpk(f[0], f[1]), cvtpk(f[2], f[3])}; *(u32x2*)(crow_ + 1536 + col) = wf; }
  }
}


#define XB_TMO      128
#define XB_XCNT(j)  (256  + 64 * (j))
#define XB_XSUB(j)  (1280 + 64 * (j))
#define XB_XGEN(j)  (2304 + 64 * (j))
#define XB_TOP      3328
#define XB_TOPGEN   3392
#define XCD_BAR_WORDS 3456
#define XB_SPIN_CAP (1u << 18)
__device__ __forceinline__ unsigned xb_ld(unsigned* p)              { return __hip_atomic_load(p, __ATOMIC_RELAXED, __HIP_MEMORY_SCOPE_AGENT); }
__device__ __forceinline__ unsigned xb_add(unsigned* p, unsigned v) { return __hip_atomic_fetch_add(p, v, __ATOMIC_RELAXED, __HIP_MEMORY_SCOPE_AGENT); }
__device__ __forceinline__ unsigned xb_xcc_id() { return (unsigned)__builtin_amdgcn_s_getreg((3 << 11) | 20) & 0xFu; }
#define XB_SPIN(cond, bar) do { unsigned _sp = 0; while (cond) { __builtin_amdgcn_s_sleep(1); \
    if ((++_sp & 255u) == 0u) { if (xb_ld(&(bar)[XB_TMO])) break; if (_sp > XB_SPIN_CAP) { atomicAdd(&(bar)[XB_TMO], 1u); break; } } } } while (0)
struct XcdBarrier { unsigned* bar; unsigned x; volatile LAS unsigned* st; };
__device__ __forceinline__ XcdBarrier xcd_barrier_post(unsigned* bar, volatile LAS unsigned* st) {
  XcdBarrier b; b.bar = bar; b.x = xb_xcc_id(); b.st = st;
  if (threadIdx.x == 0) (void)xb_add(&bar[XB_XCNT(b.x)], 1u);
  return b;
}
__device__ __forceinline__ void xcd_barrier_complete(unsigned* bar, unsigned x, unsigned& nloc, unsigned& nx) {
  const unsigned G = gridDim.x * gridDim.y * gridDim.z;
  unsigned sum, cnt, mine, sp = 0u;
  for (;;) {
    sum = 0u; cnt = 0u; mine = 0u;
#pragma unroll
    for (unsigned j = 0; j < 16; ++j) { const unsigned c = xb_ld(&bar[XB_XCNT(j)]); sum += c; cnt += (c > 0u) ? 1u : 0u; mine = (j == x) ? c : mine; }
    if (sum == G) break;
    __builtin_amdgcn_s_sleep(1);
    if ((++sp & 255u) == 0u) { if (xb_ld(&bar[XB_TMO])) break; if (sp > XB_SPIN_CAP) { atomicAdd(&bar[XB_TMO], 1u); break; } }
  }
  nloc = mine > 0u ? mine : 1u; nx = cnt > 0u ? cnt : 1u;
}
__device__ __forceinline__ void xcd_barrier(const XcdBarrier& b) {
  asm volatile("s_waitcnt vmcnt(0)" ::: "memory");
  __syncthreads();
  if (threadIdx.x == 0) {
    unsigned* bar = b.bar;
    __builtin_amdgcn_s_waitcnt(0);
    unsigned nloc = b.st[0], nx = b.st[1];
    if (nloc == 0u) { xcd_barrier_complete(bar, b.x, nloc, nx); b.st[0] = nloc; b.st[1] = nx; }
    const unsigned old = xb_add(&bar[XB_XSUB(b.x)], 1u);
    const unsigned gen = old / nloc;
    if (old + 1u == (gen + 1u) * nloc) {
      __builtin_amdgcn_fence(__ATOMIC_RELEASE, "agent");
      asm volatile("s_waitcnt vmcnt(0)" ::: "memory");
      const unsigned og = xb_add(&bar[XB_TOP], 1u);
      const unsigned tg = og / nx;
      if (og + 1u == (tg + 1u) * nx) xb_add(&bar[XB_TOPGEN], 1u);
      else XB_SPIN(xb_ld(&bar[XB_TOPGEN]) == tg, bar);
      __builtin_amdgcn_fence(__ATOMIC_ACQUIRE, "agent");
      xb_add(&bar[XB_XGEN(b.x)], 1u);
      asm volatile("s_waitcnt vmcnt(0)" ::: "memory");
    } else {
      XB_SPIN(xb_ld(&bar[XB_XGEN(b.x)]) == gen, bar);
      __builtin_amdgcn_fence(__ATOMIC_ACQUIRE, "agent");
      asm volatile("s_waitcnt vmcnt(0)" ::: "memory");
    }
  }
  __syncthreads();
}

__global__ void __launch_bounds__(NTHREADS) mega(Params p_arg) {
  extern __shared__ __attribute__((aligned(16))) char shm[];
  __shared__ uint4 xb_words;
  cg::grid_group grid = cg::this_grid();
  typedef const __attribute__((address_space(4))) Params* KP;
  KP kp = (KP)__builtin_amdgcn_kernarg_segment_ptr();
  unsigned* bar = (unsigned*)(p_arg.ws + OFF_BAR);
  if (threadIdx.x == 0) xb_words = make_uint4(0u, 0u, 0u, 0u);
  if (p_arg.out == nullptr) grid.sync();
  if (threadIdx.x == 0) (void)xb_add(bar + XB_XCNT(xb_xcc_id()), 1u);
  __syncthreads();
  Ctx c;
#define RECTX() do { asm volatile("" : "+s"(kp)); int t_ = threadIdx.x; asm volatile("" : "+v"(t_)); int b_ = blockIdx.x; asm volatile("" : "+s"(b_)); \
    c.tid = t_; c.wid = t_ >> 6; c.lane = t_ & 63; c.blk = b_; c.nblk = gridDim.x; c.gwave = c.blk * 8 + c.wid; c.nwave = c.nblk * 8; \
    c.gtid = (long)c.blk * NTHREADS + c.tid; c.nthr = (long)c.nblk * NTHREADS; } while (0)
  RECTX();
  LAS unsigned char* gshm = (LAS unsigned char*)shm; float* fl = (float*)shm;

#define PP (*(const Params*)kp)
#define GSYNC() do { RECTX(); XcdBarrier xb_; xb_.bar = (unsigned*)(kp->ws + OFF_BAR); xb_.x = xb_xcc_id(); xb_.st = (volatile LAS unsigned*)&xb_words; xcd_barrier(xb_); } while (0)
  phase0a(PP, c, fl);
  RECTX(); ssm_tables(PP, c);
  RECTX(); convert_weights(PP, c, 0, fl);
  GSYNC();
  RECTX(); reduce_mod(PP, c);
  RECTX(); fold_four(PP, c, 0, fl);
  RECTX(); ssm_build_mef(PP, c, 0);
  GSYNC();
  RECTX(); ssm_build_t(PP, c, 0);
  RECTX(); phase_prenorm(PP, c, 0);
  GSYNC();
  for (int l = 0; l < 2; ++l) {
    const bool last = (l == 1);
    RECTX(); phase_gemm_in(PP, c, l, gshm);
    GSYNC();
    RECTX(); phase_fourier(PP, c, l, gshm);
    RECTX(); phase_ssm_states(PP, c, gshm);
    GSYNC();
    RECTX(); ssm_carry(PP, c, l);
    RECTX(); phase_attn(PP, c, l, shm);
    GSYNC();
    RECTX(); phase_ssm_y(PP, c, last, gshm);
    RECTX(); phase_combine(PP, c, l, last);
    GSYNC();
    RECTX(); phase_glu(PP, c, l, last, gshm);
    GSYNC();
    RECTX(); phase_gemm_f32out<DM, 8>(PP, c, last, kp->ws + OFF_Z2 + Z2_CAT, kp->ws + OFF_WOUT, kp->ws + OFF_Z1, kp->ws + OFF_Z2, gshm);
    GSYNC();
    if (!last) { RECTX(); ssm_build_mef(PP, c, 1); }
    RECTX(); phase_postmix(PP, c, l, last);
    GSYNC();
    RECTX(); phase_gemm_gu(PP, c, last, gshm);
    GSYNC();
    RECTX(); phase_gemm_f32out<DFF, 11>(PP, c, last, kp->ws + OFF_Z2, kp->ws + OFF_WD, kp->ws + OFF_Z1 + (size_t)TT * DM * 2, kp->ws + OFF_Z1, gshm);
    GSYNC();
    if (!last) { RECTX(); ssm_build_t(PP, c, 1); }
    RECTX(); phase_postffn(PP, c, l, last);
    if (!last) { RECTX(); convert_weights(PP, c, 1, fl); RECTX(); fold_four(PP, c, 1, fl); GSYNC(); }
  }
}

extern "C" void kernel_launch(void* const* d_in, const int* in_sizes, int n_in, void* d_out, int out_size, void* d_ws, size_t ws_size,
                              hipStream_t stream) {
  static int grid_blocks = 0;
  if (!grid_blocks) {
    (void)hipFuncSetAttribute((const void*)mega, hipFuncAttributeMaxDynamicSharedMemorySize, SHM_BYTES);
    int dev = 0, cus = 0, per_cu = 0;
    (void)hipGetDevice(&dev);
    (void)hipDeviceGetAttribute(&cus, hipDeviceAttributeMultiprocessorCount, dev);
    (void)hipOccupancyMaxActiveBlocksPerMultiprocessor(&per_cu, mega, NTHREADS, SHM_BYTES);
    if (per_cu < 1) per_cu = 1;
    grid_blocks = cus;
  }
  if (n_in != 32 || ws_size < WS_NEED) { fprintf(stderr, "kernel_launch: bad n_in %d or ws %zu < %zu\n", n_in, ws_size, WS_NEED); return; }
  Params p{};
  const float** f = (const float**)&p;
  for (int i = 0; i < 32; ++i) f[i] = (const float*)d_in[i];
  p.out = (float*)d_out; p.ws = (char*)d_ws;
  (void)hipMemsetAsync((char*)d_ws + OFF_BAR, 0, 16384, stream);
  void* args[] = {&p};
  hipError_t e = hipLaunchCooperativeKernel((void*)mega, dim3(grid_blocks), dim3(NTHREADS), args, SHM_BYTES, stream);
  if (e != hipSuccess) fprintf(stderr, "cooperative launch failed: %s (grid %d)\n", hipGetErrorString(e), grid_blocks);
}
```

```cpp
#include <hip/hip_runtime.h>
#include <hip/hip_cooperative_groups.h>
#include <cstdio>
#include <cstdint>
namespace cg = cooperative_groups;

typedef unsigned short bf16_t;
using bf16x8 = __attribute__((ext_vector_type(8))) short;
using s16x4  = __attribute__((ext_vector_type(4))) short;
using f32x4  = __attribute__((ext_vector_type(4))) float;
using f32x16 = __attribute__((ext_vector_type(16))) float;
using u32x4  = __attribute__((ext_vector_type(4))) unsigned;
using u32x2  = __attribute__((ext_vector_type(2))) unsigned;
#define LAS __attribute__((address_space(3)))

constexpr int NB = 4, SEQ = 4096, CTXL = 256, TPB = SEQ + CTXL  , TT = NB * TPB  ;
constexpr int DM = 2048, NIN = 4608, DFF = 5632, NMODC = 6 * DM  ;
constexpr int NTHREADS = 512, SHM_BYTES = 131072;

constexpr size_t al256(size_t x) { return (x + 255) / 256 * 256; }
constexpr size_t OFF_X    = 0;
constexpr size_t OFF_WIN  = OFF_X + (size_t)TT * DM * 2;
constexpr size_t OFF_WOUT = OFF_WIN + (size_t)NIN * DM * 2;
constexpr size_t OFF_WGU  = OFF_WOUT + (size_t)DM * DM * 2;
constexpr size_t OFF_WD   = OFF_WGU + (size_t)2 * DFF * DM * 2;
constexpr size_t OFF_WGLU = OFF_WD + (size_t)DM * DFF * 2;
constexpr size_t OFF_DFTL = OFF_WGLU + (size_t)512 * 512 * 2;
constexpr size_t OFF_DFTC = OFF_DFTL + (size_t)2 * 4096 * 4096 * 2;
constexpr size_t OFF_MP   = OFF_DFTC + (size_t)2 * 256 * 256 * 2;
constexpr size_t OFF_MOD  = OFF_MP + (size_t)16 * 5 * 24576 * 4;
constexpr size_t OFF_ROPE = OFF_MOD + (size_t)2 * 5 * NMODC * 4;
constexpr size_t OFF_WCS  = OFF_ROPE + (size_t)2 * 64 * 32 * 4;
constexpr size_t OFF_PW   = OFF_WCS + (size_t)2 * 2 * 4 * 128 * 128 * 4;
constexpr size_t OFF_BB   = OFF_PW + (size_t)2 * 32 * 2 * 33 * 64 * 8;
constexpr size_t OFF_MK   = OFF_BB + (size_t)2 * 32 * 2 * 64 * 16 * 8;
constexpr size_t OFF_TF   = OFF_MK + (size_t)2 * 32 * 2 * 32 * 256 * 4;
constexpr size_t OFF_EM   = OFF_TF + (size_t)32 * 512 * 768 * 2;
constexpr size_t OFF_BAR  = OFF_EM + (size_t)32 * 256 * 512 * 2;
constexpr size_t OFF_HN   = OFF_BAR + 16384;
constexpr size_t OFF_Z1   = OFF_HN + (size_t)TT * DM * 2;
constexpr size_t Z1_Q = 0, Z1_K = (size_t)TT * 1024 * 2, Z1_V = 2 * Z1_K;
constexpr size_t OFF_Z2   = OFF_Z1 + (size_t)TT * DM * 4;
constexpr size_t Z2_FC = 0, Z2_FS = Z2_FC + (size_t)TT * 512 * 4;
constexpr size_t Z2_UG = Z2_FS + (size_t)TT * 512 * 4;
constexpr size_t Z2_SB = Z2_UG + (size_t)32 * 768 * 768 * 2;
constexpr size_t Z2_CAT = Z2_SB + (size_t)32 * 768 * 256 * 4;
constexpr size_t Z2_GG = Z2_CAT + (size_t)TT * DM * 2;
constexpr size_t Z2_END = Z2_GG + (size_t)TT * 512 * 2;
constexpr size_t Z2_SIZE = Z2_END > (size_t)TT * DFF * 2 ? Z2_END : (size_t)TT * DFF * 2;
constexpr size_t WS_NEED = OFF_Z2 + Z2_SIZE;
static_assert(WS_NEED <= (size_t)805306368, "workspace over 768 MiB");


struct Params {
  const float *x, *c, *ctx, *c_ctx, *w_mod, *b_mod, *g_mix_pre, *g_mix_post, *g_ffn_pre, *g_ffn_post, *w_in, *w_out;
  const float *lam_q1, *lam_k1, *lam_q2, *lam_k2, *g_subln, *ssm_a_re, *ssm_a_im, *ssm_log_dt, *ssm_b_re, *ssm_b_im;
  const float *ssm_c_re, *ssm_c_im, *ssm_d, *w_glu, *b_glu, *w_four, *b_four, *w_gate, *w_up, *w_down;
  float* out; char* ws;
};

__device__ __forceinline__ unsigned cvtpk(float lo, float hi) { unsigned r; asm volatile("v_cvt_pk_bf16_f32 %0, %1, %2" : "=v"(r) : "v"(lo), "v"(hi)); return r; }
__device__ __forceinline__ float bf2f(unsigned short b) { return __uint_as_float((unsigned)b << 16); }
template <int CTRL> __device__ __forceinline__ float dpp_add(float v) { return v + __uint_as_float(__builtin_amdgcn_update_dpp(0u, __float_as_uint(v), CTRL, 0xf, 0xf, false)); }
__device__ __forceinline__ float wave_sum(float v) {
  v = dpp_add<0xB1>(v); v = dpp_add<0x4E>(v); v = dpp_add<0x141>(v); v = dpp_add<0x140>(v);
  const int vi = (int)__float_as_uint(v);
  return (__uint_as_float((unsigned)__builtin_amdgcn_readlane(vi, 0)) + __uint_as_float((unsigned)__builtin_amdgcn_readlane(vi, 16))) + (__uint_as_float((unsigned)__builtin_amdgcn_readlane(vi, 32)) + __uint_as_float((unsigned)__builtin_amdgcn_readlane(vi, 48)));
}
__device__ __forceinline__ void my_sincos(float x, float& s, float& c) {
  const double xd = (double)x; const double kd = rint(xd * 0.63661977236758134); const double r = xd - kd * 1.5707963267948966;
  const double r2 = r * r;
  const double sn = r * (1.0 - r2 / 6.0 * (1.0 - r2 / 20.0 * (1.0 - r2 / 42.0 * (1.0 - r2 / 72.0 * (1.0 - r2 / 110.0 * (1.0 - r2 / 156.0))))));
  const double cs = 1.0 - r2 / 2.0 * (1.0 - r2 / 12.0 * (1.0 - r2 / 30.0 * (1.0 - r2 / 56.0 * (1.0 - r2 / 90.0 * (1.0 - r2 / 132.0)))));
  const int q = ((int)kd) & 3;
  const double ss = (q == 0) ? sn : (q == 1) ? cs : (q == 2) ? -sn : -cs;
  const double cc = (q == 0) ? cs : (q == 1) ? -sn : (q == 2) ? -cs : sn;
  s = (float)ss; c = (float)cc;
}
__device__ __forceinline__ float sigmoidf_(float x) { return 1.f / (1.f + __expf(-x)); }
__device__ __forceinline__ float gelu_tanh(float y) { const float u = 0.7978845608028654f * (y + 0.044715f * y * y * y); return y * sigmoidf_(2.f * u); }

namespace gm {
constexpr int BM = 256, BK = 64, HALF = 128, HTB = HALF * BK * 2, NXCD = 8, WGM = 8;
__device__ __forceinline__ int lds_byte(int r, int c) { const int st = (r >> 4) * 2 + (c >> 5), rr = r & 15, cc = c & 31, ob = rr * 64 + cc * 2; return st * 1024 + (ob ^ (((ob >> 9) & 1) << 5)); }
__device__ __forceinline__ void stage_rc(int b, int& R, int& C) { const int st = b / 1024, sb = b % 1024, swz = sb ^ (((sb >> 9) & 1) << 5); R = (st >> 1) * 16 + swz / 64; C = (st & 1) * 32 + (swz % 64) / 2; }
__device__ __forceinline__ void tile_of(int wgid, int nM, int nN, int& pm, int& pn) {
  const int nwg = nM * nN; { const int q = nwg / NXCD, r = nwg % NXCD, xcd = wgid % NXCD, off = wgid / NXCD; wgid = (xcd < r ? xcd * (q + 1) : r * (q + 1) + (xcd - r) * q) + off; }
  const int nig = WGM * nN, gid = wgid / nig, fm = gid * WGM, gsz = (nM - fm) < WGM ? (nM - fm) : WGM;
  pm = fm + ((wgid % nig) % gsz); pn = (wgid % nig) / gsz;
}
struct Unit { int pm, pn; };

template <bool SWAP, class Epi, class Sched>
__device__ __forceinline__ void gemm_phase(LAS unsigned char* lds, const int lda, const int ldb, const int K, const Sched& S, const Epi& E) {
  int tid_ = threadIdx.x; asm volatile("" : "+v"(tid_));
  const int tid = tid_, wid = __builtin_amdgcn_readfirstlane(tid >> 6), lane = tid & 63, wr = wid >> 2, wc = wid & 3, fr = lane & 15, fq = lane >> 4;
  const int nt = K / BK;
  unsigned voffA[2], voffB[2];
#pragma unroll
  for (int i = 0; i < 2; ++i) { int R, C; stage_rc(tid * 16 + i * 8192, R, C); voffA[i] = (unsigned)(R * lda + C) * 2u; voffB[i] = (unsigned)(R * ldb + C) * 2u; }
  const size_t kstep = (size_t)(BK * 2), hstepA = (size_t)HALF * lda * 2, hstepB = (size_t)HALF * ldb * 2;
  const unsigned ldsw = (unsigned)wid * 1024u;
  const int aoff = lds_byte(wr * 64 + fr, fq * 8), boff = lds_byte(wc * 32 + fr, fq * 8);
#define PG8_SA(b, h) (((b) * 2 + (h)) * HTB)
#define PG8_SB(b, h) ((4 + (b) * 2 + (h)) * HTB)
#define PG8_STAGE(bufoff, gbase, voff) do { _Pragma("unroll") for (int _i = 0; _i < 2; ++_i) \
    __builtin_amdgcn_global_load_lds((const unsigned*)((const char*)(gbase) + (voff)[_i]), (LAS unsigned*)(lds + (bufoff) + ldsw + _i * 8192), 16, 0, 0); } while (0)
#define PG8_LDA(dst, b, h) do { _Pragma("unroll") for (int m = 0; m < 4; ++m) _Pragma("unroll") for (int k = 0; k < 2; ++k) dst[m][k] = *(const LAS bf16x8*)(lds + PG8_SA(b, h) + aoff + m * 2048 + k * 1024); } while (0)
#define PG8_LDB(dst, b, h) do { _Pragma("unroll") for (int n = 0; n < 2; ++n) _Pragma("unroll") for (int k = 0; k < 2; ++k) dst[n][k] = *(const LAS bf16x8*)(lds + PG8_SB(b, h) + boff + n * 2048 + k * 1024); } while (0)
#define PG8_MMA(ai, bj, At, Bt) do { __builtin_amdgcn_s_setprio(1); _Pragma("unroll") for (int m = 0; m < 4; ++m) _Pragma("unroll") for (int n = 0; n < 2; ++n) _Pragma("unroll") for (int k = 0; k < 2; ++k) \
    acc[ai][bj][m][n] = SWAP ? __builtin_amdgcn_mfma_f32_16x16x32_bf16(Bt[n][k], At[m][k], acc[ai][bj][m][n], 0, 0, 0) \
                             : __builtin_amdgcn_mfma_f32_16x16x32_bf16(At[m][k], Bt[n][k], acc[ai][bj][m][n], 0, 0, 0); __builtin_amdgcn_s_setprio(0); } while (0)
#define PG8_WAIT_V(n) asm volatile("s_waitcnt vmcnt(" #n ")" ::: "memory")
#define PG8_WAIT_L(n) asm volatile("s_waitcnt lgkmcnt(" #n ")" ::: "memory")
#define PG8_BAR __builtin_amdgcn_s_barrier()
#define PG8_SCHED __builtin_amdgcn_sched_barrier(0)
  Unit cur, nxt; int ui = 0;
  if (!S.next(0, cur)) return;
  f32x4 acc[2][2][4][2];
#pragma unroll
  for (int a = 0; a < 2; ++a)
#pragma unroll
    for (int b = 0; b < 2; ++b)
#pragma unroll
      for (int m = 0; m < 4; ++m)
#pragma unroll
        for (int n = 0; n < 2; ++n) acc[a][b][m][n] = (f32x4){0.f, 0.f, 0.f, 0.f};
  bf16x8 At[4][2], B0[2][2], B1[2][2];
  const char* cA = S.pA(cur); const char* cB = S.pB(cur);
  PG8_STAGE(PG8_SB(0, 0), cB, voffB); PG8_STAGE(PG8_SB(0, 1), cB + hstepB, voffB); PG8_STAGE(PG8_SA(0, 0), cA, voffA); PG8_STAGE(PG8_SA(0, 1), cA + hstepA, voffA);
  if (wr == 1) PG8_BAR;
  PG8_WAIT_V(2); PG8_BAR;
  PG8_STAGE(PG8_SB(1, 0), cB + kstep, voffB); PG8_STAGE(PG8_SA(1, 0), cA + kstep, voffA); PG8_STAGE(PG8_SB(1, 1), cB + hstepB + kstep, voffB);
  PG8_WAIT_V(6); PG8_BAR;
  for (;;) {
    const bool has_next = S.next(ui + 1, nxt);
    const char* nA = has_next ? S.pA(nxt) : cA; const char* nB = has_next ? S.pB(nxt) : cB;
    for (int t = 0; t < nt; t += 2) {
      const bool last = (t == nt - 2);
      const char* a1 = cA + (size_t)(t + 1) * kstep;
      const char* a2 = last ? nA : cA + (size_t)(t + 2) * kstep; const char* b2 = last ? nB : cB + (size_t)(t + 2) * kstep;
      const char* a3 = a2 + kstep; const char* b3 = b2 + kstep;
      PG8_LDB(B0, 0, 0); PG8_LDB(B1, 0, 1); PG8_SCHED; PG8_LDA(At, 0, 0); PG8_STAGE(PG8_SA(1, 1), a1 + hstepA, voffA);
      PG8_WAIT_V(8); PG8_WAIT_L(0); PG8_BAR; PG8_MMA(0, 0, At, B0); PG8_MMA(0, 1, At, B1); PG8_BAR; PG8_SCHED;
      PG8_LDA(At, 0, 1); PG8_STAGE(PG8_SB(0, 0), b2, voffB); PG8_STAGE(PG8_SB(0, 1), b2 + hstepB, voffB); PG8_STAGE(PG8_SA(0, 0), a2, voffA);
      PG8_WAIT_V(8); PG8_WAIT_L(0); PG8_BAR; PG8_MMA(1, 0, At, B0); PG8_MMA(1, 1, At, B1); PG8_BAR; PG8_SCHED;
      PG8_LDB(B0, 1, 0); PG8_LDB(B1, 1, 1); PG8_SCHED; PG8_LDA(At, 1, 0); PG8_STAGE(PG8_SA(0, 1), a2 + hstepA, voffA);
      PG8_WAIT_V(8); PG8_WAIT_L(0); PG8_BAR; PG8_MMA(0, 0, At, B0); PG8_MMA(0, 1, At, B1); PG8_BAR; PG8_SCHED;
      PG8_LDA(At, 1, 1); PG8_STAGE(PG8_SB(1, 0), b3, voffB); PG8_STAGE(PG8_SB(1, 1), b3 + hstepB, voffB); PG8_STAGE(PG8_SA(1, 0), a3, voffA);
      PG8_WAIT_V(8); PG8_WAIT_L(0); PG8_BAR; PG8_MMA(1, 0, At, B0); PG8_MMA(1, 1, At, B1); PG8_BAR; PG8_SCHED;
    }
    if (wr == 0) PG8_BAR;
    { int fr2 = fr, fq2 = fq; asm volatile("" : "+v"(fr2), "+v"(fq2));
      E(acc, cur, wr, wc, fr2, fq2); }
    if (!has_next) break;
#pragma unroll
    for (int a = 0; a < 2; ++a)
#pragma unroll
      for (int b = 0; b < 2; ++b)
#pragma unroll
        for (int m = 0; m < 4; ++m)
#pragma unroll
          for (int n = 0; n < 2; ++n) acc[a][b][m][n] = (f32x4){0.f, 0.f, 0.f, 0.f};
    cur = nxt; cA = nA; cB = nB; ++ui;
    if (wr == 1) PG8_BAR;
  }
  PG8_WAIT_V(0);
  PG8_BAR;
#undef PG8_SA
#undef PG8_SB
#undef PG8_STAGE
#undef PG8_LDA
#undef PG8_LDB
#undef PG8_MMA
#undef PG8_WAIT_V
#undef PG8_WAIT_L
#undef PG8_BAR
#undef PG8_SCHED
}
}

namespace at {
constexpr int D = 128, NW = 8, QBLK = 32, KVBLK = 64;
constexpr float SCALE = 0.088388347648318440f;
constexpr float THR = 8.f;
constexpr int LDQ = 1024, LDK = 1024, LDV = 1024, LDO = 2048;
constexpr size_t SHM_V = KVBLK * D * 2, SHM_K = KVBLK * D * 2;
#define KSWZ(row, colB) ((row) * 256 + ((colB) ^ (((row) & 7) << 4)))
#define SBAR() __builtin_amdgcn_sched_barrier(0)
__device__ __forceinline__ int crow(int r, int hi) { return (r & 3) + 8 * (r >> 2) + 4 * hi; }
__device__ __forceinline__ void partialSM(f32x16& p0, f32x16& p1, float& m_reg, float& mn, float& alpha) {
  constexpr float C = SCALE * 1.4426950408889634f;
  float pmax = p0[0];
#pragma unroll
  for (int r = 1; r < 16; ++r) pmax = fmaxf(pmax, p0[r]);
#pragma unroll
  for (int r = 0; r < 16; ++r) pmax = fmaxf(pmax, p1[r]);
  { auto rr = __builtin_amdgcn_permlane32_swap(__float_as_uint(pmax), __float_as_uint(pmax), false, false);
    pmax = fmaxf(__uint_as_float(rr[0]), __uint_as_float(rr[1])); }
  if (__builtin_expect(__all(pmax - m_reg <= THR / SCALE), 1)) { mn = m_reg; alpha = 1.f; }
  else { mn = fmaxf(m_reg, pmax); alpha = __builtin_amdgcn_exp2f((m_reg - mn) * C); m_reg = mn; }
  float mnC = -mn * C;
#pragma unroll
  for (int r = 0; r < 16; ++r) p0[r] = fmaf(p0[r], C, mnC);
#pragma unroll
  for (int r = 0; r < 16; ++r) p1[r] = fmaf(p1[r], C, mnC);
#pragma unroll
  for (int r = 0; r < 16; ++r) p0[r] = __builtin_amdgcn_exp2f(p0[r]);
}
__device__ __forceinline__ void finishSM(f32x16& p0, f32x16& p1, float alpha, float& l_reg, bf16x8& pa0, bf16x8& pa1, bf16x8& pa2, bf16x8& pa3) {
#pragma unroll
  for (int r = 0; r < 16; ++r) p1[r] = __builtin_amdgcn_exp2f(p1[r]);
  float ps = 0;
#pragma unroll
  for (int r = 0; r < 16; ++r) ps += p0[r];
#pragma unroll
  for (int r = 0; r < 16; ++r) ps += p1[r];
  { auto rr = __builtin_amdgcn_permlane32_swap(__float_as_uint(ps), __float_as_uint(ps), false, false);
    ps = __uint_as_float(rr[0]) + __uint_as_float(rr[1]); }
  l_reg = l_reg * alpha + ps;
#define PK4(P, BASE, OUT) do { unsigned a0 = cvtpk(P[BASE + 0], P[BASE + 1]), a1 = cvtpk(P[BASE + 2], P[BASE + 3]);   \
    unsigned b0 = cvtpk(P[BASE + 4], P[BASE + 5]), b1 = cvtpk(P[BASE + 6], P[BASE + 7]);                              \
    auto r0 = __builtin_amdgcn_permlane32_swap(a0, b0, false, false); auto r1 = __builtin_amdgcn_permlane32_swap(a1, b1, false, false); \
    u32x4 w = {r0[0], r1[0], r0[1], r1[1]}; OUT = *reinterpret_cast<bf16x8*>(&w); } while (0)
  PK4(p0, 0, pa0); PK4(p0, 8, pa1); PK4(p1, 0, pa2); PK4(p1, 8, pa3);
#undef PK4
}
__device__ __forceinline__ void qkt(f32x16& p0, f32x16& p1, const char* Ks, const bf16x8* qr, int r32, int hi) {
  p0 = f32x16{}; p1 = f32x16{};
#pragma unroll
  for (int d0 = 0; d0 < 8; ++d0) { int cb = (d0 * 16 + hi * 8) * 2;
    bf16x8 b0 = *reinterpret_cast<const bf16x8*>(Ks + KSWZ(r32, cb));
    bf16x8 b1 = *reinterpret_cast<const bf16x8*>(Ks + KSWZ(32 + r32, cb));
    p0 = __builtin_amdgcn_mfma_f32_32x32x16_bf16(b0, qr[d0], p0, 0, 0, 0);
    p1 = __builtin_amdgcn_mfma_f32_32x32x16_bf16(b1, qr[d0], p1, 0, 0, 0); }
}
__device__ __forceinline__ int v_st(int k, int c) { const int kk = (k & ~0xC) | ((k & 4) << 1) | ((k & 8) >> 1); return ((kk >> 3) * 8 + (c >> 5)) * 512 + ((kk & 7) * 32 + (c & 31)) * 2; }
__device__ __forceinline__ int v_rd_base(int lane) { return ((lane & 3) << 3) | (((lane >> 2) & 3) << 6) | (((lane >> 4) & 1) << 5) | (((lane >> 5) & 1) << 8); }
constexpr int v_rd_off(int d0, int ks, int half) { return d0 * 512 + ks * 8192 + half * 4096; }
template <int OFF> __device__ __forceinline__ s16x4 tr_read(int vb) {
  s16x4 r; asm volatile("ds_read_b64_tr_b16 %0, %1 offset:%2" : "=&v"(r) : "v"(vb), "i"(OFF) : "memory"); return r;
}
template <int D0> __device__ __forceinline__ void pv_one(f32x16& od, int vb, bf16x8 pa0, bf16x8 pa1, bf16x8 pa2, bf16x8 pa3) {
  const s16x4 l0 = tr_read<v_rd_off(D0, 0, 0)>(vb), h0 = tr_read<v_rd_off(D0, 0, 1)>(vb), l1 = tr_read<v_rd_off(D0, 1, 0)>(vb), h1 = tr_read<v_rd_off(D0, 1, 1)>(vb);
  const s16x4 l2 = tr_read<v_rd_off(D0, 2, 0)>(vb), h2 = tr_read<v_rd_off(D0, 2, 1)>(vb), l3 = tr_read<v_rd_off(D0, 3, 0)>(vb), h3 = tr_read<v_rd_off(D0, 3, 1)>(vb);
  asm volatile("s_waitcnt lgkmcnt(0)" ::: "memory"); SBAR();
#define PK(L, H) (bf16x8){L[0], L[1], L[2], L[3], H[0], H[1], H[2], H[3]}
  od = __builtin_amdgcn_mfma_f32_32x32x16_bf16(pa0, PK(l0, h0), od, 0, 0, 0);
  od = __builtin_amdgcn_mfma_f32_32x32x16_bf16(pa1, PK(l1, h1), od, 0, 0, 0);
  od = __builtin_amdgcn_mfma_f32_32x32x16_bf16(pa2, PK(l2, h2), od, 0, 0, 0);
  od = __builtin_amdgcn_mfma_f32_32x32x16_bf16(pa3, PK(l3, h3), od, 0, 0, 0);
#undef PK
}
__device__ __forceinline__ void body(const bf16_t* __restrict__ Qb, const bf16_t* __restrict__ Kh, const bf16_t* __restrict__ Vh, bf16_t* __restrict__ Ob, int seq, char* lds) {
  int tid_ = threadIdx.x; asm volatile("" : "+v"(tid_));
  const int tid = tid_, wid = tid >> 6, lane = tid & 63, r32 = lane & 31, hi = lane >> 5;
  constexpr int SV = 64 * 256 * 2, SK = 64 * 128 * 2;
  char* V_lds = lds; char* K_lds = lds + 2 * SV;
  float* ws = (float*)(lds + 2 * SV + 2 * SK) + wid * 64; float* li_l = ws; float* al_l = ws + 32;
  float m_reg = -1e30f, l_reg = 0; f32x16 o[8] = {}; bf16x8 qr[8];
  const bf16_t* Qw = Qb + (long)(wid * QBLK + r32) * LDQ + hi * 8;
#pragma unroll
  for (int d0 = 0; d0 < 8; ++d0) qr[d0] = *reinterpret_cast<const bf16x8*>(Qw + d0 * 16);
  const int wu = __builtin_amdgcn_readfirstlane(wid);
  int koff[2], voff[4];
#pragma unroll
  for (int q = 0; q < 2; ++q) { const int row = 4 * (wu * 2 + q) + (lane >> 4); koff[q] = row * LDK + ((((lane & 15) << 4) ^ ((row & 7) << 4)) >> 1); }
#pragma unroll
  for (int q = 0; q < 4; ++q) { const int s = 2 * (wu * 4 + q) + (lane >> 5), kk = (s >> 3) * 8 + ((lane & 31) >> 2), k = (kk & ~0xC) | ((kk & 4) << 1) | ((kk & 8) >> 1);
    voff[q] = k * LDV + (s & 7) * 32 + (lane & 3) * 8; }
  const int vb0 = (int)(uintptr_t)(LAS char*)V_lds + v_rd_base(lane);
  LAS char* Vl = (LAS char*)V_lds; LAS char* Kl = (LAS char*)K_lds;
#define STAGE(b, k0) do { const bf16_t* kg = Kh + (long)(k0) * LDK; const bf16_t* vg = Vh + (long)(k0) * LDV; \
    _Pragma("unroll") for (int q = 0; q < 2; ++q) __builtin_amdgcn_global_load_lds((const unsigned*)(kg + koff[q]), (LAS unsigned*)(Kl + (b) * SK + (wu * 2 + q) * 1024), 16, 0, 0); \
    _Pragma("unroll") for (int q = 0; q < 4; ++q) __builtin_amdgcn_global_load_lds((const unsigned*)(vg + voff[q]), (LAS unsigned*)(Vl + (b) * SV + (wu * 4 + q) * 1024), 16, 0, 0); } while (0)
  const int NT = seq / KVBLK;
  STAGE(0, 0);
  asm volatile("s_waitcnt vmcnt(0) lgkmcnt(0)" ::: "memory"); __builtin_amdgcn_s_barrier(); asm volatile("" ::: "memory");
  for (int j = 0; j < NT; ++j) {
    const int b = j & 1;
    f32x16 p0, p1; float mn, al; bf16x8 pa0, pa1, pa2, pa3;
    if (j + 1 < NT) STAGE(b ^ 1, (j + 1) * KVBLK);
    SBAR(); qkt(p0, p1, K_lds + b * SK, qr, r32, hi);
    partialSM(p0, p1, m_reg, mn, al);
    if (__any(al < 1.f)) { if (hi == 0) al_l[r32] = al; asm volatile("s_waitcnt lgkmcnt(0)" ::: "memory");
#pragma unroll
      for (int d = 0; d < 8; ++d)
#pragma unroll
        for (int r = 0; r < 16; ++r) o[d][r] *= al_l[crow(r, hi)]; }
    finishSM(p0, p1, al, l_reg, pa0, pa1, pa2, pa3); SBAR();
    const int vb = vb0 + b * SV;
    pv_one<0>(o[0], vb, pa0, pa1, pa2, pa3); pv_one<1>(o[1], vb, pa0, pa1, pa2, pa3); pv_one<2>(o[2], vb, pa0, pa1, pa2, pa3); pv_one<3>(o[3], vb, pa0, pa1, pa2, pa3);
    pv_one<4>(o[4], vb, pa0, pa1, pa2, pa3); pv_one<5>(o[5], vb, pa0, pa1, pa2, pa3); pv_one<6>(o[6], vb, pa0, pa1, pa2, pa3); pv_one<7>(o[7], vb, pa0, pa1, pa2, pa3);
    asm volatile("s_waitcnt vmcnt(0) lgkmcnt(0)" ::: "memory"); __builtin_amdgcn_s_barrier(); asm volatile("" ::: "memory");
  }
  if (hi == 0) li_l[r32] = l_reg; asm volatile("s_waitcnt lgkmcnt(0)" ::: "memory");
  float rli[16];
#pragma unroll
  for (int r = 0; r < 16; ++r) rli[r] = __builtin_amdgcn_rcpf(li_l[crow(r, hi)]);
  bf16_t* Ow = Ob + (long)(wid * QBLK) * LDO;
#pragma unroll
  for (int r = 0; r < 16; ++r) { int orow = crow(r, hi);
#pragma unroll
    for (int d0 = 0; d0 < 8; ++d0) Ow[(long)orow * LDO + d0 * 32 + r32] = (bf16_t)(cvtpk(o[d0][r] * rli[r], 0.f) & 0xffff); }
#undef STAGE
  __syncthreads();
}
}

struct Ctx {
  int tid, wid, lane, blk, nblk, gwave, nwave; long gtid, nthr;
};

__device__ __forceinline__ const float* modp(const Params& p, int l, int v, int j) { return (const float*)(p.ws + OFF_MOD) + ((size_t)(l * 5 + v) * NMODC + (size_t)j * DM); }

__device__ __forceinline__ void convert_weights(const Params& p, const Ctx& c, int l, float* lds) {
  constexpr int T0 = 14 * 32, T1 = 8 * 32, T2 = 44 * 32, T3 = 8 * 88, T4 = 2 * 8, TALL = T0 + T1 + T2 + T3 + T4;
  for (int it = c.blk; it < TALL; it += c.nblk) {
    int mat, ti = it;
    if (ti < T0) mat = 0; else if ((ti -= T0) < T1) mat = 1; else if ((ti -= T1) < T2) mat = 2; else if ((ti -= T2) < T3) mat = 3; else { ti -= T3; mat = 4; }
    const float* src; long ld; bf16_t* dst; long dld; int nkt;
    if (mat == 0) { src = p.w_in + (size_t)l * DM * 4096; ld = 4096; dst = (bf16_t*)(p.ws + OFF_WIN); dld = DM; nkt = 32; }
    else if (mat == 1) { src = p.w_out + (size_t)l * DM * DM; ld = DM; dst = (bf16_t*)(p.ws + OFF_WOUT); dld = DM; nkt = 32; }
    else if (mat == 2) { src = p.w_gate + (size_t)l * DM * DFF; ld = DFF; dst = (bf16_t*)(p.ws + OFF_WGU); dld = DM; nkt = 32; }
    else if (mat == 3) { src = p.w_down + (size_t)l * DFF * DM; ld = DM; dst = (bf16_t*)(p.ws + OFF_WD); dld = DFF; nkt = 88; }
    else { src = p.w_glu + (size_t)l * 512 * 512; ld = 512; dst = (bf16_t*)(p.ws + OFF_WGLU); dld = 512; nkt = 8; }
    const int n0 = (ti / nkt) * 256, k0 = (ti % nkt) * 64;
    {
      const int nn = c.tid & 255, kk0 = c.tid >> 8, np = n0 + nn; int scol = np;
      if (mat == 0) { if (np < 2048) scol = (np & ~0x30) | ((np & 16) << 1) | ((np & 32) >> 1); }
      else if (mat == 2) { const int pn = np >> 8, bj = (np >> 7) & 1; scol = pn * 128 + (np & 127); if (bj) src = p.w_up + (size_t)l * DM * DFF; }
      const float* sp = src + (size_t)(k0 + kk0) * ld + scol; float v[32];
#pragma unroll
      for (int i = 0; i < 32; ++i) v[i] = sp[(size_t)(2 * i) * ld];
#pragma unroll
      for (int i = 0; i < 32; ++i) lds[(kk0 + 2 * i) * 257 + nn] = v[i];
    }
    __syncthreads();
    {
      const int kc = (c.tid & 7) * 8;
#pragma unroll
      for (int j = 0; j < 4; ++j) { const int nn = (c.tid >> 3) + 64 * j; float v[8];
#pragma unroll
        for (int i = 0; i < 8; ++i) v[i] = lds[(kc + i) * 257 + nn];
        u32x4 w = {cvtpk(v[0], v[1]), cvtpk(v[2], v[3]), cvtpk(v[4], v[5]), cvtpk(v[6], v[7])};
        *(u32x4*)(dst + (size_t)(n0 + nn) * dld + k0 + kc) = w; }
    }
    __syncthreads();
  }
}

__device__ __forceinline__ void fold_four(const Params& p, const Ctx& c, int l, float* lds) {
  float* WlT = lds;
  float* Wc = lds + 128 * 68;
  const float* wcs = (const float*)(p.ws + OFF_WCS) + (size_t)l * 2 * 4 * 128 * 128;
  bf16_t* dstb = (bf16_t*)(p.ws + OFF_WIN);
  for (int u = c.blk; u < 256; u += c.nblk) {
    const int kt = u & 31, cs = (u >> 5) & 1, g = u >> 6, k0 = kt * 64;
    const float* src = p.w_in + (size_t)l * DM * 4096 + 3584 + g * 128;
    for (int i = c.tid; i < 64 * 128; i += NTHREADS) { const int kk = i >> 7, cc = i & 127; WlT[cc * 68 + kk] = src[(size_t)(k0 + kk) * 4096 + cc]; }
    const float* wsrc = wcs + (size_t)(cs * 4 + g) * 128 * 128;
    for (int i = c.tid; i < 128 * 128; i += NTHREADS) Wc[i] = wsrc[i];
    __syncthreads();
    const int kq = c.tid & 15, dq = c.tid >> 4;
    f32x4 acc[4] = {};
    for (int cc = 0; cc < 128; ++cc) {
      const f32x4 a = *(const f32x4*)(WlT + cc * 68 + kq * 4), w = *(const f32x4*)(Wc + cc * 128 + dq * 4);
#pragma unroll
      for (int di = 0; di < 4; ++di) acc[di] += a * w[di];
    }
#pragma unroll
    for (int di = 0; di < 4; ++di) { u32x2 o = {cvtpk(acc[di][0], acc[di][1]), cvtpk(acc[di][2], acc[di][3])};
      *(u32x2*)(dstb + (size_t)(3584 + cs * 512 + g * 128 + dq * 4 + di) * DM + k0 + kq * 4) = o; }
    __syncthreads();
  }
}


__device__ __forceinline__ void ssm_tables(const Params& p, const Ctx& c) {
  float2* PW = (float2*)(p.ws + OFF_PW); float2* BB = (float2*)(p.ws + OFF_BB);
  for (long i = c.gtid; i < 2L * 32 * 2 * 64; i += c.nthr) { const int pp = (int)(i & 63), idx = (int)(i >> 6);
    const int d = idx & 1, g = (idx >> 1) & 31, l = idx >> 6, iidx = (l * 2 + d) * 32 + g;
    const float lre = p.ssm_a_re[iidx * 64 + pp], lim = p.ssm_a_im[iidx * 64 + pp], dt = expf(p.ssm_log_dt[iidx]);
    float ar = 1.f, ai = 0.f;
    for (int j = 0; j <= 32; ++j) { const float mag = expf(lre * dt * (float)j); float sn, cs; my_sincos(lim * dt * (float)j, sn, cs);
      PW[((size_t)idx * 33 + j) * 64 + pp] = make_float2(mag * cs, mag * sn); if (j == 1) { ar = mag * cs; ai = mag * sn; } }
    const float nr = ar - 1.f, ni = ai, den = 1.f / (lre * lre + lim * lim), cr = (nr * lre + ni * lim) * den, ci = (ni * lre - nr * lim) * den;
    const float* br = p.ssm_b_re + ((size_t)iidx * 64 + pp) * 16; const float* bi = p.ssm_b_im + ((size_t)iidx * 64 + pp) * 16;
    for (int h = 0; h < 16; ++h) BB[((size_t)idx * 64 + pp) * 16 + h] = make_float2(cr * br[h] - ci * bi[h], cr * bi[h] + ci * br[h]); }
}
__device__ __forceinline__ void ssm_build_mef(const Params& p, const Ctx& c, int l) {
  const float2* PW = (const float2*)(p.ws + OFF_PW) + (size_t)l * 32 * 2 * 33 * 64; const float2* BB = (const float2*)(p.ws + OFF_BB) + (size_t)l * 32 * 2 * 64 * 16;
  float* MK = (float*)(p.ws + OFF_MK) + (size_t)l * 32 * 2 * 32 * 256; bf16_t* EM = (bf16_t*)(p.ws + OFF_EM); bf16_t* TF = (bf16_t*)(p.ws + OFF_TF);
  for (long i = c.gtid; i < 32L * 2 * 32 * 256; i += c.nthr) { const int hp = (int)(i & 15), h = (int)((i >> 4) & 15), j = (int)((i >> 8) & 31), gd = (int)(i >> 13), d = gd & 1, g = gd >> 1;
    const size_t ci = ((size_t)((l * 2 + d) * 32 + g) * 16 + h) * 64; const float2* pw = PW + ((size_t)gd * 33 + j) * 64; const float2* bb = BB + (size_t)gd * 64 * 16 + hp; float a = 0.f;
    for (int pp = 0; pp < 64; ++pp) { const float cr = p.ssm_c_re[ci + pp], cim = p.ssm_c_im[ci + pp]; const float2 b = bb[pp * 16], w = pw[pp];
      const float wr = cr * b.x - cim * b.y, wi = cr * b.y + cim * b.x; a += wr * w.x - wi * w.y; }
    MK[i] = a; }
  for (long i = c.gtid; i < 32L * 256 * 32 * 2; i += c.nthr) { const int hh = (int)(i & 1), s = (int)((i >> 1) & 31), n = (int)((i >> 6) & 255), g = (int)(i >> 14), ri = n & 1, pp = (n >> 1) & 63, d = n >> 7;
    const int gd = g * 2 + d, e = d ? s : 31 - s; const float2 w = PW[((size_t)gd * 33 + e) * 64 + pp]; const float2* bb = BB + ((size_t)gd * 64 + pp) * 16 + hh * 8; float v[8];
#pragma unroll
    for (int k = 0; k < 8; ++k) { const float2 b = bb[k]; v[k] = ri ? (w.x * b.y + w.y * b.x) : (w.x * b.x - w.y * b.y); }
    u32x4 o = {cvtpk(v[0], v[1]), cvtpk(v[2], v[3]), cvtpk(v[4], v[5]), cvtpk(v[6], v[7])}; *(u32x4*)(EM + ((size_t)g * 256 + n) * 512 + s * 16 + hh * 8) = o; }
  for (long i = c.gtid; i < 32L * 512 * 2 * 16; i += c.nthr) { const int pq = (int)(i & 15), d = (int)((i >> 4) & 1), n = (int)((i >> 5) & 511), g = (int)(i >> 14), h = n & 15, t = n >> 4;
    const int gd = g * 2 + d, f = d ? 32 - t : t + 1; const size_t ci = ((size_t)((l * 2 + d) * 32 + g) * 16 + h) * 64 + pq * 4; const float2* pw = PW + ((size_t)gd * 33 + f) * 64 + pq * 4; float v[8];
#pragma unroll
    for (int k = 0; k < 4; ++k) { const float cr = p.ssm_c_re[ci + k], cim = p.ssm_c_im[ci + k]; const float2 w = pw[k]; v[2 * k] = cr * w.x - cim * w.y; v[2 * k + 1] = -(cr * w.y + cim * w.x); }
    u32x4 o = {cvtpk(v[0], v[1]), cvtpk(v[2], v[3]), cvtpk(v[4], v[5]), cvtpk(v[6], v[7])}; *(u32x4*)(TF + ((size_t)g * 512 + n) * 768 + 512 + d * 128 + pq * 8) = o; }
}
__device__ __forceinline__ void ssm_build_t(const Params& p, const Ctx& c, int l) {
  const float* MK = (const float*)(p.ws + OFF_MK) + (size_t)l * 32 * 2 * 32 * 256; bf16_t* TF = (bf16_t*)(p.ws + OFF_TF);
  for (long i = c.gtid; i < 32L * 512 * 32 * 2; i += c.nthr) { const int hh = (int)(i & 1), s = (int)((i >> 1) & 31), n = (int)((i >> 6) & 511), g = (int)(i >> 15), h = n & 15, t = n >> 4;
    const int lag = t - s; float v[8];
    if (lag != 0) { const float* m = MK + ((size_t)((g * 2 + (lag < 0 ? 1 : 0)) * 32 + (lag < 0 ? -lag : lag)) * 16 + h) * 16 + hh * 8;
#pragma unroll
      for (int k = 0; k < 8; ++k) v[k] = m[k]; }
    else { const float* m0 = MK + ((size_t)((g * 2) * 32) * 16 + h) * 16 + hh * 8; const float* m1 = MK + ((size_t)((g * 2 + 1) * 32) * 16 + h) * 16 + hh * 8; const float dsk = p.ssm_d[(size_t)l * 512 + g * 16 + h];
#pragma unroll
      for (int k = 0; k < 8; ++k) v[k] = m0[k] + m1[k] + ((hh * 8 + k) == h ? dsk : 0.f); }
    u32x4 o = {cvtpk(v[0], v[1]), cvtpk(v[2], v[3]), cvtpk(v[4], v[5]), cvtpk(v[6], v[7])}; *(u32x4*)(TF + ((size_t)g * 512 + n) * 768 + s * 16 + hh * 8) = o; }
}
__device__ __forceinline__ void ssm_carry(const Params& p, const Ctx& c, int l) {
  if (c.wid != 0) return;
  const float2* PW = (const float2*)(p.ws + OFF_PW) + (size_t)l * 32 * 2 * 33 * 64; const float* SB = (const float*)(p.ws + OFF_Z2 + Z2_SB); bf16_t* UG = (bf16_t*)(p.ws + OFF_Z2 + Z2_UG);
  for (int i = c.blk * 64 + c.lane; i < NB * 32 * 2 * 64; i += c.nblk * 64) { const int pp = i & 63, d = (i >> 6) & 1, g = (i >> 7) & 31, b = i >> 12;
    const float2 a32 = PW[((size_t)(g * 2 + d) * 33 + 32) * 64 + pp]; float hr = 0.f, hi = 0.f;
    const size_t rbase = (size_t)g * 768 + b * 136; const int col = (d * 64 + pp) * 2;
#pragma unroll 8
    for (int k = 0; k < 136; ++k) { const int ch = d == 0 ? k : (k < 8 ? 7 - k : 143 - k);
      const float2 s = *(const float2*)(SB + (rbase + ch) * 256 + col);
      *(unsigned*)(UG + (rbase + ch) * 768 + 512 + col) = cvtpk(hr, hi);
      const float nr = a32.x * hr - a32.y * hi + s.x, ni = a32.x * hi + a32.y * hr + s.y; hr = nr; hi = ni; } }
}

__device__ __forceinline__ void phase0a(const Params& p, const Ctx& c, float* lds) {
  for (int i = c.tid; i < 5 * DM; i += NTHREADS) { const float v = i < 4 * DM ? p.c[i] : p.c_ctx[i - 4 * DM]; lds[i] = v * sigmoidf_(v); }
  __syncthreads();
  {
    float* MP = (float*)(p.ws + OFF_MP);
    for (long it = c.gtid; it < 16 * 6144; it += c.nthr) {
      const int cq = (int)(it % 6144), ks = (int)(it / 6144); const int gc = cq * 4, l = gc / NMODC, col = gc % NMODC;
      const float* wp = p.w_mod + ((size_t)l * DM + (size_t)ks * 128) * NMODC + col;
      f32x4 a[5] = {};
#pragma unroll 8
      for (int k = 0; k < 128; ++k) { const f32x4 w = *(const f32x4*)(wp + (size_t)k * NMODC);
#pragma unroll
        for (int v = 0; v < 5; ++v) a[v] += w * lds[v * DM + ks * 128 + k]; }
#pragma unroll
      for (int v = 0; v < 5; ++v) *(f32x4*)(MP + ((size_t)ks * 5 + v) * 24576 + gc) = a[v];
    }
  }
  __syncthreads();
  {
    float* rc = (float*)(p.ws + OFF_ROPE); float* rs = rc + 64 * 32;
    for (long i = c.gtid; i < 64 * 32; i += c.nthr) { const int pos = (int)(i >> 5), pp = (int)(i & 31);
      const float inv = (float)exp2(-(double)pp / 32.0 * 13.287712379549449); float s, cc; my_sincos((float)pos * inv, s, cc); rc[i] = cc; rs[i] = s; }
  }
  {
    bf16_t* DB = (bf16_t*)(p.ws + OFF_DFTC);
    for (long i = c.gtid; i < 256L * 64; i += c.nthr) { const int k = (int)(i >> 6), c0 = (int)(i & 63) * 8, part = c0 >> 8, t0 = c0 & 255; float v[8];
#pragma unroll
      for (int j = 0; j < 8; ++j) { const float ph = (float)((k * (t0 + j)) & 255) * (1.f / 256.f); v[j] = (part ? __builtin_amdgcn_sinf(ph) : __builtin_amdgcn_cosf(ph)) * (1.f / 16.f); }
      u32x4 w = {cvtpk(v[0], v[1]), cvtpk(v[2], v[3]), cvtpk(v[4], v[5]), cvtpk(v[6], v[7])}; *(u32x4*)(DB + i * 8) = w; }
  }
  {
    float* W = (float*)(p.ws + OFF_WCS);
    for (long i = c.gtid; i < 2L * 2 * 4 * 128 * 128; i += c.nthr) { const int d = (int)(i & 127), cc = (int)((i >> 7) & 127), g = (int)((i >> 14) & 3), cs = (int)((i >> 16) & 1), l = (int)(i >> 17);
      const float* wf = p.w_four + ((size_t)(l * 4 + g) * 128) * 128 + d; float a = 0.f;
      for (int j = 0; j < 128; ++j) { const float ph = (float)((j * cc) & 127) * (1.f / 128.f); a += (cs ? __builtin_amdgcn_sinf(ph) : __builtin_amdgcn_cosf(ph)) * wf[(size_t)j * 128]; }
      W[i] = a * 0.08838834764831845f; }
  }
}

__device__ __forceinline__ void reduce_mod(const Params& p, const Ctx& c) {
  const float* MP = (const float*)(p.ws + OFF_MP); float* MOD = (float*)(p.ws + OFF_MOD);
  for (long o = c.gtid; o < 5L * 24576; o += c.nthr) { const int v = (int)(o / 24576), gc = (int)(o % 24576), l = gc / NMODC, col = gc % NMODC;
    float a = p.b_mod[gc];
#pragma unroll
    for (int ks = 0; ks < 16; ++ks) a += MP[((size_t)ks * 5 + v) * 24576 + gc];
    MOD[(size_t)(l * 5 + v) * NMODC + col] = a; }
}

__device__ __forceinline__ void prenorm_row(const f32x4 (&x)[8], float rinv, const float* g, const float* sc, const float* sh, bf16_t* dst, int lane) {
#pragma unroll
  for (int i = 0; i < 8; ++i) { const int col = (lane + 64 * i) * 4; const f32x4 gg = *(const f32x4*)(g + col), s1 = *(const f32x4*)(sc + col), s0 = *(const f32x4*)(sh + col);
    const f32x4 y = (x[i] * rinv * gg) * (s1 + 1.f) + s0; u32x2 o = {cvtpk(y[0], y[1]), cvtpk(y[2], y[3])}; *(u32x2*)(dst + col) = o; }
}
__device__ __forceinline__ float sumsq8(const f32x4 (&x)[8]) { float s = 0.f;
#pragma unroll
  for (int i = 0; i < 8; ++i) s += x[i][0] * x[i][0] + x[i][1] * x[i][1] + x[i][2] * x[i][2] + x[i][3] * x[i][3];
  return wave_sum(s); }

typedef _Float16 h16x4 __attribute__((ext_vector_type(4)));
__device__ __forceinline__ f32x4 ldx(const _Float16* p) { const h16x4 h = *(const h16x4*)p; return __builtin_convertvector(h, f32x4); }
__device__ __forceinline__ void stx(_Float16* p, f32x4 v) { *(h16x4*)p = __builtin_convertvector(v, h16x4); }
__device__ __forceinline__ const float* xrow_src(const Params& p, int l, int b, int t, int row) {
  const float* base = t < CTXL ? p.ctx : p.x; const size_t off = t < CTXL ? ((size_t)b * CTXL + t) * DM : ((size_t)b * SEQ + (t - CTXL)) * DM; return base + off;
}
__device__ __forceinline__ void phase_prenorm(const Params& p, const Ctx& c, int l) {
  bf16_t* Hn = (bf16_t*)(p.ws + OFF_HN);
  for (int row = c.gwave; row < TT; row += c.nwave) { const int b = row / TPB, t = row % TPB, v = t < CTXL ? 4 : b;
    f32x4 x[8]; const f32x4* xr = (const f32x4*)xrow_src(p, l, b, t, row);
#pragma unroll
    for (int i = 0; i < 8; ++i) x[i] = xr[c.lane + 64 * i];
    const float rinv = rsqrtf(sumsq8(x) * (1.f / DM) + 1e-6f);
    prenorm_row(x, rinv, p.g_mix_pre + (size_t)l * DM, modp(p, l, v, 1), modp(p, l, v, 0), Hn + (size_t)row * DM, c.lane); }
}
__device__ __forceinline__ void phase_postmix(const Params& p, const Ctx& c, int l, bool last) {
  _Float16* X = (_Float16*)(p.ws + OFF_X); const bf16_t* MIX = (const bf16_t*)(p.ws + OFF_Z1); bf16_t* Hn = (bf16_t*)(p.ws + OFF_HN);
  for (int row = c.gwave; row < TT; row += c.nwave) { const int b = row / TPB, t = row % TPB, v = t < CTXL ? 4 : b; if (last && t < CTXL) continue;
    f32x4 m[8], x[8]; const u32x2* mr = (const u32x2*)(MIX + (size_t)row * DM); _Float16* xr = X + (size_t)row * DM; const f32x4* xs = (const f32x4*)xrow_src(p, 0, b, t, row);
    if (t < CTXL) { const u32x2* sl = (const u32x2*)(p.ws + OFF_Z2) + ((size_t)b * CTXL + t) * (DM / 4);
#pragma unroll
      for (int i = 0; i < 8; ++i) { m[i] = (f32x4){0.f, 0.f, 0.f, 0.f}; x[i] = xs[c.lane + 64 * i]; }
      for (int s = 0; s < 8; ++s) {
#pragma unroll
        for (int i = 0; i < 8; ++i) { const u32x2 w = sl[(size_t)s * NB * CTXL * (DM / 4) + c.lane + 64 * i]; m[i] += (f32x4){__uint_as_float(w[0] << 16), __uint_as_float(w[0] & 0xffff0000u), __uint_as_float(w[1] << 16), __uint_as_float(w[1] & 0xffff0000u)}; } } }
    else {
#pragma unroll
    for (int i = 0; i < 8; ++i) { const u32x2 w = mr[c.lane + 64 * i]; m[i] = (f32x4){__uint_as_float(w[0] << 16), __uint_as_float(w[0] & 0xffff0000u), __uint_as_float(w[1] << 16), __uint_as_float(w[1] & 0xffff0000u)}; x[i] = (l == 0) ? xs[c.lane + 64 * i] : ldx(xr + (c.lane + 64 * i) * 4); } }
    const float r1 = rsqrtf(sumsq8(m) * (1.f / DM) + 1e-6f); const float* gp = p.g_mix_post + (size_t)l * DM; const float* m2 = modp(p, l, v, 2);
#pragma unroll
    for (int i = 0; i < 8; ++i) { const int col = (c.lane + 64 * i) * 4; x[i] += *(const f32x4*)(m2 + col) * (m[i] * r1 * *(const f32x4*)(gp + col)); stx(xr + col, x[i]); }
    const float r2 = rsqrtf(sumsq8(x) * (1.f / DM) + 1e-6f);
    prenorm_row(x, r2, p.g_ffn_pre + (size_t)l * DM, modp(p, l, v, 4), modp(p, l, v, 3), Hn + (size_t)row * DM, c.lane); }
}
__device__ __forceinline__ void phase_postffn(const Params& p, const Ctx& c, int l, bool last) {
  _Float16* X = (_Float16*)(p.ws + OFF_X); const bf16_t* F = (const bf16_t*)(p.ws + OFF_Z1 + (size_t)TT * DM * 2); bf16_t* Hn = (bf16_t*)(p.ws + OFF_HN);
  for (int row = c.gwave; row < TT; row += c.nwave) { const int b = row / TPB, t = row % TPB, v = t < CTXL ? 4 : b; if (last && t < CTXL) continue;
    f32x4 m[8], x[8]; const u32x2* mr = (const u32x2*)(F + (size_t)row * DM); _Float16* xr = X + (size_t)row * DM;
    if (t < CTXL) { const u32x2* sl = (const u32x2*)(p.ws + OFF_Z1) + ((size_t)b * CTXL + t) * (DM / 4);
#pragma unroll
      for (int i = 0; i < 8; ++i) { m[i] = (f32x4){0.f, 0.f, 0.f, 0.f}; x[i] = ldx(xr + (c.lane + 64 * i) * 4); }
      for (int s = 0; s < 11; ++s) {
#pragma unroll
        for (int i = 0; i < 8; ++i) { const u32x2 w = sl[(size_t)s * NB * CTXL * (DM / 4) + c.lane + 64 * i]; m[i] += (f32x4){__uint_as_float(w[0] << 16), __uint_as_float(w[0] & 0xffff0000u), __uint_as_float(w[1] << 16), __uint_as_float(w[1] & 0xffff0000u)}; } } }
    else {
#pragma unroll
    for (int i = 0; i < 8; ++i) { const u32x2 w = mr[c.lane + 64 * i]; m[i] = (f32x4){__uint_as_float(w[0] << 16), __uint_as_float(w[0] & 0xffff0000u), __uint_as_float(w[1] << 16), __uint_as_float(w[1] & 0xffff0000u)}; x[i] = ldx(xr + (c.lane + 64 * i) * 4); } }
    const float r1 = rsqrtf(sumsq8(m) * (1.f / DM) + 1e-6f); const float* gp = p.g_ffn_post + (size_t)l * DM; const float* m5 = modp(p, l, v, 5);
#pragma unroll
    for (int i = 0; i < 8; ++i) { const int col = (c.lane + 64 * i) * 4; x[i] += *(const f32x4*)(m5 + col) * (m[i] * r1 * *(const f32x4*)(gp + col)); }
    if (last) { f32x4* o = (f32x4*)(p.out + ((size_t)b * SEQ + (t - CTXL)) * DM);
#pragma unroll
      for (int i = 0; i < 8; ++i) o[c.lane + 64 * i] = x[i]; }
    else {
#pragma unroll
      for (int i = 0; i < 8; ++i) stx(xr + (c.lane + 64 * i) * 4, x[i]);
      const float r2 = rsqrtf(sumsq8(x) * (1.f / DM) + 1e-6f);
      prenorm_row(x, r2, p.g_mix_pre + (size_t)(l + 1) * DM, modp(p, l + 1, v, 1), modp(p, l + 1, v, 0), Hn + (size_t)row * DM, c.lane); } }
}

typedef f32x4 Acc[2][2][4][2];
__device__ __forceinline__ int lat_pm(int i) { return (i >> 4) * 17 + 1 + (i & 15); }

struct SchedMN {
  const char* A; const char* B; size_t strA, strB;
  int nM, nN, pn0, latonly, nextra, blk, nblk;
  __device__ __forceinline__ bool next(int i, gm::Unit& u) const {
    const int it = i * nblk + blk, nmain = nM * nN;
    if (it < nmain) { gm::tile_of(it, nM, nN, u.pm, u.pn); if (latonly) u.pm = lat_pm(u.pm); u.pn += pn0; return true; }
    if (it < nmain + nextra) { const int j = it - nmain; u.pm = (j / 10) * 17; u.pn = 4 + (j % 10); return true; }
    return false;
  }
  __device__ __forceinline__ const char* pA(const gm::Unit& u) const { return A + (size_t)u.pm * strA; }
  __device__ __forceinline__ const char* pB(const gm::Unit& u) const { return B + (size_t)u.pn * strB; }
};

struct EpiIn {
  bf16_t *Qb, *Kb, *Vb, *UG, *PT; const float *rc, *rs;
  __device__ __forceinline__ void operator()(const Acc& acc, const gm::Unit& u, int wr, int wc, int fr, int fq) const {
    const int pm = u.pm, pn = u.pn; const bool isctx = (pm % 17) == 0; const int brow = pm * 256;
#pragma unroll
    for (int ai = 0; ai < 2; ++ai)
#pragma unroll
      for (int m = 0; m < 4; ++m) { const int row = brow + ai * 128 + wr * 64 + m * 16 + fr;
        if (pn < 8) { bf16_t* dst = Qb + (size_t)(pn >> 2) * TT * 1024 + (size_t)row * 1024 + (pn & 3) * 256 + wc * 32 + fq * 4;
          f32x4 cs = {1.f, 1.f, 1.f, 1.f}, sn = {0.f, 0.f, 0.f, 0.f};
          if (!isctx) { const int tl = (row % TPB) - CTXL; const int pos = (wc >> 1) ? (tl & 63) : (tl >> 6); const int p0 = (wc & 1) * 16 + fq * 4;
            cs = *(const f32x4*)(rc + pos * 32 + p0); sn = *(const f32x4*)(rs + pos * 32 + p0); }
#pragma unroll
          for (int bj = 0; bj < 2; ++bj) { const f32x4 v1 = acc[ai][bj][m][0], v2 = acc[ai][bj][m][1]; const f32x4 o1 = v1 * cs - v2 * sn, o2 = v2 * cs + v1 * sn;
            u32x2 w1 = {cvtpk(o1[0], o1[1]), cvtpk(o1[2], o1[3])}, w2 = {cvtpk(o2[0], o2[1]), cvtpk(o2[2], o2[3])};
            *(u32x2*)(dst + bj * 128) = w1; *(u32x2*)(dst + bj * 128 + 16) = w2; } }
        else if (pn < 12) { bf16_t* dst = Vb + (size_t)row * 1024 + (pn - 8) * 256 + wc * 32 + fq * 4;
#pragma unroll
          for (int bj = 0; bj < 2; ++bj)
#pragma unroll
            for (int n = 0; n < 2; ++n) { const f32x4 v = acc[ai][bj][m][n]; u32x2 w = {cvtpk(v[0], v[1]), cvtpk(v[2], v[3])}; *(u32x2*)(dst + bj * 128 + n * 16) = w; } }
        else if (pn < 14) { const int b = row / TPB, t = row % TPB; bf16_t* dst = UG + ((size_t)(b * 136 + (t >> 5))) * 768 + (t & 31) * 16 + ((fq * 4) & 15);
#pragma unroll
          for (int bj = 0; bj < 2; ++bj)
#pragma unroll
            for (int n = 0; n < 2; ++n) { const int g = ((pn - 12) * 256 + bj * 128 + wc * 32 + n * 16 + fq * 4) >> 4; const f32x4 v = acc[ai][bj][m][n];
              u32x2 w = {cvtpk(v[0], v[1]), cvtpk(v[2], v[3])}; *(u32x2*)(dst + (size_t)g * 768 * 768) = w; } }
        else {
          const int b = pm / 17, tt = pm % 17, part = (pn - 14) >> 1; const size_t cb = (size_t)(part * NB + b) * 512 + (pn & 1) * 256; const size_t ld = tt == 0 ? 256 : 4096;
          bf16_t* dstm = PT + (tt == 0 ? (size_t)2 * NB * 512 * 4096 + cb * 256 : cb * 4096 + (size_t)(tt - 1) * 256) + ai * 128 + wr * 64 + m * 16 + fr;
#pragma unroll
          for (int bj = 0; bj < 2; ++bj)
#pragma unroll
            for (int n = 0; n < 2; ++n) { const f32x4 v = acc[ai][bj][m][n]; const unsigned w0 = cvtpk(v[0], v[1]), w1 = cvtpk(v[2], v[3]); bf16_t* d = dstm + (size_t)(bj * 128 + wc * 32 + n * 16 + fq * 4) * ld;
              d[0] = (bf16_t)(w0 & 0xffff); d[ld] = (bf16_t)(w0 >> 16); d[2 * ld] = (bf16_t)(w1 & 0xffff); d[3 * ld] = (bf16_t)(w1 >> 16); } } }
  }
};
__device__ __forceinline__ void phase_gemm_in(const Params& p, const Ctx& c, int l, LAS unsigned char* lds) {
  SchedMN S; S.A = p.ws + OFF_HN; S.B = p.ws + OFF_WIN; S.strA = (size_t)256 * DM * 2; S.strB = (size_t)256 * DM * 2; S.blk = c.blk; S.nblk = c.nblk;
  S.nM = l == 0 ? 68 : 64; S.latonly = l == 0 ? 0 : 1;
  { S.nN = 18; S.pn0 = 0; S.nextra = l == 0 ? 0 : 40;
    EpiIn E; E.PT = (bf16_t*)(p.ws + OFF_Z2 + Z2_CAT); E.Qb = (bf16_t*)(p.ws + OFF_Z1 + Z1_Q); E.Kb = (bf16_t*)(p.ws + OFF_Z1 + Z1_K); E.Vb = (bf16_t*)(p.ws + OFF_Z1 + Z1_V); E.UG = (bf16_t*)(p.ws + OFF_Z2 + Z2_UG);
    E.rc = (const float*)(p.ws + OFF_ROPE); E.rs = E.rc + 64 * 32;
    gm::gemm_phase<true>(lds, DM, DM, DM, S, E); }
}

__device__ __forceinline__ void fourier_stage_a(const Params& p, const Ctx& c, int l) {
  const bf16_t* PT = (const bf16_t*)(p.ws + OFF_Z2 + Z2_CAT); bf16_t* Y = (bf16_t*)(p.ws + OFF_Z2 + Z2_FC);
  constexpr float C16[16] = {1.f, 0.92387953251f, 0.70710678119f, 0.38268343237f, 0.f, -0.38268343237f, -0.70710678119f, -0.92387953251f, -1.f, -0.92387953251f, -0.70710678119f, -0.38268343237f, 0.f, 0.38268343237f, 0.70710678119f, 0.92387953251f};
  constexpr float S16[16] = {0.f, 0.38268343237f, 0.70710678119f, 0.92387953251f, 1.f, 0.92387953251f, 0.70710678119f, 0.38268343237f, 0.f, -0.38268343237f, -0.70710678119f, -0.92387953251f, -1.f, -0.92387953251f, -0.70710678119f, -0.38268343237f};
  for (long i = c.gtid; i < (long)NB * 512 * 256; i += c.nthr) { const int t2 = (int)(i & 255), ch = (int)((i >> 8) & 511), b = (int)(i >> 17);
    const bf16_t* Pb = PT + ((size_t)(0 * NB + b) * 512 + ch) * 4096 + t2; const bf16_t* Qb = PT + ((size_t)(1 * NB + b) * 512 + ch) * 4096 + t2;
    float zr[16], zq[16];
#pragma unroll
    for (int t1 = 0; t1 < 16; ++t1) { zr[t1] = bf2f(Pb[256 * t1]); zq[t1] = bf2f(Qb[256 * t1]); }
    bf16_t* Yo = Y + ((size_t)(b * 16) * 512 + ch) * 512 + t2;
#pragma unroll
    for (int k1 = 0; k1 < 16; ++k1) { float ar = 0.f, ai = 0.f;
#pragma unroll
      for (int t1 = 0; t1 < 16; ++t1) { const float cc = C16[(k1 * t1) & 15], ss = S16[(k1 * t1) & 15]; ar += zr[t1] * cc - zq[t1] * ss; ai -= zr[t1] * ss + zq[t1] * cc; }
      const float ph = (float)(k1 * t2) * (1.f / 4096.f), ct = __builtin_amdgcn_cosf(ph), st = __builtin_amdgcn_sinf(ph);
      const float yr = (ar * ct + ai * st) * 0.25f, yi = (ai * ct - ar * st) * 0.25f;
      bf16_t* yo = Yo + (size_t)k1 * 512 * 512; const unsigned w = cvtpk(yr, yi); yo[0] = (bf16_t)(w & 0xffff); yo[256] = (bf16_t)(w >> 16); } }
  if (l == 0) {
    const bf16_t* PC = PT + (size_t)2 * NB * 512 * 4096;
    for (long i = c.gtid; i < (long)NB * 512 * 64; i += c.nthr) { const int t0 = (int)(i & 31) * 8, ri = (int)((i >> 5) & 1), ch = (int)((i >> 6) & 511), b = (int)(i >> 15);
      u32x4 w = *(const u32x4*)(PC + ((size_t)(ri * NB + b) * 512 + ch) * 256 + t0); if (ri) { w[0] ^= 0x80008000u; w[1] ^= 0x80008000u; w[2] ^= 0x80008000u; w[3] ^= 0x80008000u; }
      *(u32x4*)(Y + ((size_t)32768 + b * 512 + ch) * 512 + ri * 256 + t0) = w; } }
}
struct SchedFB { const char *DB, *Y; int nunits, blk, nblk;
  __device__ __forceinline__ bool next(int i, gm::Unit& u) const { const int it = i * nblk + blk; if (it >= nunits) return false; u.pm = it; u.pn = 0; return true; }
  __device__ __forceinline__ const char* pA(const gm::Unit&) const { return DB; }
  __device__ __forceinline__ const char* pB(const gm::Unit& u) const { const int it = u.pm; const size_t row = it < 128 ? (size_t)it * 256 : (size_t)32768 + (it - 128) * 256; return Y + row * 1024; } };
struct EpiFB { bf16_t* Cat; const float* bf;
  __device__ __forceinline__ void operator()(const Acc& acc, const gm::Unit& u, int wr, int wc, int fr, int fq) const { const int it = u.pm;
    int b, tok0, tstride, chb; if (it < 128) { b = it >> 5; const int pn = it & 31; tok0 = CTXL + (pn >> 1); tstride = 16; chb = (pn & 1) * 256; } else { const int j = it - 128; b = j >> 1; tok0 = 0; tstride = 1; chb = (j & 1) * 256; }
#pragma unroll
    for (int ai = 0; ai < 2; ++ai)
#pragma unroll
      for (int m = 0; m < 4; ++m) { const int k2 = ai * 128 + wr * 64 + m * 16 + fr; bf16_t* dr = Cat + ((size_t)b * TPB + tok0 + tstride * k2) * DM + 1536 + chb + wc * 32 + fq * 4;
#pragma unroll
        for (int bj = 0; bj < 2; ++bj)
#pragma unroll
          for (int n = 0; n < 2; ++n) { const f32x4 v = acc[ai][bj][m][n] + *(const f32x4*)(bf + chb + bj * 128 + wc * 32 + n * 16 + fq * 4); u32x2 w = {cvtpk(v[0], v[1]), cvtpk(v[2], v[3])}; *(u32x2*)(dr + bj * 128 + n * 16) = w; } }
  } };
__device__ __forceinline__ void fourier_stage_b(const Params& p, const Ctx& c, int l, LAS unsigned char* lds) {
  const SchedFB S{p.ws + OFF_DFTC, p.ws + OFF_Z2 + Z2_FC, l == 0 ? 136 : 128, c.blk, c.nblk}; const EpiFB E{(bf16_t*)(p.ws + OFF_Z2 + Z2_CAT), p.b_four + (size_t)l * 512};
  gm::gemm_phase<true>(lds, 512, 512, 512, S, E);
}

struct SchedSsmS { const char *UG, *EM; int blk, nblk;
  __device__ __forceinline__ bool next(int i, gm::Unit& u) const { const int it = i * nblk + blk; if (it >= 96) return false; u.pm = it; u.pn = 0; return true; }
  __device__ __forceinline__ const char* pA(const gm::Unit& u) const { const int g = u.pm / 3, pm = u.pm % 3; return UG + ((size_t)g * 768 + pm * 256) * 768 * 2; }
  __device__ __forceinline__ const char* pB(const gm::Unit& u) const { const int g = u.pm / 3; return EM + (size_t)g * 256 * 512 * 2; } };
struct EpiSsmS { float* SB;
  __device__ __forceinline__ void operator()(const Acc& acc, const gm::Unit& u, int wr, int wc, int fr, int fq) const { const int g = u.pm / 3, pm = u.pm % 3;
#pragma unroll
    for (int ai = 0; ai < 2; ++ai)
#pragma unroll
      for (int m = 0; m < 4; ++m) { const int r = pm * 256 + ai * 128 + wr * 64 + m * 16 + fr; if (r >= 544) continue; float* dr = SB + ((size_t)g * 768 + r) * 256 + wc * 32 + fq * 4;
#pragma unroll
        for (int bj = 0; bj < 2; ++bj)
#pragma unroll
          for (int n = 0; n < 2; ++n) *(f32x4*)(dr + bj * 128 + n * 16) = acc[ai][bj][m][n]; }
  } };
__device__ __forceinline__ void phase_ssm_states(const Params& p, const Ctx& c, LAS unsigned char* lds) {
  const SchedSsmS S{p.ws + OFF_Z2 + Z2_UG, p.ws + OFF_EM, c.blk, c.nblk}; const EpiSsmS E{(float*)(p.ws + OFF_Z2 + Z2_SB)};
  gm::gemm_phase<true>(lds, 768, 512, 512, S, E);
}
struct SchedSsmY { const char *UG, *TF; int blk, nblk;
  __device__ __forceinline__ bool next(int i, gm::Unit& u) const { const int it = i * nblk + blk; if (it >= 192) return false; u.pm = it >> 1; u.pn = it & 1; return true; }
  __device__ __forceinline__ const char* pA(const gm::Unit& u) const { const int g = u.pm / 3, pm = u.pm % 3; return UG + ((size_t)g * 768 + pm * 256) * 768 * 2; }
  __device__ __forceinline__ const char* pB(const gm::Unit& u) const { const int g = u.pm / 3; return TF + ((size_t)g * 512 + u.pn * 256) * 768 * 2; } };
struct EpiSsmY { bf16_t* Gg; int last;
  __device__ __forceinline__ void operator()(const Acc& acc, const gm::Unit& u, int wr, int wc, int fr, int fq) const { const int g = u.pm / 3, pm = u.pm % 3;
#pragma unroll
    for (int ai = 0; ai < 2; ++ai)
#pragma unroll
      for (int m = 0; m < 4; ++m) { const int r = pm * 256 + ai * 128 + wr * 64 + m * 16 + fr; if (r >= 544) continue; const int b = r / 136, ch = r % 136; if (last && ch < 8) continue;
        bf16_t* dr = Gg + ((size_t)b * TPB + ch * 32) * 512 + g * 16 + ((fq * 4) & 15);
#pragma unroll
        for (int bj = 0; bj < 2; ++bj)
#pragma unroll
          for (int n = 0; n < 2; ++n) { const int t = (u.pn * 256 + bj * 128 + wc * 32 + n * 16 + fq * 4) >> 4; const f32x4 y = acc[ai][bj][m][n];
            u32x2 w = {cvtpk(gelu_tanh(y[0]), gelu_tanh(y[1])), cvtpk(gelu_tanh(y[2]), gelu_tanh(y[3]))}; *(u32x2*)(dr + (size_t)t * 512) = w; } }
  } };
__device__ __forceinline__ void phase_ssm_y(const Params& p, const Ctx& c, bool last, LAS unsigned char* lds) {
  const SchedSsmY S{p.ws + OFF_Z2 + Z2_UG, p.ws + OFF_TF, c.blk, c.nblk}; const EpiSsmY E{(bf16_t*)(p.ws + OFF_Z2 + Z2_GG), last ? 1 : 0};
  gm::gemm_phase<true>(lds, 768, 768, 768, S, E);
}

struct EpiGlu {
  const bf16_t* Gg; bf16_t* Cat; const float* bg;
  __device__ __forceinline__ void operator()(const Acc& acc, const gm::Unit& u, int wr, int wc, int fr, int fq) const { const int pm = u.pm, pn = u.pn;
#pragma unroll
    for (int ai = 0; ai < 2; ++ai)
#pragma unroll
      for (int m = 0; m < 4; ++m) { const int row = pm * 256 + ai * 128 + wr * 64 + m * 16 + fr;
#pragma unroll
        for (int bj = 0; bj < 2; ++bj)
#pragma unroll
          for (int n = 0; n < 2; ++n) { const int col = pn * 256 + bj * 128 + wc * 32 + n * 16 + fq * 4; const f32x4 z = acc[ai][bj][m][n] + *(const f32x4*)(bg + col);
            const u32x2 gw = *(const u32x2*)(Gg + (size_t)row * 512 + col);
            const float g0 = __uint_as_float(gw[0] << 16), g1 = __uint_as_float(gw[0] & 0xffff0000u), g2 = __uint_as_float(gw[1] << 16), g3 = __uint_as_float(gw[1] & 0xffff0000u);
            u32x2 w = {cvtpk(g0 * sigmoidf_(z[0]), g1 * sigmoidf_(z[1])), cvtpk(g2 * sigmoidf_(z[2]), g3 * sigmoidf_(z[3]))};
            *(u32x2*)(Cat + (size_t)row * DM + 1024 + col) = w; } }
  }
};
__device__ __forceinline__ void phase_glu(const Params& p, const Ctx& c, int l, bool last, LAS unsigned char* lds) {
  SchedMN S; S.A = p.ws + OFF_Z2 + Z2_GG; S.B = p.ws + OFF_WGLU; S.strA = (size_t)256 * 512 * 2; S.strB = (size_t)256 * 512 * 2; S.blk = c.blk; S.nblk = c.nblk;
  S.nM = last ? 64 : 68; S.latonly = last ? 1 : 0; S.nN = 2; S.pn0 = 0; S.nextra = 0;
  EpiGlu E; E.Gg = (const bf16_t*)(p.ws + OFF_Z2 + Z2_GG); E.Cat = (bf16_t*)(p.ws + OFF_Z2 + Z2_CAT); E.bg = p.b_glu + (size_t)l * 512;
  gm::gemm_phase<true>(lds, 512, 512, 512, S, E);
}

struct EpiF32 {
  bf16_t* O;
  __device__ __forceinline__ void operator()(const Acc& acc, const gm::Unit& u, int wr, int wc, int fr, int fq) const {
    bf16_t* dst = O + (size_t)u.pm * 256 * DM + u.pn * 256 + wc * 32 + fq * 4;
#pragma unroll
    for (int ai = 0; ai < 2; ++ai)
#pragma unroll
      for (int m = 0; m < 4; ++m) { bf16_t* dr = dst + (size_t)(ai * 128 + wr * 64 + m * 16 + fr) * DM;
#pragma unroll
        for (int bj = 0; bj < 2; ++bj)
#pragma unroll
          for (int n = 0; n < 2; ++n) { const f32x4 v = acc[ai][bj][m][n]; u32x2 w = {cvtpk(v[0], v[1]), cvtpk(v[2], v[3])}; *(u32x2*)(dr + bj * 128 + n * 16) = w; } }
  }
};
struct SchedSplit { const char *A, *B; size_t strA, strB, kbytes; int nunits, blk, nblk;
  __device__ __forceinline__ bool next(int i, gm::Unit& u) const { const int it = i * nblk + blk; if (it >= nunits) return false; u.pm = it; u.pn = 0; return true; }
  __device__ __forceinline__ const char* pA(const gm::Unit& u) const { const int tile = u.pm & 31, sp = u.pm >> 5; return A + (size_t)((tile >> 3) * 17) * strA + sp * kbytes; }
  __device__ __forceinline__ const char* pB(const gm::Unit& u) const { const int tile = u.pm & 31, sp = u.pm >> 5; return B + (size_t)(tile & 7) * strB + sp * kbytes; } };
struct EpiAcc { bf16_t* SLAB;
  __device__ __forceinline__ void operator()(const Acc& acc, const gm::Unit& u, int wr, int wc, int fr, int fq) const { const int tile = u.pm & 31, sp = u.pm >> 5;
    bf16_t* dst = SLAB + ((size_t)sp * NB * CTXL + (tile >> 3) * 256) * DM + (tile & 7) * 256 + wc * 32 + fq * 4;
#pragma unroll
    for (int ai = 0; ai < 2; ++ai)
#pragma unroll
      for (int m = 0; m < 4; ++m) { bf16_t* dr = dst + (size_t)(ai * 128 + wr * 64 + m * 16 + fr) * DM;
#pragma unroll
        for (int bj = 0; bj < 2; ++bj)
#pragma unroll
          for (int n = 0; n < 2; ++n) { const f32x4 v = acc[ai][bj][m][n]; u32x2 w = {cvtpk(v[0], v[1]), cvtpk(v[2], v[3])}; *(u32x2*)(dr + bj * 128 + n * 16) = w; } }
  } };
template <int KK, int NSPLIT>
__device__ __forceinline__ void phase_gemm_f32out(const Params& p, const Ctx& c, bool last, const char* A, const char* W, char* outp, char* slab, LAS unsigned char* lds) {
  SchedMN S; S.A = A; S.B = W; S.strA = (size_t)256 * KK * 2; S.strB = (size_t)256 * KK * 2; S.blk = c.blk; S.nblk = c.nblk;
  S.nM = 64; S.latonly = 1; S.nN = 8; S.pn0 = 0; S.nextra = 0;
  EpiF32 E; E.O = (bf16_t*)outp;
  gm::gemm_phase<true>(lds, KK, KK, KK, S, E);
  if (!last) { const SchedSplit S2{A, W, (size_t)256 * KK * 2, (size_t)256 * KK * 2, (size_t)(KK / NSPLIT) * 2, 32 * NSPLIT, c.blk, c.nblk}; const EpiAcc E2{(bf16_t*)slab};
    gm::gemm_phase<true>(lds, KK, KK, KK / NSPLIT, S2, E2); }
}

struct EpiGU {
  bf16_t* ACT;
  __device__ __forceinline__ void operator()(const Acc& acc, const gm::Unit& u, int wr, int wc, int fr, int fq) const {
    bf16_t* dst = ACT + (size_t)u.pm * 256 * DFF + u.pn * 128 + wc * 32 + fq * 4;
#pragma unroll
    for (int ai = 0; ai < 2; ++ai)
#pragma unroll
      for (int m = 0; m < 4; ++m) { bf16_t* dr = dst + (size_t)(ai * 128 + wr * 64 + m * 16 + fr) * DFF;
#pragma unroll
        for (int n = 0; n < 2; ++n) { const f32x4 g = acc[ai][0][m][n], uu = acc[ai][1][m][n];
          u32x2 w = {cvtpk(g[0] * sigmoidf_(g[0]) * uu[0], g[1] * sigmoidf_(g[1]) * uu[1]), cvtpk(g[2] * sigmoidf_(g[2]) * uu[2], g[3] * sigmoidf_(g[3]) * uu[3])};
          *(u32x2*)(dr + n * 16) = w; } }
  }
};
__device__ __forceinline__ void phase_gemm_gu(const Params& p, const Ctx& c, bool last, LAS unsigned char* lds) {
  SchedMN S; S.A = p.ws + OFF_HN; S.B = p.ws + OFF_WGU; S.strA = (size_t)256 * DM * 2; S.strB = (size_t)256 * DM * 2; S.blk = c.blk; S.nblk = c.nblk;
  S.nM = last ? 64 : 68; S.latonly = last ? 1 : 0; S.nN = 44; S.pn0 = 0; S.nextra = 0;
  EpiGU E; E.ACT = (bf16_t*)(p.ws + OFF_Z2);
  gm::gemm_phase<true>(lds, DM, DM, DM, S, E);
}

__device__ __forceinline__ void phase_attn(const Params& p, const Ctx& c, int l, char* lds) {
  const bf16_t* Qb = (const bf16_t*)(p.ws + OFF_Z1 + Z1_Q); const bf16_t* Kb = (const bf16_t*)(p.ws + OFF_Z1 + Z1_K); const bf16_t* Vb = (const bf16_t*)(p.ws + OFF_Z1 + Z1_V);
  bf16_t* O = (bf16_t*)(p.ws + OFF_HN);
  const int ntot = (l == 0) ? 512 + 32 : 512;
  for (int v = c.blk; v < ntot; v += c.nblk) {
    int combo, qb, seq;
    if (v < 512) { const int rd = v >> 8, w = v & 255; combo = rd * 16 + (w & 7) * 2 + ((w >> 3) >> 4); qb = 1 + ((w >> 3) & 15); seq = TPB; }
    else { combo = v - 512; qb = 0; seq = CTXL; }
    const int mp = combo & 1, h = (combo >> 1) & 3, b = combo >> 3;
    const size_t r0 = (size_t)b * TPB;
    at::body(Qb + (r0 + qb * 256) * 1024 + (h * 2 + mp) * 128, Kb + r0 * 1024 + (h * 2 + mp) * 128, Vb + r0 * 1024 + h * 256,
             O + (r0 + qb * 256) * DM + (h * 2 + mp) * 256, seq, lds);
  }
}

__device__ __forceinline__ void phase_combine(const Params& p, const Ctx& c, int l, bool last) {
  const bf16_t* O = (const bf16_t*)(p.ws + OFF_HN); bf16_t* Cat = (bf16_t*)(p.ws + OFF_Z2 + Z2_CAT);
  const float lam_init = 0.8f - 0.6f * expf(-0.3f * (float)l);
  float lam;
  { const float a1 = p.lam_q1[l * 128 + c.lane] * p.lam_k1[l * 128 + c.lane] + p.lam_q1[l * 128 + 64 + c.lane] * p.lam_k1[l * 128 + 64 + c.lane];
    const float a2 = p.lam_q2[l * 128 + c.lane] * p.lam_k2[l * 128 + c.lane] + p.lam_q2[l * 128 + 64 + c.lane] * p.lam_k2[l * 128 + 64 + c.lane];
    lam = expf(wave_sum(a1)) - expf(wave_sum(a2)) + lam_init; }
  const f32x4 gs = *(const f32x4*)(p.g_subln + (size_t)l * 256 + c.lane * 4);
  for (int row = c.gwave; row < TT; row += c.nwave) { const int t = row % TPB; if (last && t < CTXL) continue;
    const bf16_t* orow = O + (size_t)row * DM; bf16_t* crow_ = Cat + (size_t)row * DM;
#pragma unroll
    for (int h = 0; h < 4; ++h) { const u32x2 a = *(const u32x2*)(orow + (h * 2) * 256 + c.lane * 4), bq = *(const u32x2*)(orow + (h * 2 + 1) * 256 + c.lane * 4);
      f32x4 o; o[0] = __uint_as_float(a[0] << 16) - lam * __uint_as_float(bq[0] << 16); o[1] = __uint_as_float(a[0] & 0xffff0000u) - lam * __uint_as_float(bq[0] & 0xffff0000u);
      o[2] = __uint_as_float(a[1] << 16) - lam * __uint_as_float(bq[1] << 16); o[3] = __uint_as_float(a[1] & 0xffff0000u) - lam * __uint_as_float(bq[1] & 0xffff0000u);
      const float ss = wave_sum(o[0] * o[0] + o[1] * o[1] + o[2] * o[2] + o[3] * o[3]); const float r = rsqrtf(ss * (1.f / 256.f) + 1e-5f) * (1.f - lam_init);
      o = o * r * gs; u32x2 w = {cvtpk(o[0], o[1]), cvtpk(o[2], o[3])}; *(u32x2*)(crow_ + h * 256 + c.lane * 4) = w; }
  }
}


#define XB_TMO      128
#define XB_XCNT(j)  (256  + 64 * (j))
#define XB_XSUB(j)  (1280 + 64 * (j))
#define XB_XGEN(j)  (2304 + 64 * (j))
#define XB_TOP      3328
#define XB_TOPGEN   3392
#define XCD_BAR_WORDS 3456
#define XB_SPIN_CAP (1u << 18)
__device__ __forceinline__ unsigned xb_ld(unsigned* p)              { return __hip_atomic_load(p, __ATOMIC_RELAXED, __HIP_MEMORY_SCOPE_AGENT); }
__device__ __forceinline__ unsigned xb_add(unsigned* p, unsigned v) { return __hip_atomic_fetch_add(p, v, __ATOMIC_RELAXED, __HIP_MEMORY_SCOPE_AGENT); }
__device__ __forceinline__ unsigned xb_xcc_id() { return (unsigned)__builtin_amdgcn_s_getreg((3 << 11) | 20) & 0xFu; }
#define XB_SPIN(cond, bar) do { unsigned _sp = 0; while (cond) { __builtin_amdgcn_s_sleep(1); \
    if ((++_sp & 255u) == 0u) { if (xb_ld(&(bar)[XB_TMO])) break; if (_sp > XB_SPIN_CAP) { atomicAdd(&(bar)[XB_TMO], 1u); break; } } } } while (0)
struct XcdBarrier { unsigned* bar; unsigned x; volatile LAS unsigned* st; };
__device__ __forceinline__ XcdBarrier xcd_barrier_post(unsigned* bar, volatile LAS unsigned* st) {
  XcdBarrier b; b.bar = bar; b.x = xb_xcc_id(); b.st = st;
  if (threadIdx.x == 0) (void)xb_add(&bar[XB_XCNT(b.x)], 1u);
  return b;
}
__device__ __forceinline__ void xcd_barrier_complete(unsigned* bar, unsigned x, unsigned& nloc, unsigned& nx) {
  const unsigned G = gridDim.x * gridDim.y * gridDim.z;
  unsigned sum, cnt, mine, sp = 0u;
  for (;;) {
    sum = 0u; cnt = 0u; mine = 0u;
#pragma unroll
    for (unsigned j = 0; j < 16; ++j) { const unsigned c = xb_ld(&bar[XB_XCNT(j)]); sum += c; cnt += (c > 0u) ? 1u : 0u; mine = (j == x) ? c : mine; }
    if (sum == G) break;
    __builtin_amdgcn_s_sleep(1);
    if ((++sp & 255u) == 0u) { if (xb_ld(&bar[XB_TMO])) break; if (sp > XB_SPIN_CAP) { atomicAdd(&bar[XB_TMO], 1u); break; } }
  }
  nloc = mine > 0u ? mine : 1u; nx = cnt > 0u ? cnt : 1u;
}
__device__ __forceinline__ void xcd_barrier(const XcdBarrier& b) {
  asm volatile("s_waitcnt vmcnt(0)" ::: "memory");
  __syncthreads();
  if (threadIdx.x == 0) {
    unsigned* bar = b.bar;
    __builtin_amdgcn_s_waitcnt(0);
    unsigned nloc = b.st[0], nx = b.st[1];
    if (nloc == 0u) { xcd_barrier_complete(bar, b.x, nloc, nx); b.st[0] = nloc; b.st[1] = nx; }
    const unsigned old = xb_add(&bar[XB_XSUB(b.x)], 1u);
    const unsigned gen = old / nloc;
    if (old + 1u == (gen + 1u) * nloc) {
      __builtin_amdgcn_fence(__ATOMIC_RELEASE, "agent");
      asm volatile("s_waitcnt vmcnt(0)" ::: "memory");
      const unsigned og = xb_add(&bar[XB_TOP], 1u);
      const unsigned tg = og / nx;
      if (og + 1u == (tg + 1u) * nx) xb_add(&bar[XB_TOPGEN], 1u);
      else XB_SPIN(xb_ld(&bar[XB_TOPGEN]) == tg, bar);
      __builtin_amdgcn_fence(__ATOMIC_ACQUIRE, "agent");
      xb_add(&bar[XB_XGEN(b.x)], 1u);
      asm volatile("s_waitcnt vmcnt(0)" ::: "memory");
    } else {
      XB_SPIN(xb_ld(&bar[XB_XGEN(b.x)]) == gen, bar);
      __builtin_amdgcn_fence(__ATOMIC_ACQUIRE, "agent");
      asm volatile("s_waitcnt vmcnt(0)" ::: "memory");
    }
  }
  __syncthreads();
}

__global__ void __launch_bounds__(NTHREADS) mega(Params p_arg) {
  extern __shared__ __attribute__((aligned(16))) char shm[];
  __shared__ uint4 xb_words;
  cg::grid_group grid = cg::this_grid();
  typedef const __attribute__((address_space(4))) Params* KP;
  KP kp = (KP)__builtin_amdgcn_kernarg_segment_ptr();
  unsigned* bar = (unsigned*)(p_arg.ws + OFF_BAR);
  if (threadIdx.x == 0) xb_words = make_uint4(0u, 0u, 0u, 0u);
  if (p_arg.out == nullptr) grid.sync();
  if (threadIdx.x == 0) (void)xb_add(bar + XB_XCNT(xb_xcc_id()), 1u);
  __syncthreads();
  Ctx c;
#define RECTX() do { asm volatile("" : "+s"(kp)); int t_ = threadIdx.x; asm volatile("" : "+v"(t_)); int b_ = blockIdx.x; asm volatile("" : "+s"(b_)); \
    c.tid = t_; c.wid = t_ >> 6; c.lane = t_ & 63; c.blk = b_; c.nblk = gridDim.x; c.gwave = c.blk * 8 + c.wid; c.nwave = c.nblk * 8; \
    c.gtid = (long)c.blk * NTHREADS + c.tid; c.nthr = (long)c.nblk * NTHREADS; } while (0)
  RECTX();
  LAS unsigned char* gshm = (LAS unsigned char*)shm; float* fl = (float*)shm;

#define PP (*(const Params*)kp)
#define GSYNC() do { RECTX(); XcdBarrier xb_; xb_.bar = (unsigned*)(kp->ws + OFF_BAR); xb_.x = xb_xcc_id(); xb_.st = (volatile LAS unsigned*)&xb_words; xcd_barrier(xb_); } while (0)
  phase0a(PP, c, fl);
  RECTX(); ssm_tables(PP, c);
  RECTX(); convert_weights(PP, c, 0, fl);
  GSYNC();
  RECTX(); reduce_mod(PP, c);
  RECTX(); fold_four(PP, c, 0, fl);
  RECTX(); ssm_build_mef(PP, c, 0);
  GSYNC();
  RECTX(); ssm_build_t(PP, c, 0);
  RECTX(); phase_prenorm(PP, c, 0);
  GSYNC();
  for (int l = 0; l < 2; ++l) {
    const bool last = (l == 1);
    RECTX(); phase_gemm_in(PP, c, l, gshm);
    GSYNC();
    RECTX(); fourier_stage_a(PP, c, l);
    RECTX(); phase_ssm_states(PP, c, gshm);
    GSYNC();
    RECTX(); ssm_carry(PP, c, l);
    RECTX(); phase_attn(PP, c, l, shm);
    GSYNC();
    RECTX(); phase_ssm_y(PP, c, last, gshm);
    RECTX(); phase_combine(PP, c, l, last);
    GSYNC();
    RECTX(); phase_glu(PP, c, l, last, gshm);
    RECTX(); fourier_stage_b(PP, c, l, gshm);
    GSYNC();
    RECTX(); phase_gemm_f32out<DM, 8>(PP, c, last, kp->ws + OFF_Z2 + Z2_CAT, kp->ws + OFF_WOUT, kp->ws + OFF_Z1, kp->ws + OFF_Z2, gshm);
    GSYNC();
    if (!last) { RECTX(); ssm_build_mef(PP, c, 1); }
    RECTX(); phase_postmix(PP, c, l, last);
    GSYNC();
    RECTX(); phase_gemm_gu(PP, c, last, gshm);
    GSYNC();
    RECTX(); phase_gemm_f32out<DFF, 11>(PP, c, last, kp->ws + OFF_Z2, kp->ws + OFF_WD, kp->ws + OFF_Z1 + (size_t)TT * DM * 2, kp->ws + OFF_Z1, gshm);
    GSYNC();
    if (!last) { RECTX(); ssm_build_t(PP, c, 1); }
    RECTX(); phase_postffn(PP, c, l, last);
    if (!last) { RECTX(); convert_weights(PP, c, 1, fl); RECTX(); fold_four(PP, c, 1, fl); GSYNC(); }
  }
}

extern "C" void kernel_launch(void* const* d_in, const int* in_sizes, int n_in, void* d_out, int out_size, void* d_ws, size_t ws_size,
                              hipStream_t stream) {
  static int grid_blocks = 0;
  if (!grid_blocks) {
    (void)hipFuncSetAttribute((const void*)mega, hipFuncAttributeMaxDynamicSharedMemorySize, SHM_BYTES);
    int dev = 0, cus = 0, per_cu = 0;
    (void)hipGetDevice(&dev);
    (void)hipDeviceGetAttribute(&cus, hipDeviceAttributeMultiprocessorCount, dev);
    (void)hipOccupancyMaxActiveBlocksPerMultiprocessor(&per_cu, mega, NTHREADS, SHM_BYTES);
    if (per_cu < 1) per_cu = 1;
    grid_blocks = cus;
  }
  if (n_in != 32 || ws_size < WS_NEED) { fprintf(stderr, "kernel_launch: bad n_in %d or ws %zu < %zu\n", n_in, ws_size, WS_NEED); return; }
  Params p{};
  const float** f = (const float**)&p;
  for (int i = 0; i < 32; ++i) f[i] = (const float*)d_in[i];
  p.out = (float*)d_out; p.ws = (char*)d_ws;
  (void)hipMemsetAsync((char*)d_ws + OFF_BAR, 0, 16384, stream);
  void* args[] = {&p};
  hipError_t e = hipLaunchCooperativeKernel((void*)mega, dim3(grid_blocks), dim3(NTHREADS), args, SHM_BYTES, stream);
  if (e != hipSuccess) fprintf(stderr, "cooperative launch failed: %s (grid %d)\n", hipGetErrorString(e), grid_blocks);
}
```

```cpp
#include <hip/hip_runtime.h>
#include <hip/hip_cooperative_groups.h>
#include <cstdio>
#include <cstdint>
namespace cg = cooperative_groups;

typedef unsigned short bf16_t;
using bf16x8 = __attribute__((ext_vector_type(8))) short;
using s16x4  = __attribute__((ext_vector_type(4))) short;
using f32x4  = __attribute__((ext_vector_type(4))) float;
using f32x16 = __attribute__((ext_vector_type(16))) float;
using u32x4  = __attribute__((ext_vector_type(4))) unsigned;
using u32x2  = __attribute__((ext_vector_type(2))) unsigned;
#define LAS __attribute__((address_space(3)))

constexpr int NB = 4, SEQ = 4096, CTXL = 256, TPB = SEQ + CTXL  , TT = NB * TPB  ;
constexpr int DM = 2048, NIN = 4608, DFF = 5632, NMODC = 6 * DM  ;
constexpr int NTHREADS = 512, SHM_BYTES = 131072;

constexpr size_t al256(size_t x) { return (x + 255) / 256 * 256; }
constexpr size_t OFF_X    = 0;
constexpr size_t OFF_WIN  = OFF_X + (size_t)TT * DM * 2;
constexpr size_t OFF_WOUT = OFF_WIN + (size_t)NIN * DM * 2;
constexpr size_t OFF_WGU  = OFF_WOUT + (size_t)DM * DM * 2;
constexpr size_t OFF_WD   = OFF_WGU + (size_t)2 * DFF * DM * 2;
constexpr size_t OFF_WGLU = OFF_WD + (size_t)DM * DFF * 2;
constexpr size_t OFF_DFTL = OFF_WGLU + (size_t)512 * 512 * 2;
constexpr size_t OFF_DFTC = OFF_DFTL + (size_t)2 * 4096 * 4096 * 2;
constexpr size_t OFF_MP   = OFF_DFTC + (size_t)2 * 256 * 256 * 2;
constexpr size_t OFF_MOD  = OFF_MP + (size_t)16 * 5 * 24576 * 4;
constexpr size_t OFF_ROPE = OFF_MOD + (size_t)2 * 5 * NMODC * 4;
constexpr size_t OFF_WCS  = OFF_ROPE + (size_t)2 * 64 * 32 * 4;
constexpr size_t OFF_PW   = OFF_WCS + (size_t)2 * 2 * 4 * 128 * 128 * 4;
constexpr size_t OFF_BB   = OFF_PW + (size_t)2 * 32 * 2 * 33 * 64 * 8;
constexpr size_t OFF_MK   = OFF_BB + (size_t)2 * 32 * 2 * 64 * 16 * 8;
constexpr size_t OFF_TF   = OFF_MK + (size_t)2 * 32 * 2 * 32 * 256 * 4;
constexpr size_t OFF_EM   = OFF_TF + (size_t)32 * 512 * 768 * 2;
constexpr size_t OFF_BAR  = OFF_EM + (size_t)32 * 256 * 512 * 2;
constexpr size_t OFF_HN   = OFF_BAR + 16384;
constexpr size_t OFF_Z1   = OFF_HN + (size_t)TT * DM * 2;
constexpr size_t Z1_Q = 0, Z1_K = (size_t)TT * 1024 * 2, Z1_V = 2 * Z1_K;
constexpr size_t OFF_Z2   = OFF_Z1 + (size_t)TT * DM * 4;
constexpr size_t Z2_FC = 0, Z2_FS = Z2_FC + (size_t)TT * 512 * 4;
constexpr size_t Z2_UG = Z2_FS + (size_t)TT * 512 * 4;
constexpr size_t Z2_SB = Z2_UG + (size_t)32 * 768 * 768 * 2;
constexpr size_t Z2_CAT = Z2_SB + (size_t)32 * 768 * 256 * 4;
constexpr size_t Z2_GG = Z2_CAT + (size_t)TT * DM * 2;
constexpr size_t Z2_END = Z2_GG + (size_t)TT * 512 * 2;
constexpr size_t Z2_SIZE = Z2_END > (size_t)TT * DFF * 2 ? Z2_END : (size_t)TT * DFF * 2;
constexpr size_t WS_NEED = OFF_Z2 + Z2_SIZE;
static_assert(WS_NEED <= (size_t)805306368, "workspace over 768 MiB");


struct Params {
  const float *x, *c, *ctx, *c_ctx, *w_mod, *b_mod, *g_mix_pre, *g_mix_post, *g_ffn_pre, *g_ffn_post, *w_in, *w_out;
  const float *lam_q1, *lam_k1, *lam_q2, *lam_k2, *g_subln, *ssm_a_re, *ssm_a_im, *ssm_log_dt, *ssm_b_re, *ssm_b_im;
  const float *ssm_c_re, *ssm_c_im, *ssm_d, *w_glu, *b_glu, *w_four, *b_four, *w_gate, *w_up, *w_down;
  float* out; char* ws;
};

__device__ __forceinline__ unsigned cvtpk(float lo, float hi) { unsigned r; asm volatile("v_cvt_pk_bf16_f32 %0, %1, %2" : "=v"(r) : "v"(lo), "v"(hi)); return r; }
__device__ __forceinline__ float bf2f(unsigned short b) { return __uint_as_float((unsigned)b << 16); }
template <int CTRL> __device__ __forceinline__ float dpp_add(float v) { return v + __uint_as_float(__builtin_amdgcn_update_dpp(0u, __float_as_uint(v), CTRL, 0xf, 0xf, false)); }
__device__ __forceinline__ float wave_sum(float v) {
  v = dpp_add<0xB1>(v); v = dpp_add<0x4E>(v); v = dpp_add<0x141>(v); v = dpp_add<0x140>(v);
  const int vi = (int)__float_as_uint(v);
  return (__uint_as_float((unsigned)__builtin_amdgcn_readlane(vi, 0)) + __uint_as_float((unsigned)__builtin_amdgcn_readlane(vi, 16))) + (__uint_as_float((unsigned)__builtin_amdgcn_readlane(vi, 32)) + __uint_as_float((unsigned)__builtin_amdgcn_readlane(vi, 48)));
}
__device__ __forceinline__ void my_sincos(float x, float& s, float& c) {
  const double xd = (double)x; const double kd = rint(xd * 0.63661977236758134); const double r = xd - kd * 1.5707963267948966;
  const double r2 = r * r;
  const double sn = r * (1.0 - r2 / 6.0 * (1.0 - r2 / 20.0 * (1.0 - r2 / 42.0 * (1.0 - r2 / 72.0 * (1.0 - r2 / 110.0 * (1.0 - r2 / 156.0))))));
  const double cs = 1.0 - r2 / 2.0 * (1.0 - r2 / 12.0 * (1.0 - r2 / 30.0 * (1.0 - r2 / 56.0 * (1.0 - r2 / 90.0 * (1.0 - r2 / 132.0)))));
  const int q = ((int)kd) & 3;
  const double ss = (q == 0) ? sn : (q == 1) ? cs : (q == 2) ? -sn : -cs;
  const double cc = (q == 0) ? cs : (q == 1) ? -sn : (q == 2) ? -cs : sn;
  s = (float)ss; c = (float)cc;
}
__device__ __forceinline__ float sigmoidf_(float x) { return __builtin_amdgcn_rcpf(1.f + __builtin_amdgcn_exp2f(x * -1.4426950408889634f)); }
__device__ __forceinline__ float gelu_tanh(float y) { const float u = 0.7978845608028654f * (y + 0.044715f * y * y * y); return y * sigmoidf_(2.f * u); }

namespace gm {
constexpr int BM = 256, BK = 64, HALF = 128, HTB = HALF * BK * 2, NXCD = 8, WGM = 8;
__device__ __forceinline__ int lds_byte(int r, int c) { const int st = (r >> 4) * 2 + (c >> 5), rr = r & 15, cc = c & 31, ob = rr * 64 + cc * 2; return st * 1024 + (ob ^ (((ob >> 9) & 1) << 5)); }
__device__ __forceinline__ void stage_rc(int b, int& R, int& C) { const int st = b / 1024, sb = b % 1024, swz = sb ^ (((sb >> 9) & 1) << 5); R = (st >> 1) * 16 + swz / 64; C = (st & 1) * 32 + (swz % 64) / 2; }
__device__ __forceinline__ void tile_of(int wgid, int nM, int nN, int& pm, int& pn) {
  const int nwg = nM * nN; { const int q = nwg / NXCD, r = nwg % NXCD, xcd = wgid % NXCD, off = wgid / NXCD; wgid = (xcd < r ? xcd * (q + 1) : r * (q + 1) + (xcd - r) * q) + off; }
  const int nig = WGM * nN, gid = wgid / nig, fm = gid * WGM, gsz = (nM - fm) < WGM ? (nM - fm) : WGM;
  pm = fm + ((wgid % nig) % gsz); pn = (wgid % nig) / gsz;
}
struct Unit { int pm, pn; };

template <bool SWAP, bool PERM = false, class Epi, class Sched>
__device__ __forceinline__ void gemm_phase(LAS unsigned char* lds, const int lda, const int ldb, const int K, const Sched& S, const Epi& E) {
  int tid_ = threadIdx.x; asm volatile("" : "+v"(tid_));
  const int tid = tid_, wid = __builtin_amdgcn_readfirstlane(tid >> 6), lane = tid & 63, wr = wid >> 2, wc = wid & 3, fr = lane & 15, fq = lane >> 4;
  const int nt = K / BK;
  unsigned voffA[2], voffB[2];
#pragma unroll
  for (int i = 0; i < 2; ++i) { int R, C; stage_rc(tid * 16 + i * 8192, R, C); voffA[i] = (unsigned)(R * lda + C) * 2u;
    const int rho = R & 31, Rb = PERM ? ((R & ~31) + 8 * ((rho & 15) >> 2) + 4 * (rho >> 4) + (rho & 3)) : R;
    voffB[i] = (unsigned)(Rb * ldb + C) * 2u; }
  const size_t kstep = (size_t)(BK * 2), hstepA = (size_t)HALF * lda * 2, hstepB = (size_t)HALF * ldb * 2;
  const unsigned ldsw = (unsigned)wid * 1024u;
  const int aoff = lds_byte(wr * 64 + fr, fq * 8), boff = lds_byte(wc * 32 + fr, fq * 8);
#define PG8_SA(b, h) (((b) * 2 + (h)) * HTB)
#define PG8_SB(b, h) ((4 + (b) * 2 + (h)) * HTB)
#define PG8_STAGE(bufoff, gbase, voff) do { _Pragma("unroll") for (int _i = 0; _i < 2; ++_i) \
    __builtin_amdgcn_global_load_lds((const unsigned*)((const char*)(gbase) + (voff)[_i]), (LAS unsigned*)(lds + (bufoff) + ldsw + _i * 8192), 16, 0, 0); } while (0)
#define PG8_LDA(dst, b, h) do { _Pragma("unroll") for (int m = 0; m < 4; ++m) _Pragma("unroll") for (int k = 0; k < 2; ++k) dst[m][k] = *(const LAS bf16x8*)(lds + PG8_SA(b, h) + aoff + m * 2048 + k * 1024); } while (0)
#define PG8_LDB(dst, b, h) do { _Pragma("unroll") for (int n = 0; n < 2; ++n) _Pragma("unroll") for (int k = 0; k < 2; ++k) dst[n][k] = *(const LAS bf16x8*)(lds + PG8_SB(b, h) + boff + n * 2048 + k * 1024); } while (0)
#define PG8_MMA(ai, bj, At, Bt) do { __builtin_amdgcn_s_setprio(1); _Pragma("unroll") for (int m = 0; m < 4; ++m) _Pragma("unroll") for (int n = 0; n < 2; ++n) _Pragma("unroll") for (int k = 0; k < 2; ++k) \
    acc[ai][bj][m][n] = SWAP ? __builtin_amdgcn_mfma_f32_16x16x32_bf16(Bt[n][k], At[m][k], acc[ai][bj][m][n], 0, 0, 0) \
                             : __builtin_amdgcn_mfma_f32_16x16x32_bf16(At[m][k], Bt[n][k], acc[ai][bj][m][n], 0, 0, 0); __builtin_amdgcn_s_setprio(0); } while (0)
#define PG8_WAIT_V(n) asm volatile("s_waitcnt vmcnt(" #n ")" ::: "memory")
#define PG8_WAIT_L(n) asm volatile("s_waitcnt lgkmcnt(" #n ")" ::: "memory")
#define PG8_BAR __builtin_amdgcn_s_barrier()
#define PG8_SCHED __builtin_amdgcn_sched_barrier(0)
  Unit cur, nxt; int ui = 0;
  if (!S.next(0, cur)) return;
  f32x4 acc[2][2][4][2];
#pragma unroll
  for (int a = 0; a < 2; ++a)
#pragma unroll
    for (int b = 0; b < 2; ++b)
#pragma unroll
      for (int m = 0; m < 4; ++m)
#pragma unroll
        for (int n = 0; n < 2; ++n) acc[a][b][m][n] = (f32x4){0.f, 0.f, 0.f, 0.f};
  bf16x8 At[4][2], B0[2][2], B1[2][2];
  const char* cA = S.pA(cur); const char* cB = S.pB(cur);
  PG8_STAGE(PG8_SB(0, 0), cB, voffB); PG8_STAGE(PG8_SB(0, 1), cB + hstepB, voffB); PG8_STAGE(PG8_SA(0, 0), cA, voffA); PG8_STAGE(PG8_SA(0, 1), cA + hstepA, voffA);
  if (wr == 1) PG8_BAR;
  PG8_WAIT_V(2); PG8_BAR;
  PG8_STAGE(PG8_SB(1, 0), cB + kstep, voffB); PG8_STAGE(PG8_SA(1, 0), cA + kstep, voffA); PG8_STAGE(PG8_SB(1, 1), cB + hstepB + kstep, voffB);
  PG8_WAIT_V(6); PG8_BAR;
  for (;;) {
    const bool has_next = S.next(ui + 1, nxt);
    const char* nA = has_next ? S.pA(nxt) : cA; const char* nB = has_next ? S.pB(nxt) : cB;
    for (int t = 0; t < nt; t += 2) {
      const bool last = (t == nt - 2);
      const char* a1 = cA + (size_t)(t + 1) * kstep;
      const char* a2 = last ? nA : cA + (size_t)(t + 2) * kstep; const char* b2 = last ? nB : cB + (size_t)(t + 2) * kstep;
      const char* a3 = a2 + kstep; const char* b3 = b2 + kstep;
      PG8_LDB(B0, 0, 0); PG8_LDB(B1, 0, 1); PG8_SCHED; PG8_LDA(At, 0, 0); PG8_STAGE(PG8_SA(1, 1), a1 + hstepA, voffA);
      PG8_WAIT_V(8); PG8_WAIT_L(0); PG8_BAR; PG8_MMA(0, 0, At, B0); PG8_MMA(0, 1, At, B1); PG8_BAR; PG8_SCHED;
      PG8_LDA(At, 0, 1); PG8_STAGE(PG8_SB(0, 0), b2, voffB); PG8_STAGE(PG8_SB(0, 1), b2 + hstepB, voffB); PG8_STAGE(PG8_SA(0, 0), a2, voffA);
      PG8_WAIT_V(8); PG8_WAIT_L(0); PG8_BAR; PG8_MMA(1, 0, At, B0); PG8_MMA(1, 1, At, B1); PG8_BAR; PG8_SCHED;
      PG8_LDB(B0, 1, 0); PG8_LDB(B1, 1, 1); PG8_SCHED; PG8_LDA(At, 1, 0); PG8_STAGE(PG8_SA(0, 1), a2 + hstepA, voffA);
      PG8_WAIT_V(8); PG8_WAIT_L(0); PG8_BAR; PG8_MMA(0, 0, At, B0); PG8_MMA(0, 1, At, B1); PG8_BAR; PG8_SCHED;
      PG8_LDA(At, 1, 1); PG8_STAGE(PG8_SB(1, 0), b3, voffB); PG8_STAGE(PG8_SB(1, 1), b3 + hstepB, voffB); PG8_STAGE(PG8_SA(1, 0), a3, voffA);
      PG8_WAIT_V(8); PG8_WAIT_L(0); PG8_BAR; PG8_MMA(1, 0, At, B0); PG8_MMA(1, 1, At, B1); PG8_BAR; PG8_SCHED;
    }
    if (wr == 0) PG8_BAR;
    { int fr2 = fr, fq2 = fq; asm volatile("" : "+v"(fr2), "+v"(fq2));
      E(acc, cur, wr, wc, fr2, fq2); }
    if (!has_next) break;
#pragma unroll
    for (int a = 0; a < 2; ++a)
#pragma unroll
      for (int b = 0; b < 2; ++b)
#pragma unroll
        for (int m = 0; m < 4; ++m)
#pragma unroll
          for (int n = 0; n < 2; ++n) acc[a][b][m][n] = (f32x4){0.f, 0.f, 0.f, 0.f};
    cur = nxt; cA = nA; cB = nB; ++ui;
    if (wr == 1) PG8_BAR;
  }
  PG8_WAIT_V(0);
  PG8_BAR;
#undef PG8_SA
#undef PG8_SB
#undef PG8_STAGE
#undef PG8_LDA
#undef PG8_LDB
#undef PG8_MMA
#undef PG8_WAIT_V
#undef PG8_WAIT_L
#undef PG8_BAR
#undef PG8_SCHED
}
}

namespace at {
constexpr int D = 128, NW = 8, QBLK = 32, KVBLK = 64;
constexpr float SCALE = 0.088388347648318440f;
constexpr float THR = 8.f;
constexpr int LDQ = 1024, LDK = 1024, LDV = 1024, LDO = 2048;
constexpr size_t SHM_V = KVBLK * D * 2, SHM_K = KVBLK * D * 2;
#define KSWZ(row, colB) ((row) * 256 + ((colB) ^ (((row) & 7) << 4)))
#define SBAR() __builtin_amdgcn_sched_barrier(0)
__device__ __forceinline__ int crow(int r, int hi) { return (r & 3) + 8 * (r >> 2) + 4 * hi; }
__device__ __forceinline__ void partialSM(f32x16& p0, f32x16& p1, float& m_reg, float& mn, float& alpha) {
  constexpr float C = SCALE * 1.4426950408889634f;
  float pmax = p0[0];
#pragma unroll
  for (int r = 1; r < 16; ++r) pmax = fmaxf(pmax, p0[r]);
#pragma unroll
  for (int r = 0; r < 16; ++r) pmax = fmaxf(pmax, p1[r]);
  { auto rr = __builtin_amdgcn_permlane32_swap(__float_as_uint(pmax), __float_as_uint(pmax), false, false);
    pmax = fmaxf(__uint_as_float(rr[0]), __uint_as_float(rr[1])); }
  if (__builtin_expect(__all(pmax - m_reg <= THR / SCALE), 1)) { mn = m_reg; alpha = 1.f; }
  else { mn = fmaxf(m_reg, pmax); alpha = __builtin_amdgcn_exp2f((m_reg - mn) * C); m_reg = mn; }
  float mnC = -mn * C;
#pragma unroll
  for (int r = 0; r < 16; ++r) p0[r] = fmaf(p0[r], C, mnC);
#pragma unroll
  for (int r = 0; r < 16; ++r) p1[r] = fmaf(p1[r], C, mnC);
#pragma unroll
  for (int r = 0; r < 16; ++r) p0[r] = __builtin_amdgcn_exp2f(p0[r]);
}
__device__ __forceinline__ void finishSM(f32x16& p0, f32x16& p1, float alpha, float& l_reg, bf16x8& pa0, bf16x8& pa1, bf16x8& pa2, bf16x8& pa3) {
#pragma unroll
  for (int r = 0; r < 16; ++r) p1[r] = __builtin_amdgcn_exp2f(p1[r]);
  float ps = 0;
#pragma unroll
  for (int r = 0; r < 16; ++r) ps += p0[r];
#pragma unroll
  for (int r = 0; r < 16; ++r) ps += p1[r];
  { auto rr = __builtin_amdgcn_permlane32_swap(__float_as_uint(ps), __float_as_uint(ps), false, false);
    ps = __uint_as_float(rr[0]) + __uint_as_float(rr[1]); }
  l_reg = l_reg * alpha + ps;
#define PK4(P, BASE, OUT) do { unsigned a0 = cvtpk(P[BASE + 0], P[BASE + 1]), a1 = cvtpk(P[BASE + 2], P[BASE + 3]);   \
    unsigned b0 = cvtpk(P[BASE + 4], P[BASE + 5]), b1 = cvtpk(P[BASE + 6], P[BASE + 7]);                              \
    auto r0 = __builtin_amdgcn_permlane32_swap(a0, b0, false, false); auto r1 = __builtin_amdgcn_permlane32_swap(a1, b1, false, false); \
    u32x4 w = {r0[0], r1[0], r0[1], r1[1]}; OUT = *reinterpret_cast<bf16x8*>(&w); } while (0)
  PK4(p0, 0, pa0); PK4(p0, 8, pa1); PK4(p1, 0, pa2); PK4(p1, 8, pa3);
#undef PK4
}
__device__ __forceinline__ void qkt(f32x16& p0, f32x16& p1, const char* Ks, const bf16x8* qr, int r32, int hi) {
  p0 = f32x16{}; p1 = f32x16{};
#pragma unroll
  for (int d0 = 0; d0 < 8; ++d0) { int cb = (d0 * 16 + hi * 8) * 2;
    bf16x8 b0 = *reinterpret_cast<const bf16x8*>(Ks + KSWZ(r32, cb));
    bf16x8 b1 = *reinterpret_cast<const bf16x8*>(Ks + KSWZ(32 + r32, cb));
    p0 = __builtin_amdgcn_mfma_f32_32x32x16_bf16(b0, qr[d0], p0, 0, 0, 0);
    p1 = __builtin_amdgcn_mfma_f32_32x32x16_bf16(b1, qr[d0], p1, 0, 0, 0); }
}
__device__ __forceinline__ int v_st(int k, int c) { const int kk = (k & ~0xC) | ((k & 4) << 1) | ((k & 8) >> 1); return ((kk >> 3) * 8 + (c >> 5)) * 512 + ((kk & 7) * 32 + (c & 31)) * 2; }
__device__ __forceinline__ int v_rd_base(int lane) { return ((lane & 3) << 3) | (((lane >> 2) & 3) << 6) | (((lane >> 4) & 1) << 5) | (((lane >> 5) & 1) << 8); }
constexpr int v_rd_off(int d0, int ks, int half) { return d0 * 512 + ks * 8192 + half * 4096; }
template <int OFF> __device__ __forceinline__ s16x4 tr_read(int vb) {
  s16x4 r; asm volatile("ds_read_b64_tr_b16 %0, %1 offset:%2" : "=&v"(r) : "v"(vb), "i"(OFF) : "memory"); return r;
}
template <int D0> __device__ __forceinline__ void pv_one(f32x16& od, int vb, bf16x8 pa0, bf16x8 pa1, bf16x8 pa2, bf16x8 pa3) {
  const s16x4 l0 = tr_read<v_rd_off(D0, 0, 0)>(vb), h0 = tr_read<v_rd_off(D0, 0, 1)>(vb), l1 = tr_read<v_rd_off(D0, 1, 0)>(vb), h1 = tr_read<v_rd_off(D0, 1, 1)>(vb);
  const s16x4 l2 = tr_read<v_rd_off(D0, 2, 0)>(vb), h2 = tr_read<v_rd_off(D0, 2, 1)>(vb), l3 = tr_read<v_rd_off(D0, 3, 0)>(vb), h3 = tr_read<v_rd_off(D0, 3, 1)>(vb);
  asm volatile("s_waitcnt lgkmcnt(0)" ::: "memory"); SBAR();
#define PK(L, H) (bf16x8){L[0], L[1], L[2], L[3], H[0], H[1], H[2], H[3]}
  od = __builtin_amdgcn_mfma_f32_32x32x16_bf16(pa0, PK(l0, h0), od, 0, 0, 0);
  od = __builtin_amdgcn_mfma_f32_32x32x16_bf16(pa1, PK(l1, h1), od, 0, 0, 0);
  od = __builtin_amdgcn_mfma_f32_32x32x16_bf16(pa2, PK(l2, h2), od, 0, 0, 0);
  od = __builtin_amdgcn_mfma_f32_32x32x16_bf16(pa3, PK(l3, h3), od, 0, 0, 0);
#undef PK
}
__device__ __forceinline__ void body(const bf16_t* __restrict__ Qb, const bf16_t* __restrict__ Kh, const bf16_t* __restrict__ Vh, bf16_t* __restrict__ Ob, int seq, char* lds) {
  int tid_ = threadIdx.x; asm volatile("" : "+v"(tid_));
  const int tid = tid_, wid = tid >> 6, lane = tid & 63, r32 = lane & 31, hi = lane >> 5;
  constexpr int SV = 64 * 256 * 2, SK = 64 * 128 * 2;
  char* V_lds = lds; char* K_lds = lds + 2 * SV;
  float* ws = (float*)(lds + 2 * SV + 2 * SK) + wid * 64; float* li_l = ws; float* al_l = ws + 32;
  float m_reg = -1e30f, l_reg = 0; f32x16 o[8] = {}; bf16x8 qr[8];
  const bf16_t* Qw = Qb + (long)(wid * QBLK + r32) * LDQ + hi * 8;
#pragma unroll
  for (int d0 = 0; d0 < 8; ++d0) qr[d0] = *reinterpret_cast<const bf16x8*>(Qw + d0 * 16);
  const int wu = __builtin_amdgcn_readfirstlane(wid);
  int koff[2], voff[4];
#pragma unroll
  for (int q = 0; q < 2; ++q) { const int row = 4 * (wu * 2 + q) + (lane >> 4); koff[q] = row * LDK + ((((lane & 15) << 4) ^ ((row & 7) << 4)) >> 1); }
#pragma unroll
  for (int q = 0; q < 4; ++q) { const int s = 2 * (wu * 4 + q) + (lane >> 5), kk = (s >> 3) * 8 + ((lane & 31) >> 2), k = (kk & ~0xC) | ((kk & 4) << 1) | ((kk & 8) >> 1);
    voff[q] = k * LDV + (s & 7) * 32 + (lane & 3) * 8; }
  const int vb0 = (int)(uintptr_t)(LAS char*)V_lds + v_rd_base(lane);
  LAS char* Vl = (LAS char*)V_lds; LAS char* Kl = (LAS char*)K_lds;
#define STAGE(b, k0) do { const bf16_t* kg = Kh + (long)(k0) * LDK; const bf16_t* vg = Vh + (long)(k0) * LDV; \
    _Pragma("unroll") for (int q = 0; q < 2; ++q) __builtin_amdgcn_global_load_lds((const unsigned*)(kg + koff[q]), (LAS unsigned*)(Kl + (b) * SK + (wu * 2 + q) * 1024), 16, 0, 0); \
    _Pragma("unroll") for (int q = 0; q < 4; ++q) __builtin_amdgcn_global_load_lds((const unsigned*)(vg + voff[q]), (LAS unsigned*)(Vl + (b) * SV + (wu * 4 + q) * 1024), 16, 0, 0); } while (0)
  const int NT = seq / KVBLK;
  STAGE(0, 0);
  asm volatile("s_waitcnt vmcnt(0) lgkmcnt(0)" ::: "memory"); __builtin_amdgcn_s_barrier(); asm volatile("" ::: "memory");
  for (int j = 0; j < NT; ++j) {
    const int b = j & 1;
    f32x16 p0, p1; float mn, al; bf16x8 pa0, pa1, pa2, pa3;
    if (j + 1 < NT) STAGE(b ^ 1, (j + 1) * KVBLK);
    SBAR(); qkt(p0, p1, K_lds + b * SK, qr, r32, hi);
    partialSM(p0, p1, m_reg, mn, al);
    if (__any(al < 1.f)) { if (hi == 0) al_l[r32] = al; asm volatile("s_waitcnt lgkmcnt(0)" ::: "memory");
#pragma unroll
      for (int d = 0; d < 8; ++d)
#pragma unroll
        for (int r = 0; r < 16; ++r) o[d][r] *= al_l[crow(r, hi)]; }
    finishSM(p0, p1, al, l_reg, pa0, pa1, pa2, pa3); SBAR();
    const int vb = vb0 + b * SV;
    pv_one<0>(o[0], vb, pa0, pa1, pa2, pa3); pv_one<1>(o[1], vb, pa0, pa1, pa2, pa3); pv_one<2>(o[2], vb, pa0, pa1, pa2, pa3); pv_one<3>(o[3], vb, pa0, pa1, pa2, pa3);
    pv_one<4>(o[4], vb, pa0, pa1, pa2, pa3); pv_one<5>(o[5], vb, pa0, pa1, pa2, pa3); pv_one<6>(o[6], vb, pa0, pa1, pa2, pa3); pv_one<7>(o[7], vb, pa0, pa1, pa2, pa3);
    asm volatile("s_waitcnt vmcnt(0) lgkmcnt(0)" ::: "memory"); __builtin_amdgcn_s_barrier(); asm volatile("" ::: "memory");
  }
  if (hi == 0) li_l[r32] = l_reg; asm volatile("s_waitcnt lgkmcnt(0)" ::: "memory");
  float rli[16];
#pragma unroll
  for (int r = 0; r < 16; ++r) rli[r] = __builtin_amdgcn_rcpf(li_l[crow(r, hi)]);
  bf16_t* Ow = Ob + (long)(wid * QBLK) * LDO;
#pragma unroll
  for (int r = 0; r < 16; ++r) { int orow = crow(r, hi);
#pragma unroll
    for (int d0 = 0; d0 < 8; ++d0) Ow[(long)orow * LDO + d0 * 32 + r32] = (bf16_t)(cvtpk(o[d0][r] * rli[r], 0.f) & 0xffff); }
#undef STAGE
  __syncthreads();
}
}

struct Ctx {
  int tid, wid, lane, blk, nblk, gwave, nwave; long gtid, nthr;
};

__device__ __forceinline__ const float* modp(const Params& p, int l, int v, int j) { return (const float*)(p.ws + OFF_MOD) + ((size_t)(l * 5 + v) * NMODC + (size_t)j * DM); }

__device__ __forceinline__ void convert_weights(const Params& p, const Ctx& c, int l, float* lds) {
  constexpr int T0 = 14 * 32, T1 = 8 * 32, T2 = 44 * 32, T3 = 8 * 88, T4 = 2 * 8, TALL = T0 + T1 + T2 + T3 + T4;
  for (int it = c.blk; it < TALL; it += c.nblk) {
    int mat, ti = it;
    if (ti < T0) mat = 0; else if ((ti -= T0) < T1) mat = 1; else if ((ti -= T1) < T2) mat = 2; else if ((ti -= T2) < T3) mat = 3; else { ti -= T3; mat = 4; }
    const float* src; long ld; bf16_t* dst; long dld; int nkt;
    if (mat == 0) { src = p.w_in + (size_t)l * DM * 4096; ld = 4096; dst = (bf16_t*)(p.ws + OFF_WIN); dld = DM; nkt = 32; }
    else if (mat == 1) { src = p.w_out + (size_t)l * DM * DM; ld = DM; dst = (bf16_t*)(p.ws + OFF_WOUT); dld = DM; nkt = 32; }
    else if (mat == 2) { src = p.w_gate + (size_t)l * DM * DFF; ld = DFF; dst = (bf16_t*)(p.ws + OFF_WGU); dld = DM; nkt = 32; }
    else if (mat == 3) { src = p.w_down + (size_t)l * DFF * DM; ld = DM; dst = (bf16_t*)(p.ws + OFF_WD); dld = DFF; nkt = 88; }
    else { src = p.w_glu + (size_t)l * 512 * 512; ld = 512; dst = (bf16_t*)(p.ws + OFF_WGLU); dld = 512; nkt = 8; }
    const int n0 = (ti / nkt) * 256, k0 = (ti % nkt) * 64;
    {
      const int nn = c.tid & 255, kk0 = c.tid >> 8, np = n0 + nn; int scol = np;
      if (mat == 0) { if (np < 2048) { const int ph = np & 127; scol = (np & ~127) | (ph & 64) | (((ph >> 2) & 1) << 5) | (((ph >> 5) & 1) << 4) | (((ph >> 3) & 3) << 2) | (ph & 3); } }
      else if (mat == 2) { const int pn = np >> 8, bj = (np >> 7) & 1; scol = pn * 128 + (np & 127); if (bj) src = p.w_up + (size_t)l * DM * DFF; }
      const float* sp = src + (size_t)(k0 + kk0) * ld + scol; float v[32];
#pragma unroll
      for (int i = 0; i < 32; ++i) v[i] = sp[(size_t)(2 * i) * ld];
#pragma unroll
      for (int i = 0; i < 32; ++i) lds[(kk0 + 2 * i) * 257 + nn] = v[i];
    }
    __syncthreads();
    {
      const int kc = (c.tid & 7) * 8;
#pragma unroll
      for (int j = 0; j < 4; ++j) { const int nn = (c.tid >> 3) + 64 * j; float v[8];
#pragma unroll
        for (int i = 0; i < 8; ++i) v[i] = lds[(kc + i) * 257 + nn];
        u32x4 w = {cvtpk(v[0], v[1]), cvtpk(v[2], v[3]), cvtpk(v[4], v[5]), cvtpk(v[6], v[7])};
        *(u32x4*)(dst + (size_t)(n0 + nn) * dld + k0 + kc) = w; }
    }
    __syncthreads();
  }
}

__device__ __forceinline__ void fold_four(const Params& p, const Ctx& c, int l, float* lds) {
  float* WlT = lds;
  float* Wc = lds + 128 * 68;
  const float* wcs = (const float*)(p.ws + OFF_WCS) + (size_t)l * 2 * 4 * 128 * 128;
  bf16_t* dstb = (bf16_t*)(p.ws + OFF_WIN);
  for (int u = c.blk; u < 256; u += c.nblk) {
    const int kt = u & 31, cs = (u >> 5) & 1, g = u >> 6, k0 = kt * 64;
    const float* src = p.w_in + (size_t)l * DM * 4096 + 3584 + g * 128;
    for (int i = c.tid; i < 64 * 128; i += NTHREADS) { const int kk = i >> 7, cc = i & 127; WlT[cc * 68 + kk] = src[(size_t)(k0 + kk) * 4096 + cc]; }
    const float* wsrc = wcs + (size_t)(cs * 4 + g) * 128 * 128;
    for (int i = c.tid; i < 128 * 128; i += NTHREADS) Wc[i] = wsrc[i];
    __syncthreads();
    const int kq = c.tid & 15, dq = c.tid >> 4;
    f32x4 acc[4] = {};
    for (int cc = 0; cc < 128; ++cc) {
      const f32x4 a = *(const f32x4*)(WlT + cc * 68 + kq * 4), w = *(const f32x4*)(Wc + cc * 128 + dq * 4);
#pragma unroll
      for (int di = 0; di < 4; ++di) acc[di] += a * w[di];
    }
#pragma unroll
    for (int di = 0; di < 4; ++di) { u32x2 o = {cvtpk(acc[di][0], acc[di][1]), cvtpk(acc[di][2], acc[di][3])};
      *(u32x2*)(dstb + (size_t)(3584 + cs * 512 + g * 128 + dq * 4 + di) * DM + k0 + kq * 4) = o; }
    __syncthreads();
  }
}


__device__ __forceinline__ void ssm_tables(const Params& p, const Ctx& c) {
  float2* PW = (float2*)(p.ws + OFF_PW); float2* BB = (float2*)(p.ws + OFF_BB);
  for (long i = c.gtid; i < 2L * 32 * 2 * 64; i += c.nthr) { const int pp = (int)(i & 63), idx = (int)(i >> 6);
    const int d = idx & 1, g = (idx >> 1) & 31, l = idx >> 6, iidx = (l * 2 + d) * 32 + g;
    const float lre = p.ssm_a_re[iidx * 64 + pp], lim = p.ssm_a_im[iidx * 64 + pp], dt = expf(p.ssm_log_dt[iidx]);
    float ar = 1.f, ai = 0.f;
    for (int j = 0; j <= 32; ++j) { const float mag = expf(lre * dt * (float)j); float sn, cs; my_sincos(lim * dt * (float)j, sn, cs);
      PW[((size_t)idx * 33 + j) * 64 + pp] = make_float2(mag * cs, mag * sn); if (j == 1) { ar = mag * cs; ai = mag * sn; } }
    const float nr = ar - 1.f, ni = ai, den = 1.f / (lre * lre + lim * lim), cr = (nr * lre + ni * lim) * den, ci = (ni * lre - nr * lim) * den;
    const float* br = p.ssm_b_re + ((size_t)iidx * 64 + pp) * 16; const float* bi = p.ssm_b_im + ((size_t)iidx * 64 + pp) * 16;
    for (int h = 0; h < 16; ++h) BB[((size_t)idx * 64 + pp) * 16 + h] = make_float2(cr * br[h] - ci * bi[h], cr * bi[h] + ci * br[h]); }
}
__device__ __forceinline__ void ssm_build_mef(const Params& p, const Ctx& c, int l) {
  const float2* PW = (const float2*)(p.ws + OFF_PW) + (size_t)l * 32 * 2 * 33 * 64; const float2* BB = (const float2*)(p.ws + OFF_BB) + (size_t)l * 32 * 2 * 64 * 16;
  float* MK = (float*)(p.ws + OFF_MK) + (size_t)l * 32 * 2 * 32 * 256; bf16_t* EM = (bf16_t*)(p.ws + OFF_EM); bf16_t* TF = (bf16_t*)(p.ws + OFF_TF);
  for (long i = c.gtid; i < 32L * 2 * 32 * 256; i += c.nthr) { const int hp = (int)(i & 15), h = (int)((i >> 4) & 15), j = (int)((i >> 8) & 31), gd = (int)(i >> 13), d = gd & 1, g = gd >> 1;
    const size_t ci = ((size_t)((l * 2 + d) * 32 + g) * 16 + h) * 64; const float2* pw = PW + ((size_t)gd * 33 + j) * 64; const float2* bb = BB + (size_t)gd * 64 * 16 + hp; float a = 0.f;
    for (int pp = 0; pp < 64; ++pp) { const float cr = p.ssm_c_re[ci + pp], cim = p.ssm_c_im[ci + pp]; const float2 b = bb[pp * 16], w = pw[pp];
      const float wr = cr * b.x - cim * b.y, wi = cr * b.y + cim * b.x; a += wr * w.x - wi * w.y; }
    MK[i] = a; }
  for (long i = c.gtid; i < 32L * 256 * 32 * 2; i += c.nthr) { const int hh = (int)(i & 1), s = (int)((i >> 1) & 31), n = (int)((i >> 6) & 255), g = (int)(i >> 14), ri = n & 1, pp = (n >> 1) & 63, d = n >> 7;
    const int gd = g * 2 + d, e = d ? s : 31 - s; const float2 w = PW[((size_t)gd * 33 + e) * 64 + pp]; const float2* bb = BB + ((size_t)gd * 64 + pp) * 16 + hh * 8; float v[8];
#pragma unroll
    for (int k = 0; k < 8; ++k) { const float2 b = bb[k]; v[k] = ri ? (w.x * b.y + w.y * b.x) : (w.x * b.x - w.y * b.y); }
    u32x4 o = {cvtpk(v[0], v[1]), cvtpk(v[2], v[3]), cvtpk(v[4], v[5]), cvtpk(v[6], v[7])}; *(u32x4*)(EM + ((size_t)g * 256 + n) * 512 + s * 16 + hh * 8) = o; }
  for (long i = c.gtid; i < 32L * 512 * 2 * 16; i += c.nthr) { const int pq = (int)(i & 15), d = (int)((i >> 4) & 1), n = (int)((i >> 5) & 511), g = (int)(i >> 14), h = n & 15, t = n >> 4;
    const int gd = g * 2 + d, f = d ? 32 - t : t + 1; const size_t ci = ((size_t)((l * 2 + d) * 32 + g) * 16 + h) * 64 + pq * 4; const float2* pw = PW + ((size_t)gd * 33 + f) * 64 + pq * 4; float v[8];
#pragma unroll
    for (int k = 0; k < 4; ++k) { const float cr = p.ssm_c_re[ci + k], cim = p.ssm_c_im[ci + k]; const float2 w = pw[k]; v[2 * k] = cr * w.x - cim * w.y; v[2 * k + 1] = -(cr * w.y + cim * w.x); }
    u32x4 o = {cvtpk(v[0], v[1]), cvtpk(v[2], v[3]), cvtpk(v[4], v[5]), cvtpk(v[6], v[7])}; *(u32x4*)(TF + ((size_t)g * 512 + n) * 768 + 512 + d * 128 + pq * 8) = o; }
}
__device__ __forceinline__ void ssm_build_t(const Params& p, const Ctx& c, int l) {
  const float* MK = (const float*)(p.ws + OFF_MK) + (size_t)l * 32 * 2 * 32 * 256; bf16_t* TF = (bf16_t*)(p.ws + OFF_TF);
  for (long i = c.gtid; i < 32L * 512 * 32 * 2; i += c.nthr) { const int hh = (int)(i & 1), s = (int)((i >> 1) & 31), n = (int)((i >> 6) & 511), g = (int)(i >> 15), h = n & 15, t = n >> 4;
    const int lag = t - s; float v[8];
    if (lag != 0) { const float* m = MK + ((size_t)((g * 2 + (lag < 0 ? 1 : 0)) * 32 + (lag < 0 ? -lag : lag)) * 16 + h) * 16 + hh * 8;
#pragma unroll
      for (int k = 0; k < 8; ++k) v[k] = m[k]; }
    else { const float* m0 = MK + ((size_t)((g * 2) * 32) * 16 + h) * 16 + hh * 8; const float* m1 = MK + ((size_t)((g * 2 + 1) * 32) * 16 + h) * 16 + hh * 8; const float dsk = p.ssm_d[(size_t)l * 512 + g * 16 + h];
#pragma unroll
      for (int k = 0; k < 8; ++k) v[k] = m0[k] + m1[k] + ((hh * 8 + k) == h ? dsk : 0.f); }
    u32x4 o = {cvtpk(v[0], v[1]), cvtpk(v[2], v[3]), cvtpk(v[4], v[5]), cvtpk(v[6], v[7])}; *(u32x4*)(TF + ((size_t)g * 512 + n) * 768 + s * 16 + hh * 8) = o; }
}
__device__ __forceinline__ void ssm_carry(const Params& p, const Ctx& c, int l) {
  if (c.wid != 0) return;
  const float2* PW = (const float2*)(p.ws + OFF_PW) + (size_t)l * 32 * 2 * 33 * 64; const float* SB = (const float*)(p.ws + OFF_Z2 + Z2_SB); bf16_t* UG = (bf16_t*)(p.ws + OFF_Z2 + Z2_UG);
  for (int i = c.blk * 64 + c.lane; i < NB * 32 * 2 * 64; i += c.nblk * 64) { const int pp = i & 63, d = (i >> 6) & 1, g = (i >> 7) & 31, b = i >> 12;
    const float2 a32 = PW[((size_t)(g * 2 + d) * 33 + 32) * 64 + pp]; float hr = 0.f, hi = 0.f;
    const size_t rbase = (size_t)g * 768 + b * 136; const int col = (d * 64 + pp) * 2;
#pragma unroll 8
    for (int k = 0; k < 136; ++k) { const int ch = d == 0 ? k : (k < 8 ? 7 - k : 143 - k);
      const float2 s = *(const float2*)(SB + (rbase + ch) * 256 + col);
      *(unsigned*)(UG + (rbase + ch) * 768 + 512 + col) = cvtpk(hr, hi);
      const float nr = a32.x * hr - a32.y * hi + s.x, ni = a32.x * hi + a32.y * hr + s.y; hr = nr; hi = ni; } }
}

__device__ __forceinline__ void phase0a(const Params& p, const Ctx& c, float* lds) {
  for (int i = c.tid; i < 5 * DM; i += NTHREADS) { const float v = i < 4 * DM ? p.c[i] : p.c_ctx[i - 4 * DM]; lds[i] = v * sigmoidf_(v); }
  __syncthreads();
  {
    float* MP = (float*)(p.ws + OFF_MP);
    for (long it = c.gtid; it < 16 * 6144; it += c.nthr) {
      const int cq = (int)(it % 6144), ks = (int)(it / 6144); const int gc = cq * 4, l = gc / NMODC, col = gc % NMODC;
      const float* wp = p.w_mod + ((size_t)l * DM + (size_t)ks * 128) * NMODC + col;
      f32x4 a[5] = {};
#pragma unroll 8
      for (int k = 0; k < 128; ++k) { const f32x4 w = *(const f32x4*)(wp + (size_t)k * NMODC);
#pragma unroll
        for (int v = 0; v < 5; ++v) a[v] += w * lds[v * DM + ks * 128 + k]; }
#pragma unroll
      for (int v = 0; v < 5; ++v) *(f32x4*)(MP + ((size_t)ks * 5 + v) * 24576 + gc) = a[v];
    }
  }
  __syncthreads();
  {
    float* rc = (float*)(p.ws + OFF_ROPE); float* rs = rc + 64 * 32;
    for (long i = c.gtid; i < 64 * 32; i += c.nthr) { const int pos = (int)(i >> 5), pp = (int)(i & 31);
      const float inv = (float)exp2(-(double)pp / 32.0 * 13.287712379549449); float s, cc; my_sincos((float)pos * inv, s, cc); rc[i] = cc; rs[i] = s; }
  }
  {
    bf16_t* DB = (bf16_t*)(p.ws + OFF_DFTC);
    for (long i = c.gtid; i < 256L * 64; i += c.nthr) { const int k = (int)(i >> 6), c0 = (int)(i & 63) * 8, part = c0 >> 8, t0 = c0 & 255; float v[8];
#pragma unroll
      for (int j = 0; j < 8; ++j) { const float ph = (float)((k * (t0 + j)) & 255) * (1.f / 256.f); v[j] = (part ? __builtin_amdgcn_sinf(ph) : __builtin_amdgcn_cosf(ph)) * (1.f / 16.f); }
      u32x4 w = {cvtpk(v[0], v[1]), cvtpk(v[2], v[3]), cvtpk(v[4], v[5]), cvtpk(v[6], v[7])}; *(u32x4*)(DB + i * 8) = w; }
  }
  {
    float* W = (float*)(p.ws + OFF_WCS);
    for (long i = c.gtid; i < 2L * 2 * 4 * 128 * 128; i += c.nthr) { const int d = (int)(i & 127), cc = (int)((i >> 7) & 127), g = (int)((i >> 14) & 3), cs = (int)((i >> 16) & 1), l = (int)(i >> 17);
      const float* wf = p.w_four + ((size_t)(l * 4 + g) * 128) * 128 + d; float a = 0.f;
      for (int j = 0; j < 128; ++j) { const float ph = (float)((j * cc) & 127) * (1.f / 128.f); a += (cs ? __builtin_amdgcn_sinf(ph) : __builtin_amdgcn_cosf(ph)) * wf[(size_t)j * 128]; }
      W[i] = a * 0.08838834764831845f; }
  }
}

__device__ __forceinline__ void reduce_mod(const Params& p, const Ctx& c) {
  const float* MP = (const float*)(p.ws + OFF_MP); float* MOD = (float*)(p.ws + OFF_MOD);
  for (long o = c.gtid; o < 5L * 24576; o += c.nthr) { const int v = (int)(o / 24576), gc = (int)(o % 24576), l = gc / NMODC, col = gc % NMODC;
    float a = p.b_mod[gc];
#pragma unroll
    for (int ks = 0; ks < 16; ++ks) a += MP[((size_t)ks * 5 + v) * 24576 + gc];
    MOD[(size_t)(l * 5 + v) * NMODC + col] = a; }
}

__device__ __forceinline__ void prenorm_row(const f32x4 (&x)[8], float rinv, const float* g, const float* sc, const float* sh, bf16_t* dst, int lane) {
#pragma unroll
  for (int i = 0; i < 8; ++i) { const int col = (lane + 64 * i) * 4; const f32x4 gg = *(const f32x4*)(g + col), s1 = *(const f32x4*)(sc + col), s0 = *(const f32x4*)(sh + col);
    const f32x4 y = (x[i] * rinv * gg) * (s1 + 1.f) + s0; u32x2 o = {cvtpk(y[0], y[1]), cvtpk(y[2], y[3])}; *(u32x2*)(dst + col) = o; }
}
__device__ __forceinline__ float sumsq8(const f32x4 (&x)[8]) { float s = 0.f;
#pragma unroll
  for (int i = 0; i < 8; ++i) s += x[i][0] * x[i][0] + x[i][1] * x[i][1] + x[i][2] * x[i][2] + x[i][3] * x[i][3];
  return wave_sum(s); }

typedef _Float16 h16x4 __attribute__((ext_vector_type(4)));
__device__ __forceinline__ f32x4 ldx(const _Float16* p) { const h16x4 h = *(const h16x4*)p; return __builtin_convertvector(h, f32x4); }
__device__ __forceinline__ void stx(_Float16* p, f32x4 v) { *(h16x4*)p = __builtin_convertvector(v, h16x4); }
__device__ __forceinline__ const float* xrow_src(const Params& p, int l, int b, int t, int row) {
  const float* base = t < CTXL ? p.ctx : p.x; const size_t off = t < CTXL ? ((size_t)b * CTXL + t) * DM : ((size_t)b * SEQ + (t - CTXL)) * DM; return base + off;
}
__device__ __forceinline__ void phase_prenorm(const Params& p, const Ctx& c, int l) {
  bf16_t* Hn = (bf16_t*)(p.ws + OFF_HN);
  for (int row = c.gwave; row < TT; row += c.nwave) { const int b = row / TPB, t = row % TPB, v = t < CTXL ? 4 : b;
    f32x4 x[8]; const f32x4* xr = (const f32x4*)xrow_src(p, l, b, t, row);
#pragma unroll
    for (int i = 0; i < 8; ++i) x[i] = xr[c.lane + 64 * i];
    const float rinv = rsqrtf(sumsq8(x) * (1.f / DM) + 1e-6f);
    prenorm_row(x, rinv, p.g_mix_pre + (size_t)l * DM, modp(p, l, v, 1), modp(p, l, v, 0), Hn + (size_t)row * DM, c.lane); }
}
__device__ __forceinline__ void phase_postmix(const Params& p, const Ctx& c, int l, bool last) {
  _Float16* X = (_Float16*)(p.ws + OFF_X); const bf16_t* MIX = (const bf16_t*)(p.ws + OFF_Z1); bf16_t* Hn = (bf16_t*)(p.ws + OFF_HN);
  for (int row = c.gwave; row < TT; row += c.nwave) { const int b = row / TPB, t = row % TPB, v = t < CTXL ? 4 : b; if (last && t < CTXL) continue;
    f32x4 m[8], x[8]; const u32x2* mr = (const u32x2*)(MIX + (size_t)row * DM); _Float16* xr = X + (size_t)row * DM; const f32x4* xs = (const f32x4*)xrow_src(p, 0, b, t, row);
    if (t < CTXL) { const u32x2* sl = (const u32x2*)(p.ws + OFF_Z2) + ((size_t)b * CTXL + t) * (DM / 4);
#pragma unroll
      for (int i = 0; i < 8; ++i) { m[i] = (f32x4){0.f, 0.f, 0.f, 0.f}; x[i] = xs[c.lane + 64 * i]; }
      for (int s = 0; s < 8; ++s) {
#pragma unroll
        for (int i = 0; i < 8; ++i) { const u32x2 w = sl[(size_t)s * NB * CTXL * (DM / 4) + c.lane + 64 * i]; m[i] += (f32x4){__uint_as_float(w[0] << 16), __uint_as_float(w[0] & 0xffff0000u), __uint_as_float(w[1] << 16), __uint_as_float(w[1] & 0xffff0000u)}; } } }
    else {
#pragma unroll
    for (int i = 0; i < 8; ++i) { const u32x2 w = mr[c.lane + 64 * i]; m[i] = (f32x4){__uint_as_float(w[0] << 16), __uint_as_float(w[0] & 0xffff0000u), __uint_as_float(w[1] << 16), __uint_as_float(w[1] & 0xffff0000u)}; x[i] = (l == 0) ? xs[c.lane + 64 * i] : ldx(xr + (c.lane + 64 * i) * 4); } }
    const float r1 = rsqrtf(sumsq8(m) * (1.f / DM) + 1e-6f); const float* gp = p.g_mix_post + (size_t)l * DM; const float* m2 = modp(p, l, v, 2);
#pragma unroll
    for (int i = 0; i < 8; ++i) { const int col = (c.lane + 64 * i) * 4; x[i] += *(const f32x4*)(m2 + col) * (m[i] * r1 * *(const f32x4*)(gp + col)); stx(xr + col, x[i]); }
    const float r2 = rsqrtf(sumsq8(x) * (1.f / DM) + 1e-6f);
    prenorm_row(x, r2, p.g_ffn_pre + (size_t)l * DM, modp(p, l, v, 4), modp(p, l, v, 3), Hn + (size_t)row * DM, c.lane); }
}
__device__ __forceinline__ void phase_postffn(const Params& p, const Ctx& c, int l, bool last) {
  _Float16* X = (_Float16*)(p.ws + OFF_X); const bf16_t* F = (const bf16_t*)(p.ws + OFF_Z1 + (size_t)TT * DM * 2); bf16_t* Hn = (bf16_t*)(p.ws + OFF_HN);
  for (int row = c.gwave; row < TT; row += c.nwave) { const int b = row / TPB, t = row % TPB, v = t < CTXL ? 4 : b; if (last && t < CTXL) continue;
    f32x4 m[8], x[8]; const u32x2* mr = (const u32x2*)(F + (size_t)row * DM); _Float16* xr = X + (size_t)row * DM;
    if (t < CTXL) { const u32x2* sl = (const u32x2*)(p.ws + OFF_Z1) + ((size_t)b * CTXL + t) * (DM / 4);
#pragma unroll
      for (int i = 0; i < 8; ++i) { m[i] = (f32x4){0.f, 0.f, 0.f, 0.f}; x[i] = ldx(xr + (c.lane + 64 * i) * 4); }
      for (int s = 0; s < 11; ++s) {
#pragma unroll
        for (int i = 0; i < 8; ++i) { const u32x2 w = sl[(size_t)s * NB * CTXL * (DM / 4) + c.lane + 64 * i]; m[i] += (f32x4){__uint_as_float(w[0] << 16), __uint_as_float(w[0] & 0xffff0000u), __uint_as_float(w[1] << 16), __uint_as_float(w[1] & 0xffff0000u)}; } } }
    else {
#pragma unroll
    for (int i = 0; i < 8; ++i) { const u32x2 w = mr[c.lane + 64 * i]; m[i] = (f32x4){__uint_as_float(w[0] << 16), __uint_as_float(w[0] & 0xffff0000u), __uint_as_float(w[1] << 16), __uint_as_float(w[1] & 0xffff0000u)}; x[i] = ldx(xr + (c.lane + 64 * i) * 4); } }
    const float r1 = rsqrtf(sumsq8(m) * (1.f / DM) + 1e-6f); const float* gp = p.g_ffn_post + (size_t)l * DM; const float* m5 = modp(p, l, v, 5);
#pragma unroll
    for (int i = 0; i < 8; ++i) { const int col = (c.lane + 64 * i) * 4; x[i] += *(const f32x4*)(m5 + col) * (m[i] * r1 * *(const f32x4*)(gp + col)); }
    if (last) { f32x4* o = (f32x4*)(p.out + ((size_t)b * SEQ + (t - CTXL)) * DM);
#pragma unroll
      for (int i = 0; i < 8; ++i) o[c.lane + 64 * i] = x[i]; }
    else {
#pragma unroll
      for (int i = 0; i < 8; ++i) stx(xr + (c.lane + 64 * i) * 4, x[i]);
      const float r2 = rsqrtf(sumsq8(x) * (1.f / DM) + 1e-6f);
      prenorm_row(x, r2, p.g_mix_pre + (size_t)(l + 1) * DM, modp(p, l + 1, v, 1), modp(p, l + 1, v, 0), Hn + (size_t)row * DM, c.lane); } }
}

typedef f32x4 Acc[2][2][4][2];
__device__ __forceinline__ int lat_pm(int i) { return (i >> 4) * 17 + 1 + (i & 15); }

struct SchedMN {
  const char* A; const char* B; size_t strA, strB;
  int nM, nN, pn0, latonly, nextra, blk, nblk;
  __device__ __forceinline__ bool next(int i, gm::Unit& u) const {
    const int it = i * nblk + blk, nmain = nM * nN;
    if (it < nmain) { gm::tile_of(it, nM, nN, u.pm, u.pn); if (latonly) u.pm = lat_pm(u.pm); u.pn += pn0; return true; }
    if (it < nmain + nextra) { const int j = it - nmain; u.pm = (j / 10) * 17; u.pn = 4 + (j % 10); return true; }
    return false;
  }
  __device__ __forceinline__ const char* pA(const gm::Unit& u) const { return A + (size_t)u.pm * strA; }
  __device__ __forceinline__ const char* pB(const gm::Unit& u) const { return B + (size_t)u.pn * strB; }
};

struct EpiIn {
  bf16_t *Qb, *Kb, *Vb, *UG, *PT; const float *rc, *rs;
  __device__ __forceinline__ void operator()(const Acc& acc, const gm::Unit& u, int wr, int wc, int fr, int fq) const {
    const int pm = u.pm, pn = u.pn; const bool isctx = (pm % 17) == 0; const int brow = pm * 256;
#pragma unroll
    for (int ai = 0; ai < 2; ++ai)
#pragma unroll
      for (int m = 0; m < 4; ++m) { const int row = brow + ai * 128 + wr * 64 + m * 16 + fr;
        if (pn < 8) { bf16_t* dst = Qb + (size_t)(pn >> 2) * TT * 1024 + (size_t)row * 1024 + (pn & 3) * 256 + wc * 32 + fq * 8;
          f32x4 cs = {1.f, 1.f, 1.f, 1.f}, sn = {0.f, 0.f, 0.f, 0.f};
          if (!isctx) { const int tl = (row % TPB) - CTXL; const int pos = (wc >> 1) ? (tl & 63) : (tl >> 6); const int p0 = (wc & 1) * 16 + fq * 4;
            cs = *(const f32x4*)(rc + pos * 32 + p0); sn = *(const f32x4*)(rs + pos * 32 + p0); }
#pragma unroll
          for (int bj = 0; bj < 2; ++bj) { const f32x4 v1 = acc[ai][bj][m][0], v2 = acc[ai][bj][m][1]; const f32x4 o1 = v1 * cs - v2 * sn, o2 = v2 * cs + v1 * sn;
            u32x4 w = {cvtpk(o1[0], o1[1]), cvtpk(o1[2], o1[3]), cvtpk(o2[0], o2[1]), cvtpk(o2[2], o2[3])}; *(u32x4*)(dst + bj * 128) = w; } }
        else if (pn < 12) { bf16_t* dst = Vb + (size_t)row * 1024 + (pn - 8) * 256 + wc * 32 + fq * 8;
#pragma unroll
          for (int bj = 0; bj < 2; ++bj) { const f32x4 v0 = acc[ai][bj][m][0], v1 = acc[ai][bj][m][1]; u32x4 w = {cvtpk(v0[0], v0[1]), cvtpk(v0[2], v0[3]), cvtpk(v1[0], v1[1]), cvtpk(v1[2], v1[3])}; *(u32x4*)(dst + bj * 128) = w; } }
        else if (pn < 14) { const int b = row / TPB, t = row % TPB; bf16_t* dst = UG + ((size_t)(b * 136 + (t >> 5))) * 768 + (t & 31) * 16 + ((fq * 8) & 15);
#pragma unroll
          for (int bj = 0; bj < 2; ++bj) { const int g = ((pn - 12) * 256 + bj * 128 + wc * 32 + fq * 8) >> 4; const f32x4 v0 = acc[ai][bj][m][0], v1 = acc[ai][bj][m][1];
            u32x4 w = {cvtpk(v0[0], v0[1]), cvtpk(v0[2], v0[3]), cvtpk(v1[0], v1[1]), cvtpk(v1[2], v1[3])}; *(u32x4*)(dst + (size_t)g * 768 * 768) = w; } }
        else {
          const int b = pm / 17, tt = pm % 17, part = (pn - 14) >> 1; const size_t cb = (size_t)(part * NB + b) * 512 + (pn & 1) * 256; const size_t ld = tt == 0 ? 256 : 4096;
          bf16_t* dstm = PT + (tt == 0 ? (size_t)2 * NB * 512 * 4096 + cb * 256 : cb * 4096 + (size_t)(tt - 1) * 256) + ai * 128 + wr * 64 + m * 16 + fr;
#pragma unroll
          for (int bj = 0; bj < 2; ++bj)
#pragma unroll
            for (int n = 0; n < 2; ++n) { const f32x4 v = acc[ai][bj][m][n]; const unsigned w0 = cvtpk(v[0], v[1]), w1 = cvtpk(v[2], v[3]); bf16_t* d = dstm + (size_t)(bj * 128 + wc * 32 + fq * 8 + n * 4) * ld;
              d[0] = (bf16_t)(w0 & 0xffff); d[ld] = (bf16_t)(w0 >> 16); d[2 * ld] = (bf16_t)(w1 & 0xffff); d[3 * ld] = (bf16_t)(w1 >> 16); } } }
  }
};
__device__ __forceinline__ void phase_gemm_in(const Params& p, const Ctx& c, int l, LAS unsigned char* lds) {
  SchedMN S; S.A = p.ws + OFF_HN; S.B = p.ws + OFF_WIN; S.strA = (size_t)256 * DM * 2; S.strB = (size_t)256 * DM * 2; S.blk = c.blk; S.nblk = c.nblk;
  S.nM = l == 0 ? 68 : 64; S.latonly = l == 0 ? 0 : 1;
  { S.nN = 18; S.pn0 = 0; S.nextra = l == 0 ? 0 : 40;
    EpiIn E; E.PT = (bf16_t*)(p.ws + OFF_Z2 + Z2_CAT); E.Qb = (bf16_t*)(p.ws + OFF_Z1 + Z1_Q); E.Kb = (bf16_t*)(p.ws + OFF_Z1 + Z1_K); E.Vb = (bf16_t*)(p.ws + OFF_Z1 + Z1_V); E.UG = (bf16_t*)(p.ws + OFF_Z2 + Z2_UG);
    E.rc = (const float*)(p.ws + OFF_ROPE); E.rs = E.rc + 64 * 32;
    gm::gemm_phase<true, true>(lds, DM, DM, DM, S, E); }
}

__device__ __forceinline__ void fourier_stage_a(const Params& p, const Ctx& c, int l) {
  const bf16_t* PT = (const bf16_t*)(p.ws + OFF_Z2 + Z2_CAT); bf16_t* Y = (bf16_t*)(p.ws + OFF_Z2 + Z2_FC);
  constexpr float C16[16] = {1.f, 0.92387953251f, 0.70710678119f, 0.38268343237f, 0.f, -0.38268343237f, -0.70710678119f, -0.92387953251f, -1.f, -0.92387953251f, -0.70710678119f, -0.38268343237f, 0.f, 0.38268343237f, 0.70710678119f, 0.92387953251f};
  constexpr float S16[16] = {0.f, 0.38268343237f, 0.70710678119f, 0.92387953251f, 1.f, 0.92387953251f, 0.70710678119f, 0.38268343237f, 0.f, -0.38268343237f, -0.70710678119f, -0.92387953251f, -1.f, -0.92387953251f, -0.70710678119f, -0.38268343237f};
  for (long i = c.gtid; i < (long)NB * 512 * 256; i += c.nthr) { const int t2 = (int)(i & 255), ch = (int)((i >> 8) & 511), b = (int)(i >> 17);
    const bf16_t* Pb = PT + ((size_t)(0 * NB + b) * 512 + ch) * 4096 + t2; const bf16_t* Qb = PT + ((size_t)(1 * NB + b) * 512 + ch) * 4096 + t2;
    float zr[16], zq[16];
#pragma unroll
    for (int t1 = 0; t1 < 16; ++t1) { zr[t1] = bf2f(Pb[256 * t1]); zq[t1] = bf2f(Qb[256 * t1]); }
    bf16_t* Yo = Y + ((size_t)(b * 16) * 512 + ch) * 512 + t2;
#pragma unroll
    for (int k1 = 0; k1 < 16; ++k1) { float ar = 0.f, ai = 0.f;
#pragma unroll
      for (int t1 = 0; t1 < 16; ++t1) { const float cc = C16[(k1 * t1) & 15], ss = S16[(k1 * t1) & 15]; ar += zr[t1] * cc - zq[t1] * ss; ai -= zr[t1] * ss + zq[t1] * cc; }
      const float ph = (float)(k1 * t2) * (1.f / 4096.f), ct = __builtin_amdgcn_cosf(ph), st = __builtin_amdgcn_sinf(ph);
      const float yr = (ar * ct + ai * st) * 0.25f, yi = (ai * ct - ar * st) * 0.25f;
      bf16_t* yo = Yo + (size_t)k1 * 512 * 512; const unsigned w = cvtpk(yr, yi); yo[0] = (bf16_t)(w & 0xffff); yo[256] = (bf16_t)(w >> 16); } }
  if (l == 0) {
    const bf16_t* PC = PT + (size_t)2 * NB * 512 * 4096;
    for (long i = c.gtid; i < (long)NB * 512 * 64; i += c.nthr) { const int t0 = (int)(i & 31) * 8, ri = (int)((i >> 5) & 1), ch = (int)((i >> 6) & 511), b = (int)(i >> 15);
      u32x4 w = *(const u32x4*)(PC + ((size_t)(ri * NB + b) * 512 + ch) * 256 + t0); if (ri) { w[0] ^= 0x80008000u; w[1] ^= 0x80008000u; w[2] ^= 0x80008000u; w[3] ^= 0x80008000u; }
      *(u32x4*)(Y + ((size_t)32768 + b * 512 + ch) * 512 + ri * 256 + t0) = w; } }
}
struct SchedFB { const char *DB, *Y; int nunits, blk, nblk;
  __device__ __forceinline__ bool next(int i, gm::Unit& u) const { const int it = i * nblk + blk; if (it >= nunits) return false; u.pm = it; u.pn = 0; return true; }
  __device__ __forceinline__ const char* pA(const gm::Unit&) const { return DB; }
  __device__ __forceinline__ const char* pB(const gm::Unit& u) const { const int it = u.pm; const size_t row = it < 128 ? (size_t)it * 256 : (size_t)32768 + (it - 128) * 256; return Y + row * 1024; } };
struct EpiFB { bf16_t* Cat; const float* bf;
  __device__ __forceinline__ void operator()(const Acc& acc, const gm::Unit& u, int wr, int wc, int fr, int fq) const { const int it = u.pm;
    int b, tok0, tstride, chb; if (it < 128) { b = it >> 5; const int pn = it & 31; tok0 = CTXL + (pn >> 1); tstride = 16; chb = (pn & 1) * 256; } else { const int j = it - 128; b = j >> 1; tok0 = 0; tstride = 1; chb = (j & 1) * 256; }
#pragma unroll
    for (int ai = 0; ai < 2; ++ai)
#pragma unroll
      for (int m = 0; m < 4; ++m) { const int k2 = ai * 128 + wr * 64 + m * 16 + fr; bf16_t* dr = Cat + ((size_t)b * TPB + tok0 + tstride * k2) * DM + 1536 + chb + wc * 32 + fq * 4;
#pragma unroll
        for (int bj = 0; bj < 2; ++bj)
#pragma unroll
          for (int n = 0; n < 2; ++n) { const f32x4 v = acc[ai][bj][m][n] + *(const f32x4*)(bf + chb + bj * 128 + wc * 32 + n * 16 + fq * 4); u32x2 w = {cvtpk(v[0], v[1]), cvtpk(v[2], v[3])}; *(u32x2*)(dr + bj * 128 + n * 16) = w; } }
  } };
__device__ __forceinline__ void fourier_stage_b(const Params& p, const Ctx& c, int l, LAS unsigned char* lds) {
  const SchedFB S{p.ws + OFF_DFTC, p.ws + OFF_Z2 + Z2_FC, l == 0 ? 136 : 128, c.blk, c.nblk}; const EpiFB E{(bf16_t*)(p.ws + OFF_Z2 + Z2_CAT), p.b_four + (size_t)l * 512};
  gm::gemm_phase<true>(lds, 512, 512, 512, S, E);
}

struct SchedSsmS { const char *UG, *EM; int blk, nblk;
  __device__ __forceinline__ bool next(int i, gm::Unit& u) const { const int it = i * nblk + blk; if (it >= 96) return false; u.pm = it; u.pn = 0; return true; }
  __device__ __forceinline__ const char* pA(const gm::Unit& u) const { const int g = u.pm / 3, pm = u.pm % 3; return UG + ((size_t)g * 768 + pm * 256) * 768 * 2; }
  __device__ __forceinline__ const char* pB(const gm::Unit& u) const { const int g = u.pm / 3; return EM + (size_t)g * 256 * 512 * 2; } };
struct EpiSsmS { float* SB;
  __device__ __forceinline__ void operator()(const Acc& acc, const gm::Unit& u, int wr, int wc, int fr, int fq) const { const int g = u.pm / 3, pm = u.pm % 3;
#pragma unroll
    for (int ai = 0; ai < 2; ++ai)
#pragma unroll
      for (int m = 0; m < 4; ++m) { const int r = pm * 256 + ai * 128 + wr * 64 + m * 16 + fr; if (r >= 544) continue; float* dr = SB + ((size_t)g * 768 + r) * 256 + wc * 32 + fq * 4;
#pragma unroll
        for (int bj = 0; bj < 2; ++bj)
#pragma unroll
          for (int n = 0; n < 2; ++n) *(f32x4*)(dr + bj * 128 + n * 16) = acc[ai][bj][m][n]; }
  } };
__device__ __forceinline__ void phase_ssm_states(const Params& p, const Ctx& c, LAS unsigned char* lds) {
  const SchedSsmS S{p.ws + OFF_Z2 + Z2_UG, p.ws + OFF_EM, c.blk, c.nblk}; const EpiSsmS E{(float*)(p.ws + OFF_Z2 + Z2_SB)};
  gm::gemm_phase<true>(lds, 768, 512, 512, S, E);
}
struct SchedSsmY { const char *UG, *TF; int blk, nblk;
  __device__ __forceinline__ bool next(int i, gm::Unit& u) const { const int it = i * nblk + blk; if (it >= 192) return false; u.pm = it >> 1; u.pn = it & 1; return true; }
  __device__ __forceinline__ const char* pA(const gm::Unit& u) const { const int g = u.pm / 3, pm = u.pm % 3; return UG + ((size_t)g * 768 + pm * 256) * 768 * 2; }
  __device__ __forceinline__ const char* pB(const gm::Unit& u) const { const int g = u.pm / 3; return TF + ((size_t)g * 512 + u.pn * 256) * 768 * 2; } };
struct EpiSsmY { bf16_t* Gg; int last;
  __device__ __forceinline__ void operator()(const Acc& acc, const gm::Unit& u, int wr, int wc, int fr, int fq) const { const int g = u.pm / 3, pm = u.pm % 3;
#pragma unroll
    for (int ai = 0; ai < 2; ++ai)
#pragma unroll
      for (int m = 0; m < 4; ++m) { const int r = pm * 256 + ai * 128 + wr * 64 + m * 16 + fr; if (r >= 544) continue; const int b = r / 136, ch = r % 136; if (last && ch < 8) continue;
        bf16_t* dr = Gg + ((size_t)b * TPB + ch * 32) * 512 + g * 16 + ((fq * 4) & 15);
#pragma unroll
        for (int bj = 0; bj < 2; ++bj)
#pragma unroll
          for (int n = 0; n < 2; ++n) { const int t = (u.pn * 256 + bj * 128 + wc * 32 + n * 16 + fq * 4) >> 4; const f32x4 y = acc[ai][bj][m][n];
            u32x2 w = {cvtpk(gelu_tanh(y[0]), gelu_tanh(y[1])), cvtpk(gelu_tanh(y[2]), gelu_tanh(y[3]))}; *(u32x2*)(dr + (size_t)t * 512) = w; } }
  } };
__device__ __forceinline__ void phase_ssm_y(const Params& p, const Ctx& c, bool last, LAS unsigned char* lds) {
  const SchedSsmY S{p.ws + OFF_Z2 + Z2_UG, p.ws + OFF_TF, c.blk, c.nblk}; const EpiSsmY E{(bf16_t*)(p.ws + OFF_Z2 + Z2_GG), last ? 1 : 0};
  gm::gemm_phase<true>(lds, 768, 768, 768, S, E);
}

struct EpiGlu {
  const bf16_t* Gg; bf16_t* Cat; const float* bg;
  __device__ __forceinline__ void operator()(const Acc& acc, const gm::Unit& u, int wr, int wc, int fr, int fq) const { const int pm = u.pm, pn = u.pn;
#pragma unroll
    for (int ai = 0; ai < 2; ++ai)
#pragma unroll
      for (int m = 0; m < 4; ++m) { const int row = pm * 256 + ai * 128 + wr * 64 + m * 16 + fr;
#pragma unroll
        for (int bj = 0; bj < 2; ++bj)
#pragma unroll
          for (int n = 0; n < 2; ++n) { const int col = pn * 256 + bj * 128 + wc * 32 + n * 16 + fq * 4; const f32x4 z = acc[ai][bj][m][n] + *(const f32x4*)(bg + col);
            const u32x2 gw = *(const u32x2*)(Gg + (size_t)row * 512 + col);
            const float g0 = __uint_as_float(gw[0] << 16), g1 = __uint_as_float(gw[0] & 0xffff0000u), g2 = __uint_as_float(gw[1] << 16), g3 = __uint_as_float(gw[1] & 0xffff0000u);
            u32x2 w = {cvtpk(g0 * sigmoidf_(z[0]), g1 * sigmoidf_(z[1])), cvtpk(g2 * sigmoidf_(z[2]), g3 * sigmoidf_(z[3]))};
            *(u32x2*)(Cat + (size_t)row * DM + 1024 + col) = w; } }
  }
};
__device__ __forceinline__ void phase_glu(const Params& p, const Ctx& c, int l, bool last, LAS unsigned char* lds) {
  SchedMN S; S.A = p.ws + OFF_Z2 + Z2_GG; S.B = p.ws + OFF_WGLU; S.strA = (size_t)256 * 512 * 2; S.strB = (size_t)256 * 512 * 2; S.blk = c.blk; S.nblk = c.nblk;
  S.nM = last ? 64 : 68; S.latonly = last ? 1 : 0; S.nN = 2; S.pn0 = 0; S.nextra = 0;
  EpiGlu E; E.Gg = (const bf16_t*)(p.ws + OFF_Z2 + Z2_GG); E.Cat = (bf16_t*)(p.ws + OFF_Z2 + Z2_CAT); E.bg = p.b_glu + (size_t)l * 512;
  gm::gemm_phase<true>(lds, 512, 512, 512, S, E);
}

struct EpiF32 {
  bf16_t* O;
  __device__ __forceinline__ void operator()(const Acc& acc, const gm::Unit& u, int wr, int wc, int fr, int fq) const {
    bf16_t* dst = O + (size_t)u.pm * 256 * DM + u.pn * 256 + wc * 32 + fq * 8;
#pragma unroll
    for (int ai = 0; ai < 2; ++ai)
#pragma unroll
      for (int m = 0; m < 4; ++m) { bf16_t* dr = dst + (size_t)(ai * 128 + wr * 64 + m * 16 + fr) * DM;
#pragma unroll
        for (int bj = 0; bj < 2; ++bj) { const f32x4 v0 = acc[ai][bj][m][0], v1 = acc[ai][bj][m][1]; u32x4 w = {cvtpk(v0[0], v0[1]), cvtpk(v0[2], v0[3]), cvtpk(v1[0], v1[1]), cvtpk(v1[2], v1[3])}; *(u32x4*)(dr + bj * 128) = w; } }
  }
};
struct SchedSplit { const char *A, *B; size_t strA, strB, kbytes; int nunits, blk, nblk;
  __device__ __forceinline__ bool next(int i, gm::Unit& u) const { const int it = i * nblk + blk; if (it >= nunits) return false; u.pm = it; u.pn = 0; return true; }
  __device__ __forceinline__ const char* pA(const gm::Unit& u) const { const int tile = u.pm & 31, sp = u.pm >> 5; return A + (size_t)((tile >> 3) * 17) * strA + sp * kbytes; }
  __device__ __forceinline__ const char* pB(const gm::Unit& u) const { const int tile = u.pm & 31, sp = u.pm >> 5; return B + (size_t)(tile & 7) * strB + sp * kbytes; } };
struct EpiAcc { bf16_t* SLAB;
  __device__ __forceinline__ void operator()(const Acc& acc, const gm::Unit& u, int wr, int wc, int fr, int fq) const { const int tile = u.pm & 31, sp = u.pm >> 5;
    bf16_t* dst = SLAB + ((size_t)sp * NB * CTXL + (tile >> 3) * 256) * DM + (tile & 7) * 256 + wc * 32 + fq * 8;
#pragma unroll
    for (int ai = 0; ai < 2; ++ai)
#pragma unroll
      for (int m = 0; m < 4; ++m) { bf16_t* dr = dst + (size_t)(ai * 128 + wr * 64 + m * 16 + fr) * DM;
#pragma unroll
        for (int bj = 0; bj < 2; ++bj) { const f32x4 v0 = acc[ai][bj][m][0], v1 = acc[ai][bj][m][1]; u32x4 w = {cvtpk(v0[0], v0[1]), cvtpk(v0[2], v0[3]), cvtpk(v1[0], v1[1]), cvtpk(v1[2], v1[3])}; *(u32x4*)(dr + bj * 128) = w; } }
  } };
template <int KK, int NSPLIT>
__device__ __forceinline__ void phase_gemm_f32out(const Params& p, const Ctx& c, bool last, const char* A, const char* W, char* outp, char* slab, LAS unsigned char* lds) {
  SchedMN S; S.A = A; S.B = W; S.strA = (size_t)256 * KK * 2; S.strB = (size_t)256 * KK * 2; S.blk = c.blk; S.nblk = c.nblk;
  S.nM = 64; S.latonly = 1; S.nN = 8; S.pn0 = 0; S.nextra = 0;
  EpiF32 E; E.O = (bf16_t*)outp;
  gm::gemm_phase<true, true>(lds, KK, KK, KK, S, E);
  if (!last) { const SchedSplit S2{A, W, (size_t)256 * KK * 2, (size_t)256 * KK * 2, (size_t)(KK / NSPLIT) * 2, 32 * NSPLIT, c.blk, c.nblk}; const EpiAcc E2{(bf16_t*)slab};
    gm::gemm_phase<true, true>(lds, KK, KK, KK / NSPLIT, S2, E2); }
}

struct EpiGU {
  bf16_t* ACT;
  __device__ __forceinline__ void operator()(const Acc& acc, const gm::Unit& u, int wr, int wc, int fr, int fq) const {
    bf16_t* dst = ACT + (size_t)u.pm * 256 * DFF + u.pn * 128 + wc * 32 + fq * 8;
#pragma unroll
    for (int ai = 0; ai < 2; ++ai)
#pragma unroll
      for (int m = 0; m < 4; ++m) { bf16_t* dr = dst + (size_t)(ai * 128 + wr * 64 + m * 16 + fr) * DFF; u32x4 w;
#pragma unroll
        for (int n = 0; n < 2; ++n) { const f32x4 g = acc[ai][0][m][n], uu = acc[ai][1][m][n];
          w[2 * n] = cvtpk(g[0] * sigmoidf_(g[0]) * uu[0], g[1] * sigmoidf_(g[1]) * uu[1]); w[2 * n + 1] = cvtpk(g[2] * sigmoidf_(g[2]) * uu[2], g[3] * sigmoidf_(g[3]) * uu[3]); }
        *(u32x4*)dr = w; }
  }
};
__device__ __forceinline__ void phase_gemm_gu(const Params& p, const Ctx& c, bool last, LAS unsigned char* lds) {
  SchedMN S; S.A = p.ws + OFF_HN; S.B = p.ws + OFF_WGU; S.strA = (size_t)256 * DM * 2; S.strB = (size_t)256 * DM * 2; S.blk = c.blk; S.nblk = c.nblk;
  S.nM = last ? 64 : 68; S.latonly = last ? 1 : 0; S.nN = 44; S.pn0 = 0; S.nextra = 0;
  EpiGU E; E.ACT = (bf16_t*)(p.ws + OFF_Z2);
  gm::gemm_phase<true, true>(lds, DM, DM, DM, S, E);
}

__device__ __forceinline__ void phase_attn(const Params& p, const Ctx& c, int l, char* lds) {
  const bf16_t* Qb = (const bf16_t*)(p.ws + OFF_Z1 + Z1_Q); const bf16_t* Kb = (const bf16_t*)(p.ws + OFF_Z1 + Z1_K); const bf16_t* Vb = (const bf16_t*)(p.ws + OFF_Z1 + Z1_V);
  bf16_t* O = (bf16_t*)(p.ws + OFF_HN);
  const int ntot = (l == 0) ? 512 + 32 : 512;
  for (int v = c.blk; v < ntot; v += c.nblk) {
    int combo, qb, seq;
    if (v < 512) { const int rd = v >> 8, w = v & 255; combo = rd * 16 + (w & 7) * 2 + ((w >> 3) >> 4); qb = 1 + ((w >> 3) & 15); seq = TPB; }
    else { combo = v - 512; qb = 0; seq = CTXL; }
    const int mp = combo & 1, h = (combo >> 1) & 3, b = combo >> 3;
    const size_t r0 = (size_t)b * TPB;
    at::body(Qb + (r0 + qb * 256) * 1024 + (h * 2 + mp) * 128, Kb + r0 * 1024 + (h * 2 + mp) * 128, Vb + r0 * 1024 + h * 256,
             O + (r0 + qb * 256) * DM + (h * 2 + mp) * 256, seq, lds);
  }
}

__device__ __forceinline__ void phase_combine(const Params& p, const Ctx& c, int l, bool last) {
  const bf16_t* O = (const bf16_t*)(p.ws + OFF_HN); bf16_t* Cat = (bf16_t*)(p.ws + OFF_Z2 + Z2_CAT);
  const float lam_init = 0.8f - 0.6f * expf(-0.3f * (float)l);
  float lam;
  { const float a1 = p.lam_q1[l * 128 + c.lane] * p.lam_k1[l * 128 + c.lane] + p.lam_q1[l * 128 + 64 + c.lane] * p.lam_k1[l * 128 + 64 + c.lane];
    const float a2 = p.lam_q2[l * 128 + c.lane] * p.lam_k2[l * 128 + c.lane] + p.lam_q2[l * 128 + 64 + c.lane] * p.lam_k2[l * 128 + 64 + c.lane];
    lam = expf(wave_sum(a1)) - expf(wave_sum(a2)) + lam_init; }
  const f32x4 gs = *(const f32x4*)(p.g_subln + (size_t)l * 256 + c.lane * 4);
  for (int row = c.gwave; row < TT; row += c.nwave) { const int t = row % TPB; if (last && t < CTXL) continue;
    const bf16_t* orow = O + (size_t)row * DM; bf16_t* crow_ = Cat + (size_t)row * DM;
#pragma unroll
    for (int h = 0; h < 4; ++h) { const u32x2 a = *(const u32x2*)(orow + (h * 2) * 256 + c.lane * 4), bq = *(const u32x2*)(orow + (h * 2 + 1) * 256 + c.lane * 4);
      f32x4 o; o[0] = __uint_as_float(a[0] << 16) - lam * __uint_as_float(bq[0] << 16); o[1] = __uint_as_float(a[0] & 0xffff0000u) - lam * __uint_as_float(bq[0] & 0xffff0000u);
      o[2] = __uint_as_float(a[1] << 16) - lam * __uint_as_float(bq[1] << 16); o[3] = __uint_as_float(a[1] & 0xffff0000u) - lam * __uint_as_float(bq[1] & 0xffff0000u);
      const float ss = wave_sum(o[0] * o[0] + o[1] * o[1] + o[2] * o[2] + o[3] * o[3]); const float r = rsqrtf(ss * (1.f / 256.f) + 1e-5f) * (1.f - lam_init);
      o = o * r * gs; u32x2 w = {cvtpk(o[0], o[1]), cvtpk(o[2], o[3])}; *(u32x2*)(crow_ + h * 256 + c.lane * 4) = w; }
  }
}


#define XB_TMO      128
#define XB_XCNT(j)  (256  + 64 * (j))
#define XB_XSUB(j)  (1280 + 64 * (j))
#define XB_XGEN(j)  (2304 + 64 * (j))
#define XB_TOP      3328
#define XB_TOPGEN   3392
#define XCD_BAR_WORDS 3456
#define XB_SPIN_CAP (1u << 18)
__device__ __forceinline__ unsigned xb_ld(unsigned* p)              { return __hip_atomic_load(p, __ATOMIC_RELAXED, __HIP_MEMORY_SCOPE_AGENT); }
__device__ __forceinline__ unsigned xb_add(unsigned* p, unsigned v) { return __hip_atomic_fetch_add(p, v, __ATOMIC_RELAXED, __HIP_MEMORY_SCOPE_AGENT); }
__device__ __forceinline__ unsigned xb_xcc_id() { return (unsigned)__builtin_amdgcn_s_getreg((3 << 11) | 20) & 0xFu; }
#define XB_SPIN(cond, bar) do { unsigned _sp = 0; while (cond) { __builtin_amdgcn_s_sleep(1); \
    if ((++_sp & 255u) == 0u) { if (xb_ld(&(bar)[XB_TMO])) break; if (_sp > XB_SPIN_CAP) { atomicAdd(&(bar)[XB_TMO], 1u); break; } } } } while (0)
struct XcdBarrier { unsigned* bar; unsigned x; volatile LAS unsigned* st; };
__device__ __forceinline__ XcdBarrier xcd_barrier_post(unsigned* bar, volatile LAS unsigned* st) {
  XcdBarrier b; b.bar = bar; b.x = xb_xcc_id(); b.st = st;
  if (threadIdx.x == 0) (void)xb_add(&bar[XB_XCNT(b.x)], 1u);
  return b;
}
__device__ __forceinline__ void xcd_barrier_complete(unsigned* bar, unsigned x, unsigned& nloc, unsigned& nx) {
  const unsigned G = gridDim.x * gridDim.y * gridDim.z;
  unsigned sum, cnt, mine, sp = 0u;
  for (;;) {
    sum = 0u; cnt = 0u; mine = 0u;
#pragma unroll
    for (unsigned j = 0; j < 16; ++j) { const unsigned c = xb_ld(&bar[XB_XCNT(j)]); sum += c; cnt += (c > 0u) ? 1u : 0u; mine = (j == x) ? c : mine; }
    if (sum == G) break;
    __builtin_amdgcn_s_sleep(1);
    if ((++sp & 255u) == 0u) { if (xb_ld(&bar[XB_TMO])) break; if (sp > XB_SPIN_CAP) { atomicAdd(&bar[XB_TMO], 1u); break; } }
  }
  nloc = mine > 0u ? mine : 1u; nx = cnt > 0u ? cnt : 1u;
}
__device__ __forceinline__ void xcd_barrier(const XcdBarrier& b) {
  asm volatile("s_waitcnt vmcnt(0)" ::: "memory");
  __syncthreads();
  if (threadIdx.x == 0) {
    unsigned* bar = b.bar;
    __builtin_amdgcn_s_waitcnt(0);
    unsigned nloc = b.st[0], nx = b.st[1];
    if (nloc == 0u) { xcd_barrier_complete(bar, b.x, nloc, nx); b.st[0] = nloc; b.st[1] = nx; }
    const unsigned old = xb_add(&bar[XB_XSUB(b.x)], 1u);
    const unsigned gen = old / nloc;
    if (old + 1u == (gen + 1u) * nloc) {
      __builtin_amdgcn_fence(__ATOMIC_RELEASE, "agent");
      asm volatile("s_waitcnt vmcnt(0)" ::: "memory");
      const unsigned og = xb_add(&bar[XB_TOP], 1u);
      const unsigned tg = og / nx;
      if (og + 1u == (tg + 1u) * nx) xb_add(&bar[XB_TOPGEN], 1u);
      else XB_SPIN(xb_ld(&bar[XB_TOPGEN]) == tg, bar);
      __builtin_amdgcn_fence(__ATOMIC_ACQUIRE, "agent");
      xb_add(&bar[XB_XGEN(b.x)], 1u);
      asm volatile("s_waitcnt vmcnt(0)" ::: "memory");
    } else {
      XB_SPIN(xb_ld(&bar[XB_XGEN(b.x)]) == gen, bar);
      __builtin_amdgcn_fence(__ATOMIC_ACQUIRE, "agent");
      asm volatile("s_waitcnt vmcnt(0)" ::: "memory");
    }
  }
  __syncthreads();
}

__global__ void __launch_bounds__(NTHREADS) mega(Params p_arg) {
  extern __shared__ __attribute__((aligned(16))) char shm[];
  __shared__ uint4 xb_words;
  cg::grid_group grid = cg::this_grid();
  typedef const __attribute__((address_space(4))) Params* KP;
  KP kp = (KP)__builtin_amdgcn_kernarg_segment_ptr();
  unsigned* bar = (unsigned*)(p_arg.ws + OFF_BAR);
  if (threadIdx.x == 0) xb_words = make_uint4(0u, 0u, 0u, 0u);
  if (p_arg.out == nullptr) grid.sync();
  if (threadIdx.x == 0) (void)xb_add(bar + XB_XCNT(xb_xcc_id()), 1u);
  __syncthreads();
  Ctx c;
#define RECTX() do { asm volatile("" : "+s"(kp)); int t_ = threadIdx.x; asm volatile("" : "+v"(t_)); int b_ = blockIdx.x; asm volatile("" : "+s"(b_)); \
    c.tid = t_; c.wid = t_ >> 6; c.lane = t_ & 63; c.blk = b_; c.nblk = gridDim.x; c.gwave = c.blk * 8 + c.wid; c.nwave = c.nblk * 8; \
    c.gtid = (long)c.blk * NTHREADS + c.tid; c.nthr = (long)c.nblk * NTHREADS; } while (0)
  RECTX();
  LAS unsigned char* gshm = (LAS unsigned char*)shm; float* fl = (float*)shm;

#define PP (*(const Params*)kp)
#define GSYNC() do { RECTX(); XcdBarrier xb_; xb_.bar = (unsigned*)(kp->ws + OFF_BAR); xb_.x = xb_xcc_id(); xb_.st = (volatile LAS unsigned*)&xb_words; xcd_barrier(xb_); } while (0)
  phase0a(PP, c, fl);
  RECTX(); ssm_tables(PP, c);
  RECTX(); convert_weights(PP, c, 0, fl);
  GSYNC();
  RECTX(); reduce_mod(PP, c);
  RECTX(); fold_four(PP, c, 0, fl);
  RECTX(); ssm_build_mef(PP, c, 0);
  GSYNC();
  RECTX(); ssm_build_t(PP, c, 0);
  RECTX(); phase_prenorm(PP, c, 0);
  GSYNC();
  for (int l = 0; l < 2; ++l) {
    const bool last = (l == 1);
    RECTX(); phase_gemm_in(PP, c, l, gshm);
    GSYNC();
    RECTX(); fourier_stage_a(PP, c, l);
    RECTX(); phase_ssm_states(PP, c, gshm);
    GSYNC();
    RECTX(); ssm_carry(PP, c, l);
    RECTX(); phase_attn(PP, c, l, shm);
    GSYNC();
    RECTX(); phase_ssm_y(PP, c, last, gshm);
    RECTX(); phase_combine(PP, c, l, last);
    GSYNC();
    RECTX(); phase_glu(PP, c, l, last, gshm);
    RECTX(); fourier_stage_b(PP, c, l, gshm);
    GSYNC();
    RECTX(); phase_gemm_f32out<DM, 8>(PP, c, last, kp->ws + OFF_Z2 + Z2_CAT, kp->ws + OFF_WOUT, kp->ws + OFF_Z1, kp->ws + OFF_Z2, gshm);
    GSYNC();
    if (!last) { RECTX(); ssm_build_mef(PP, c, 1); }
    RECTX(); phase_postmix(PP, c, l, last);
    GSYNC();
    RECTX(); phase_gemm_gu(PP, c, last, gshm);
    GSYNC();
    RECTX(); phase_gemm_f32out<DFF, 11>(PP, c, last, kp->ws + OFF_Z2, kp->ws + OFF_WD, kp->ws + OFF_Z1 + (size_t)TT * DM * 2, kp->ws + OFF_Z1, gshm);
    GSYNC();
    if (!last) { RECTX(); ssm_build_t(PP, c, 1); }
    RECTX(); phase_postffn(PP, c, l, last);
    if (!last) { RECTX(); convert_weights(PP, c, 1, fl); RECTX(); fold_four(PP, c, 1, fl); GSYNC(); }
  }
}

extern "C" void kernel_launch(void* const* d_in, const int* in_sizes, int n_in, void* d_out, int out_size, void* d_ws, size_t ws_size,
                              hipStream_t stream) {
  static int grid_blocks = 0;
  if (!grid_blocks) {
    (void)hipFuncSetAttribute((const void*)mega, hipFuncAttributeMaxDynamicSharedMemorySize, SHM_BYTES);
    int dev = 0, cus = 0, per_cu = 0;
    (void)hipGetDevice(&dev);
    (void)hipDeviceGetAttribute(&cus, hipDeviceAttributeMultiprocessorCount, dev);
    (void)hipOccupancyMaxActiveBlocksPerMultiprocessor(&per_cu, mega, NTHREADS, SHM_BYTES);
    if (per_cu < 1) per_cu = 1;
    grid_blocks = cus;
  }
  if (n_in != 32 || ws_size < WS_NEED) { fprintf(stderr, "kernel_launch: bad n_in %d or ws %zu < %zu\n", n_in, ws_size, WS_NEED); return; }
  Params p{};
  const float** f = (const float**)&p;
  for (int i = 0; i < 32; ++i) f[i] = (const float*)d_in[i];
  p.out = (float*)d_out; p.ws = (char*)d_ws;
  (void)hipMemsetAsync((char*)d_ws + OFF_BAR, 0, 16384, stream);
  void* args[] = {&p};
  hipError_t e = hipLaunchCooperativeKernel((void*)mega, dim3(grid_blocks), dim3(NTHREADS), args, SHM_BYTES, stream);
  if (e != hipSuccess) fprintf(stderr, "cooperative launch failed: %s (grid %d)\n", hipGetErrorString(e), grid_blocks);
}
```

```cpp
#include <hip/hip_runtime.h>
#include <hip/hip_cooperative_groups.h>
#include <cstdio>
#include <cstdint>
namespace cg = cooperative_groups;

typedef unsigned short bf16_t;
using bf16x8 = __attribute__((ext_vector_type(8))) short;
using s16x4  = __attribute__((ext_vector_type(4))) short;
using f32x4  = __attribute__((ext_vector_type(4))) float;
using f32x16 = __attribute__((ext_vector_type(16))) float;
using u32x4  = __attribute__((ext_vector_type(4))) unsigned;
using u32x2  = __attribute__((ext_vector_type(2))) unsigned;
#define LAS __attribute__((address_space(3)))

constexpr int NB = 4, SEQ = 4096, CTXL = 256, TPB = SEQ + CTXL  , TT = NB * TPB  ;
constexpr int DM = 2048, NIN = 4608, DFF = 5632, NMODC = 6 * DM  ;
constexpr int NTHREADS = 512, SHM_BYTES = 131072;

constexpr size_t al256(size_t x) { return (x + 255) / 256 * 256; }
constexpr size_t OFF_X    = 0;
constexpr size_t OFF_WIN  = OFF_X + (size_t)TT * DM * 2;
constexpr size_t OFF_WOUT = OFF_WIN + (size_t)NIN * DM * 2;
constexpr size_t OFF_WGU  = OFF_WOUT + (size_t)DM * DM * 2;
constexpr size_t OFF_WD   = OFF_WGU + (size_t)2 * DFF * DM * 2;
constexpr size_t OFF_WGLU = OFF_WD + (size_t)DM * DFF * 2;
constexpr size_t OFF_DFTL = OFF_WGLU + (size_t)512 * 512 * 2;
constexpr size_t OFF_DFTC = OFF_DFTL + (size_t)2 * 4096 * 4096 * 2;
constexpr size_t OFF_MP   = OFF_DFTC + (size_t)2 * 256 * 256 * 2;
constexpr size_t OFF_MOD  = OFF_MP + (size_t)16 * 5 * 24576 * 4;
constexpr size_t OFF_ROPE = OFF_MOD + (size_t)2 * 5 * NMODC * 4;
constexpr size_t OFF_WCS  = OFF_ROPE + (size_t)2 * 64 * 32 * 4;
constexpr size_t OFF_PW   = OFF_WCS + (size_t)2 * 2 * 4 * 128 * 128 * 4;
constexpr size_t OFF_BB   = OFF_PW + (size_t)2 * 32 * 2 * 33 * 64 * 8;
constexpr size_t OFF_MK   = OFF_BB + (size_t)2 * 32 * 2 * 64 * 16 * 8;
constexpr size_t OFF_TF   = OFF_MK + (size_t)2 * 32 * 2 * 32 * 256 * 4;
constexpr size_t OFF_EM   = OFF_TF + (size_t)32 * 512 * 768 * 2;
constexpr size_t OFF_BAR  = OFF_EM + (size_t)32 * 256 * 512 * 2;
constexpr size_t OFF_HN   = OFF_BAR + 16384;
constexpr size_t OFF_Z1   = OFF_HN + (size_t)TT * DM * 2;
constexpr size_t Z1_Q = 0, Z1_K = (size_t)TT * 1024 * 2, Z1_V = 2 * Z1_K;
constexpr size_t OFF_Z2   = OFF_Z1 + (size_t)TT * DM * 4;
constexpr size_t Z2_FC = 0, Z2_FS = Z2_FC + (size_t)TT * 512 * 4;
constexpr size_t Z2_UG = Z2_FS + (size_t)TT * 512 * 4;
constexpr size_t Z2_SB = Z2_UG + (size_t)32 * 768 * 768 * 2;
constexpr size_t Z2_CAT = Z2_SB + (size_t)32 * 768 * 256 * 4;
constexpr size_t Z2_GG = Z2_CAT + (size_t)TT * DM * 2;
constexpr size_t Z2_END = Z2_GG + (size_t)TT * 512 * 2;
constexpr size_t Z2_SIZE = Z2_END > (size_t)TT * DFF * 2 ? Z2_END : (size_t)TT * DFF * 2;
constexpr size_t WS_NEED = OFF_Z2 + Z2_SIZE;
static_assert(WS_NEED <= (size_t)805306368, "workspace over 768 MiB");


struct Params {
  const float *x, *c, *ctx, *c_ctx, *w_mod, *b_mod, *g_mix_pre, *g_mix_post, *g_ffn_pre, *g_ffn_post, *w_in, *w_out;
  const float *lam_q1, *lam_k1, *lam_q2, *lam_k2, *g_subln, *ssm_a_re, *ssm_a_im, *ssm_log_dt, *ssm_b_re, *ssm_b_im;
  const float *ssm_c_re, *ssm_c_im, *ssm_d, *w_glu, *b_glu, *w_four, *b_four, *w_gate, *w_up, *w_down;
  float* out; char* ws;
};

__device__ __forceinline__ unsigned cvtpk(float lo, float hi) { unsigned r; asm volatile("v_cvt_pk_bf16_f32 %0, %1, %2" : "=v"(r) : "v"(lo), "v"(hi)); return r; }
__device__ __forceinline__ float bf2f(unsigned short b) { return __uint_as_float((unsigned)b << 16); }
template <int CTRL> __device__ __forceinline__ float dpp_add(float v) { return v + __uint_as_float(__builtin_amdgcn_update_dpp(0u, __float_as_uint(v), CTRL, 0xf, 0xf, false)); }
__device__ __forceinline__ float wave_sum(float v) {
  v = dpp_add<0xB1>(v); v = dpp_add<0x4E>(v); v = dpp_add<0x141>(v); v = dpp_add<0x140>(v);
  const int vi = (int)__float_as_uint(v);
  return (__uint_as_float((unsigned)__builtin_amdgcn_readlane(vi, 0)) + __uint_as_float((unsigned)__builtin_amdgcn_readlane(vi, 16))) + (__uint_as_float((unsigned)__builtin_amdgcn_readlane(vi, 32)) + __uint_as_float((unsigned)__builtin_amdgcn_readlane(vi, 48)));
}
__device__ __forceinline__ void my_sincos(float x, float& s, float& c) {
  const double xd = (double)x; const double kd = rint(xd * 0.63661977236758134); const double r = xd - kd * 1.5707963267948966;
  const double r2 = r * r;
  const double sn = r * (1.0 - r2 / 6.0 * (1.0 - r2 / 20.0 * (1.0 - r2 / 42.0 * (1.0 - r2 / 72.0 * (1.0 - r2 / 110.0 * (1.0 - r2 / 156.0))))));
  const double cs = 1.0 - r2 / 2.0 * (1.0 - r2 / 12.0 * (1.0 - r2 / 30.0 * (1.0 - r2 / 56.0 * (1.0 - r2 / 90.0 * (1.0 - r2 / 132.0)))));
  const int q = ((int)kd) & 3;
  const double ss = (q == 0) ? sn : (q == 1) ? cs : (q == 2) ? -sn : -cs;
  const double cc = (q == 0) ? cs : (q == 1) ? -sn : (q == 2) ? -cs : sn;
  s = (float)ss; c = (float)cc;
}
__device__ __forceinline__ float sigmoidf_(float x) { return __builtin_amdgcn_rcpf(1.f + __builtin_amdgcn_exp2f(x * -1.4426950408889634f)); }
__device__ __forceinline__ float gelu_tanh(float y) { const float u = 0.7978845608028654f * (y + 0.044715f * y * y * y); return y * sigmoidf_(2.f * u); }

namespace gm {
constexpr int BM = 256, BK = 64, HALF = 128, HTB = HALF * BK * 2, NXCD = 8, WGM = 8;
__device__ __forceinline__ int lds_byte(int r, int c) { const int st = (r >> 4) * 2 + (c >> 5), rr = r & 15, cc = c & 31, ob = rr * 64 + cc * 2; return st * 1024 + (ob ^ (((ob >> 9) & 1) << 5)); }
__device__ __forceinline__ void stage_rc(int b, int& R, int& C) { const int st = b / 1024, sb = b % 1024, swz = sb ^ (((sb >> 9) & 1) << 5); R = (st >> 1) * 16 + swz / 64; C = (st & 1) * 32 + (swz % 64) / 2; }
__device__ __forceinline__ void tile_of(int wgid, int nM, int nN, int& pm, int& pn) {
  const int nwg = nM * nN; { const int q = nwg / NXCD, r = nwg % NXCD, xcd = wgid % NXCD, off = wgid / NXCD; wgid = (xcd < r ? xcd * (q + 1) : r * (q + 1) + (xcd - r) * q) + off; }
  const int nig = WGM * nN, gid = wgid / nig, fm = gid * WGM, gsz = (nM - fm) < WGM ? (nM - fm) : WGM;
  pm = fm + ((wgid % nig) % gsz); pn = (wgid % nig) / gsz;
}
struct Unit { int pm, pn; };

template <bool SWAP, bool PERM = false, class Epi, class Sched>
__device__ __forceinline__ void gemm_phase(LAS unsigned char* lds, const int lda, const int ldb, const int K, const Sched& S, const Epi& E) {
  int tid_ = threadIdx.x; asm volatile("" : "+v"(tid_));
  const int tid = tid_, wid = __builtin_amdgcn_readfirstlane(tid >> 6), lane = tid & 63, wr = wid >> 2, wc = wid & 3, fr = lane & 15, fq = lane >> 4;
  const int nt = K / BK;
  unsigned voffA[2], voffB[2];
#pragma unroll
  for (int i = 0; i < 2; ++i) { int R, C; stage_rc(tid * 16 + i * 8192, R, C); voffA[i] = (unsigned)(R * lda + C) * 2u;
    const int rho = R & 31, Rb = PERM ? ((R & ~31) + 8 * ((rho & 15) >> 2) + 4 * (rho >> 4) + (rho & 3)) : R;
    voffB[i] = (unsigned)(Rb * ldb + C) * 2u; }
  const size_t kstep = (size_t)(BK * 2), hstepA = (size_t)HALF * lda * 2, hstepB = (size_t)HALF * ldb * 2;
  const unsigned ldsw = (unsigned)wid * 1024u;
  const int aoff = lds_byte(wr * 64 + fr, fq * 8), boff = lds_byte(wc * 32 + fr, fq * 8);
#define PG8_SA(b, h) (((b) * 2 + (h)) * HTB)
#define PG8_SB(b, h) ((4 + (b) * 2 + (h)) * HTB)
#define PG8_STAGE(bufoff, gbase, voff) do { _Pragma("unroll") for (int _i = 0; _i < 2; ++_i) \
    __builtin_amdgcn_global_load_lds((const unsigned*)((const char*)(gbase) + (voff)[_i]), (LAS unsigned*)(lds + (bufoff) + ldsw + _i * 8192), 16, 0, 0); } while (0)
#define PG8_LDA(dst, b, h) do { _Pragma("unroll") for (int m = 0; m < 4; ++m) _Pragma("unroll") for (int k = 0; k < 2; ++k) dst[m][k] = *(const LAS bf16x8*)(lds + PG8_SA(b, h) + aoff + m * 2048 + k * 1024); } while (0)
#define PG8_LDB(dst, b, h) do { _Pragma("unroll") for (int n = 0; n < 2; ++n) _Pragma("unroll") for (int k = 0; k < 2; ++k) dst[n][k] = *(const LAS bf16x8*)(lds + PG8_SB(b, h) + boff + n * 2048 + k * 1024); } while (0)
#define PG8_MMA(ai, bj, At, Bt) do { __builtin_amdgcn_s_setprio(1); _Pragma("unroll") for (int m = 0; m < 4; ++m) _Pragma("unroll") for (int n = 0; n < 2; ++n) _Pragma("unroll") for (int k = 0; k < 2; ++k) \
    acc[ai][bj][m][n] = SWAP ? __builtin_amdgcn_mfma_f32_16x16x32_bf16(Bt[n][k], At[m][k], acc[ai][bj][m][n], 0, 0, 0) \
                             : __builtin_amdgcn_mfma_f32_16x16x32_bf16(At[m][k], Bt[n][k], acc[ai][bj][m][n], 0, 0, 0); __builtin_amdgcn_s_setprio(0); } while (0)
#define PG8_WAIT_V(n) asm volatile("s_waitcnt vmcnt(" #n ")" ::: "memory")
#define PG8_WAIT_L(n) asm volatile("s_waitcnt lgkmcnt(" #n ")" ::: "memory")
#define PG8_BAR __builtin_amdgcn_s_barrier()
#define PG8_SCHED __builtin_amdgcn_sched_barrier(0)
  Unit cur, nxt; int ui = 0;
  if (!S.next(0, cur)) return;
  f32x4 acc[2][2][4][2];
#pragma unroll
  for (int a = 0; a < 2; ++a)
#pragma unroll
    for (int b = 0; b < 2; ++b)
#pragma unroll
      for (int m = 0; m < 4; ++m)
#pragma unroll
        for (int n = 0; n < 2; ++n) acc[a][b][m][n] = (f32x4){0.f, 0.f, 0.f, 0.f};
  bf16x8 At[4][2], B0[2][2], B1[2][2];
  const char* cA = S.pA(cur); const char* cB = S.pB(cur);
  PG8_STAGE(PG8_SB(0, 0), cB, voffB); PG8_STAGE(PG8_SB(0, 1), cB + hstepB, voffB); PG8_STAGE(PG8_SA(0, 0), cA, voffA); PG8_STAGE(PG8_SA(0, 1), cA + hstepA, voffA);
  if (wr == 1) PG8_BAR;
  PG8_WAIT_V(2); PG8_BAR;
  PG8_STAGE(PG8_SB(1, 0), cB + kstep, voffB); PG8_STAGE(PG8_SA(1, 0), cA + kstep, voffA); PG8_STAGE(PG8_SB(1, 1), cB + hstepB + kstep, voffB);
  PG8_WAIT_V(6); PG8_BAR;
  for (;;) {
    const bool has_next = S.next(ui + 1, nxt);
    const char* nA = has_next ? S.pA(nxt) : cA; const char* nB = has_next ? S.pB(nxt) : cB;
    for (int t = 0; t < nt; t += 2) {
      const bool last = (t == nt - 2);
      const char* a1 = cA + (size_t)(t + 1) * kstep;
      const char* a2 = last ? nA : cA + (size_t)(t + 2) * kstep; const char* b2 = last ? nB : cB + (size_t)(t + 2) * kstep;
      const char* a3 = a2 + kstep; const char* b3 = b2 + kstep;
      PG8_LDB(B0, 0, 0); PG8_LDB(B1, 0, 1); PG8_SCHED; PG8_LDA(At, 0, 0); PG8_STAGE(PG8_SA(1, 1), a1 + hstepA, voffA);
      PG8_WAIT_V(8); PG8_WAIT_L(0); PG8_BAR; PG8_MMA(0, 0, At, B0); PG8_MMA(0, 1, At, B1); PG8_BAR; PG8_SCHED;
      PG8_LDA(At, 0, 1); PG8_STAGE(PG8_SB(0, 0), b2, voffB); PG8_STAGE(PG8_SB(0, 1), b2 + hstepB, voffB); PG8_STAGE(PG8_SA(0, 0), a2, voffA);
      PG8_WAIT_V(8); PG8_WAIT_L(0); PG8_BAR; PG8_MMA(1, 0, At, B0); PG8_MMA(1, 1, At, B1); PG8_BAR; PG8_SCHED;
      PG8_LDB(B0, 1, 0); PG8_LDB(B1, 1, 1); PG8_SCHED; PG8_LDA(At, 1, 0); PG8_STAGE(PG8_SA(0, 1), a2 + hstepA, voffA);
      PG8_WAIT_V(8); PG8_WAIT_L(0); PG8_BAR; PG8_MMA(0, 0, At, B0); PG8_MMA(0, 1, At, B1); PG8_BAR; PG8_SCHED;
      PG8_LDA(At, 1, 1); PG8_STAGE(PG8_SB(1, 0), b3, voffB); PG8_STAGE(PG8_SB(1, 1), b3 + hstepB, voffB); PG8_STAGE(PG8_SA(1, 0), a3, voffA);
      PG8_WAIT_V(8); PG8_WAIT_L(0); PG8_BAR; PG8_MMA(1, 0, At, B0); PG8_MMA(1, 1, At, B1); PG8_BAR; PG8_SCHED;
    }
    if (wr == 0) PG8_BAR;
    { int fr2 = fr, fq2 = fq; asm volatile("" : "+v"(fr2), "+v"(fq2));
      E(acc, cur, wr, wc, fr2, fq2); }
    if (!has_next) break;
#pragma unroll
    for (int a = 0; a < 2; ++a)
#pragma unroll
      for (int b = 0; b < 2; ++b)
#pragma unroll
        for (int m = 0; m < 4; ++m)
#pragma unroll
          for (int n = 0; n < 2; ++n) acc[a][b][m][n] = (f32x4){0.f, 0.f, 0.f, 0.f};
    cur = nxt; cA = nA; cB = nB; ++ui;
    if (wr == 1) PG8_BAR;
  }
  PG8_WAIT_V(0);
  PG8_BAR;
#undef PG8_SA
#undef PG8_SB
#undef PG8_STAGE
#undef PG8_LDA
#undef PG8_LDB
#undef PG8_MMA
#undef PG8_WAIT_V
#undef PG8_WAIT_L
#undef PG8_BAR
#undef PG8_SCHED
}
}

namespace at {
constexpr int D = 128, NW = 8, QBLK = 32, KVBLK = 64;
constexpr float SCALE = 0.088388347648318440f;
constexpr float THR = 8.f;
constexpr int LDQ = 1024, LDK = 1024, LDV = 1024, LDO = 2048;
constexpr size_t SHM_V = KVBLK * D * 2, SHM_K = KVBLK * D * 2;
#define KSWZ(row, colB) ((row) * 256 + ((colB) ^ (((row) & 7) << 4)))
#define SBAR() __builtin_amdgcn_sched_barrier(0)
__device__ __forceinline__ int crow(int r, int hi) { return (r & 3) + 8 * (r >> 2) + 4 * hi; }
__device__ __forceinline__ void partialSM(f32x16& p0, f32x16& p1, float& m_reg, float& mn, float& alpha) {
  constexpr float C = SCALE * 1.4426950408889634f;
  float pmax = p0[0];
#pragma unroll
  for (int r = 1; r < 16; ++r) pmax = fmaxf(pmax, p0[r]);
#pragma unroll
  for (int r = 0; r < 16; ++r) pmax = fmaxf(pmax, p1[r]);
  { auto rr = __builtin_amdgcn_permlane32_swap(__float_as_uint(pmax), __float_as_uint(pmax), false, false);
    pmax = fmaxf(__uint_as_float(rr[0]), __uint_as_float(rr[1])); }
  if (__builtin_expect(__all(pmax - m_reg <= THR / SCALE), 1)) { mn = m_reg; alpha = 1.f; }
  else { mn = fmaxf(m_reg, pmax); alpha = __builtin_amdgcn_exp2f((m_reg - mn) * C); m_reg = mn; }
  float mnC = -mn * C;
#pragma unroll
  for (int r = 0; r < 16; ++r) p0[r] = fmaf(p0[r], C, mnC);
#pragma unroll
  for (int r = 0; r < 16; ++r) p1[r] = fmaf(p1[r], C, mnC);
#pragma unroll
  for (int r = 0; r < 16; ++r) p0[r] = __builtin_amdgcn_exp2f(p0[r]);
}
__device__ __forceinline__ void finishSM(f32x16& p0, f32x16& p1, float alpha, float& l_reg, bf16x8& pa0, bf16x8& pa1, bf16x8& pa2, bf16x8& pa3) {
#pragma unroll
  for (int r = 0; r < 16; ++r) p1[r] = __builtin_amdgcn_exp2f(p1[r]);
  float ps = 0;
#pragma unroll
  for (int r = 0; r < 16; ++r) ps += p0[r];
#pragma unroll
  for (int r = 0; r < 16; ++r) ps += p1[r];
  { auto rr = __builtin_amdgcn_permlane32_swap(__float_as_uint(ps), __float_as_uint(ps), false, false);
    ps = __uint_as_float(rr[0]) + __uint_as_float(rr[1]); }
  l_reg = l_reg * alpha + ps;
#define PK4(P, BASE, OUT) do { unsigned a0 = cvtpk(P[BASE + 0], P[BASE + 1]), a1 = cvtpk(P[BASE + 2], P[BASE + 3]);   \
    unsigned b0 = cvtpk(P[BASE + 4], P[BASE + 5]), b1 = cvtpk(P[BASE + 6], P[BASE + 7]);                              \
    auto r0 = __builtin_amdgcn_permlane32_swap(a0, b0, false, false); auto r1 = __builtin_amdgcn_permlane32_swap(a1, b1, false, false); \
    u32x4 w = {r0[0], r1[0], r0[1], r1[1]}; OUT = *reinterpret_cast<bf16x8*>(&w); } while (0)
  PK4(p0, 0, pa0); PK4(p0, 8, pa1); PK4(p1, 0, pa2); PK4(p1, 8, pa3);
#undef PK4
}
__device__ __forceinline__ void qkt(f32x16& p0, f32x16& p1, const char* Ks, const bf16x8* qr, int r32, int hi) {
  p0 = f32x16{}; p1 = f32x16{};
#pragma unroll
  for (int d0 = 0; d0 < 8; ++d0) { int cb = (d0 * 16 + hi * 8) * 2;
    bf16x8 b0 = *reinterpret_cast<const bf16x8*>(Ks + KSWZ(r32, cb));
    bf16x8 b1 = *reinterpret_cast<const bf16x8*>(Ks + KSWZ(32 + r32, cb));
    p0 = __builtin_amdgcn_mfma_f32_32x32x16_bf16(b0, qr[d0], p0, 0, 0, 0);
    p1 = __builtin_amdgcn_mfma_f32_32x32x16_bf16(b1, qr[d0], p1, 0, 0, 0); }
}
__device__ __forceinline__ int v_st(int k, int c) { const int kk = (k & ~0xC) | ((k & 4) << 1) | ((k & 8) >> 1); return ((kk >> 3) * 8 + (c >> 5)) * 512 + ((kk & 7) * 32 + (c & 31)) * 2; }
__device__ __forceinline__ int v_rd_base(int lane) { return ((lane & 3) << 3) | (((lane >> 2) & 3) << 6) | (((lane >> 4) & 1) << 5) | (((lane >> 5) & 1) << 8); }
constexpr int v_rd_off(int d0, int ks, int half) { return d0 * 512 + ks * 8192 + half * 4096; }
template <int OFF> __device__ __forceinline__ s16x4 tr_read(int vb) {
  s16x4 r; asm volatile("ds_read_b64_tr_b16 %0, %1 offset:%2" : "=&v"(r) : "v"(vb), "i"(OFF) : "memory"); return r;
}
struct VFrag { s16x4 l0, h0, l1, h1, l2, h2, l3, h3; };
template <int D0> __device__ __forceinline__ void v_load(VFrag& f, int vb) {
  f.l0 = tr_read<v_rd_off(D0, 0, 0)>(vb); f.h0 = tr_read<v_rd_off(D0, 0, 1)>(vb); f.l1 = tr_read<v_rd_off(D0, 1, 0)>(vb); f.h1 = tr_read<v_rd_off(D0, 1, 1)>(vb);
  f.l2 = tr_read<v_rd_off(D0, 2, 0)>(vb); f.h2 = tr_read<v_rd_off(D0, 2, 1)>(vb); f.l3 = tr_read<v_rd_off(D0, 3, 0)>(vb); f.h3 = tr_read<v_rd_off(D0, 3, 1)>(vb);
}
__device__ __forceinline__ void pv_mma(f32x16& od, const VFrag& f, bf16x8 pa0, bf16x8 pa1, bf16x8 pa2, bf16x8 pa3) {
#define PK(L, H) (bf16x8){L[0], L[1], L[2], L[3], H[0], H[1], H[2], H[3]}
  od = __builtin_amdgcn_mfma_f32_32x32x16_bf16(pa0, PK(f.l0, f.h0), od, 0, 0, 0);
  od = __builtin_amdgcn_mfma_f32_32x32x16_bf16(pa1, PK(f.l1, f.h1), od, 0, 0, 0);
  od = __builtin_amdgcn_mfma_f32_32x32x16_bf16(pa2, PK(f.l2, f.h2), od, 0, 0, 0);
  od = __builtin_amdgcn_mfma_f32_32x32x16_bf16(pa3, PK(f.l3, f.h3), od, 0, 0, 0);
#undef PK
}
__device__ __forceinline__ void pv_all(f32x16* o, int vb, bf16x8 pa0, bf16x8 pa1, bf16x8 pa2, bf16x8 pa3) {
  VFrag fa, fb;
  v_load<0>(fa, vb);
#define STEP(D, CUR, NXT) v_load<D + 1>(NXT, vb); asm volatile("s_waitcnt lgkmcnt(8)" ::: "memory"); SBAR(); pv_mma(o[D], CUR, pa0, pa1, pa2, pa3); SBAR();
  STEP(0, fa, fb) STEP(1, fb, fa) STEP(2, fa, fb) STEP(3, fb, fa) STEP(4, fa, fb) STEP(5, fb, fa) STEP(6, fa, fb)
#undef STEP
  asm volatile("s_waitcnt lgkmcnt(0)" ::: "memory"); SBAR(); pv_mma(o[7], fb, pa0, pa1, pa2, pa3);
}
__device__ __forceinline__ void body(const bf16_t* __restrict__ Qb, const bf16_t* __restrict__ Kh, const bf16_t* __restrict__ Vh, bf16_t* __restrict__ Ob, int seq, char* lds) {
  int tid_ = threadIdx.x; asm volatile("" : "+v"(tid_));
  const int tid = tid_, wid = tid >> 6, lane = tid & 63, r32 = lane & 31, hi = lane >> 5;
  constexpr int SV = 64 * 256 * 2, SK = 64 * 128 * 2;
  char* V_lds = lds; char* K_lds = lds + 2 * SV;
  float* ws = (float*)(lds + 2 * SV + 2 * SK) + wid * 64; float* li_l = ws; float* al_l = ws + 32;
  float m_reg = -1e30f, l_reg = 0; f32x16 o[8] = {}; bf16x8 qr[8];
  const bf16_t* Qw = Qb + (long)(wid * QBLK + r32) * LDQ + hi * 8;
#pragma unroll
  for (int d0 = 0; d0 < 8; ++d0) qr[d0] = *reinterpret_cast<const bf16x8*>(Qw + d0 * 16);
  const int wu = __builtin_amdgcn_readfirstlane(wid);
  int koff[2], voff[4];
#pragma unroll
  for (int q = 0; q < 2; ++q) { const int row = 4 * (wu * 2 + q) + (lane >> 4); koff[q] = row * LDK + ((((lane & 15) << 4) ^ ((row & 7) << 4)) >> 1); }
#pragma unroll
  for (int q = 0; q < 4; ++q) { const int s = 2 * (wu * 4 + q) + (lane >> 5), kk = (s >> 3) * 8 + ((lane & 31) >> 2), k = (kk & ~0xC) | ((kk & 4) << 1) | ((kk & 8) >> 1);
    voff[q] = k * LDV + (s & 7) * 32 + (lane & 3) * 8; }
  const int vb0 = (int)(uintptr_t)(LAS char*)V_lds + v_rd_base(lane);
  LAS char* Vl = (LAS char*)V_lds; LAS char* Kl = (LAS char*)K_lds;
#define STAGE(b, k0) do { const bf16_t* kg = Kh + (long)(k0) * LDK; const bf16_t* vg = Vh + (long)(k0) * LDV; \
    _Pragma("unroll") for (int q = 0; q < 2; ++q) __builtin_amdgcn_global_load_lds((const unsigned*)(kg + koff[q]), (LAS unsigned*)(Kl + (b) * SK + (wu * 2 + q) * 1024), 16, 0, 0); \
    _Pragma("unroll") for (int q = 0; q < 4; ++q) __builtin_amdgcn_global_load_lds((const unsigned*)(vg + voff[q]), (LAS unsigned*)(Vl + (b) * SV + (wu * 4 + q) * 1024), 16, 0, 0); } while (0)
  const int NT = seq / KVBLK;
  STAGE(0, 0);
  asm volatile("s_waitcnt vmcnt(0) lgkmcnt(0)" ::: "memory"); __builtin_amdgcn_s_barrier(); asm volatile("" ::: "memory");
  for (int j = 0; j < NT; ++j) {
    const int b = j & 1;
    f32x16 p0, p1; float mn, al; bf16x8 pa0, pa1, pa2, pa3;
    if (j + 1 < NT) STAGE(b ^ 1, (j + 1) * KVBLK);
    SBAR(); qkt(p0, p1, K_lds + b * SK, qr, r32, hi);
    partialSM(p0, p1, m_reg, mn, al);
    if (__any(al < 1.f)) { if (hi == 0) al_l[r32] = al; asm volatile("s_waitcnt lgkmcnt(0)" ::: "memory");
#pragma unroll
      for (int d = 0; d < 8; ++d)
#pragma unroll
        for (int r = 0; r < 16; ++r) o[d][r] *= al_l[crow(r, hi)]; }
    finishSM(p0, p1, al, l_reg, pa0, pa1, pa2, pa3); SBAR();
    const int vb = vb0 + b * SV;
    pv_all(o, vb, pa0, pa1, pa2, pa3);
    asm volatile("s_waitcnt vmcnt(0) lgkmcnt(0)" ::: "memory"); __builtin_amdgcn_s_barrier(); asm volatile("" ::: "memory");
  }
  if (hi == 0) li_l[r32] = l_reg; asm volatile("s_waitcnt lgkmcnt(0)" ::: "memory");
  float rli[16];
#pragma unroll
  for (int r = 0; r < 16; ++r) rli[r] = __builtin_amdgcn_rcpf(li_l[crow(r, hi)]);
  bf16_t* Ow = Ob + (long)(wid * QBLK) * LDO;
#pragma unroll
  for (int r = 0; r < 16; ++r) { int orow = crow(r, hi);
#pragma unroll
    for (int d0 = 0; d0 < 8; ++d0) Ow[(long)orow * LDO + d0 * 32 + r32] = (bf16_t)(cvtpk(o[d0][r] * rli[r], 0.f) & 0xffff); }
#undef STAGE
  __syncthreads();
}
}

struct Ctx {
  int tid, wid, lane, blk, nblk, gwave, nwave; long gtid, nthr;
};

__device__ __forceinline__ const float* modp(const Params& p, int l, int v, int j) { return (const float*)(p.ws + OFF_MOD) + ((size_t)(l * 5 + v) * NMODC + (size_t)j * DM); }

__device__ __forceinline__ void convert_weights(const Params& p, const Ctx& c, int l, float* lds) {
  constexpr int T0 = 14 * 32, T1 = 8 * 32, T2 = 44 * 32, T3 = 8 * 88, T4 = 2 * 8, TALL = T0 + T1 + T2 + T3 + T4;
  for (int it = c.blk; it < TALL; it += c.nblk) {
    int mat, ti = it;
    if (ti < T0) mat = 0; else if ((ti -= T0) < T1) mat = 1; else if ((ti -= T1) < T2) mat = 2; else if ((ti -= T2) < T3) mat = 3; else { ti -= T3; mat = 4; }
    const float* src; long ld; bf16_t* dst; long dld; int nkt;
    if (mat == 0) { src = p.w_in + (size_t)l * DM * 4096; ld = 4096; dst = (bf16_t*)(p.ws + OFF_WIN); dld = DM; nkt = 32; }
    else if (mat == 1) { src = p.w_out + (size_t)l * DM * DM; ld = DM; dst = (bf16_t*)(p.ws + OFF_WOUT); dld = DM; nkt = 32; }
    else if (mat == 2) { src = p.w_gate + (size_t)l * DM * DFF; ld = DFF; dst = (bf16_t*)(p.ws + OFF_WGU); dld = DM; nkt = 32; }
    else if (mat == 3) { src = p.w_down + (size_t)l * DFF * DM; ld = DM; dst = (bf16_t*)(p.ws + OFF_WD); dld = DFF; nkt = 88; }
    else { src = p.w_glu + (size_t)l * 512 * 512; ld = 512; dst = (bf16_t*)(p.ws + OFF_WGLU); dld = 512; nkt = 8; }
    const int n0 = (ti / nkt) * 256, k0 = (ti % nkt) * 64;
    {
      const int nn = c.tid & 255, kk0 = c.tid >> 8, np = n0 + nn; int scol = np;
      if (mat == 0) { if (np < 2048) { const int ph = np & 127; scol = (np & ~127) | (ph & 64) | (((ph >> 2) & 1) << 5) | (((ph >> 5) & 1) << 4) | (((ph >> 3) & 3) << 2) | (ph & 3); } }
      else if (mat == 2) { const int pn = np >> 8, bj = (np >> 7) & 1; scol = pn * 128 + (np & 127); if (bj) src = p.w_up + (size_t)l * DM * DFF; }
      const float* sp = src + (size_t)(k0 + kk0) * ld + scol; float v[32];
#pragma unroll
      for (int i = 0; i < 32; ++i) v[i] = sp[(size_t)(2 * i) * ld];
#pragma unroll
      for (int i = 0; i < 32; ++i) lds[(kk0 + 2 * i) * 257 + nn] = v[i];
    }
    __syncthreads();
    {
      const int kc = (c.tid & 7) * 8;
#pragma unroll
      for (int j = 0; j < 4; ++j) { const int nn = (c.tid >> 3) + 64 * j; float v[8];
#pragma unroll
        for (int i = 0; i < 8; ++i) v[i] = lds[(kc + i) * 257 + nn];
        u32x4 w = {cvtpk(v[0], v[1]), cvtpk(v[2], v[3]), cvtpk(v[4], v[5]), cvtpk(v[6], v[7])};
        *(u32x4*)(dst + (size_t)(n0 + nn) * dld + k0 + kc) = w; }
    }
    __syncthreads();
  }
}

__device__ __forceinline__ void fold_four(const Params& p, const Ctx& c, int l, float* lds) {
  float* WlT = lds;
  float* Wc = lds + 128 * 68;
  const float* wcs = (const float*)(p.ws + OFF_WCS) + (size_t)l * 2 * 4 * 128 * 128;
  bf16_t* dstb = (bf16_t*)(p.ws + OFF_WIN);
  for (int u = c.blk; u < 256; u += c.nblk) {
    const int kt = u & 31, cs = (u >> 5) & 1, g = u >> 6, k0 = kt * 64;
    const float* src = p.w_in + (size_t)l * DM * 4096 + 3584 + g * 128;
    for (int i = c.tid; i < 64 * 128; i += NTHREADS) { const int kk = i >> 7, cc = i & 127; WlT[cc * 68 + kk] = src[(size_t)(k0 + kk) * 4096 + cc]; }
    const float* wsrc = wcs + (size_t)(cs * 4 + g) * 128 * 128;
    for (int i = c.tid; i < 128 * 128; i += NTHREADS) Wc[i] = wsrc[i];
    __syncthreads();
    const int kq = c.tid & 15, dq = c.tid >> 4;
    f32x4 acc[4] = {};
    for (int cc = 0; cc < 128; ++cc) {
      const f32x4 a = *(const f32x4*)(WlT + cc * 68 + kq * 4), w = *(const f32x4*)(Wc + cc * 128 + dq * 4);
#pragma unroll
      for (int di = 0; di < 4; ++di) acc[di] += a * w[di];
    }
#pragma unroll
    for (int di = 0; di < 4; ++di) { u32x2 o = {cvtpk(acc[di][0], acc[di][1]), cvtpk(acc[di][2], acc[di][3])};
      *(u32x2*)(dstb + (size_t)(3584 + cs * 512 + g * 128 + dq * 4 + di) * DM + k0 + kq * 4) = o; }
    __syncthreads();
  }
}


__device__ __forceinline__ void ssm_tables(const Params& p, const Ctx& c) {
  float2* PW = (float2*)(p.ws + OFF_PW); float2* BB = (float2*)(p.ws + OFF_BB);
  for (long i = c.gtid; i < 2L * 32 * 2 * 64; i += c.nthr) { const int pp = (int)(i & 63), idx = (int)(i >> 6);
    const int d = idx & 1, g = (idx >> 1) & 31, l = idx >> 6, iidx = (l * 2 + d) * 32 + g;
    const float lre = p.ssm_a_re[iidx * 64 + pp], lim = p.ssm_a_im[iidx * 64 + pp], dt = expf(p.ssm_log_dt[iidx]);
    float ar = 1.f, ai = 0.f;
    for (int j = 0; j <= 32; ++j) { const float mag = expf(lre * dt * (float)j); float sn, cs; my_sincos(lim * dt * (float)j, sn, cs);
      PW[((size_t)idx * 33 + j) * 64 + pp] = make_float2(mag * cs, mag * sn); if (j == 1) { ar = mag * cs; ai = mag * sn; } }
    const float nr = ar - 1.f, ni = ai, den = 1.f / (lre * lre + lim * lim), cr = (nr * lre + ni * lim) * den, ci = (ni * lre - nr * lim) * den;
    const float* br = p.ssm_b_re + ((size_t)iidx * 64 + pp) * 16; const float* bi = p.ssm_b_im + ((size_t)iidx * 64 + pp) * 16;
    for (int h = 0; h < 16; ++h) BB[((size_t)idx * 64 + pp) * 16 + h] = make_float2(cr * br[h] - ci * bi[h], cr * bi[h] + ci * br[h]); }
}
__device__ __forceinline__ void ssm_build_mef(const Params& p, const Ctx& c, int l) {
  const float2* PW = (const float2*)(p.ws + OFF_PW) + (size_t)l * 32 * 2 * 33 * 64; const float2* BB = (const float2*)(p.ws + OFF_BB) + (size_t)l * 32 * 2 * 64 * 16;
  float* MK = (float*)(p.ws + OFF_MK) + (size_t)l * 32 * 2 * 32 * 256; bf16_t* EM = (bf16_t*)(p.ws + OFF_EM); bf16_t* TF = (bf16_t*)(p.ws + OFF_TF);
  for (long i = c.gtid; i < 32L * 2 * 32 * 256; i += c.nthr) { const int hp = (int)(i & 15), h = (int)((i >> 4) & 15), j = (int)((i >> 8) & 31), gd = (int)(i >> 13), d = gd & 1, g = gd >> 1;
    const size_t ci = ((size_t)((l * 2 + d) * 32 + g) * 16 + h) * 64; const float2* pw = PW + ((size_t)gd * 33 + j) * 64; const float2* bb = BB + (size_t)gd * 64 * 16 + hp; float a = 0.f;
    for (int pp = 0; pp < 64; ++pp) { const float cr = p.ssm_c_re[ci + pp], cim = p.ssm_c_im[ci + pp]; const float2 b = bb[pp * 16], w = pw[pp];
      const float wr = cr * b.x - cim * b.y, wi = cr * b.y + cim * b.x; a += wr * w.x - wi * w.y; }
    MK[i] = a; }
  for (long i = c.gtid; i < 32L * 256 * 32 * 2; i += c.nthr) { const int hh = (int)(i & 1), s = (int)((i >> 1) & 31), n = (int)((i >> 6) & 255), g = (int)(i >> 14), ri = n & 1, pp = (n >> 1) & 63, d = n >> 7;
    const int gd = g * 2 + d, e = d ? s : 31 - s; const float2 w = PW[((size_t)gd * 33 + e) * 64 + pp]; const float2* bb = BB + ((size_t)gd * 64 + pp) * 16 + hh * 8; float v[8];
#pragma unroll
    for (int k = 0; k < 8; ++k) { const float2 b = bb[k]; v[k] = ri ? (w.x * b.y + w.y * b.x) : (w.x * b.x - w.y * b.y); }
    u32x4 o = {cvtpk(v[0], v[1]), cvtpk(v[2], v[3]), cvtpk(v[4], v[5]), cvtpk(v[6], v[7])}; *(u32x4*)(EM + ((size_t)g * 256 + n) * 512 + s * 16 + hh * 8) = o; }
  for (long i = c.gtid; i < 32L * 512 * 2 * 16; i += c.nthr) { const int pq = (int)(i & 15), d = (int)((i >> 4) & 1), n = (int)((i >> 5) & 511), g = (int)(i >> 14), h = n & 15, t = n >> 4;
    const int gd = g * 2 + d, f = d ? 32 - t : t + 1; const size_t ci = ((size_t)((l * 2 + d) * 32 + g) * 16 + h) * 64 + pq * 4; const float2* pw = PW + ((size_t)gd * 33 + f) * 64 + pq * 4; float v[8];
#pragma unroll
    for (int k = 0; k < 4; ++k) { const float cr = p.ssm_c_re[ci + k], cim = p.ssm_c_im[ci + k]; const float2 w = pw[k]; v[2 * k] = cr * w.x - cim * w.y; v[2 * k + 1] = -(cr * w.y + cim * w.x); }
    u32x4 o = {cvtpk(v[0], v[1]), cvtpk(v[2], v[3]), cvtpk(v[4], v[5]), cvtpk(v[6], v[7])}; *(u32x4*)(TF + ((size_t)g * 512 + n) * 768 + 512 + d * 128 + pq * 8) = o; }
}
__device__ __forceinline__ void ssm_build_t(const Params& p, const Ctx& c, int l) {
  const float* MK = (const float*)(p.ws + OFF_MK) + (size_t)l * 32 * 2 * 32 * 256; bf16_t* TF = (bf16_t*)(p.ws + OFF_TF);
  for (long i = c.gtid; i < 32L * 512 * 32 * 2; i += c.nthr) { const int hh = (int)(i & 1), s = (int)((i >> 1) & 31), n = (int)((i >> 6) & 511), g = (int)(i >> 15), h = n & 15, t = n >> 4;
    const int lag = t - s; float v[8];
    if (lag != 0) { const float* m = MK + ((size_t)((g * 2 + (lag < 0 ? 1 : 0)) * 32 + (lag < 0 ? -lag : lag)) * 16 + h) * 16 + hh * 8;
#pragma unroll
      for (int k = 0; k < 8; ++k) v[k] = m[k]; }
    else { const float* m0 = MK + ((size_t)((g * 2) * 32) * 16 + h) * 16 + hh * 8; const float* m1 = MK + ((size_t)((g * 2 + 1) * 32) * 16 + h) * 16 + hh * 8; const float dsk = p.ssm_d[(size_t)l * 512 + g * 16 + h];
#pragma unroll
      for (int k = 0; k < 8; ++k) v[k] = m0[k] + m1[k] + ((hh * 8 + k) == h ? dsk : 0.f); }
    u32x4 o = {cvtpk(v[0], v[1]), cvtpk(v[2], v[3]), cvtpk(v[4], v[5]), cvtpk(v[6], v[7])}; *(u32x4*)(TF + ((size_t)g * 512 + n) * 768 + s * 16 + hh * 8) = o; }
}
__device__ __forceinline__ void ssm_carry(const Params& p, const Ctx& c, int l) {
  if (c.wid != 0) return;
  const float2* PW = (const float2*)(p.ws + OFF_PW) + (size_t)l * 32 * 2 * 33 * 64; const float* SB = (const float*)(p.ws + OFF_Z2 + Z2_SB); bf16_t* UG = (bf16_t*)(p.ws + OFF_Z2 + Z2_UG);
  for (int i = c.blk * 64 + c.lane; i < NB * 32 * 2 * 64; i += c.nblk * 64) { const int pp = i & 63, d = (i >> 6) & 1, g = (i >> 7) & 31, b = i >> 12;
    const float2 a32 = PW[((size_t)(g * 2 + d) * 33 + 32) * 64 + pp]; float hr = 0.f, hi = 0.f;
    const size_t rbase = (size_t)g * 768 + b * 136; const int col = (d * 64 + pp) * 2;
#pragma unroll 8
    for (int k = 0; k < 136; ++k) { const int ch = d == 0 ? k : (k < 8 ? 7 - k : 143 - k);
      const float2 s = *(const float2*)(SB + (rbase + ch) * 256 + col);
      *(unsigned*)(UG + (rbase + ch) * 768 + 512 + col) = cvtpk(hr, hi);
      const float nr = a32.x * hr - a32.y * hi + s.x, ni = a32.x * hi + a32.y * hr + s.y; hr = nr; hi = ni; } }
}

__device__ __forceinline__ void phase0a(const Params& p, const Ctx& c, float* lds) {
  for (int i = c.tid; i < 5 * DM; i += NTHREADS) { const float v = i < 4 * DM ? p.c[i] : p.c_ctx[i - 4 * DM]; lds[i] = v * sigmoidf_(v); }
  __syncthreads();
  {
    float* MP = (float*)(p.ws + OFF_MP);
    for (long it = c.gtid; it < 16 * 6144; it += c.nthr) {
      const int cq = (int)(it % 6144), ks = (int)(it / 6144); const int gc = cq * 4, l = gc / NMODC, col = gc % NMODC;
      const float* wp = p.w_mod + ((size_t)l * DM + (size_t)ks * 128) * NMODC + col;
      f32x4 a[5] = {};
#pragma unroll 8
      for (int k = 0; k < 128; ++k) { const f32x4 w = *(const f32x4*)(wp + (size_t)k * NMODC);
#pragma unroll
        for (int v = 0; v < 5; ++v) a[v] += w * lds[v * DM + ks * 128 + k]; }
#pragma unroll
      for (int v = 0; v < 5; ++v) *(f32x4*)(MP + ((size_t)ks * 5 + v) * 24576 + gc) = a[v];
    }
  }
  __syncthreads();
  {
    float* rc = (float*)(p.ws + OFF_ROPE); float* rs = rc + 64 * 32;
    for (long i = c.gtid; i < 64 * 32; i += c.nthr) { const int pos = (int)(i >> 5), pp = (int)(i & 31);
      const float inv = (float)exp2(-(double)pp / 32.0 * 13.287712379549449); float s, cc; my_sincos((float)pos * inv, s, cc); rc[i] = cc; rs[i] = s; }
  }
  {
    bf16_t* DB = (bf16_t*)(p.ws + OFF_DFTC);
    for (long i = c.gtid; i < 256L * 64; i += c.nthr) { const int k = (int)(i >> 6), c0 = (int)(i & 63) * 8, part = c0 >> 8, t0 = c0 & 255; float v[8];
#pragma unroll
      for (int j = 0; j < 8; ++j) { const float ph = (float)((k * (t0 + j)) & 255) * (1.f / 256.f); v[j] = (part ? __builtin_amdgcn_sinf(ph) : __builtin_amdgcn_cosf(ph)) * (1.f / 16.f); }
      u32x4 w = {cvtpk(v[0], v[1]), cvtpk(v[2], v[3]), cvtpk(v[4], v[5]), cvtpk(v[6], v[7])}; *(u32x4*)(DB + i * 8) = w; }
  }
  {
    float* W = (float*)(p.ws + OFF_WCS);
    for (long i = c.gtid; i < 2L * 2 * 4 * 128 * 128; i += c.nthr) { const int d = (int)(i & 127), cc = (int)((i >> 7) & 127), g = (int)((i >> 14) & 3), cs = (int)((i >> 16) & 1), l = (int)(i >> 17);
      const float* wf = p.w_four + ((size_t)(l * 4 + g) * 128) * 128 + d; float a = 0.f;
      for (int j = 0; j < 128; ++j) { const float ph = (float)((j * cc) & 127) * (1.f / 128.f); a += (cs ? __builtin_amdgcn_sinf(ph) : __builtin_amdgcn_cosf(ph)) * wf[(size_t)j * 128]; }
      W[i] = a * 0.08838834764831845f; }
  }
}

__device__ __forceinline__ void reduce_mod(const Params& p, const Ctx& c) {
  const float* MP = (const float*)(p.ws + OFF_MP); float* MOD = (float*)(p.ws + OFF_MOD);
  for (long o = c.gtid; o < 5L * 24576; o += c.nthr) { const int v = (int)(o / 24576), gc = (int)(o % 24576), l = gc / NMODC, col = gc % NMODC;
    float a = p.b_mod[gc];
#pragma unroll
    for (int ks = 0; ks < 16; ++ks) a += MP[((size_t)ks * 5 + v) * 24576 + gc];
    MOD[(size_t)(l * 5 + v) * NMODC + col] = a; }
}

__device__ __forceinline__ void prenorm_row(const f32x4 (&x)[8], float rinv, const float* g, const float* sc, const float* sh, bf16_t* dst, int lane) {
#pragma unroll
  for (int i = 0; i < 8; ++i) { const int col = (lane + 64 * i) * 4; const f32x4 gg = *(const f32x4*)(g + col), s1 = *(const f32x4*)(sc + col), s0 = *(const f32x4*)(sh + col);
    const f32x4 y = (x[i] * rinv * gg) * (s1 + 1.f) + s0; u32x2 o = {cvtpk(y[0], y[1]), cvtpk(y[2], y[3])}; *(u32x2*)(dst + col) = o; }
}
__device__ __forceinline__ float sumsq8(const f32x4 (&x)[8]) { float s = 0.f;
#pragma unroll
  for (int i = 0; i < 8; ++i) s += x[i][0] * x[i][0] + x[i][1] * x[i][1] + x[i][2] * x[i][2] + x[i][3] * x[i][3];
  return wave_sum(s); }

typedef _Float16 h16x4 __attribute__((ext_vector_type(4)));
__device__ __forceinline__ f32x4 ldx(const _Float16* p) { const h16x4 h = *(const h16x4*)p; return __builtin_convertvector(h, f32x4); }
__device__ __forceinline__ void stx(_Float16* p, f32x4 v) { *(h16x4*)p = __builtin_convertvector(v, h16x4); }
__device__ __forceinline__ const float* xrow_src(const Params& p, int l, int b, int t, int row) {
  const float* base = t < CTXL ? p.ctx : p.x; const size_t off = t < CTXL ? ((size_t)b * CTXL + t) * DM : ((size_t)b * SEQ + (t - CTXL)) * DM; return base + off;
}
__device__ __forceinline__ void phase_prenorm(const Params& p, const Ctx& c, int l) {
  bf16_t* Hn = (bf16_t*)(p.ws + OFF_HN);
  for (int row = c.gwave; row < TT; row += c.nwave) { const int b = row / TPB, t = row % TPB, v = t < CTXL ? 4 : b;
    f32x4 x[8]; const f32x4* xr = (const f32x4*)xrow_src(p, l, b, t, row);
#pragma unroll
    for (int i = 0; i < 8; ++i) x[i] = xr[c.lane + 64 * i];
    const float rinv = rsqrtf(sumsq8(x) * (1.f / DM) + 1e-6f);
    prenorm_row(x, rinv, p.g_mix_pre + (size_t)l * DM, modp(p, l, v, 1), modp(p, l, v, 0), Hn + (size_t)row * DM, c.lane); }
}
__device__ __forceinline__ void phase_postmix(const Params& p, const Ctx& c, int l, bool last) {
  _Float16* X = (_Float16*)(p.ws + OFF_X); const bf16_t* MIX = (const bf16_t*)(p.ws + OFF_Z1); bf16_t* Hn = (bf16_t*)(p.ws + OFF_HN);
  for (int row = c.gwave; row < TT; row += c.nwave) { const int b = row / TPB, t = row % TPB, v = t < CTXL ? 4 : b; if (last && t < CTXL) continue;
    f32x4 m[8], x[8]; const u32x2* mr = (const u32x2*)(MIX + (size_t)row * DM); _Float16* xr = X + (size_t)row * DM; const f32x4* xs = (const f32x4*)xrow_src(p, 0, b, t, row);
    if (t < CTXL) { const u32x2* sl = (const u32x2*)(p.ws + OFF_Z2) + ((size_t)b * CTXL + t) * (DM / 4);
#pragma unroll
      for (int i = 0; i < 8; ++i) { m[i] = (f32x4){0.f, 0.f, 0.f, 0.f}; x[i] = xs[c.lane + 64 * i]; }
      for (int s = 0; s < 8; ++s) {
#pragma unroll
        for (int i = 0; i < 8; ++i) { const u32x2 w = sl[(size_t)s * NB * CTXL * (DM / 4) + c.lane + 64 * i]; m[i] += (f32x4){__uint_as_float(w[0] << 16), __uint_as_float(w[0] & 0xffff0000u), __uint_as_float(w[1] << 16), __uint_as_float(w[1] & 0xffff0000u)}; } } }
    else {
#pragma unroll
    for (int i = 0; i < 8; ++i) { const u32x2 w = mr[c.lane + 64 * i]; m[i] = (f32x4){__uint_as_float(w[0] << 16), __uint_as_float(w[0] & 0xffff0000u), __uint_as_float(w[1] << 16), __uint_as_float(w[1] & 0xffff0000u)}; x[i] = (l == 0) ? xs[c.lane + 64 * i] : ldx(xr + (c.lane + 64 * i) * 4); } }
    const float r1 = rsqrtf(sumsq8(m) * (1.f / DM) + 1e-6f); const float* gp = p.g_mix_post + (size_t)l * DM; const float* m2 = modp(p, l, v, 2);
#pragma unroll
    for (int i = 0; i < 8; ++i) { const int col = (c.lane + 64 * i) * 4; x[i] += *(const f32x4*)(m2 + col) * (m[i] * r1 * *(const f32x4*)(gp + col)); stx(xr + col, x[i]); }
    const float r2 = rsqrtf(sumsq8(x) * (1.f / DM) + 1e-6f);
    prenorm_row(x, r2, p.g_ffn_pre + (size_t)l * DM, modp(p, l, v, 4), modp(p, l, v, 3), Hn + (size_t)row * DM, c.lane); }
}
__device__ __forceinline__ void phase_postffn(const Params& p, const Ctx& c, int l, bool last) {
  _Float16* X = (_Float16*)(p.ws + OFF_X); const bf16_t* F = (const bf16_t*)(p.ws + OFF_Z1 + (size_t)TT * DM * 2); bf16_t* Hn = (bf16_t*)(p.ws + OFF_HN);
  for (int row = c.gwave; row < TT; row += c.nwave) { const int b = row / TPB, t = row % TPB, v = t < CTXL ? 4 : b; if (last && t < CTXL) continue;
    f32x4 m[8], x[8]; const u32x2* mr = (const u32x2*)(F + (size_t)row * DM); _Float16* xr = X + (size_t)row * DM;
    if (t < CTXL) { const u32x2* sl = (const u32x2*)(p.ws + OFF_Z1) + ((size_t)b * CTXL + t) * (DM / 4);
#pragma unroll
      for (int i = 0; i < 8; ++i) { m[i] = (f32x4){0.f, 0.f, 0.f, 0.f}; x[i] = ldx(xr + (c.lane + 64 * i) * 4); }
      for (int s = 0; s < 11; ++s) {
#pragma unroll
        for (int i = 0; i < 8; ++i) { const u32x2 w = sl[(size_t)s * NB * CTXL * (DM / 4) + c.lane + 64 * i]; m[i] += (f32x4){__uint_as_float(w[0] << 16), __uint_as_float(w[0] & 0xffff0000u), __uint_as_float(w[1] << 16), __uint_as_float(w[1] & 0xffff0000u)}; } } }
    else {
#pragma unroll
    for (int i = 0; i < 8; ++i) { const u32x2 w = mr[c.lane + 64 * i]; m[i] = (f32x4){__uint_as_float(w[0] << 16), __uint_as_float(w[0] & 0xffff0000u), __uint_as_float(w[1] << 16), __uint_as_float(w[1] & 0xffff0000u)}; x[i] = ldx(xr + (c.lane + 64 * i) * 4); } }
    const float r1 = rsqrtf(sumsq8(m) * (1.f / DM) + 1e-6f); const float* gp = p.g_ffn_post + (size_t)l * DM; const float* m5 = modp(p, l, v, 5);
#pragma unroll
    for (int i = 0; i < 8; ++i) { const int col = (c.lane + 64 * i) * 4; x[i] += *(const f32x4*)(m5 + col) * (m[i] * r1 * *(const f32x4*)(gp + col)); }
    if (last) { f32x4* o = (f32x4*)(p.out + ((size_t)b * SEQ + (t - CTXL)) * DM);
#pragma unroll
      for (int i = 0; i < 8; ++i) o[c.lane + 64 * i] = x[i]; }
    else {
#pragma unroll
      for (int i = 0; i < 8; ++i) stx(xr + (c.lane + 64 * i) * 4, x[i]);
      const float r2 = rsqrtf(sumsq8(x) * (1.f / DM) + 1e-6f);
      prenorm_row(x, r2, p.g_mix_pre + (size_t)(l + 1) * DM, modp(p, l + 1, v, 1), modp(p, l + 1, v, 0), Hn + (size_t)row * DM, c.lane); } }
}

typedef f32x4 Acc[2][2][4][2];
__device__ __forceinline__ int lat_pm(int i) { return (i >> 4) * 17 + 1 + (i & 15); }

struct SchedMN {
  const char* A; const char* B; size_t strA, strB;
  int nM, nN, pn0, latonly, nextra, blk, nblk;
  __device__ __forceinline__ bool next(int i, gm::Unit& u) const {
    const int it = i * nblk + blk, nmain = nM * nN;
    if (it < nmain) { gm::tile_of(it, nM, nN, u.pm, u.pn); if (latonly) u.pm = lat_pm(u.pm); u.pn += pn0; return true; }
    if (it < nmain + nextra) { const int j = it - nmain; u.pm = (j / 10) * 17; u.pn = 4 + (j % 10); return true; }
    return false;
  }
  __device__ __forceinline__ const char* pA(const gm::Unit& u) const { return A + (size_t)u.pm * strA; }
  __device__ __forceinline__ const char* pB(const gm::Unit& u) const { return B + (size_t)u.pn * strB; }
};

struct EpiIn {
  bf16_t *Qb, *Kb, *Vb, *UG, *PT; const float *rc, *rs;
  __device__ __forceinline__ void operator()(const Acc& acc, const gm::Unit& u, int wr, int wc, int fr, int fq) const {
    const int pm = u.pm, pn = u.pn; const bool isctx = (pm % 17) == 0; const int brow = pm * 256;
#pragma unroll
    for (int ai = 0; ai < 2; ++ai)
#pragma unroll
      for (int m = 0; m < 4; ++m) { const int row = brow + ai * 128 + wr * 64 + m * 16 + fr;
        if (pn < 8) { bf16_t* dst = Qb + (size_t)(pn >> 2) * TT * 1024 + (size_t)row * 1024 + (pn & 3) * 256 + wc * 32 + fq * 8;
          f32x4 cs = {1.f, 1.f, 1.f, 1.f}, sn = {0.f, 0.f, 0.f, 0.f};
          if (!isctx) { const int tl = (row % TPB) - CTXL; const int pos = (wc >> 1) ? (tl & 63) : (tl >> 6); const int p0 = (wc & 1) * 16 + fq * 4;
            cs = *(const f32x4*)(rc + pos * 32 + p0); sn = *(const f32x4*)(rs + pos * 32 + p0); }
#pragma unroll
          for (int bj = 0; bj < 2; ++bj) { const f32x4 v1 = acc[ai][bj][m][0], v2 = acc[ai][bj][m][1]; const f32x4 o1 = v1 * cs - v2 * sn, o2 = v2 * cs + v1 * sn;
            u32x4 w = {cvtpk(o1[0], o1[1]), cvtpk(o1[2], o1[3]), cvtpk(o2[0], o2[1]), cvtpk(o2[2], o2[3])}; *(u32x4*)(dst + bj * 128) = w; } }
        else if (pn < 12) { bf16_t* dst = Vb + (size_t)row * 1024 + (pn - 8) * 256 + wc * 32 + fq * 8;
#pragma unroll
          for (int bj = 0; bj < 2; ++bj) { const f32x4 v0 = acc[ai][bj][m][0], v1 = acc[ai][bj][m][1]; u32x4 w = {cvtpk(v0[0], v0[1]), cvtpk(v0[2], v0[3]), cvtpk(v1[0], v1[1]), cvtpk(v1[2], v1[3])}; *(u32x4*)(dst + bj * 128) = w; } }
        else if (pn < 14) { const int b = row / TPB, t = row % TPB; bf16_t* dst = UG + ((size_t)(b * 136 + (t >> 5))) * 768 + (t & 31) * 16 + ((fq * 8) & 15);
#pragma unroll
          for (int bj = 0; bj < 2; ++bj) { const int g = ((pn - 12) * 256 + bj * 128 + wc * 32 + fq * 8) >> 4; const f32x4 v0 = acc[ai][bj][m][0], v1 = acc[ai][bj][m][1];
            u32x4 w = {cvtpk(v0[0], v0[1]), cvtpk(v0[2], v0[3]), cvtpk(v1[0], v1[1]), cvtpk(v1[2], v1[3])}; *(u32x4*)(dst + (size_t)g * 768 * 768) = w; } }
        else {
          const int b = pm / 17, tt = pm % 17, part = (pn - 14) >> 1; const size_t cb = (size_t)(part * NB + b) * 512 + (pn & 1) * 256; const size_t ld = tt == 0 ? 256 : 4096;
          bf16_t* dstm = PT + (tt == 0 ? (size_t)2 * NB * 512 * 4096 + cb * 256 : cb * 4096 + (size_t)(tt - 1) * 256) + ai * 128 + wr * 64 + m * 16 + fr;
#pragma unroll
          for (int bj = 0; bj < 2; ++bj)
#pragma unroll
            for (int n = 0; n < 2; ++n) { const f32x4 v = acc[ai][bj][m][n]; const unsigned w0 = cvtpk(v[0], v[1]), w1 = cvtpk(v[2], v[3]); bf16_t* d = dstm + (size_t)(bj * 128 + wc * 32 + fq * 8 + n * 4) * ld;
              d[0] = (bf16_t)(w0 & 0xffff); d[ld] = (bf16_t)(w0 >> 16); d[2 * ld] = (bf16_t)(w1 & 0xffff); d[3 * ld] = (bf16_t)(w1 >> 16); } } }
  }
};
__device__ __forceinline__ void phase_gemm_in(const Params& p, const Ctx& c, int l, LAS unsigned char* lds) {
  SchedMN S; S.A = p.ws + OFF_HN; S.B = p.ws + OFF_WIN; S.strA = (size_t)256 * DM * 2; S.strB = (size_t)256 * DM * 2; S.blk = c.blk; S.nblk = c.nblk;
  S.nM = l == 0 ? 68 : 64; S.latonly = l == 0 ? 0 : 1;
  { S.nN = 18; S.pn0 = 0; S.nextra = l == 0 ? 0 : 40;
    EpiIn E; E.PT = (bf16_t*)(p.ws + OFF_Z2 + Z2_CAT); E.Qb = (bf16_t*)(p.ws + OFF_Z1 + Z1_Q); E.Kb = (bf16_t*)(p.ws + OFF_Z1 + Z1_K); E.Vb = (bf16_t*)(p.ws + OFF_Z1 + Z1_V); E.UG = (bf16_t*)(p.ws + OFF_Z2 + Z2_UG);
    E.rc = (const float*)(p.ws + OFF_ROPE); E.rs = E.rc + 64 * 32;
    gm::gemm_phase<true, true>(lds, DM, DM, DM, S, E); }
}

__device__ __forceinline__ void fourier_stage_a(const Params& p, const Ctx& c, int l) {
  const bf16_t* PT = (const bf16_t*)(p.ws + OFF_Z2 + Z2_CAT); bf16_t* Y = (bf16_t*)(p.ws + OFF_Z2 + Z2_FC);
  constexpr float C16[16] = {1.f, 0.92387953251f, 0.70710678119f, 0.38268343237f, 0.f, -0.38268343237f, -0.70710678119f, -0.92387953251f, -1.f, -0.92387953251f, -0.70710678119f, -0.38268343237f, 0.f, 0.38268343237f, 0.70710678119f, 0.92387953251f};
  constexpr float S16[16] = {0.f, 0.38268343237f, 0.70710678119f, 0.92387953251f, 1.f, 0.92387953251f, 0.70710678119f, 0.38268343237f, 0.f, -0.38268343237f, -0.70710678119f, -0.92387953251f, -1.f, -0.92387953251f, -0.70710678119f, -0.38268343237f};
  for (long i = c.gtid; i < (long)NB * 512 * 256; i += c.nthr) { const int t2 = (int)(i & 255), ch = (int)((i >> 8) & 511), b = (int)(i >> 17);
    const bf16_t* Pb = PT + ((size_t)(0 * NB + b) * 512 + ch) * 4096 + t2; const bf16_t* Qb = PT + ((size_t)(1 * NB + b) * 512 + ch) * 4096 + t2;
    float zr[16], zq[16];
#pragma unroll
    for (int t1 = 0; t1 < 16; ++t1) { zr[t1] = bf2f(Pb[256 * t1]); zq[t1] = bf2f(Qb[256 * t1]); }
    bf16_t* Yo = Y + ((size_t)(b * 16) * 512 + ch) * 512 + t2;
#pragma unroll
    for (int k1 = 0; k1 < 16; ++k1) { float ar = 0.f, ai = 0.f;
#pragma unroll
      for (int t1 = 0; t1 < 16; ++t1) { const float cc = C16[(k1 * t1) & 15], ss = S16[(k1 * t1) & 15]; ar += zr[t1] * cc - zq[t1] * ss; ai -= zr[t1] * ss + zq[t1] * cc; }
      const float ph = (float)(k1 * t2) * (1.f / 4096.f), ct = __builtin_amdgcn_cosf(ph), st = __builtin_amdgcn_sinf(ph);
      const float yr = (ar * ct + ai * st) * 0.25f, yi = (ai * ct - ar * st) * 0.25f;
      bf16_t* yo = Yo + (size_t)k1 * 512 * 512; const unsigned w = cvtpk(yr, yi); yo[0] = (bf16_t)(w & 0xffff); yo[256] = (bf16_t)(w >> 16); } }
  if (l == 0) {
    const bf16_t* PC = PT + (size_t)2 * NB * 512 * 4096;
    for (long i = c.gtid; i < (long)NB * 512 * 64; i += c.nthr) { const int t0 = (int)(i & 31) * 8, ri = (int)((i >> 5) & 1), ch = (int)((i >> 6) & 511), b = (int)(i >> 15);
      u32x4 w = *(const u32x4*)(PC + ((size_t)(ri * NB + b) * 512 + ch) * 256 + t0); if (ri) { w[0] ^= 0x80008000u; w[1] ^= 0x80008000u; w[2] ^= 0x80008000u; w[3] ^= 0x80008000u; }
      *(u32x4*)(Y + ((size_t)32768 + b * 512 + ch) * 512 + ri * 256 + t0) = w; } }
}
struct SchedFB { const char *DB, *Y; int nunits, blk, nblk;
  __device__ __forceinline__ bool next(int i, gm::Unit& u) const { const int it = i * nblk + blk; if (it >= nunits) return false; u.pm = it; u.pn = 0; return true; }
  __device__ __forceinline__ const char* pA(const gm::Unit&) const { return DB; }
  __device__ __forceinline__ const char* pB(const gm::Unit& u) const { const int it = u.pm; const size_t row = it < 128 ? (size_t)it * 256 : (size_t)32768 + (it - 128) * 256; return Y + row * 1024; } };
struct EpiFB { bf16_t* Cat; const float* bf;
  __device__ __forceinline__ void operator()(const Acc& acc, const gm::Unit& u, int wr, int wc, int fr, int fq) const { const int it = u.pm;
    int b, tok0, tstride, chb; if (it < 128) { b = it >> 5; const int pn = it & 31; tok0 = CTXL + (pn >> 1); tstride = 16; chb = (pn & 1) * 256; } else { const int j = it - 128; b = j >> 1; tok0 = 0; tstride = 1; chb = (j & 1) * 256; }
#pragma unroll
    for (int ai = 0; ai < 2; ++ai)
#pragma unroll
      for (int m = 0; m < 4; ++m) { const int k2 = ai * 128 + wr * 64 + m * 16 + fr; bf16_t* dr = Cat + ((size_t)b * TPB + tok0 + tstride * k2) * DM + 1536 + chb + wc * 32 + fq * 4;
#pragma unroll
        for (int bj = 0; bj < 2; ++bj)
#pragma unroll
          for (int n = 0; n < 2; ++n) { const f32x4 v = acc[ai][bj][m][n] + *(const f32x4*)(bf + chb + bj * 128 + wc * 32 + n * 16 + fq * 4); u32x2 w = {cvtpk(v[0], v[1]), cvtpk(v[2], v[3])}; *(u32x2*)(dr + bj * 128 + n * 16) = w; } }
  } };
__device__ __forceinline__ void fourier_stage_b(const Params& p, const Ctx& c, int l, LAS unsigned char* lds) {
  const SchedFB S{p.ws + OFF_DFTC, p.ws + OFF_Z2 + Z2_FC, l == 0 ? 136 : 128, c.blk, c.nblk}; const EpiFB E{(bf16_t*)(p.ws + OFF_Z2 + Z2_CAT), p.b_four + (size_t)l * 512};
  gm::gemm_phase<true>(lds, 512, 512, 512, S, E);
}

struct SchedSsmS { const char *UG, *EM; int blk, nblk;
  __device__ __forceinline__ bool next(int i, gm::Unit& u) const { const int it = i * nblk + blk; if (it >= 96) return false; u.pm = it; u.pn = 0; return true; }
  __device__ __forceinline__ const char* pA(const gm::Unit& u) const { const int g = u.pm / 3, pm = u.pm % 3; return UG + ((size_t)g * 768 + pm * 256) * 768 * 2; }
  __device__ __forceinline__ const char* pB(const gm::Unit& u) const { const int g = u.pm / 3; return EM + (size_t)g * 256 * 512 * 2; } };
struct EpiSsmS { float* SB;
  __device__ __forceinline__ void operator()(const Acc& acc, const gm::Unit& u, int wr, int wc, int fr, int fq) const { const int g = u.pm / 3, pm = u.pm % 3;
#pragma unroll
    for (int ai = 0; ai < 2; ++ai)
#pragma unroll
      for (int m = 0; m < 4; ++m) { const int r = pm * 256 + ai * 128 + wr * 64 + m * 16 + fr; if (r >= 544) continue; float* dr = SB + ((size_t)g * 768 + r) * 256 + wc * 32 + fq * 4;
#pragma unroll
        for (int bj = 0; bj < 2; ++bj)
#pragma unroll
          for (int n = 0; n < 2; ++n) *(f32x4*)(dr + bj * 128 + n * 16) = acc[ai][bj][m][n]; }
  } };
__device__ __forceinline__ void phase_ssm_states(const Params& p, const Ctx& c, LAS unsigned char* lds) {
  const SchedSsmS S{p.ws + OFF_Z2 + Z2_UG, p.ws + OFF_EM, c.blk, c.nblk}; const EpiSsmS E{(float*)(p.ws + OFF_Z2 + Z2_SB)};
  gm::gemm_phase<true>(lds, 768, 512, 512, S, E);
}
struct SchedSsmY { const char *UG, *TF; int blk, nblk;
  __device__ __forceinline__ bool next(int i, gm::Unit& u) const { const int it = i * nblk + blk; if (it >= 192) return false; u.pm = it >> 1; u.pn = it & 1; return true; }
  __device__ __forceinline__ const char* pA(const gm::Unit& u) const { const int g = u.pm / 3, pm = u.pm % 3; return UG + ((size_t)g * 768 + pm * 256) * 768 * 2; }
  __device__ __forceinline__ const char* pB(const gm::Unit& u) const { const int g = u.pm / 3; return TF + ((size_t)g * 512 + u.pn * 256) * 768 * 2; } };
struct EpiSsmY { bf16_t* Gg; int last;
  __device__ __forceinline__ void operator()(const Acc& acc, const gm::Unit& u, int wr, int wc, int fr, int fq) const { const int g = u.pm / 3, pm = u.pm % 3;
#pragma unroll
    for (int ai = 0; ai < 2; ++ai)
#pragma unroll
      for (int m = 0; m < 4; ++m) { const int r = pm * 256 + ai * 128 + wr * 64 + m * 16 + fr; if (r >= 544) continue; const int b = r / 136, ch = r % 136; if (last && ch < 8) continue;
        bf16_t* dr = Gg + ((size_t)b * TPB + ch * 32) * 512 + g * 16 + ((fq * 4) & 15);
#pragma unroll
        for (int bj = 0; bj < 2; ++bj)
#pragma unroll
          for (int n = 0; n < 2; ++n) { const int t = (u.pn * 256 + bj * 128 + wc * 32 + n * 16 + fq * 4) >> 4; const f32x4 y = acc[ai][bj][m][n];
            u32x2 w = {cvtpk(gelu_tanh(y[0]), gelu_tanh(y[1])), cvtpk(gelu_tanh(y[2]), gelu_tanh(y[3]))}; *(u32x2*)(dr + (size_t)t * 512) = w; } }
  } };
__device__ __forceinline__ void phase_ssm_y(const Params& p, const Ctx& c, bool last, LAS unsigned char* lds) {
  const SchedSsmY S{p.ws + OFF_Z2 + Z2_UG, p.ws + OFF_TF, c.blk, c.nblk}; const EpiSsmY E{(bf16_t*)(p.ws + OFF_Z2 + Z2_GG), last ? 1 : 0};
  gm::gemm_phase<true>(lds, 768, 768, 768, S, E);
}

struct EpiGlu {
  const bf16_t* Gg; bf16_t* Cat; const float* bg;
  __device__ __forceinline__ void operator()(const Acc& acc, const gm::Unit& u, int wr, int wc, int fr, int fq) const { const int pm = u.pm, pn = u.pn;
#pragma unroll
    for (int ai = 0; ai < 2; ++ai)
#pragma unroll
      for (int m = 0; m < 4; ++m) { const int row = pm * 256 + ai * 128 + wr * 64 + m * 16 + fr;
#pragma unroll
        for (int bj = 0; bj < 2; ++bj)
#pragma unroll
          for (int n = 0; n < 2; ++n) { const int col = pn * 256 + bj * 128 + wc * 32 + n * 16 + fq * 4; const f32x4 z = acc[ai][bj][m][n] + *(const f32x4*)(bg + col);
            const u32x2 gw = *(const u32x2*)(Gg + (size_t)row * 512 + col);
            const float g0 = __uint_as_float(gw[0] << 16), g1 = __uint_as_float(gw[0] & 0xffff0000u), g2 = __uint_as_float(gw[1] << 16), g3 = __uint_as_float(gw[1] & 0xffff0000u);
            u32x2 w = {cvtpk(g0 * sigmoidf_(z[0]), g1 * sigmoidf_(z[1])), cvtpk(g2 * sigmoidf_(z[2]), g3 * sigmoidf_(z[3]))};
            *(u32x2*)(Cat + (size_t)row * DM + 1024 + col) = w; } }
  }
};
__device__ __forceinline__ void phase_glu(const Params& p, const Ctx& c, int l, bool last, LAS unsigned char* lds) {
  SchedMN S; S.A = p.ws + OFF_Z2 + Z2_GG; S.B = p.ws + OFF_WGLU; S.strA = (size_t)256 * 512 * 2; S.strB = (size_t)256 * 512 * 2; S.blk = c.blk; S.nblk = c.nblk;
  S.nM = last ? 64 : 68; S.latonly = last ? 1 : 0; S.nN = 2; S.pn0 = 0; S.nextra = 0;
  EpiGlu E; E.Gg = (const bf16_t*)(p.ws + OFF_Z2 + Z2_GG); E.Cat = (bf16_t*)(p.ws + OFF_Z2 + Z2_CAT); E.bg = p.b_glu + (size_t)l * 512;
  gm::gemm_phase<true>(lds, 512, 512, 512, S, E);
}

struct EpiF32 {
  bf16_t* O;
  __device__ __forceinline__ void operator()(const Acc& acc, const gm::Unit& u, int wr, int wc, int fr, int fq) const {
    bf16_t* dst = O + (size_t)u.pm * 256 * DM + u.pn * 256 + wc * 32 + fq * 8;
#pragma unroll
    for (int ai = 0; ai < 2; ++ai)
#pragma unroll
      for (int m = 0; m < 4; ++m) { bf16_t* dr = dst + (size_t)(ai * 128 + wr * 64 + m * 16 + fr) * DM;
#pragma unroll
        for (int bj = 0; bj < 2; ++bj) { const f32x4 v0 = acc[ai][bj][m][0], v1 = acc[ai][bj][m][1]; u32x4 w = {cvtpk(v0[0], v0[1]), cvtpk(v0[2], v0[3]), cvtpk(v1[0], v1[1]), cvtpk(v1[2], v1[3])}; *(u32x4*)(dr + bj * 128) = w; } }
  }
};
struct SchedSplit { const char *A, *B; size_t strA, strB, kbytes; int nunits, blk, nblk;
  __device__ __forceinline__ bool next(int i, gm::Unit& u) const { const int it = i * nblk + blk; if (it >= nunits) return false; u.pm = it; u.pn = 0; return true; }
  __device__ __forceinline__ const char* pA(const gm::Unit& u) const { const int tile = u.pm & 31, sp = u.pm >> 5; return A + (size_t)((tile >> 3) * 17) * strA + sp * kbytes; }
  __device__ __forceinline__ const char* pB(const gm::Unit& u) const { const int tile = u.pm & 31, sp = u.pm >> 5; return B + (size_t)(tile & 7) * strB + sp * kbytes; } };
struct EpiAcc { bf16_t* SLAB;
  __device__ __forceinline__ void operator()(const Acc& acc, const gm::Unit& u, int wr, int wc, int fr, int fq) const { const int tile = u.pm & 31, sp = u.pm >> 5;
    bf16_t* dst = SLAB + ((size_t)sp * NB * CTXL + (tile >> 3) * 256) * DM + (tile & 7) * 256 + wc * 32 + fq * 8;
#pragma unroll
    for (int ai = 0; ai < 2; ++ai)
#pragma unroll
      for (int m = 0; m < 4; ++m) { bf16_t* dr = dst + (size_t)(ai * 128 + wr * 64 + m * 16 + fr) * DM;
#pragma unroll
        for (int bj = 0; bj < 2; ++bj) { const f32x4 v0 = acc[ai][bj][m][0], v1 = acc[ai][bj][m][1]; u32x4 w = {cvtpk(v0[0], v0[1]), cvtpk(v0[2], v0[3]), cvtpk(v1[0], v1[1]), cvtpk(v1[2], v1[3])}; *(u32x4*)(dr + bj * 128) = w; } }
  } };
template <int KK, int NSPLIT>
__device__ __forceinline__ void phase_gemm_f32out(const Params& p, const Ctx& c, bool last, const char* A, const char* W, char* outp, char* slab, LAS unsigned char* lds) {
  SchedMN S; S.A = A; S.B = W; S.strA = (size_t)256 * KK * 2; S.strB = (size_t)256 * KK * 2; S.blk = c.blk; S.nblk = c.nblk;
  S.nM = 64; S.latonly = 1; S.nN = 8; S.pn0 = 0; S.nextra = 0;
  EpiF32 E; E.O = (bf16_t*)outp;
  gm::gemm_phase<true, true>(lds, KK, KK, KK, S, E);
  if (!last) { const SchedSplit S2{A, W, (size_t)256 * KK * 2, (size_t)256 * KK * 2, (size_t)(KK / NSPLIT) * 2, 32 * NSPLIT, c.blk, c.nblk}; const EpiAcc E2{(bf16_t*)slab};
    gm::gemm_phase<true, true>(lds, KK, KK, KK / NSPLIT, S2, E2); }
}

struct EpiGU {
  bf16_t* ACT;
  __device__ __forceinline__ void operator()(const Acc& acc, const gm::Unit& u, int wr, int wc, int fr, int fq) const {
    bf16_t* dst = ACT + (size_t)u.pm * 256 * DFF + u.pn * 128 + wc * 32 + fq * 8;
#pragma unroll
    for (int ai = 0; ai < 2; ++ai)
#pragma unroll
      for (int m = 0; m < 4; ++m) { bf16_t* dr = dst + (size_t)(ai * 128 + wr * 64 + m * 16 + fr) * DFF; u32x4 w;
#pragma unroll
        for (int n = 0; n < 2; ++n) { const f32x4 g = acc[ai][0][m][n], uu = acc[ai][1][m][n];
          w[2 * n] = cvtpk(g[0] * sigmoidf_(g[0]) * uu[0], g[1] * sigmoidf_(g[1]) * uu[1]); w[2 * n + 1] = cvtpk(g[2] * sigmoidf_(g[2]) * uu[2], g[3] * sigmoidf_(g[3]) * uu[3]); }
        *(u32x4*)dr = w; }
  }
};
__device__ __forceinline__ void phase_gemm_gu(const Params& p, const Ctx& c, bool last, LAS unsigned char* lds) {
  SchedMN S; S.A = p.ws + OFF_HN; S.B = p.ws + OFF_WGU; S.strA = (size_t)256 * DM * 2; S.strB = (size_t)256 * DM * 2; S.blk = c.blk; S.nblk = c.nblk;
  S.nM = last ? 64 : 68; S.latonly = last ? 1 : 0; S.nN = 44; S.pn0 = 0; S.nextra = 0;
  EpiGU E; E.ACT = (bf16_t*)(p.ws + OFF_Z2);
  gm::gemm_phase<true, true>(lds, DM, DM, DM, S, E);
}

__device__ __forceinline__ void phase_attn(const Params& p, const Ctx& c, int l, char* lds) {
  const bf16_t* Qb = (const bf16_t*)(p.ws + OFF_Z1 + Z1_Q); const bf16_t* Kb = (const bf16_t*)(p.ws + OFF_Z1 + Z1_K); const bf16_t* Vb = (const bf16_t*)(p.ws + OFF_Z1 + Z1_V);
  bf16_t* O = (bf16_t*)(p.ws + OFF_HN);
  const int ntot = (l == 0) ? 512 + 32 : 512;
  for (int v = c.blk; v < ntot; v += c.nblk) {
    int combo, qb, seq;
    if (v < 512) { const int rd = v >> 8, w = v & 255; combo = rd * 16 + (w & 7) * 2 + ((w >> 3) >> 4); qb = 1 + ((w >> 3) & 15); seq = TPB; }
    else { combo = v - 512; qb = 0; seq = CTXL; }
    const int mp = combo & 1, h = (combo >> 1) & 3, b = combo >> 3;
    const size_t r0 = (size_t)b * TPB;
    at::body(Qb + (r0 + qb * 256) * 1024 + (h * 2 + mp) * 128, Kb + r0 * 1024 + (h * 2 + mp) * 128, Vb + r0 * 1024 + h * 256,
             O + (r0 + qb * 256) * DM + (h * 2 + mp) * 256, seq, lds);
  }
}

__device__ __forceinline__ void phase_combine(const Params& p, const Ctx& c, int l, bool last) {
  const bf16_t* O = (const bf16_t*)(p.ws + OFF_HN); bf16_t* Cat = (bf16_t*)(p.ws + OFF_Z2 + Z2_CAT);
  const float lam_init = 0.8f - 0.6f * expf(-0.3f * (float)l);
  float lam;
  { const float a1 = p.lam_q1[l * 128 + c.lane] * p.lam_k1[l * 128 + c.lane] + p.lam_q1[l * 128 + 64 + c.lane] * p.lam_k1[l * 128 + 64 + c.lane];
    const float a2 = p.lam_q2[l * 128 + c.lane] * p.lam_k2[l * 128 + c.lane] + p.lam_q2[l * 128 + 64 + c.lane] * p.lam_k2[l * 128 + 64 + c.lane];
    lam = expf(wave_sum(a1)) - expf(wave_sum(a2)) + lam_init; }
  const f32x4 gs = *(const f32x4*)(p.g_subln + (size_t)l * 256 + c.lane * 4);
  for (int row = c.gwave; row < TT; row += c.nwave) { const int t = row % TPB; if (last && t < CTXL) continue;
    const bf16_t* orow = O + (size_t)row * DM; bf16_t* crow_ = Cat + (size_t)row * DM;
#pragma unroll
    for (int h = 0; h < 4; ++h) { const u32x2 a = *(const u32x2*)(orow + (h * 2) * 256 + c.lane * 4), bq = *(const u32x2*)(orow + (h * 2 + 1) * 256 + c.lane * 4);
      f32x4 o; o[0] = __uint_as_float(a[0] << 16) - lam * __uint_as_float(bq[0] << 16); o[1] = __uint_as_float(a[0] & 0xffff0000u) - lam * __uint_as_float(bq[0] & 0xffff0000u);
      o[2] = __uint_as_float(a[1] << 16) - lam * __uint_as_float(bq[1] << 16); o[3] = __uint_as_float(a[1] & 0xffff0000u) - lam * __uint_as_float(bq[1] & 0xffff0000u);
      const float ss = wave_sum(o[0] * o[0] + o[1] * o[1] + o[2] * o[2] + o[3] * o[3]); const float r = rsqrtf(ss * (1.f / 256.f) + 1e-5f) * (1.f - lam_init);
      o = o * r * gs; u32x2 w = {cvtpk(o[0], o[1]), cvtpk(o[2], o[3])}; *(u32x2*)(crow_ + h * 256 + c.lane * 4) = w; }
  }
}


#define XB_TMO      128
#define XB_XCNT(j)  (256  + 64 * (j))
#define XB_XSUB(j)  (1280 + 64 * (j))
#define XB_XGEN(j)  (2304 + 64 * (j))
#define XB_TOP      3328
#define XB_TOPGEN   3392
#define XCD_BAR_WORDS 3456
#define XB_SPIN_CAP (1u << 18)
__device__ __forceinline__ unsigned xb_ld(unsigned* p)              { return __hip_atomic_load(p, __ATOMIC_RELAXED, __HIP_MEMORY_SCOPE_AGENT); }
__device__ __forceinline__ unsigned xb_add(unsigned* p, unsigned v) { return __hip_atomic_fetch_add(p, v, __ATOMIC_RELAXED, __HIP_MEMORY_SCOPE_AGENT); }
__device__ __forceinline__ unsigned xb_xcc_id() { return (unsigned)__builtin_amdgcn_s_getreg((3 << 11) | 20) & 0xFu; }
#define XB_SPIN(cond, bar) do { unsigned _sp = 0; while (cond) { __builtin_amdgcn_s_sleep(1); \
    if ((++_sp & 255u) == 0u) { if (xb_ld(&(bar)[XB_TMO])) break; if (_sp > XB_SPIN_CAP) { atomicAdd(&(bar)[XB_TMO], 1u); break; } } } } while (0)
struct XcdBarrier { unsigned* bar; unsigned x; volatile LAS unsigned* st; };
__device__ __forceinline__ XcdBarrier xcd_barrier_post(unsigned* bar, volatile LAS unsigned* st) {
  XcdBarrier b; b.bar = bar; b.x = xb_xcc_id(); b.st = st;
  if (threadIdx.x == 0) (void)xb_add(&bar[XB_XCNT(b.x)], 1u);
  return b;
}
__device__ __forceinline__ void xcd_barrier_complete(unsigned* bar, unsigned x, unsigned& nloc, unsigned& nx) {
  const unsigned G = gridDim.x * gridDim.y * gridDim.z;
  unsigned sum, cnt, mine, sp = 0u;
  for (;;) {
    sum = 0u; cnt = 0u; mine = 0u;
#pragma unroll
    for (unsigned j = 0; j < 16; ++j) { const unsigned c = xb_ld(&bar[XB_XCNT(j)]); sum += c; cnt += (c > 0u) ? 1u : 0u; mine = (j == x) ? c : mine; }
    if (sum == G) break;
    __builtin_amdgcn_s_sleep(1);
    if ((++sp & 255u) == 0u) { if (xb_ld(&bar[XB_TMO])) break; if (sp > XB_SPIN_CAP) { atomicAdd(&bar[XB_TMO], 1u); break; } }
  }
  nloc = mine > 0u ? mine : 1u; nx = cnt > 0u ? cnt : 1u;
}
__device__ __forceinline__ void xcd_barrier(const XcdBarrier& b) {
  asm volatile("s_waitcnt vmcnt(0)" ::: "memory");
  __syncthreads();
  if (threadIdx.x == 0) {
    unsigned* bar = b.bar;
    __builtin_amdgcn_s_waitcnt(0);
    unsigned nloc = b.st[0], nx = b.st[1];
    if (nloc == 0u) { xcd_barrier_complete(bar, b.x, nloc, nx); b.st[0] = nloc; b.st[1] = nx; }
    const unsigned old = xb_add(&bar[XB_XSUB(b.x)], 1u);
    const unsigned gen = old / nloc;
    if (old + 1u == (gen + 1u) * nloc) {
      __builtin_amdgcn_fence(__ATOMIC_RELEASE, "agent");
      asm volatile("s_waitcnt vmcnt(0)" ::: "memory");
      const unsigned og = xb_add(&bar[XB_TOP], 1u);
      const unsigned tg = og / nx;
      if (og + 1u == (tg + 1u) * nx) xb_add(&bar[XB_TOPGEN], 1u);
      else XB_SPIN(xb_ld(&bar[XB_TOPGEN]) == tg, bar);
      __builtin_amdgcn_fence(__ATOMIC_ACQUIRE, "agent");
      xb_add(&bar[XB_XGEN(b.x)], 1u);
      asm volatile("s_waitcnt vmcnt(0)" ::: "memory");
    } else {
      XB_SPIN(xb_ld(&bar[XB_XGEN(b.x)]) == gen, bar);
      __builtin_amdgcn_fence(__ATOMIC_ACQUIRE, "agent");
      asm volatile("s_waitcnt vmcnt(0)" ::: "memory");
    }
  }
  __syncthreads();
}

__global__ void __launch_bounds__(NTHREADS) mega(Params p_arg) {
  extern __shared__ __attribute__((aligned(16))) char shm[];
  __shared__ uint4 xb_words;
  cg::grid_group grid = cg::this_grid();
  typedef const __attribute__((address_space(4))) Params* KP;
  KP kp = (KP)__builtin_amdgcn_kernarg_segment_ptr();
  unsigned* bar = (unsigned*)(p_arg.ws + OFF_BAR);
  if (threadIdx.x == 0) xb_words = make_uint4(0u, 0u, 0u, 0u);
  if (p_arg.out == nullptr) grid.sync();
  if (threadIdx.x == 0) (void)xb_add(bar + XB_XCNT(xb_xcc_id()), 1u);
  __syncthreads();
  Ctx c;
#define RECTX() do { asm volatile("" : "+s"(kp)); int t_ = threadIdx.x; asm volatile("" : "+v"(t_)); int b_ = blockIdx.x; asm volatile("" : "+s"(b_)); \
    c.tid = t_; c.wid = t_ >> 6; c.lane = t_ & 63; c.blk = b_; c.nblk = gridDim.x; c.gwave = c.blk * 8 + c.wid; c.nwave = c.nblk * 8; \
    c.gtid = (long)c.blk * NTHREADS + c.tid; c.nthr = (long)c.nblk * NTHREADS; } while (0)
  RECTX();
  LAS unsigned char* gshm = (LAS unsigned char*)shm; float* fl = (float*)shm;

#define PP (*(const Params*)kp)
#define GSYNC() do { RECTX(); XcdBarrier xb_; xb_.bar = (unsigned*)(kp->ws + OFF_BAR); xb_.x = xb_xcc_id(); xb_.st = (volatile LAS unsigned*)&xb_words; xcd_barrier(xb_); } while (0)
  phase0a(PP, c, fl);
  RECTX(); ssm_tables(PP, c);
  RECTX(); convert_weights(PP, c, 0, fl);
  GSYNC();
  RECTX(); reduce_mod(PP, c);
  RECTX(); fold_four(PP, c, 0, fl);
  RECTX(); ssm_build_mef(PP, c, 0);
  GSYNC();
  RECTX(); ssm_build_t(PP, c, 0);
  RECTX(); phase_prenorm(PP, c, 0);
  GSYNC();
  for (int l = 0; l < 2; ++l) {
    const bool last = (l == 1);
    RECTX(); phase_gemm_in(PP, c, l, gshm);
    GSYNC();
    RECTX(); fourier_stage_a(PP, c, l);
    RECTX(); phase_ssm_states(PP, c, gshm);
    GSYNC();
    RECTX(); ssm_carry(PP, c, l);
    RECTX(); phase_attn(PP, c, l, shm);
    GSYNC();
    RECTX(); phase_ssm_y(PP, c, last, gshm);
    RECTX(); phase_combine(PP, c, l, last);
    GSYNC();
    RECTX(); phase_glu(PP, c, l, last, gshm);
    RECTX(); fourier_stage_b(PP, c, l, gshm);
    GSYNC();
    RECTX(); phase_gemm_f32out<DM, 8>(PP, c, last, kp->ws + OFF_Z2 + Z2_CAT, kp->ws + OFF_WOUT, kp->ws + OFF_Z1, kp->ws + OFF_Z2, gshm);
    GSYNC();
    if (!last) { RECTX(); ssm_build_mef(PP, c, 1); }
    RECTX(); phase_postmix(PP, c, l, last);
    GSYNC();
    RECTX(); phase_gemm_gu(PP, c, last, gshm);
    GSYNC();
    RECTX(); phase_gemm_f32out<DFF, 11>(PP, c, last, kp->ws + OFF_Z2, kp->ws + OFF_WD, kp->ws + OFF_Z1 + (size_t)TT * DM * 2, kp->ws + OFF_Z1, gshm);
    GSYNC();
    if (!last) { RECTX(); ssm_build_t(PP, c, 1); }
    RECTX(); phase_postffn(PP, c, l, last);
    if (!last) { RECTX(); convert_weights(PP, c, 1, fl); RECTX(); fold_four(PP, c, 1, fl); GSYNC(); }
  }
}

extern "C" void kernel_launch(void* const* d_in, const int* in_sizes, int n_in, void* d_out, int out_size, void* d_ws, size_t ws_size,
                              hipStream_t stream) {
  static int grid_blocks = 0;
  if (!grid_blocks) {
    (void)hipFuncSetAttribute((const void*)mega, hipFuncAttributeMaxDynamicSharedMemorySize, SHM_BYTES);
    int dev = 0, cus = 0, per_cu = 0;
    (void)hipGetDevice(&dev);
    (void)hipDeviceGetAttribute(&cus, hipDeviceAttributeMultiprocessorCount, dev);
    (void)hipOccupancyMaxActiveBlocksPerMultiprocessor(&per_cu, mega, NTHREADS, SHM_BYTES);
    if (per_cu < 1) per_cu = 1;
    grid_blocks = cus;
  }
  if (n_in != 32 || ws_size < WS_NEED) { fprintf(stderr, "kernel_launch: bad n_in %d or ws %zu < %zu\n", n_in, ws_size, WS_NEED); return; }
  Params p{};
  const float** f = (const float**)&p;
  for (int i = 0; i < 32; ++i) f[i] = (const float*)d_in[i];
  p.out = (float*)d_out; p.ws = (char*)d_ws;
  (void)hipMemsetAsync((char*)d_ws + OFF_BAR, 0, 16384, stream);
  void* args[] = {&p};
  hipError_t e = hipLaunchCooperativeKernel((void*)mega, dim3(grid_blocks), dim3(NTHREADS), args, SHM_BYTES, stream);
  if (e != hipSuccess) fprintf(stderr, "cooperative launch failed: %s (grid %d)\n", hipGetErrorString(e), grid_blocks);
}
```

```cpp
#include <hip/hip_runtime.h>
#include <hip/hip_cooperative_groups.h>
#include <cstdio>
#include <cstdint>
namespace cg = cooperative_groups;

typedef unsigned short bf16_t;
using bf16x8 = __attribute__((ext_vector_type(8))) short;
using s16x4  = __attribute__((ext_vector_type(4))) short;
using f32x4  = __attribute__((ext_vector_type(4))) float;
using f32x16 = __attribute__((ext_vector_type(16))) float;
using u32x4  = __attribute__((ext_vector_type(4))) unsigned;
using u32x2  = __attribute__((ext_vector_type(2))) unsigned;
#define LAS __attribute__((address_space(3)))

constexpr int NB = 4, SEQ = 4096, CTXL = 256, TPB = SEQ + CTXL  , TT = NB * TPB  ;
constexpr int DM = 2048, NIN = 4608, DFF = 5632, NMODC = 6 * DM  ;
constexpr int NTHREADS = 512, SHM_BYTES = 131072;

constexpr size_t al256(size_t x) { return (x + 255) / 256 * 256; }
constexpr size_t OFF_X    = 0;
constexpr size_t OFF_WIN  = OFF_X + (size_t)TT * DM * 2;
constexpr size_t OFF_WOUT = OFF_WIN + (size_t)NIN * DM * 2;
constexpr size_t OFF_WGU  = OFF_WOUT + (size_t)DM * DM * 2;
constexpr size_t OFF_WD   = OFF_WGU + (size_t)2 * DFF * DM * 2;
constexpr size_t OFF_WGLU = OFF_WD + (size_t)DM * DFF * 2;
constexpr size_t OFF_DFTL = OFF_WGLU + (size_t)512 * 512 * 2;
constexpr size_t OFF_DFTC = OFF_DFTL + (size_t)2 * 4096 * 4096 * 2;
constexpr size_t OFF_MP   = OFF_DFTC + (size_t)2 * 256 * 256 * 2;
constexpr size_t OFF_MOD  = OFF_MP + (size_t)16 * 5 * 24576 * 4;
constexpr size_t OFF_ROPE = OFF_MOD + (size_t)2 * 5 * NMODC * 4;
constexpr size_t OFF_WCS  = OFF_ROPE + (size_t)2 * 64 * 32 * 4;
constexpr size_t OFF_PW   = OFF_WCS + (size_t)2 * 2 * 4 * 128 * 128 * 4;
constexpr size_t OFF_BB   = OFF_PW + (size_t)2 * 32 * 2 * 33 * 64 * 8;
constexpr size_t OFF_MK   = OFF_BB + (size_t)2 * 32 * 2 * 64 * 16 * 8;
constexpr size_t OFF_TF   = OFF_MK + (size_t)2 * 32 * 2 * 32 * 256 * 4;
constexpr size_t OFF_EM   = OFF_TF + (size_t)32 * 512 * 768 * 2;
constexpr size_t OFF_BAR  = OFF_EM + (size_t)32 * 256 * 512 * 2;
constexpr size_t OFF_HN   = OFF_BAR + 16384;
constexpr size_t OFF_Z1   = OFF_HN + (size_t)TT * DM * 2;
constexpr size_t Z1_Q = 0, Z1_K = (size_t)TT * 1024 * 2, Z1_V = 2 * Z1_K;
constexpr size_t OFF_Z2   = OFF_Z1 + (size_t)TT * DM * 4;
constexpr size_t Z2_FC = 0, Z2_FS = Z2_FC + (size_t)TT * 512 * 4;
constexpr size_t Z2_UG = Z2_FS + (size_t)TT * 512 * 4;
constexpr size_t Z2_SB = Z2_UG + (size_t)32 * 768 * 768 * 2;
constexpr size_t Z2_CAT = Z2_SB + (size_t)32 * 768 * 256 * 4;
constexpr size_t Z2_GG = Z2_CAT + (size_t)TT * DM * 2;
constexpr size_t Z2_END = Z2_GG + (size_t)TT * 512 * 2;
constexpr size_t Z2_SIZE = Z2_END > (size_t)TT * DFF * 2 ? Z2_END : (size_t)TT * DFF * 2;
constexpr size_t WS_NEED = OFF_Z2 + Z2_SIZE;
static_assert(WS_NEED <= (size_t)805306368, "workspace over 768 MiB");


struct Params {
  const float *x, *c, *ctx, *c_ctx, *w_mod, *b_mod, *g_mix_pre, *g_mix_post, *g_ffn_pre, *g_ffn_post, *w_in, *w_out;
  const float *lam_q1, *lam_k1, *lam_q2, *lam_k2, *g_subln, *ssm_a_re, *ssm_a_im, *ssm_log_dt, *ssm_b_re, *ssm_b_im;
  const float *ssm_c_re, *ssm_c_im, *ssm_d, *w_glu, *b_glu, *w_four, *b_four, *w_gate, *w_up, *w_down;
  float* out; char* ws;
};

__device__ __forceinline__ unsigned cvtpk(float lo, float hi) { unsigned r; asm volatile("v_cvt_pk_bf16_f32 %0, %1, %2" : "=v"(r) : "v"(lo), "v"(hi)); return r; }
__device__ __forceinline__ float bf2f(unsigned short b) { return __uint_as_float((unsigned)b << 16); }
template <int CTRL> __device__ __forceinline__ float dpp_add(float v) { return v + __uint_as_float(__builtin_amdgcn_update_dpp(0u, __float_as_uint(v), CTRL, 0xf, 0xf, false)); }
__device__ __forceinline__ float wave_sum(float v) {
  v = dpp_add<0xB1>(v); v = dpp_add<0x4E>(v); v = dpp_add<0x141>(v); v = dpp_add<0x140>(v);
  const int vi = (int)__float_as_uint(v);
  return (__uint_as_float((unsigned)__builtin_amdgcn_readlane(vi, 0)) + __uint_as_float((unsigned)__builtin_amdgcn_readlane(vi, 16))) + (__uint_as_float((unsigned)__builtin_amdgcn_readlane(vi, 32)) + __uint_as_float((unsigned)__builtin_amdgcn_readlane(vi, 48)));
}
__device__ __forceinline__ void my_sincos(float x, float& s, float& c) {
  const double xd = (double)x; const double kd = rint(xd * 0.63661977236758134); const double r = xd - kd * 1.5707963267948966;
  const double r2 = r * r;
  const double sn = r * (1.0 - r2 / 6.0 * (1.0 - r2 / 20.0 * (1.0 - r2 / 42.0 * (1.0 - r2 / 72.0 * (1.0 - r2 / 110.0 * (1.0 - r2 / 156.0))))));
  const double cs = 1.0 - r2 / 2.0 * (1.0 - r2 / 12.0 * (1.0 - r2 / 30.0 * (1.0 - r2 / 56.0 * (1.0 - r2 / 90.0 * (1.0 - r2 / 132.0)))));
  const int q = ((int)kd) & 3;
  const double ss = (q == 0) ? sn : (q == 1) ? cs : (q == 2) ? -sn : -cs;
  const double cc = (q == 0) ? cs : (q == 1) ? -sn : (q == 2) ? -cs : sn;
  s = (float)ss; c = (float)cc;
}
__device__ __forceinline__ float sigmoidf_(float x) { return __builtin_amdgcn_rcpf(1.f + __builtin_amdgcn_exp2f(x * -1.4426950408889634f)); }
__device__ __forceinline__ float gelu_tanh(float y) { const float u = 0.7978845608028654f * (y + 0.044715f * y * y * y); return y * sigmoidf_(2.f * u); }

namespace gm {
constexpr int BM = 256, BK = 64, HALF = 128, HTB = HALF * BK * 2, NXCD = 8, WGM = 8;
__device__ __forceinline__ int lds_byte(int r, int c) { const int st = (r >> 4) * 2 + (c >> 5), rr = r & 15, cc = c & 31, ob = rr * 64 + cc * 2; return st * 1024 + (ob ^ (((ob >> 9) & 1) << 5)); }
__device__ __forceinline__ void stage_rc(int b, int& R, int& C) { const int st = b / 1024, sb = b % 1024, swz = sb ^ (((sb >> 9) & 1) << 5); R = (st >> 1) * 16 + swz / 64; C = (st & 1) * 32 + (swz % 64) / 2; }
__device__ __forceinline__ void tile_of(int wgid, int nM, int nN, int& pm, int& pn) {
  const int nwg = nM * nN; { const int q = nwg / NXCD, r = nwg % NXCD, xcd = wgid % NXCD, off = wgid / NXCD; wgid = (xcd < r ? xcd * (q + 1) : r * (q + 1) + (xcd - r) * q) + off; }
  const int nig = WGM * nN, gid = wgid / nig, fm = gid * WGM, gsz = (nM - fm) < WGM ? (nM - fm) : WGM;
  pm = fm + ((wgid % nig) % gsz); pn = (wgid % nig) / gsz;
}
struct Unit { int pm, pn; };

template <bool SWAP, bool PERM = false, class Epi, class Sched>
__device__ __forceinline__ void gemm_phase(LAS unsigned char* lds, const int lda, const int ldb, const int K, const Sched& S, const Epi& E) {
  int tid_ = threadIdx.x; asm volatile("" : "+v"(tid_));
  const int tid = tid_, wid = __builtin_amdgcn_readfirstlane(tid >> 6), lane = tid & 63, wr = wid >> 2, wc = wid & 3, fr = lane & 15, fq = lane >> 4;
  const int nt = K / BK;
  unsigned voffA[2], voffB[2];
#pragma unroll
  for (int i = 0; i < 2; ++i) { int R, C; stage_rc(tid * 16 + i * 8192, R, C); voffA[i] = (unsigned)(R * lda + C) * 2u;
    const int rho = R & 31, Rb = PERM ? ((R & ~31) + 8 * ((rho & 15) >> 2) + 4 * (rho >> 4) + (rho & 3)) : R;
    voffB[i] = (unsigned)(Rb * ldb + C) * 2u; }
  const size_t kstep = (size_t)(BK * 2), hstepA = (size_t)HALF * lda * 2, hstepB = (size_t)HALF * ldb * 2;
  const unsigned ldsw = (unsigned)wid * 1024u;
  const int aoff = lds_byte(wr * 64 + fr, fq * 8), boff = lds_byte(wc * 32 + fr, fq * 8);
#define PG8_SA(b, h) (((b) * 2 + (h)) * HTB)
#define PG8_SB(b, h) ((4 + (b) * 2 + (h)) * HTB)
#define PG8_STAGE(bufoff, gbase, voff) do { _Pragma("unroll") for (int _i = 0; _i < 2; ++_i) \
    __builtin_amdgcn_global_load_lds((const unsigned*)((const char*)(gbase) + (voff)[_i]), (LAS unsigned*)(lds + (bufoff) + ldsw + _i * 8192), 16, 0, 0); } while (0)
#define PG8_LDA(dst, b, h) do { _Pragma("unroll") for (int m = 0; m < 4; ++m) _Pragma("unroll") for (int k = 0; k < 2; ++k) dst[m][k] = *(const LAS bf16x8*)(lds + PG8_SA(b, h) + aoff + m * 2048 + k * 1024); } while (0)
#define PG8_LDB(dst, b, h) do { _Pragma("unroll") for (int n = 0; n < 2; ++n) _Pragma("unroll") for (int k = 0; k < 2; ++k) dst[n][k] = *(const LAS bf16x8*)(lds + PG8_SB(b, h) + boff + n * 2048 + k * 1024); } while (0)
#define PG8_MMA(ai, bj, At, Bt) do { __builtin_amdgcn_s_setprio(1); _Pragma("unroll") for (int m = 0; m < 4; ++m) _Pragma("unroll") for (int n = 0; n < 2; ++n) _Pragma("unroll") for (int k = 0; k < 2; ++k) \
    acc[ai][bj][m][n] = SWAP ? __builtin_amdgcn_mfma_f32_16x16x32_bf16(Bt[n][k], At[m][k], acc[ai][bj][m][n], 0, 0, 0) \
                             : __builtin_amdgcn_mfma_f32_16x16x32_bf16(At[m][k], Bt[n][k], acc[ai][bj][m][n], 0, 0, 0); __builtin_amdgcn_s_setprio(0); } while (0)
#define PG8_WAIT_V(n) asm volatile("s_waitcnt vmcnt(" #n ")" ::: "memory")
#define PG8_WAIT_L(n) asm volatile("s_waitcnt lgkmcnt(" #n ")" ::: "memory")
#define PG8_BAR __builtin_amdgcn_s_barrier()
#define PG8_SCHED __builtin_amdgcn_sched_barrier(0)
  Unit cur, nxt; int ui = 0;
  if (!S.next(0, cur)) return;
  f32x4 acc[2][2][4][2];
#pragma unroll
  for (int a = 0; a < 2; ++a)
#pragma unroll
    for (int b = 0; b < 2; ++b)
#pragma unroll
      for (int m = 0; m < 4; ++m)
#pragma unroll
        for (int n = 0; n < 2; ++n) acc[a][b][m][n] = (f32x4){0.f, 0.f, 0.f, 0.f};
  bf16x8 At[4][2], B0[2][2], B1[2][2];
  const char* cA = S.pA(cur); const char* cB = S.pB(cur);
  PG8_STAGE(PG8_SB(0, 0), cB, voffB); PG8_STAGE(PG8_SB(0, 1), cB + hstepB, voffB); PG8_STAGE(PG8_SA(0, 0), cA, voffA); PG8_STAGE(PG8_SA(0, 1), cA + hstepA, voffA);
  if (wr == 1) PG8_BAR;
  PG8_WAIT_V(2); PG8_BAR;
  PG8_STAGE(PG8_SB(1, 0), cB + kstep, voffB); PG8_STAGE(PG8_SA(1, 0), cA + kstep, voffA); PG8_STAGE(PG8_SB(1, 1), cB + hstepB + kstep, voffB);
  PG8_WAIT_V(6); PG8_BAR;
  for (;;) {
    const bool has_next = S.next(ui + 1, nxt);
    const char* nA = has_next ? S.pA(nxt) : cA; const char* nB = has_next ? S.pB(nxt) : cB;
    for (int t = 0; t < nt; t += 2) {
      const bool last = (t == nt - 2);
      const char* a1 = cA + (size_t)(t + 1) * kstep;
      const char* a2 = last ? nA : cA + (size_t)(t + 2) * kstep; const char* b2 = last ? nB : cB + (size_t)(t + 2) * kstep;
      const char* a3 = a2 + kstep; const char* b3 = b2 + kstep;
      PG8_LDB(B0, 0, 0); PG8_LDB(B1, 0, 1); PG8_SCHED; PG8_LDA(At, 0, 0); PG8_STAGE(PG8_SA(1, 1), a1 + hstepA, voffA);
      PG8_WAIT_V(8); PG8_WAIT_L(0); PG8_BAR; PG8_MMA(0, 0, At, B0); PG8_MMA(0, 1, At, B1); PG8_BAR; PG8_SCHED;
      PG8_LDA(At, 0, 1); PG8_STAGE(PG8_SB(0, 0), b2, voffB); PG8_STAGE(PG8_SB(0, 1), b2 + hstepB, voffB); PG8_STAGE(PG8_SA(0, 0), a2, voffA);
      PG8_WAIT_V(8); PG8_WAIT_L(0); PG8_BAR; PG8_MMA(1, 0, At, B0); PG8_MMA(1, 1, At, B1); PG8_BAR; PG8_SCHED;
      PG8_LDB(B0, 1, 0); PG8_LDB(B1, 1, 1); PG8_SCHED; PG8_LDA(At, 1, 0); PG8_STAGE(PG8_SA(0, 1), a2 + hstepA, voffA);
      PG8_WAIT_V(8); PG8_WAIT_L(0); PG8_BAR; PG8_MMA(0, 0, At, B0); PG8_MMA(0, 1, At, B1); PG8_BAR; PG8_SCHED;
      PG8_LDA(At, 1, 1); PG8_STAGE(PG8_SB(1, 0), b3, voffB); PG8_STAGE(PG8_SB(1, 1), b3 + hstepB, voffB); PG8_STAGE(PG8_SA(1, 0), a3, voffA);
      PG8_WAIT_V(8); PG8_WAIT_L(0); PG8_BAR; PG8_MMA(1, 0, At, B0); PG8_MMA(1, 1, At, B1); PG8_BAR; PG8_SCHED;
    }
    if (wr == 0) PG8_BAR;
    { int fr2 = fr, fq2 = fq; asm volatile("" : "+v"(fr2), "+v"(fq2));
      E(acc, cur, wr, wc, fr2, fq2); }
    if (!has_next) break;
#pragma unroll
    for (int a = 0; a < 2; ++a)
#pragma unroll
      for (int b = 0; b < 2; ++b)
#pragma unroll
        for (int m = 0; m < 4; ++m)
#pragma unroll
          for (int n = 0; n < 2; ++n) acc[a][b][m][n] = (f32x4){0.f, 0.f, 0.f, 0.f};
    cur = nxt; cA = nA; cB = nB; ++ui;
    if (wr == 1) PG8_BAR;
  }
  PG8_WAIT_V(0);
  PG8_BAR;
#undef PG8_SA
#undef PG8_SB
#undef PG8_STAGE
#undef PG8_LDA
#undef PG8_LDB
#undef PG8_MMA
#undef PG8_WAIT_V
#undef PG8_WAIT_L
#undef PG8_BAR
#undef PG8_SCHED
}
}

namespace at {
constexpr int D = 128, NW = 8, QBLK = 32, KVBLK = 64;
constexpr float SCALE = 0.088388347648318440f;
constexpr float THR = 8.f;
constexpr int LDQ = 1024, LDK = 1024, LDV = 1024, LDO = 2048;
constexpr size_t SHM_V = KVBLK * D * 2, SHM_K = KVBLK * D * 2;
#define KSWZ(row, colB) ((row) * 256 + ((colB) ^ (((row) & 7) << 4)))
#define SBAR() __builtin_amdgcn_sched_barrier(0)
__device__ __forceinline__ int crow(int r, int hi) { return (r & 3) + 8 * (r >> 2) + 4 * hi; }
__device__ __forceinline__ void partialSM(f32x16& p0, f32x16& p1, float& m_reg, float& mn, float& alpha) {
  constexpr float C = SCALE * 1.4426950408889634f;
  float pmax = p0[0];
#pragma unroll
  for (int r = 1; r < 16; ++r) pmax = fmaxf(pmax, p0[r]);
#pragma unroll
  for (int r = 0; r < 16; ++r) pmax = fmaxf(pmax, p1[r]);
  { auto rr = __builtin_amdgcn_permlane32_swap(__float_as_uint(pmax), __float_as_uint(pmax), false, false);
    pmax = fmaxf(__uint_as_float(rr[0]), __uint_as_float(rr[1])); }
  if (__builtin_expect(__all(pmax - m_reg <= THR / SCALE), 1)) { mn = m_reg; alpha = 1.f; }
  else { mn = fmaxf(m_reg, pmax); alpha = __builtin_amdgcn_exp2f((m_reg - mn) * C); m_reg = mn; }
  float mnC = -mn * C;
#pragma unroll
  for (int r = 0; r < 16; ++r) p0[r] = fmaf(p0[r], C, mnC);
#pragma unroll
  for (int r = 0; r < 16; ++r) p1[r] = fmaf(p1[r], C, mnC);
#pragma unroll
  for (int r = 0; r < 16; ++r) p0[r] = __builtin_amdgcn_exp2f(p0[r]);
}
__device__ __forceinline__ void finishSM(f32x16& p0, f32x16& p1, float alpha, float& l_reg, bf16x8& pa0, bf16x8& pa1, bf16x8& pa2, bf16x8& pa3) {
#pragma unroll
  for (int r = 0; r < 16; ++r) p1[r] = __builtin_amdgcn_exp2f(p1[r]);
  float ps = 0;
#pragma unroll
  for (int r = 0; r < 16; ++r) ps += p0[r];
#pragma unroll
  for (int r = 0; r < 16; ++r) ps += p1[r];
  { auto rr = __builtin_amdgcn_permlane32_swap(__float_as_uint(ps), __float_as_uint(ps), false, false);
    ps = __uint_as_float(rr[0]) + __uint_as_float(rr[1]); }
  l_reg = l_reg * alpha + ps;
#define PK4(P, BASE, OUT) do { unsigned a0 = cvtpk(P[BASE + 0], P[BASE + 1]), a1 = cvtpk(P[BASE + 2], P[BASE + 3]);   \
    unsigned b0 = cvtpk(P[BASE + 4], P[BASE + 5]), b1 = cvtpk(P[BASE + 6], P[BASE + 7]);                              \
    auto r0 = __builtin_amdgcn_permlane32_swap(a0, b0, false, false); auto r1 = __builtin_amdgcn_permlane32_swap(a1, b1, false, false); \
    u32x4 w = {r0[0], r1[0], r0[1], r1[1]}; OUT = *reinterpret_cast<bf16x8*>(&w); } while (0)
  PK4(p0, 0, pa0); PK4(p0, 8, pa1); PK4(p1, 0, pa2); PK4(p1, 8, pa3);
#undef PK4
}
__device__ __forceinline__ void qkt(f32x16& p0, f32x16& p1, const char* Ks, const bf16x8* qr, int r32, int hi) {
  p0 = f32x16{}; p1 = f32x16{};
#pragma unroll
  for (int d0 = 0; d0 < 8; ++d0) { int cb = (d0 * 16 + hi * 8) * 2;
    bf16x8 b0 = *reinterpret_cast<const bf16x8*>(Ks + KSWZ(r32, cb));
    bf16x8 b1 = *reinterpret_cast<const bf16x8*>(Ks + KSWZ(32 + r32, cb));
    p0 = __builtin_amdgcn_mfma_f32_32x32x16_bf16(b0, qr[d0], p0, 0, 0, 0);
    p1 = __builtin_amdgcn_mfma_f32_32x32x16_bf16(b1, qr[d0], p1, 0, 0, 0); }
}
__device__ __forceinline__ int v_st(int k, int c) { const int kk = (k & ~0xC) | ((k & 4) << 1) | ((k & 8) >> 1); return ((kk >> 3) * 8 + (c >> 5)) * 512 + ((kk & 7) * 32 + (c & 31)) * 2; }
__device__ __forceinline__ int v_rd_base(int lane) { return ((lane & 3) << 3) | (((lane >> 2) & 3) << 6) | (((lane >> 4) & 1) << 5) | (((lane >> 5) & 1) << 8); }
constexpr int v_rd_off(int d0, int ks, int half) { return d0 * 512 + ks * 8192 + half * 4096; }
template <int OFF> __device__ __forceinline__ s16x4 tr_read(int vb) {
  s16x4 r; asm volatile("ds_read_b64_tr_b16 %0, %1 offset:%2" : "=&v"(r) : "v"(vb), "i"(OFF) : "memory"); return r;
}
struct VFrag { s16x4 l0, h0, l1, h1, l2, h2, l3, h3; };
template <int D0> __device__ __forceinline__ void v_load(VFrag& f, int vb) {
  f.l0 = tr_read<v_rd_off(D0, 0, 0)>(vb); f.h0 = tr_read<v_rd_off(D0, 0, 1)>(vb); f.l1 = tr_read<v_rd_off(D0, 1, 0)>(vb); f.h1 = tr_read<v_rd_off(D0, 1, 1)>(vb);
  f.l2 = tr_read<v_rd_off(D0, 2, 0)>(vb); f.h2 = tr_read<v_rd_off(D0, 2, 1)>(vb); f.l3 = tr_read<v_rd_off(D0, 3, 0)>(vb); f.h3 = tr_read<v_rd_off(D0, 3, 1)>(vb);
}
__device__ __forceinline__ void pv_mma(f32x16& od, const VFrag& f, bf16x8 pa0, bf16x8 pa1, bf16x8 pa2, bf16x8 pa3) {
#define PK(L, H) (bf16x8){L[0], L[1], L[2], L[3], H[0], H[1], H[2], H[3]}
  od = __builtin_amdgcn_mfma_f32_32x32x16_bf16(pa0, PK(f.l0, f.h0), od, 0, 0, 0);
  od = __builtin_amdgcn_mfma_f32_32x32x16_bf16(pa1, PK(f.l1, f.h1), od, 0, 0, 0);
  od = __builtin_amdgcn_mfma_f32_32x32x16_bf16(pa2, PK(f.l2, f.h2), od, 0, 0, 0);
  od = __builtin_amdgcn_mfma_f32_32x32x16_bf16(pa3, PK(f.l3, f.h3), od, 0, 0, 0);
#undef PK
}
__device__ __forceinline__ void pv_all(f32x16* o, int vb, bf16x8 pa0, bf16x8 pa1, bf16x8 pa2, bf16x8 pa3) {
  VFrag fa, fb;
  v_load<0>(fa, vb);
#define STEP(D, CUR, NXT) v_load<D + 1>(NXT, vb); asm volatile("s_waitcnt lgkmcnt(8)" ::: "memory"); SBAR(); pv_mma(o[D], CUR, pa0, pa1, pa2, pa3); SBAR();
  STEP(0, fa, fb) STEP(1, fb, fa) STEP(2, fa, fb) STEP(3, fb, fa) STEP(4, fa, fb) STEP(5, fb, fa) STEP(6, fa, fb)
#undef STEP
  asm volatile("s_waitcnt lgkmcnt(0)" ::: "memory"); SBAR(); pv_mma(o[7], fb, pa0, pa1, pa2, pa3);
}
__device__ __forceinline__ void body(const bf16_t* __restrict__ Qb, const bf16_t* __restrict__ Kh, const bf16_t* __restrict__ Vh, bf16_t* __restrict__ Ob, int seq, char* lds) {
  int tid_ = threadIdx.x; asm volatile("" : "+v"(tid_));
  const int tid = tid_, wid = tid >> 6, lane = tid & 63, r32 = lane & 31, hi = lane >> 5;
  constexpr int SV = 64 * 256 * 2, SK = 64 * 128 * 2;
  char* V_lds = lds; char* K_lds = lds + 2 * SV;
  float* ws = (float*)(lds + 2 * SV + 2 * SK) + wid * 64; float* li_l = ws; float* al_l = ws + 32;
  float m_reg = -1e30f, l_reg = 0; f32x16 o[8] = {}; bf16x8 qr[8];
  const bf16_t* Qw = Qb + (long)(wid * QBLK + r32) * LDQ + hi * 8;
#pragma unroll
  for (int d0 = 0; d0 < 8; ++d0) qr[d0] = *reinterpret_cast<const bf16x8*>(Qw + d0 * 16);
  const int wu = __builtin_amdgcn_readfirstlane(wid);
  int koff[2], voff[4];
#pragma unroll
  for (int q = 0; q < 2; ++q) { const int row = 4 * (wu * 2 + q) + (lane >> 4); koff[q] = row * LDK + ((((lane & 15) << 4) ^ ((row & 7) << 4)) >> 1); }
#pragma unroll
  for (int q = 0; q < 4; ++q) { const int s = 2 * (wu * 4 + q) + (lane >> 5), kk = (s >> 3) * 8 + ((lane & 31) >> 2), k = (kk & ~0xC) | ((kk & 4) << 1) | ((kk & 8) >> 1);
    voff[q] = k * LDV + (s & 7) * 32 + (lane & 3) * 8; }
  const int vb0 = (int)(uintptr_t)(LAS char*)V_lds + v_rd_base(lane);
  LAS char* Vl = (LAS char*)V_lds; LAS char* Kl = (LAS char*)K_lds;
#define STAGE(b, k0) do { const bf16_t* kg = Kh + (long)(k0) * LDK; const bf16_t* vg = Vh + (long)(k0) * LDV; \
    _Pragma("unroll") for (int q = 0; q < 2; ++q) __builtin_amdgcn_global_load_lds((const unsigned*)(kg + koff[q]), (LAS unsigned*)(Kl + (b) * SK + (wu * 2 + q) * 1024), 16, 0, 0); \
    _Pragma("unroll") for (int q = 0; q < 4; ++q) __builtin_amdgcn_global_load_lds((const unsigned*)(vg + voff[q]), (LAS unsigned*)(Vl + (b) * SV + (wu * 4 + q) * 1024), 16, 0, 0); } while (0)
  const int NT = seq / KVBLK;
  STAGE(0, 0);
  asm volatile("s_waitcnt vmcnt(0) lgkmcnt(0)" ::: "memory"); __builtin_amdgcn_s_barrier(); asm volatile("" ::: "memory");
  for (int j = 0; j < NT; ++j) {
    const int b = j & 1;
    f32x16 p0, p1; float mn, al; bf16x8 pa0, pa1, pa2, pa3;
    if (j + 1 < NT) STAGE(b ^ 1, (j + 1) * KVBLK);
    SBAR(); qkt(p0, p1, K_lds + b * SK, qr, r32, hi);
    partialSM(p0, p1, m_reg, mn, al);
    if (__any(al < 1.f)) { if (hi == 0) al_l[r32] = al; asm volatile("s_waitcnt lgkmcnt(0)" ::: "memory");
#pragma unroll
      for (int d = 0; d < 8; ++d)
#pragma unroll
        for (int r = 0; r < 16; ++r) o[d][r] *= al_l[crow(r, hi)]; }
    finishSM(p0, p1, al, l_reg, pa0, pa1, pa2, pa3); SBAR();
    const int vb = vb0 + b * SV;
    pv_all(o, vb, pa0, pa1, pa2, pa3);
    asm volatile("s_waitcnt vmcnt(0) lgkmcnt(0)" ::: "memory"); __builtin_amdgcn_s_barrier(); asm volatile("" ::: "memory");
  }
  if (hi == 0) li_l[r32] = l_reg; asm volatile("s_waitcnt lgkmcnt(0)" ::: "memory");
  float rli[16];
#pragma unroll
  for (int r = 0; r < 16; ++r) rli[r] = __builtin_amdgcn_rcpf(li_l[crow(r, hi)]);
  bf16_t* Ow = Ob + (long)(wid * QBLK) * LDO;
#pragma unroll
  for (int r = 0; r < 16; ++r) { int orow = crow(r, hi);
#pragma unroll
    for (int d0 = 0; d0 < 8; ++d0) Ow[(long)orow * LDO + d0 * 32 + r32] = (bf16_t)(cvtpk(o[d0][r] * rli[r], 0.f) & 0xffff); }
#undef STAGE
  __syncthreads();
}
}

struct Ctx {
  int tid, wid, lane, blk, nblk, gwave, nwave; long gtid, nthr;
};

__device__ __forceinline__ const float* modp(const Params& p, int l, int v, int j) { return (const float*)(p.ws + OFF_MOD) + ((size_t)(l * 5 + v) * NMODC + (size_t)j * DM); }

__device__ __forceinline__ void convert_weights(const Params& p, const Ctx& c, int l, float* lds) {
  constexpr int T0 = 14 * 32, T1 = 8 * 32, T2 = 44 * 32, T3 = 8 * 88, T4 = 2 * 8, TALL = T0 + T1 + T2 + T3 + T4;
  for (int it = c.blk; it < TALL; it += c.nblk) {
    int mat, ti = it;
    if (ti < T0) mat = 0; else if ((ti -= T0) < T1) mat = 1; else if ((ti -= T1) < T2) mat = 2; else if ((ti -= T2) < T3) mat = 3; else { ti -= T3; mat = 4; }
    const float* src; long ld; bf16_t* dst; long dld; int nkt;
    if (mat == 0) { src = p.w_in + (size_t)l * DM * 4096; ld = 4096; dst = (bf16_t*)(p.ws + OFF_WIN); dld = DM; nkt = 32; }
    else if (mat == 1) { src = p.w_out + (size_t)l * DM * DM; ld = DM; dst = (bf16_t*)(p.ws + OFF_WOUT); dld = DM; nkt = 32; }
    else if (mat == 2) { src = p.w_gate + (size_t)l * DM * DFF; ld = DFF; dst = (bf16_t*)(p.ws + OFF_WGU); dld = DM; nkt = 32; }
    else if (mat == 3) { src = p.w_down + (size_t)l * DFF * DM; ld = DM; dst = (bf16_t*)(p.ws + OFF_WD); dld = DFF; nkt = 88; }
    else { src = p.w_glu + (size_t)l * 512 * 512; ld = 512; dst = (bf16_t*)(p.ws + OFF_WGLU); dld = 512; nkt = 8; }
    const int n0 = (ti / nkt) * 256, k0 = (ti % nkt) * 64;
    {
      const int nn = c.tid & 255, kk0 = c.tid >> 8, np = n0 + nn; int scol = np;
      if (mat == 0) { if (np < 2048) { const int ph = np & 127; scol = (np & ~127) | (ph & 64) | (((ph >> 2) & 1) << 5) | (((ph >> 5) & 1) << 4) | (((ph >> 3) & 3) << 2) | (ph & 3); } }
      else if (mat == 2) { const int pn = np >> 8, bj = (np >> 7) & 1; scol = pn * 128 + (np & 127); if (bj) src = p.w_up + (size_t)l * DM * DFF; }
      const float* sp = src + (size_t)(k0 + kk0) * ld + scol; float v[32];
#pragma unroll
      for (int i = 0; i < 32; ++i) v[i] = sp[(size_t)(2 * i) * ld];
#pragma unroll
      for (int i = 0; i < 32; ++i) lds[(kk0 + 2 * i) * 257 + nn] = v[i];
    }
    __syncthreads();
    {
      const int kc = (c.tid & 7) * 8;
#pragma unroll
      for (int j = 0; j < 4; ++j) { const int nn = (c.tid >> 3) + 64 * j; float v[8];
#pragma unroll
        for (int i = 0; i < 8; ++i) v[i] = lds[(kc + i) * 257 + nn];
        u32x4 w = {cvtpk(v[0], v[1]), cvtpk(v[2], v[3]), cvtpk(v[4], v[5]), cvtpk(v[6], v[7])};
        *(u32x4*)(dst + (size_t)(n0 + nn) * dld + k0 + kc) = w; }
    }
    __syncthreads();
  }
}

__device__ __forceinline__ void fold_four(const Params& p, const Ctx& c, int l, float* lds) {
  float* WlT = lds;
  float* Wc = lds + 128 * 68;
  const float* wcs = (const float*)(p.ws + OFF_WCS) + (size_t)l * 2 * 4 * 128 * 128;
  bf16_t* dstb = (bf16_t*)(p.ws + OFF_WIN);
  for (int u = c.blk; u < 256; u += c.nblk) {
    const int kt = u & 31, cs = (u >> 5) & 1, g = u >> 6, k0 = kt * 64;
    const float* src = p.w_in + (size_t)l * DM * 4096 + 3584 + g * 128;
    for (int i = c.tid; i < 64 * 128; i += NTHREADS) { const int kk = i >> 7, cc = i & 127; WlT[cc * 68 + kk] = src[(size_t)(k0 + kk) * 4096 + cc]; }
    const float* wsrc = wcs + (size_t)(cs * 4 + g) * 128 * 128;
    for (int i = c.tid; i < 128 * 128; i += NTHREADS) Wc[i] = wsrc[i];
    __syncthreads();
    const int kq = c.tid & 15, dq = c.tid >> 4;
    f32x4 acc[4] = {};
    for (int cc = 0; cc < 128; ++cc) {
      const f32x4 a = *(const f32x4*)(WlT + cc * 68 + kq * 4), w = *(const f32x4*)(Wc + cc * 128 + dq * 4);
#pragma unroll
      for (int di = 0; di < 4; ++di) acc[di] += a * w[di];
    }
#pragma unroll
    for (int di = 0; di < 4; ++di) { u32x2 o = {cvtpk(acc[di][0], acc[di][1]), cvtpk(acc[di][2], acc[di][3])};
      *(u32x2*)(dstb + (size_t)(3584 + cs * 512 + g * 128 + dq * 4 + di) * DM + k0 + kq * 4) = o; }
    __syncthreads();
  }
}


__device__ __forceinline__ void ssm_tables(const Params& p, const Ctx& c) {
  float2* PW = (float2*)(p.ws + OFF_PW); float2* BB = (float2*)(p.ws + OFF_BB);
  for (long i = c.gtid; i < 2L * 32 * 2 * 64; i += c.nthr) { const int pp = (int)(i & 63), idx = (int)(i >> 6);
    const int d = idx & 1, g = (idx >> 1) & 31, l = idx >> 6, iidx = (l * 2 + d) * 32 + g;
    const float lre = p.ssm_a_re[iidx * 64 + pp], lim = p.ssm_a_im[iidx * 64 + pp], dt = expf(p.ssm_log_dt[iidx]);
    float ar = 1.f, ai = 0.f;
    for (int j = 0; j <= 32; ++j) { const float mag = expf(lre * dt * (float)j); float sn, cs; my_sincos(lim * dt * (float)j, sn, cs);
      PW[((size_t)idx * 33 + j) * 64 + pp] = make_float2(mag * cs, mag * sn); if (j == 1) { ar = mag * cs; ai = mag * sn; } }
    const float nr = ar - 1.f, ni = ai, den = 1.f / (lre * lre + lim * lim), cr = (nr * lre + ni * lim) * den, ci = (ni * lre - nr * lim) * den;
    const float* br = p.ssm_b_re + ((size_t)iidx * 64 + pp) * 16; const float* bi = p.ssm_b_im + ((size_t)iidx * 64 + pp) * 16;
    for (int h = 0; h < 16; ++h) BB[((size_t)idx * 64 + pp) * 16 + h] = make_float2(cr * br[h] - ci * bi[h], cr * bi[h] + ci * br[h]); }
}
__device__ __forceinline__ void ssm_build_mef(const Params& p, const Ctx& c, int l) {
  const float2* PW = (const float2*)(p.ws + OFF_PW) + (size_t)l * 32 * 2 * 33 * 64; const float2* BB = (const float2*)(p.ws + OFF_BB) + (size_t)l * 32 * 2 * 64 * 16;
  float* MK = (float*)(p.ws + OFF_MK) + (size_t)l * 32 * 2 * 32 * 256; bf16_t* EM = (bf16_t*)(p.ws + OFF_EM); bf16_t* TF = (bf16_t*)(p.ws + OFF_TF);
  for (long i = c.gtid; i < 32L * 2 * 32 * 256; i += c.nthr) { const int hp = (int)(i & 15), h = (int)((i >> 4) & 15), j = (int)((i >> 8) & 31), gd = (int)(i >> 13), d = gd & 1, g = gd >> 1;
    const size_t ci = ((size_t)((l * 2 + d) * 32 + g) * 16 + h) * 64; const float2* pw = PW + ((size_t)gd * 33 + j) * 64; const float2* bb = BB + (size_t)gd * 64 * 16 + hp; float a = 0.f;
    for (int pp = 0; pp < 64; ++pp) { const float cr = p.ssm_c_re[ci + pp], cim = p.ssm_c_im[ci + pp]; const float2 b = bb[pp * 16], w = pw[pp];
      const float wr = cr * b.x - cim * b.y, wi = cr * b.y + cim * b.x; a += wr * w.x - wi * w.y; }
    MK[i] = a; }
  for (long i = c.gtid; i < 32L * 256 * 32 * 2; i += c.nthr) { const int hh = (int)(i & 1), s = (int)((i >> 1) & 31), n = (int)((i >> 6) & 255), g = (int)(i >> 14), ri = n & 1, pp = (n >> 1) & 63, d = n >> 7;
    const int gd = g * 2 + d, e = d ? s : 31 - s; const float2 w = PW[((size_t)gd * 33 + e) * 64 + pp]; const float2* bb = BB + ((size_t)gd * 64 + pp) * 16 + hh * 8; float v[8];
#pragma unroll
    for (int k = 0; k < 8; ++k) { const float2 b = bb[k]; v[k] = ri ? (w.x * b.y + w.y * b.x) : (w.x * b.x - w.y * b.y); }
    u32x4 o = {cvtpk(v[0], v[1]), cvtpk(v[2], v[3]), cvtpk(v[4], v[5]), cvtpk(v[6], v[7])}; *(u32x4*)(EM + ((size_t)g * 256 + n) * 512 + s * 16 + hh * 8) = o; }
  for (long i = c.gtid; i < 32L * 512 * 2 * 16; i += c.nthr) { const int pq = (int)(i & 15), d = (int)((i >> 4) & 1), n = (int)((i >> 5) & 511), g = (int)(i >> 14), h = n & 15, t = n >> 4;
    const int gd = g * 2 + d, f = d ? 32 - t : t + 1; const size_t ci = ((size_t)((l * 2 + d) * 32 + g) * 16 + h) * 64 + pq * 4; const float2* pw = PW + ((size_t)gd * 33 + f) * 64 + pq * 4; float v[8];
#pragma unroll
    for (int k = 0; k < 4; ++k) { const float cr = p.ssm_c_re[ci + k], cim = p.ssm_c_im[ci + k]; const float2 w = pw[k]; v[2 * k] = cr * w.x - cim * w.y; v[2 * k + 1] = -(cr * w.y + cim * w.x); }
    u32x4 o = {cvtpk(v[0], v[1]), cvtpk(v[2], v[3]), cvtpk(v[4], v[5]), cvtpk(v[6], v[7])}; *(u32x4*)(TF + ((size_t)g * 512 + n) * 768 + 512 + d * 128 + pq * 8) = o; }
}
__device__ __forceinline__ void ssm_build_t(const Params& p, const Ctx& c, int l) {
  const float* MK = (const float*)(p.ws + OFF_MK) + (size_t)l * 32 * 2 * 32 * 256; bf16_t* TF = (bf16_t*)(p.ws + OFF_TF);
  for (long i = c.gtid; i < 32L * 512 * 32 * 2; i += c.nthr) { const int hh = (int)(i & 1), s = (int)((i >> 1) & 31), n = (int)((i >> 6) & 511), g = (int)(i >> 15), h = n & 15, t = n >> 4;
    const int lag = t - s; float v[8];
    if (lag != 0) { const float* m = MK + ((size_t)((g * 2 + (lag < 0 ? 1 : 0)) * 32 + (lag < 0 ? -lag : lag)) * 16 + h) * 16 + hh * 8;
#pragma unroll
      for (int k = 0; k < 8; ++k) v[k] = m[k]; }
    else { const float* m0 = MK + ((size_t)((g * 2) * 32) * 16 + h) * 16 + hh * 8; const float* m1 = MK + ((size_t)((g * 2 + 1) * 32) * 16 + h) * 16 + hh * 8; const float dsk = p.ssm_d[(size_t)l * 512 + g * 16 + h];
#pragma unroll
      for (int k = 0; k < 8; ++k) v[k] = m0[k] + m1[k] + ((hh * 8 + k) == h ? dsk : 0.f); }
    u32x4 o = {cvtpk(v[0], v[1]), cvtpk(v[2], v[3]), cvtpk(v[4], v[5]), cvtpk(v[6], v[7])}; *(u32x4*)(TF + ((size_t)g * 512 + n) * 768 + s * 16 + hh * 8) = o; }
}
__device__ __forceinline__ void ssm_carry(const Params& p, const Ctx& c, int l, float* lds) {
  const float2* PW = (const float2*)(p.ws + OFF_PW) + (size_t)l * 32 * 2 * 33 * 64; const float* SB = (const float*)(p.ws + OFF_Z2 + Z2_SB); bf16_t* UG = (bf16_t*)(p.ws + OFF_Z2 + Z2_UG);
  float2* E = (float2*)lds;
  for (int base = c.blk * 64; base < NB * 32 * 2 * 64; base += c.nblk * 64) {
  const int i = base + c.lane; const bool act = true; const int ii = i;
  const int pp = ii & 63, d = (ii >> 6) & 1, g = (ii >> 7) & 31, b = ii >> 12, w = c.wid;
  const float2 a32 = PW[((size_t)(g * 2 + d) * 33 + 32) * 64 + pp];
  const size_t rbase = (size_t)g * 768 + b * 136; const int col = (d * 64 + pp) * 2;
  float2 s[17], hl[17];
#pragma unroll
  for (int kk = 0; kk < 17; ++kk) { const int k = 17 * w + kk; const int ch = d == 0 ? k : (k < 8 ? 7 - k : 143 - k); s[kk] = *(const float2*)(SB + (rbase + ch) * 256 + col); }
  float hr = 0.f, hi = 0.f;
#pragma unroll
  for (int kk = 0; kk < 17; ++kk) { hl[kk] = make_float2(hr, hi); const float nr = a32.x * hr - a32.y * hi + s[kk].x, ni = a32.x * hi + a32.y * hr + s[kk].y; hr = nr; hi = ni; }
  E[w * 64 + c.lane] = make_float2(hr, hi);
  float ar = a32.x, ai = a32.y;
#pragma unroll
  for (int q = 0; q < 4; ++q) { const float t = ar * ar - ai * ai; ai = 2.f * ar * ai; ar = t; }
  { const float t = ar * a32.x - ai * a32.y; ai = ar * a32.y + ai * a32.x; ar = t; }
  __syncthreads();
  float pr = 0.f, pi = 0.f;
  for (int q = 0; q < w; ++q) { const float2 e = E[q * 64 + c.lane]; const float nr = ar * pr - ai * pi + e.x, ni = ar * pi + ai * pr + e.y; pr = nr; pi = ni; }
  if (act) {
#pragma unroll
    for (int kk = 0; kk < 17; ++kk) { const int k = 17 * w + kk; const int ch = d == 0 ? k : (k < 8 ? 7 - k : 143 - k);
      *(unsigned*)(UG + (rbase + ch) * 768 + 512 + col) = cvtpk(hl[kk].x + pr, hl[kk].y + pi);
      const float nr = a32.x * pr - a32.y * pi, ni = a32.x * pi + a32.y * pr; pr = nr; pi = ni; } }
  __syncthreads();
  }
}

__device__ __forceinline__ void phase0a(const Params& p, const Ctx& c, float* lds) {
  for (int i = c.tid; i < 5 * DM; i += NTHREADS) { const float v = i < 4 * DM ? p.c[i] : p.c_ctx[i - 4 * DM]; lds[i] = v * sigmoidf_(v); }
  __syncthreads();
  {
    float* MP = (float*)(p.ws + OFF_MP);
    for (long it = c.gtid; it < 16 * 6144; it += c.nthr) {
      const int cq = (int)(it % 6144), ks = (int)(it / 6144); const int gc = cq * 4, l = gc / NMODC, col = gc % NMODC;
      const float* wp = p.w_mod + ((size_t)l * DM + (size_t)ks * 128) * NMODC + col;
      f32x4 a[5] = {};
#pragma unroll 8
      for (int k = 0; k < 128; ++k) { const f32x4 w = *(const f32x4*)(wp + (size_t)k * NMODC);
#pragma unroll
        for (int v = 0; v < 5; ++v) a[v] += w * lds[v * DM + ks * 128 + k]; }
#pragma unroll
      for (int v = 0; v < 5; ++v) *(f32x4*)(MP + ((size_t)ks * 5 + v) * 24576 + gc) = a[v];
    }
  }
  __syncthreads();
  {
    float* rc = (float*)(p.ws + OFF_ROPE); float* rs = rc + 64 * 32;
    for (long i = c.gtid; i < 64 * 32; i += c.nthr) { const int pos = (int)(i >> 5), pp = (int)(i & 31);
      const float inv = (float)exp2(-(double)pp / 32.0 * 13.287712379549449); float s, cc; my_sincos((float)pos * inv, s, cc); rc[i] = cc; rs[i] = s; }
  }
  {
    bf16_t* DB = (bf16_t*)(p.ws + OFF_DFTC);
    for (long i = c.gtid; i < 256L * 64; i += c.nthr) { const int k = (int)(i >> 6), c0 = (int)(i & 63) * 8, part = c0 >> 8, t0 = c0 & 255; float v[8];
#pragma unroll
      for (int j = 0; j < 8; ++j) { const float ph = (float)((k * (t0 + j)) & 255) * (1.f / 256.f); v[j] = (part ? __builtin_amdgcn_sinf(ph) : __builtin_amdgcn_cosf(ph)) * (1.f / 16.f); }
      u32x4 w = {cvtpk(v[0], v[1]), cvtpk(v[2], v[3]), cvtpk(v[4], v[5]), cvtpk(v[6], v[7])}; *(u32x4*)(DB + i * 8) = w; }
  }
  {
    float* W = (float*)(p.ws + OFF_WCS);
    for (long i = c.gtid; i < 2L * 2 * 4 * 128 * 128; i += c.nthr) { const int d = (int)(i & 127), cc = (int)((i >> 7) & 127), g = (int)((i >> 14) & 3), cs = (int)((i >> 16) & 1), l = (int)(i >> 17);
      const float* wf = p.w_four + ((size_t)(l * 4 + g) * 128) * 128 + d; float a = 0.f;
      for (int j = 0; j < 128; ++j) { const float ph = (float)((j * cc) & 127) * (1.f / 128.f); a += (cs ? __builtin_amdgcn_sinf(ph) : __builtin_amdgcn_cosf(ph)) * wf[(size_t)j * 128]; }
      W[i] = a * 0.08838834764831845f; }
  }
}

__device__ __forceinline__ void reduce_mod(const Params& p, const Ctx& c) {
  const float* MP = (const float*)(p.ws + OFF_MP); float* MOD = (float*)(p.ws + OFF_MOD);
  for (long o = c.gtid; o < 5L * 24576; o += c.nthr) { const int v = (int)(o / 24576), gc = (int)(o % 24576), l = gc / NMODC, col = gc % NMODC;
    float a = p.b_mod[gc];
#pragma unroll
    for (int ks = 0; ks < 16; ++ks) a += MP[((size_t)ks * 5 + v) * 24576 + gc];
    MOD[(size_t)(l * 5 + v) * NMODC + col] = a; }
}

__device__ __forceinline__ void prenorm_row(const f32x4 (&x)[8], float rinv, const float* g, const float* sc, const float* sh, bf16_t* dst, int lane) {
#pragma unroll
  for (int i = 0; i < 8; ++i) { const int col = (lane + 64 * i) * 4; const f32x4 gg = *(const f32x4*)(g + col), s1 = *(const f32x4*)(sc + col), s0 = *(const f32x4*)(sh + col);
    const f32x4 y = (x[i] * rinv * gg) * (s1 + 1.f) + s0; u32x2 o = {cvtpk(y[0], y[1]), cvtpk(y[2], y[3])}; *(u32x2*)(dst + col) = o; }
}
__device__ __forceinline__ float sumsq8(const f32x4 (&x)[8]) { float s = 0.f;
#pragma unroll
  for (int i = 0; i < 8; ++i) s += x[i][0] * x[i][0] + x[i][1] * x[i][1] + x[i][2] * x[i][2] + x[i][3] * x[i][3];
  return wave_sum(s); }

typedef _Float16 h16x4 __attribute__((ext_vector_type(4)));
__device__ __forceinline__ f32x4 ldx(const _Float16* p) { const h16x4 h = *(const h16x4*)p; return __builtin_convertvector(h, f32x4); }
__device__ __forceinline__ void stx(_Float16* p, f32x4 v) { *(h16x4*)p = __builtin_convertvector(v, h16x4); }
__device__ __forceinline__ const float* xrow_src(const Params& p, int l, int b, int t, int row) {
  const float* base = t < CTXL ? p.ctx : p.x; const size_t off = t < CTXL ? ((size_t)b * CTXL + t) * DM : ((size_t)b * SEQ + (t - CTXL)) * DM; return base + off;
}
__device__ __forceinline__ void phase_prenorm(const Params& p, const Ctx& c, int l) {
  bf16_t* Hn = (bf16_t*)(p.ws + OFF_HN);
  for (int row = c.gwave; row < TT; row += c.nwave) { const int b = row / TPB, t = row % TPB, v = t < CTXL ? 4 : b;
    f32x4 x[8]; const f32x4* xr = (const f32x4*)xrow_src(p, l, b, t, row);
#pragma unroll
    for (int i = 0; i < 8; ++i) x[i] = xr[c.lane + 64 * i];
    const float rinv = rsqrtf(sumsq8(x) * (1.f / DM) + 1e-6f);
    prenorm_row(x, rinv, p.g_mix_pre + (size_t)l * DM, modp(p, l, v, 1), modp(p, l, v, 0), Hn + (size_t)row * DM, c.lane); }
}
__device__ __forceinline__ void phase_postmix(const Params& p, const Ctx& c, int l, bool last) {
  _Float16* X = (_Float16*)(p.ws + OFF_X); const bf16_t* MIX = (const bf16_t*)(p.ws + OFF_Z1); bf16_t* Hn = (bf16_t*)(p.ws + OFF_HN);
  for (int row = c.gwave; row < TT; row += c.nwave) { const int b = row / TPB, t = row % TPB, v = t < CTXL ? 4 : b; if (last && t < CTXL) continue;
    f32x4 m[8], x[8]; const u32x2* mr = (const u32x2*)(MIX + (size_t)row * DM); _Float16* xr = X + (size_t)row * DM; const f32x4* xs = (const f32x4*)xrow_src(p, 0, b, t, row);
    if (t < CTXL) { const u32x2* sl = (const u32x2*)(p.ws + OFF_Z2) + ((size_t)b * CTXL + t) * (DM / 4);
#pragma unroll
      for (int i = 0; i < 8; ++i) { m[i] = (f32x4){0.f, 0.f, 0.f, 0.f}; x[i] = xs[c.lane + 64 * i]; }
      for (int s = 0; s < 8; ++s) {
#pragma unroll
        for (int i = 0; i < 8; ++i) { const u32x2 w = sl[(size_t)s * NB * CTXL * (DM / 4) + c.lane + 64 * i]; m[i] += (f32x4){__uint_as_float(w[0] << 16), __uint_as_float(w[0] & 0xffff0000u), __uint_as_float(w[1] << 16), __uint_as_float(w[1] & 0xffff0000u)}; } } }
    else {
#pragma unroll
    for (int i = 0; i < 8; ++i) { const u32x2 w = mr[c.lane + 64 * i]; m[i] = (f32x4){__uint_as_float(w[0] << 16), __uint_as_float(w[0] & 0xffff0000u), __uint_as_float(w[1] << 16), __uint_as_float(w[1] & 0xffff0000u)}; x[i] = (l == 0) ? xs[c.lane + 64 * i] : ldx(xr + (c.lane + 64 * i) * 4); } }
    const float r1 = rsqrtf(sumsq8(m) * (1.f / DM) + 1e-6f); const float* gp = p.g_mix_post + (size_t)l * DM; const float* m2 = modp(p, l, v, 2);
#pragma unroll
    for (int i = 0; i < 8; ++i) { const int col = (c.lane + 64 * i) * 4; x[i] += *(const f32x4*)(m2 + col) * (m[i] * r1 * *(const f32x4*)(gp + col)); stx(xr + col, x[i]); }
    const float r2 = rsqrtf(sumsq8(x) * (1.f / DM) + 1e-6f);
    prenorm_row(x, r2, p.g_ffn_pre + (size_t)l * DM, modp(p, l, v, 4), modp(p, l, v, 3), Hn + (size_t)row * DM, c.lane); }
}
__device__ __forceinline__ void phase_postffn(const Params& p, const Ctx& c, int l, bool last) {
  _Float16* X = (_Float16*)(p.ws + OFF_X); const bf16_t* F = (const bf16_t*)(p.ws + OFF_Z1 + (size_t)TT * DM * 2); bf16_t* Hn = (bf16_t*)(p.ws + OFF_HN);
  for (int row = c.gwave; row < TT; row += c.nwave) { const int b = row / TPB, t = row % TPB, v = t < CTXL ? 4 : b; if (last && t < CTXL) continue;
    f32x4 m[8], x[8]; const u32x2* mr = (const u32x2*)(F + (size_t)row * DM); _Float16* xr = X + (size_t)row * DM;
    if (t < CTXL) { const u32x2* sl = (const u32x2*)(p.ws + OFF_Z1) + ((size_t)b * CTXL + t) * (DM / 4);
#pragma unroll
      for (int i = 0; i < 8; ++i) { m[i] = (f32x4){0.f, 0.f, 0.f, 0.f}; x[i] = ldx(xr + (c.lane + 64 * i) * 4); }
      for (int s = 0; s < 11; ++s) {
#pragma unroll
        for (int i = 0; i < 8; ++i) { const u32x2 w = sl[(size_t)s * NB * CTXL * (DM / 4) + c.lane + 64 * i]; m[i] += (f32x4){__uint_as_float(w[0] << 16), __uint_as_float(w[0] & 0xffff0000u), __uint_as_float(w[1] << 16), __uint_as_float(w[1] & 0xffff0000u)}; } } }
    else {
#pragma unroll
    for (int i = 0; i < 8; ++i) { const u32x2 w = mr[c.lane + 64 * i]; m[i] = (f32x4){__uint_as_float(w[0] << 16), __uint_as_float(w[0] & 0xffff0000u), __uint_as_float(w[1] << 16), __uint_as_float(w[1] & 0xffff0000u)}; x[i] = ldx(xr + (c.lane + 64 * i) * 4); } }
    const float r1 = rsqrtf(sumsq8(m) * (1.f / DM) + 1e-6f); const float* gp = p.g_ffn_post + (size_t)l * DM; const float* m5 = modp(p, l, v, 5);
#pragma unroll
    for (int i = 0; i < 8; ++i) { const int col = (c.lane + 64 * i) * 4; x[i] += *(const f32x4*)(m5 + col) * (m[i] * r1 * *(const f32x4*)(gp + col)); }
    if (last) { f32x4* o = (f32x4*)(p.out + ((size_t)b * SEQ + (t - CTXL)) * DM);
#pragma unroll
      for (int i = 0; i < 8; ++i) o[c.lane + 64 * i] = x[i]; }
    else {
#pragma unroll
      for (int i = 0; i < 8; ++i) stx(xr + (c.lane + 64 * i) * 4, x[i]);
      const float r2 = rsqrtf(sumsq8(x) * (1.f / DM) + 1e-6f);
      prenorm_row(x, r2, p.g_mix_pre + (size_t)(l + 1) * DM, modp(p, l + 1, v, 1), modp(p, l + 1, v, 0), Hn + (size_t)row * DM, c.lane); } }
}

typedef f32x4 Acc[2][2][4][2];
__device__ __forceinline__ int lat_pm(int i) { return (i >> 4) * 17 + 1 + (i & 15); }

struct SchedMN {
  const char* A; const char* B; size_t strA, strB;
  int nM, nN, pn0, latonly, nextra, blk, nblk;
  __device__ __forceinline__ bool next(int i, gm::Unit& u) const {
    const int it = i * nblk + blk, nmain = nM * nN;
    if (it < nmain) { gm::tile_of(it, nM, nN, u.pm, u.pn); if (latonly) u.pm = lat_pm(u.pm); u.pn += pn0; return true; }
    if (it < nmain + nextra) { const int j = it - nmain; u.pm = (j / 10) * 17; u.pn = 4 + (j % 10); return true; }
    return false;
  }
  __device__ __forceinline__ const char* pA(const gm::Unit& u) const { return A + (size_t)u.pm * strA; }
  __device__ __forceinline__ const char* pB(const gm::Unit& u) const { return B + (size_t)u.pn * strB; }
};

struct EpiIn {
  bf16_t *Qb, *Kb, *Vb, *UG, *PT; const float *rc, *rs;
  __device__ __forceinline__ void operator()(const Acc& acc, const gm::Unit& u, int wr, int wc, int fr, int fq) const {
    const int pm = u.pm, pn = u.pn; const bool isctx = (pm % 17) == 0; const int brow = pm * 256;
#pragma unroll
    for (int ai = 0; ai < 2; ++ai)
#pragma unroll
      for (int m = 0; m < 4; ++m) { const int row = brow + ai * 128 + wr * 64 + m * 16 + fr;
        if (pn < 8) { bf16_t* dst = Qb + (size_t)(pn >> 2) * TT * 1024 + (size_t)row * 1024 + (pn & 3) * 256 + wc * 32 + fq * 8;
          f32x4 cs = {1.f, 1.f, 1.f, 1.f}, sn = {0.f, 0.f, 0.f, 0.f};
          if (!isctx) { const int tl = (row % TPB) - CTXL; const int pos = (wc >> 1) ? (tl & 63) : (tl >> 6); const int p0 = (wc & 1) * 16 + fq * 4;
            cs = *(const f32x4*)(rc + pos * 32 + p0); sn = *(const f32x4*)(rs + pos * 32 + p0); }
#pragma unroll
          for (int bj = 0; bj < 2; ++bj) { const f32x4 v1 = acc[ai][bj][m][0], v2 = acc[ai][bj][m][1]; const f32x4 o1 = v1 * cs - v2 * sn, o2 = v2 * cs + v1 * sn;
            u32x4 w = {cvtpk(o1[0], o1[1]), cvtpk(o1[2], o1[3]), cvtpk(o2[0], o2[1]), cvtpk(o2[2], o2[3])}; *(u32x4*)(dst + bj * 128) = w; } }
        else if (pn < 12) { bf16_t* dst = Vb + (size_t)row * 1024 + (pn - 8) * 256 + wc * 32 + fq * 8;
#pragma unroll
          for (int bj = 0; bj < 2; ++bj) { const f32x4 v0 = acc[ai][bj][m][0], v1 = acc[ai][bj][m][1]; u32x4 w = {cvtpk(v0[0], v0[1]), cvtpk(v0[2], v0[3]), cvtpk(v1[0], v1[1]), cvtpk(v1[2], v1[3])}; *(u32x4*)(dst + bj * 128) = w; } }
        else if (pn < 14) { const int b = row / TPB, t = row % TPB; bf16_t* dst = UG + ((size_t)(b * 136 + (t >> 5))) * 768 + (t & 31) * 16 + ((fq * 8) & 15);
#pragma unroll
          for (int bj = 0; bj < 2; ++bj) { const int g = ((pn - 12) * 256 + bj * 128 + wc * 32 + fq * 8) >> 4; const f32x4 v0 = acc[ai][bj][m][0], v1 = acc[ai][bj][m][1];
            u32x4 w = {cvtpk(v0[0], v0[1]), cvtpk(v0[2], v0[3]), cvtpk(v1[0], v1[1]), cvtpk(v1[2], v1[3])}; *(u32x4*)(dst + (size_t)g * 768 * 768) = w; } }
        else {
          const int b = pm / 17, tt = pm % 17, part = (pn - 14) >> 1; const size_t cb = (size_t)(part * NB + b) * 512 + (pn & 1) * 256; const size_t ld = tt == 0 ? 256 : 4096;
          bf16_t* dstm = PT + (tt == 0 ? (size_t)2 * NB * 512 * 4096 + cb * 256 : cb * 4096 + (size_t)(tt - 1) * 256) + ai * 128 + wr * 64 + m * 16 + fr;
#pragma unroll
          for (int bj = 0; bj < 2; ++bj)
#pragma unroll
            for (int n = 0; n < 2; ++n) { const f32x4 v = acc[ai][bj][m][n]; const unsigned w0 = cvtpk(v[0], v[1]), w1 = cvtpk(v[2], v[3]); bf16_t* d = dstm + (size_t)(bj * 128 + wc * 32 + fq * 8 + n * 4) * ld;
              d[0] = (bf16_t)(w0 & 0xffff); d[ld] = (bf16_t)(w0 >> 16); d[2 * ld] = (bf16_t)(w1 & 0xffff); d[3 * ld] = (bf16_t)(w1 >> 16); } } }
  }
};
__device__ __forceinline__ void phase_gemm_in(const Params& p, const Ctx& c, int l, LAS unsigned char* lds) {
  SchedMN S; S.A = p.ws + OFF_HN; S.B = p.ws + OFF_WIN; S.strA = (size_t)256 * DM * 2; S.strB = (size_t)256 * DM * 2; S.blk = c.blk; S.nblk = c.nblk;
  S.nM = l == 0 ? 68 : 64; S.latonly = l == 0 ? 0 : 1;
  { S.nN = 18; S.pn0 = 0; S.nextra = l == 0 ? 0 : 40;
    EpiIn E; E.PT = (bf16_t*)(p.ws + OFF_Z2 + Z2_CAT); E.Qb = (bf16_t*)(p.ws + OFF_Z1 + Z1_Q); E.Kb = (bf16_t*)(p.ws + OFF_Z1 + Z1_K); E.Vb = (bf16_t*)(p.ws + OFF_Z1 + Z1_V); E.UG = (bf16_t*)(p.ws + OFF_Z2 + Z2_UG);
    E.rc = (const float*)(p.ws + OFF_ROPE); E.rs = E.rc + 64 * 32;
    gm::gemm_phase<true, true>(lds, DM, DM, DM, S, E); }
}

__device__ __forceinline__ void fourier_stage_a(const Params& p, const Ctx& c, int l) {
  const bf16_t* PT = (const bf16_t*)(p.ws + OFF_Z2 + Z2_CAT); bf16_t* Y = (bf16_t*)(p.ws + OFF_Z2 + Z2_FC);
  constexpr float C16[16] = {1.f, 0.92387953251f, 0.70710678119f, 0.38268343237f, 0.f, -0.38268343237f, -0.70710678119f, -0.92387953251f, -1.f, -0.92387953251f, -0.70710678119f, -0.38268343237f, 0.f, 0.38268343237f, 0.70710678119f, 0.92387953251f};
  constexpr float S16[16] = {0.f, 0.38268343237f, 0.70710678119f, 0.92387953251f, 1.f, 0.92387953251f, 0.70710678119f, 0.38268343237f, 0.f, -0.38268343237f, -0.70710678119f, -0.92387953251f, -1.f, -0.92387953251f, -0.70710678119f, -0.38268343237f};
  for (long i = c.gtid; i < (long)NB * 512 * 256; i += c.nthr) { const int t2 = (int)(i & 255), ch = (int)((i >> 8) & 511), b = (int)(i >> 17);
    const bf16_t* Pb = PT + ((size_t)(0 * NB + b) * 512 + ch) * 4096 + t2; const bf16_t* Qb = PT + ((size_t)(1 * NB + b) * 512 + ch) * 4096 + t2;
    float zr[16], zq[16];
#pragma unroll
    for (int t1 = 0; t1 < 16; ++t1) { zr[t1] = bf2f(Pb[256 * t1]); zq[t1] = bf2f(Qb[256 * t1]); }
    bf16_t* Yo = Y + ((size_t)(b * 16) * 512 + ch) * 512 + t2;
#pragma unroll
    for (int k1 = 0; k1 < 16; ++k1) { float ar = 0.f, ai = 0.f;
#pragma unroll
      for (int t1 = 0; t1 < 16; ++t1) { const float cc = C16[(k1 * t1) & 15], ss = S16[(k1 * t1) & 15]; ar += zr[t1] * cc - zq[t1] * ss; ai -= zr[t1] * ss + zq[t1] * cc; }
      const float ph = (float)(k1 * t2) * (1.f / 4096.f), ct = __builtin_amdgcn_cosf(ph), st = __builtin_amdgcn_sinf(ph);
      const float yr = (ar * ct + ai * st) * 0.25f, yi = (ai * ct - ar * st) * 0.25f;
      bf16_t* yo = Yo + (size_t)k1 * 512 * 512; const unsigned w = cvtpk(yr, yi); yo[0] = (bf16_t)(w & 0xffff); yo[256] = (bf16_t)(w >> 16); } }
  if (l == 0) {
    const bf16_t* PC = PT + (size_t)2 * NB * 512 * 4096;
    for (long i = c.gtid; i < (long)NB * 512 * 64; i += c.nthr) { const int t0 = (int)(i & 31) * 8, ri = (int)((i >> 5) & 1), ch = (int)((i >> 6) & 511), b = (int)(i >> 15);
      u32x4 w = *(const u32x4*)(PC + ((size_t)(ri * NB + b) * 512 + ch) * 256 + t0); if (ri) { w[0] ^= 0x80008000u; w[1] ^= 0x80008000u; w[2] ^= 0x80008000u; w[3] ^= 0x80008000u; }
      *(u32x4*)(Y + ((size_t)32768 + b * 512 + ch) * 512 + ri * 256 + t0) = w; } }
}
struct SchedFB { const char *DB, *Y; int nunits, blk, nblk;
  __device__ __forceinline__ bool next(int i, gm::Unit& u) const { const int it = i * nblk + blk; if (it >= nunits) return false; u.pm = it; u.pn = 0; return true; }
  __device__ __forceinline__ const char* pA(const gm::Unit&) const { return DB; }
  __device__ __forceinline__ const char* pB(const gm::Unit& u) const { const int it = u.pm; const size_t row = it < 128 ? (size_t)it * 256 : (size_t)32768 + (it - 128) * 256; return Y + row * 1024; } };
struct EpiFB { bf16_t* Cat; const float* bf;
  __device__ __forceinline__ void operator()(const Acc& acc, const gm::Unit& u, int wr, int wc, int fr, int fq) const { const int it = u.pm;
    int b, tok0, tstride, chb; if (it < 128) { b = it >> 5; const int pn = it & 31; tok0 = CTXL + (pn >> 1); tstride = 16; chb = (pn & 1) * 256; } else { const int j = it - 128; b = j >> 1; tok0 = 0; tstride = 1; chb = (j & 1) * 256; }
#pragma unroll
    for (int ai = 0; ai < 2; ++ai)
#pragma unroll
      for (int m = 0; m < 4; ++m) { const int k2 = ai * 128 + wr * 64 + m * 16 + fr; bf16_t* dr = Cat + ((size_t)b * TPB + tok0 + tstride * k2) * DM + 1536 + chb + wc * 32 + fq * 4;
#pragma unroll
        for (int bj = 0; bj < 2; ++bj)
#pragma unroll
          for (int n = 0; n < 2; ++n) { const f32x4 v = acc[ai][bj][m][n] + *(const f32x4*)(bf + chb + bj * 128 + wc * 32 + n * 16 + fq * 4); u32x2 w = {cvtpk(v[0], v[1]), cvtpk(v[2], v[3])}; *(u32x2*)(dr + bj * 128 + n * 16) = w; } }
  } };
__device__ __forceinline__ void fourier_stage_b(const Params& p, const Ctx& c, int l, LAS unsigned char* lds) {
  const SchedFB S{p.ws + OFF_DFTC, p.ws + OFF_Z2 + Z2_FC, l == 0 ? 136 : 128, c.blk, c.nblk}; const EpiFB E{(bf16_t*)(p.ws + OFF_Z2 + Z2_CAT), p.b_four + (size_t)l * 512};
  gm::gemm_phase<true>(lds, 512, 512, 512, S, E);
}

struct SchedSsmS { const char *UG, *EM; int blk, nblk;
  __device__ __forceinline__ bool next(int i, gm::Unit& u) const { const int it = i * nblk + blk; if (it >= 96) return false; u.pm = it; u.pn = 0; return true; }
  __device__ __forceinline__ const char* pA(const gm::Unit& u) const { const int g = u.pm / 3, pm = u.pm % 3; return UG + ((size_t)g * 768 + pm * 256) * 768 * 2; }
  __device__ __forceinline__ const char* pB(const gm::Unit& u) const { const int g = u.pm / 3; return EM + (size_t)g * 256 * 512 * 2; } };
struct EpiSsmS { float* SB;
  __device__ __forceinline__ void operator()(const Acc& acc, const gm::Unit& u, int wr, int wc, int fr, int fq) const { const int g = u.pm / 3, pm = u.pm % 3;
#pragma unroll
    for (int ai = 0; ai < 2; ++ai)
#pragma unroll
      for (int m = 0; m < 4; ++m) { const int r = pm * 256 + ai * 128 + wr * 64 + m * 16 + fr; if (r >= 544) continue; float* dr = SB + ((size_t)g * 768 + r) * 256 + wc * 32 + fq * 4;
#pragma unroll
        for (int bj = 0; bj < 2; ++bj)
#pragma unroll
          for (int n = 0; n < 2; ++n) *(f32x4*)(dr + bj * 128 + n * 16) = acc[ai][bj][m][n]; }
  } };
__device__ __forceinline__ void phase_ssm_states(const Params& p, const Ctx& c, LAS unsigned char* lds) {
  const SchedSsmS S{p.ws + OFF_Z2 + Z2_UG, p.ws + OFF_EM, c.blk, c.nblk}; const EpiSsmS E{(float*)(p.ws + OFF_Z2 + Z2_SB)};
  gm::gemm_phase<true>(lds, 768, 512, 512, S, E);
}
struct SchedSsmY { const char *UG, *TF; int blk, nblk;
  __device__ __forceinline__ bool next(int i, gm::Unit& u) const { const int it = i * nblk + blk; if (it >= 192) return false; u.pm = it >> 1; u.pn = it & 1; return true; }
  __device__ __forceinline__ const char* pA(const gm::Unit& u) const { const int g = u.pm / 3, pm = u.pm % 3; return UG + ((size_t)g * 768 + pm * 256) * 768 * 2; }
  __device__ __forceinline__ const char* pB(const gm::Unit& u) const { const int g = u.pm / 3; return TF + ((size_t)g * 512 + u.pn * 256) * 768 * 2; } };
struct EpiSsmY { bf16_t* Gg; int last;
  __device__ __forceinline__ void operator()(const Acc& acc, const gm::Unit& u, int wr, int wc, int fr, int fq) const { const int g = u.pm / 3, pm = u.pm % 3;
#pragma unroll
    for (int ai = 0; ai < 2; ++ai)
#pragma unroll
      for (int m = 0; m < 4; ++m) { const int r = pm * 256 + ai * 128 + wr * 64 + m * 16 + fr; if (r >= 544) continue; const int b = r / 136, ch = r % 136; if (last && ch < 8) continue;
        bf16_t* dr = Gg + ((size_t)b * TPB + ch * 32) * 512 + g * 16 + ((fq * 4) & 15);
#pragma unroll
        for (int bj = 0; bj < 2; ++bj)
#pragma unroll
          for (int n = 0; n < 2; ++n) { const int t = (u.pn * 256 + bj * 128 + wc * 32 + n * 16 + fq * 4) >> 4; const f32x4 y = acc[ai][bj][m][n];
            u32x2 w = {cvtpk(gelu_tanh(y[0]), gelu_tanh(y[1])), cvtpk(gelu_tanh(y[2]), gelu_tanh(y[3]))}; *(u32x2*)(dr + (size_t)t * 512) = w; } }
  } };
__device__ __forceinline__ void phase_ssm_y(const Params& p, const Ctx& c, bool last, LAS unsigned char* lds) {
  const SchedSsmY S{p.ws + OFF_Z2 + Z2_UG, p.ws + OFF_TF, c.blk, c.nblk}; const EpiSsmY E{(bf16_t*)(p.ws + OFF_Z2 + Z2_GG), last ? 1 : 0};
  gm::gemm_phase<true>(lds, 768, 768, 768, S, E);
}

struct EpiGlu {
  const bf16_t* Gg; bf16_t* Cat; const float* bg;
  __device__ __forceinline__ void operator()(const Acc& acc, const gm::Unit& u, int wr, int wc, int fr, int fq) const { const int pm = u.pm, pn = u.pn;
#pragma unroll
    for (int ai = 0; ai < 2; ++ai)
#pragma unroll
      for (int m = 0; m < 4; ++m) { const int row = pm * 256 + ai * 128 + wr * 64 + m * 16 + fr;
#pragma unroll
        for (int bj = 0; bj < 2; ++bj)
#pragma unroll
          for (int n = 0; n < 2; ++n) { const int col = pn * 256 + bj * 128 + wc * 32 + n * 16 + fq * 4; const f32x4 z = acc[ai][bj][m][n] + *(const f32x4*)(bg + col);
            const u32x2 gw = *(const u32x2*)(Gg + (size_t)row * 512 + col);
            const float g0 = __uint_as_float(gw[0] << 16), g1 = __uint_as_float(gw[0] & 0xffff0000u), g2 = __uint_as_float(gw[1] << 16), g3 = __uint_as_float(gw[1] & 0xffff0000u);
            u32x2 w = {cvtpk(g0 * sigmoidf_(z[0]), g1 * sigmoidf_(z[1])), cvtpk(g2 * sigmoidf_(z[2]), g3 * sigmoidf_(z[3]))};
            *(u32x2*)(Cat + (size_t)row * DM + 1024 + col) = w; } }
  }
};
__device__ __forceinline__ void phase_glu(const Params& p, const Ctx& c, int l, bool last, LAS unsigned char* lds) {
  SchedMN S; S.A = p.ws + OFF_Z2 + Z2_GG; S.B = p.ws + OFF_WGLU; S.strA = (size_t)256 * 512 * 2; S.strB = (size_t)256 * 512 * 2; S.blk = c.blk; S.nblk = c.nblk;
  S.nM = last ? 64 : 68; S.latonly = last ? 1 : 0; S.nN = 2; S.pn0 = 0; S.nextra = 0;
  EpiGlu E; E.Gg = (const bf16_t*)(p.ws + OFF_Z2 + Z2_GG); E.Cat = (bf16_t*)(p.ws + OFF_Z2 + Z2_CAT); E.bg = p.b_glu + (size_t)l * 512;
  gm::gemm_phase<true>(lds, 512, 512, 512, S, E);
}

struct EpiF32 {
  bf16_t* O;
  __device__ __forceinline__ void operator()(const Acc& acc, const gm::Unit& u, int wr, int wc, int fr, int fq) const {
    bf16_t* dst = O + (size_t)u.pm * 256 * DM + u.pn * 256 + wc * 32 + fq * 8;
#pragma unroll
    for (int ai = 0; ai < 2; ++ai)
#pragma unroll
      for (int m = 0; m < 4; ++m) { bf16_t* dr = dst + (size_t)(ai * 128 + wr * 64 + m * 16 + fr) * DM;
#pragma unroll
        for (int bj = 0; bj < 2; ++bj) { const f32x4 v0 = acc[ai][bj][m][0], v1 = acc[ai][bj][m][1]; u32x4 w = {cvtpk(v0[0], v0[1]), cvtpk(v0[2], v0[3]), cvtpk(v1[0], v1[1]), cvtpk(v1[2], v1[3])}; *(u32x4*)(dr + bj * 128) = w; } }
  }
};
struct SchedSplit { const char *A, *B; size_t strA, strB, kbytes; int nunits, blk, nblk;
  __device__ __forceinline__ bool next(int i, gm::Unit& u) const { const int it = i * nblk + blk; if (it >= nunits) return false; u.pm = it; u.pn = 0; return true; }
  __device__ __forceinline__ const char* pA(const gm::Unit& u) const { const int tile = u.pm & 31, sp = u.pm >> 5; return A + (size_t)((tile >> 3) * 17) * strA + sp * kbytes; }
  __device__ __forceinline__ const char* pB(const gm::Unit& u) const { const int tile = u.pm & 31, sp = u.pm >> 5; return B + (size_t)(tile & 7) * strB + sp * kbytes; } };
struct EpiAcc { bf16_t* SLAB;
  __device__ __forceinline__ void operator()(const Acc& acc, const gm::Unit& u, int wr, int wc, int fr, int fq) const { const int tile = u.pm & 31, sp = u.pm >> 5;
    bf16_t* dst = SLAB + ((size_t)sp * NB * CTXL + (tile >> 3) * 256) * DM + (tile & 7) * 256 + wc * 32 + fq * 8;
#pragma unroll
    for (int ai = 0; ai < 2; ++ai)
#pragma unroll
      for (int m = 0; m < 4; ++m) { bf16_t* dr = dst + (size_t)(ai * 128 + wr * 64 + m * 16 + fr) * DM;
#pragma unroll
        for (int bj = 0; bj < 2; ++bj) { const f32x4 v0 = acc[ai][bj][m][0], v1 = acc[ai][bj][m][1]; u32x4 w = {cvtpk(v0[0], v0[1]), cvtpk(v0[2], v0[3]), cvtpk(v1[0], v1[1]), cvtpk(v1[2], v1[3])}; *(u32x4*)(dr + bj * 128) = w; } }
  } };
template <int KK, int NSPLIT>
__device__ __forceinline__ void phase_gemm_f32out(const Params& p, const Ctx& c, bool last, const char* A, const char* W, char* outp, char* slab, LAS unsigned char* lds) {
  SchedMN S; S.A = A; S.B = W; S.strA = (size_t)256 * KK * 2; S.strB = (size_t)256 * KK * 2; S.blk = c.blk; S.nblk = c.nblk;
  S.nM = 64; S.latonly = 1; S.nN = 8; S.pn0 = 0; S.nextra = 0;
  EpiF32 E; E.O = (bf16_t*)outp;
  gm::gemm_phase<true, true>(lds, KK, KK, KK, S, E);
  if (!last) { const SchedSplit S2{A, W, (size_t)256 * KK * 2, (size_t)256 * KK * 2, (size_t)(KK / NSPLIT) * 2, 32 * NSPLIT, c.blk, c.nblk}; const EpiAcc E2{(bf16_t*)slab};
    gm::gemm_phase<true, true>(lds, KK, KK, KK / NSPLIT, S2, E2); }
}

struct EpiGU {
  bf16_t* ACT;
  __device__ __forceinline__ void operator()(const Acc& acc, const gm::Unit& u, int wr, int wc, int fr, int fq) const {
    bf16_t* dst = ACT + (size_t)u.pm * 256 * DFF + u.pn * 128 + wc * 32 + fq * 8;
#pragma unroll
    for (int ai = 0; ai < 2; ++ai)
#pragma unroll
      for (int m = 0; m < 4; ++m) { bf16_t* dr = dst + (size_t)(ai * 128 + wr * 64 + m * 16 + fr) * DFF; u32x4 w;
#pragma unroll
        for (int n = 0; n < 2; ++n) { const f32x4 g = acc[ai][0][m][n], uu = acc[ai][1][m][n];
          w[2 * n] = cvtpk(g[0] * sigmoidf_(g[0]) * uu[0], g[1] * sigmoidf_(g[1]) * uu[1]); w[2 * n + 1] = cvtpk(g[2] * sigmoidf_(g[2]) * uu[2], g[3] * sigmoidf_(g[3]) * uu[3]); }
        *(u32x4*)dr = w; }
  }
};
__device__ __forceinline__ void phase_gemm_gu(const Params& p, const Ctx& c, bool last, LAS unsigned char* lds) {
  SchedMN S; S.A = p.ws + OFF_HN; S.B = p.ws + OFF_WGU; S.strA = (size_t)256 * DM * 2; S.strB = (size_t)256 * DM * 2; S.blk = c.blk; S.nblk = c.nblk;
  S.nM = last ? 64 : 68; S.latonly = last ? 1 : 0; S.nN = 44; S.pn0 = 0; S.nextra = 0;
  EpiGU E; E.ACT = (bf16_t*)(p.ws + OFF_Z2);
  gm::gemm_phase<true, true>(lds, DM, DM, DM, S, E);
}

__device__ __forceinline__ void phase_attn(const Params& p, const Ctx& c, int l, char* lds) {
  const bf16_t* Qb = (const bf16_t*)(p.ws + OFF_Z1 + Z1_Q); const bf16_t* Kb = (const bf16_t*)(p.ws + OFF_Z1 + Z1_K); const bf16_t* Vb = (const bf16_t*)(p.ws + OFF_Z1 + Z1_V);
  bf16_t* O = (bf16_t*)(p.ws + OFF_HN);
  const int ntot = (l == 0) ? 512 + 32 : 512;
  for (int v = c.blk; v < ntot; v += c.nblk) {
    int combo, qb, seq;
    if (v < 512) { const int rd = v >> 8, w = v & 255; combo = rd * 16 + (w & 7) * 2 + ((w >> 3) >> 4); qb = 1 + ((w >> 3) & 15); seq = TPB; }
    else { combo = v - 512; qb = 0; seq = CTXL; }
    const int mp = combo & 1, h = (combo >> 1) & 3, b = combo >> 3;
    const size_t r0 = (size_t)b * TPB;
    at::body(Qb + (r0 + qb * 256) * 1024 + (h * 2 + mp) * 128, Kb + r0 * 1024 + (h * 2 + mp) * 128, Vb + r0 * 1024 + h * 256,
             O + (r0 + qb * 256) * DM + (h * 2 + mp) * 256, seq, lds);
  }
}

__device__ __forceinline__ void phase_combine(const Params& p, const Ctx& c, int l, bool last) {
  const bf16_t* O = (const bf16_t*)(p.ws + OFF_HN); bf16_t* Cat = (bf16_t*)(p.ws + OFF_Z2 + Z2_CAT);
  const float lam_init = 0.8f - 0.6f * expf(-0.3f * (float)l);
  float lam;
  { const float a1 = p.lam_q1[l * 128 + c.lane] * p.lam_k1[l * 128 + c.lane] + p.lam_q1[l * 128 + 64 + c.lane] * p.lam_k1[l * 128 + 64 + c.lane];
    const float a2 = p.lam_q2[l * 128 + c.lane] * p.lam_k2[l * 128 + c.lane] + p.lam_q2[l * 128 + 64 + c.lane] * p.lam_k2[l * 128 + 64 + c.lane];
    lam = expf(wave_sum(a1)) - expf(wave_sum(a2)) + lam_init; }
  const f32x4 gs = *(const f32x4*)(p.g_subln + (size_t)l * 256 + c.lane * 4);
  for (int row = c.gwave; row < TT; row += c.nwave) { const int t = row % TPB; if (last && t < CTXL) continue;
    const bf16_t* orow = O + (size_t)row * DM; bf16_t* crow_ = Cat + (size_t)row * DM;
#pragma unroll
    for (int h = 0; h < 4; ++h) { const u32x2 a = *(const u32x2*)(orow + (h * 2) * 256 + c.lane * 4), bq = *(const u32x2*)(orow + (h * 2 + 1) * 256 + c.lane * 4);
      f32x4 o; o[0] = __uint_as_float(a[0] << 16) - lam * __uint_as_float(bq[0] << 16); o[1] = __uint_as_float(a[0] & 0xffff0000u) - lam * __uint_as_float(bq[0] & 0xffff0000u);
      o[2] = __uint_as_float(a[1] << 16) - lam * __uint_as_float(bq[1] << 16); o[3] = __uint_as_float(a[1] & 0xffff0000u) - lam * __uint_as_float(bq[1] & 0xffff0000u);
      const float ss = wave_sum(o[0] * o[0] + o[1] * o[1] + o[2] * o[2] + o[3] * o[3]); const float r = rsqrtf(ss * (1.f / 256.f) + 1e-5f) * (1.f - lam_init);
      o = o * r * gs; u32x2 w = {cvtpk(o[0], o[1]), cvtpk(o[2], o[3])}; *(u32x2*)(crow_ + h * 256 + c.lane * 4) = w; }
  }
}


#define XB_TMO      128
#define XB_XCNT(j)  (256  + 64 * (j))
#define XB_XSUB(j)  (1280 + 64 * (j))
#define XB_XGEN(j)  (2304 + 64 * (j))
#define XB_TOP      3328
#define XB_TOPGEN   3392
#define XCD_BAR_WORDS 3456
#define XB_SPIN_CAP (1u << 18)
__device__ __forceinline__ unsigned xb_ld(unsigned* p)              { return __hip_atomic_load(p, __ATOMIC_RELAXED, __HIP_MEMORY_SCOPE_AGENT); }
__device__ __forceinline__ unsigned xb_add(unsigned* p, unsigned v) { return __hip_atomic_fetch_add(p, v, __ATOMIC_RELAXED, __HIP_MEMORY_SCOPE_AGENT); }
__device__ __forceinline__ unsigned xb_xcc_id() { return (unsigned)__builtin_amdgcn_s_getreg((3 << 11) | 20) & 0xFu; }
#define XB_SPIN(cond, bar) do { unsigned _sp = 0; while (cond) { __builtin_amdgcn_s_sleep(1); \
    if ((++_sp & 255u) == 0u) { if (xb_ld(&(bar)[XB_TMO])) break; if (_sp > XB_SPIN_CAP) { atomicAdd(&(bar)[XB_TMO], 1u); break; } } } } while (0)
struct XcdBarrier { unsigned* bar; unsigned x; volatile LAS unsigned* st; };
__device__ __forceinline__ XcdBarrier xcd_barrier_post(unsigned* bar, volatile LAS unsigned* st) {
  XcdBarrier b; b.bar = bar; b.x = xb_xcc_id(); b.st = st;
  if (threadIdx.x == 0) (void)xb_add(&bar[XB_XCNT(b.x)], 1u);
  return b;
}
__device__ __forceinline__ void xcd_barrier_complete(unsigned* bar, unsigned x, unsigned& nloc, unsigned& nx) {
  const unsigned G = gridDim.x * gridDim.y * gridDim.z;
  unsigned sum, cnt, mine, sp = 0u;
  for (;;) {
    sum = 0u; cnt = 0u; mine = 0u;
#pragma unroll
    for (unsigned j = 0; j < 16; ++j) { const unsigned c = xb_ld(&bar[XB_XCNT(j)]); sum += c; cnt += (c > 0u) ? 1u : 0u; mine = (j == x) ? c : mine; }
    if (sum == G) break;
    __builtin_amdgcn_s_sleep(1);
    if ((++sp & 255u) == 0u) { if (xb_ld(&bar[XB_TMO])) break; if (sp > XB_SPIN_CAP) { atomicAdd(&bar[XB_TMO], 1u); break; } }
  }
  nloc = mine > 0u ? mine : 1u; nx = cnt > 0u ? cnt : 1u;
}
__device__ __forceinline__ void xcd_barrier(const XcdBarrier& b) {
  asm volatile("s_waitcnt vmcnt(0)" ::: "memory");
  __syncthreads();
  if (threadIdx.x == 0) {
    unsigned* bar = b.bar;
    __builtin_amdgcn_s_waitcnt(0);
    unsigned nloc = b.st[0], nx = b.st[1];
    if (nloc == 0u) { xcd_barrier_complete(bar, b.x, nloc, nx); b.st[0] = nloc; b.st[1] = nx; }
    const unsigned old = xb_add(&bar[XB_XSUB(b.x)], 1u);
    const unsigned gen = old / nloc;
    if (old + 1u == (gen + 1u) * nloc) {
      __builtin_amdgcn_fence(__ATOMIC_RELEASE, "agent");
      asm volatile("s_waitcnt vmcnt(0)" ::: "memory");
      const unsigned og = xb_add(&bar[XB_TOP], 1u);
      const unsigned tg = og / nx;
      if (og + 1u == (tg + 1u) * nx) xb_add(&bar[XB_TOPGEN], 1u);
      else XB_SPIN(xb_ld(&bar[XB_TOPGEN]) == tg, bar);
      __builtin_amdgcn_fence(__ATOMIC_ACQUIRE, "agent");
      xb_add(&bar[XB_XGEN(b.x)], 1u);
      asm volatile("s_waitcnt vmcnt(0)" ::: "memory");
    } else {
      XB_SPIN(xb_ld(&bar[XB_XGEN(b.x)]) == gen, bar);
      __builtin_amdgcn_fence(__ATOMIC_ACQUIRE, "agent");
      asm volatile("s_waitcnt vmcnt(0)" ::: "memory");
    }
  }
  __syncthreads();
}

__global__ void __launch_bounds__(NTHREADS) mega(Params p_arg) {
  extern __shared__ __attribute__((aligned(16))) char shm[];
  __shared__ uint4 xb_words;
  cg::grid_group grid = cg::this_grid();
  typedef const __attribute__((address_space(4))) Params* KP;
  KP kp = (KP)__builtin_amdgcn_kernarg_segment_ptr();
  unsigned* bar = (unsigned*)(p_arg.ws + OFF_BAR);
  if (threadIdx.x == 0) xb_words = make_uint4(0u, 0u, 0u, 0u);
  if (p_arg.out == nullptr) grid.sync();
  if (threadIdx.x == 0) (void)xb_add(bar + XB_XCNT(xb_xcc_id()), 1u);
  __syncthreads();
  Ctx c;
#define RECTX() do { asm volatile("" : "+s"(kp)); int t_ = threadIdx.x; asm volatile("" : "+v"(t_)); int b_ = blockIdx.x; asm volatile("" : "+s"(b_)); \
    c.tid = t_; c.wid = t_ >> 6; c.lane = t_ & 63; c.blk = b_; c.nblk = gridDim.x; c.gwave = c.blk * 8 + c.wid; c.nwave = c.nblk * 8; \
    c.gtid = (long)c.blk * NTHREADS + c.tid; c.nthr = (long)c.nblk * NTHREADS; } while (0)
  RECTX();
  LAS unsigned char* gshm = (LAS unsigned char*)shm; float* fl = (float*)shm;

#define PP (*(const Params*)kp)
#define GSYNC() do { RECTX(); XcdBarrier xb_; xb_.bar = (unsigned*)(kp->ws + OFF_BAR); xb_.x = xb_xcc_id(); xb_.st = (volatile LAS unsigned*)&xb_words; xcd_barrier(xb_); } while (0)
  phase0a(PP, c, fl);
  RECTX(); ssm_tables(PP, c);
  RECTX(); convert_weights(PP, c, 0, fl);
  GSYNC();
  RECTX(); reduce_mod(PP, c);
  RECTX(); fold_four(PP, c, 0, fl);
  RECTX(); ssm_build_mef(PP, c, 0);
  GSYNC();
  RECTX(); ssm_build_t(PP, c, 0);
  RECTX(); phase_prenorm(PP, c, 0);
  GSYNC();
  for (int l = 0; l < 2; ++l) {
    const bool last = (l == 1);
    RECTX(); phase_gemm_in(PP, c, l, gshm);
    GSYNC();
    RECTX(); fourier_stage_a(PP, c, l);
    RECTX(); phase_ssm_states(PP, c, gshm);
    GSYNC();
    RECTX(); ssm_carry(PP, c, l, fl);
    RECTX(); phase_attn(PP, c, l, shm);
    GSYNC();
    RECTX(); phase_ssm_y(PP, c, last, gshm);
    RECTX(); phase_combine(PP, c, l, last);
    GSYNC();
    RECTX(); phase_glu(PP, c, l, last, gshm);
    RECTX(); fourier_stage_b(PP, c, l, gshm);
    GSYNC();
    RECTX(); phase_gemm_f32out<DM, 8>(PP, c, last, kp->ws + OFF_Z2 + Z2_CAT, kp->ws + OFF_WOUT, kp->ws + OFF_Z1, kp->ws + OFF_Z2, gshm);
    GSYNC();
    if (!last) { RECTX(); ssm_build_mef(PP, c, 1); }
    RECTX(); phase_postmix(PP, c, l, last);
    GSYNC();
    RECTX(); phase_gemm_gu(PP, c, last, gshm);
    GSYNC();
    RECTX(); phase_gemm_f32out<DFF, 11>(PP, c, last, kp->ws + OFF_Z2, kp->ws + OFF_WD, kp->ws + OFF_Z1 + (size_t)TT * DM * 2, kp->ws + OFF_Z1, gshm);
    GSYNC();
    if (!last) { RECTX(); ssm_build_t(PP, c, 1); }
    RECTX(); phase_postffn(PP, c, l, last);
    if (!last) { RECTX(); convert_weights(PP, c, 1, fl); RECTX(); fold_four(PP, c, 1, fl); GSYNC(); }
  }
}

extern "C" void kernel_launch(void* const* d_in, const int* in_sizes, int n_in, void* d_out, int out_size, void* d_ws, size_t ws_size,
                              hipStream_t stream) {
  static int grid_blocks = 0;
  if (!grid_blocks) {
    (void)hipFuncSetAttribute((const void*)mega, hipFuncAttributeMaxDynamicSharedMemorySize, SHM_BYTES);
    int dev = 0, cus = 0, per_cu = 0;
    (void)hipGetDevice(&dev);
    (void)hipDeviceGetAttribute(&cus, hipDeviceAttributeMultiprocessorCount, dev);
    (void)hipOccupancyMaxActiveBlocksPerMultiprocessor(&per_cu, mega, NTHREADS, SHM_BYTES);
    if (per_cu < 1) per_cu = 1;
    grid_blocks = cus;
  }
  if (n_in != 32 || ws_size < WS_NEED) { fprintf(stderr, "kernel_launch: bad n_in %d or ws %zu < %zu\n", n_in, ws_size, WS_NEED); return; }
  Params p{};
  const float** f = (const float**)&p;
  for (int i = 0; i < 32; ++i) f[i] = (const float*)d_in[i];
  p.out = (float*)d_out; p.ws = (char*)d_ws;
  (void)hipMemsetAsync((char*)d_ws + OFF_BAR, 0, 16384, stream);
  void* args[] = {&p};
  hipError_t e = hipLaunchCooperativeKernel((void*)mega, dim3(grid_blocks), dim3(NTHREADS), args, SHM_BYTES, stream);
  if (e != hipSuccess) fprintf(stderr, "cooperative launch failed: %s (grid %d)\n", hipGetErrorString(e), grid_blocks);
}
```

```cpp
#include <hip/hip_runtime.h>
#include <hip/hip_cooperative_groups.h>
#include <cstdio>
#include <cstdint>
namespace cg = cooperative_groups;

typedef unsigned short bf16_t;
using bf16x8 = __attribute__((ext_vector_type(8))) short;
using s16x4  = __attribute__((ext_vector_type(4))) short;
using f32x4  = __attribute__((ext_vector_type(4))) float;
using f32x16 = __attribute__((ext_vector_type(16))) float;
using u32x4  = __attribute__((ext_vector_type(4))) unsigned;
using u32x2  = __attribute__((ext_vector_type(2))) unsigned;
#define LAS __attribute__((address_space(3)))

constexpr int NB = 4, SEQ = 4096, CTXL = 256, TPB = SEQ + CTXL  , TT = NB * TPB  ;
constexpr int DM = 2048, NIN = 4608, DFF = 5632, NMODC = 6 * DM  ;
constexpr int NTHREADS = 512, SHM_BYTES = 131072;

constexpr size_t al256(size_t x) { return (x + 255) / 256 * 256; }
constexpr size_t OFF_X    = 0;
constexpr size_t OFF_WIN  = OFF_X + (size_t)TT * DM * 2;
constexpr size_t OFF_WOUT = OFF_WIN + (size_t)NIN * DM * 2;
constexpr size_t OFF_WGU  = OFF_WOUT + (size_t)DM * DM * 2;
constexpr size_t OFF_WD   = OFF_WGU + (size_t)2 * DFF * DM * 2;
constexpr size_t OFF_WGLU = OFF_WD + (size_t)DM * DFF * 2;
constexpr size_t OFF_DFTL = OFF_WGLU + (size_t)512 * 512 * 2;
constexpr size_t OFF_DFTC = OFF_DFTL + (size_t)2 * 4096 * 4096 * 2;
constexpr size_t OFF_MP   = OFF_DFTC + (size_t)2 * 256 * 256 * 2;
constexpr size_t OFF_MOD  = OFF_MP + (size_t)16 * 5 * 24576 * 4;
constexpr size_t OFF_ROPE = OFF_MOD + (size_t)2 * 5 * NMODC * 4;
constexpr size_t OFF_WCS  = OFF_ROPE + (size_t)2 * 64 * 32 * 4;
constexpr size_t OFF_PW   = OFF_WCS + (size_t)2 * 2 * 4 * 128 * 128 * 4;
constexpr size_t OFF_BB   = OFF_PW + (size_t)2 * 32 * 2 * 33 * 64 * 8;
constexpr size_t OFF_MK   = OFF_BB + (size_t)2 * 32 * 2 * 64 * 16 * 8;
constexpr size_t OFF_TF   = OFF_MK + (size_t)2 * 32 * 2 * 32 * 256 * 4;
constexpr size_t OFF_EM   = OFF_TF + (size_t)32 * 512 * 768 * 2;
constexpr size_t OFF_BAR  = OFF_EM + (size_t)32 * 256 * 512 * 2;
constexpr size_t OFF_HN   = OFF_BAR + 16384;
constexpr size_t OFF_Z1   = OFF_HN + (size_t)TT * DM * 2;
constexpr size_t Z1_Q = 0, Z1_K = (size_t)TT * 1024 * 2, Z1_V = 2 * Z1_K;
constexpr size_t OFF_Z2   = OFF_Z1 + (size_t)TT * DM * 4;
constexpr size_t Z2_FC = 0, Z2_FS = Z2_FC + (size_t)TT * 512 * 4;
constexpr size_t Z2_UG = Z2_FS + (size_t)TT * 512 * 4;
constexpr size_t Z2_SB = Z2_UG + (size_t)32 * 768 * 768 * 2;
constexpr size_t Z2_CAT = Z2_SB + (size_t)32 * 768 * 256 * 4;
constexpr size_t Z2_GG = Z2_CAT + (size_t)TT * DM * 2;
constexpr size_t Z2_END = Z2_GG + (size_t)TT * 512 * 2;
constexpr size_t Z2_SIZE = Z2_END > (size_t)TT * DFF * 2 ? Z2_END : (size_t)TT * DFF * 2;
constexpr size_t WS_NEED = OFF_Z2 + Z2_SIZE;
static_assert(WS_NEED <= (size_t)805306368, "workspace over 768 MiB");


struct Params {
  const float *x, *c, *ctx, *c_ctx, *w_mod, *b_mod, *g_mix_pre, *g_mix_post, *g_ffn_pre, *g_ffn_post, *w_in, *w_out;
  const float *lam_q1, *lam_k1, *lam_q2, *lam_k2, *g_subln, *ssm_a_re, *ssm_a_im, *ssm_log_dt, *ssm_b_re, *ssm_b_im;
  const float *ssm_c_re, *ssm_c_im, *ssm_d, *w_glu, *b_glu, *w_four, *b_four, *w_gate, *w_up, *w_down;
  float* out; char* ws;
};

__device__ __forceinline__ unsigned cvtpk(float lo, float hi) { unsigned r; asm volatile("v_cvt_pk_bf16_f32 %0, %1, %2" : "=v"(r) : "v"(lo), "v"(hi)); return r; }
__device__ __forceinline__ float bf2f(unsigned short b) { return __uint_as_float((unsigned)b << 16); }
template <int CTRL> __device__ __forceinline__ float dpp_add(float v) { return v + __uint_as_float(__builtin_amdgcn_update_dpp(0u, __float_as_uint(v), CTRL, 0xf, 0xf, false)); }
__device__ __forceinline__ float wave_sum(float v) {
  v = dpp_add<0xB1>(v); v = dpp_add<0x4E>(v); v = dpp_add<0x141>(v); v = dpp_add<0x140>(v);
  const int vi = (int)__float_as_uint(v);
  return (__uint_as_float((unsigned)__builtin_amdgcn_readlane(vi, 0)) + __uint_as_float((unsigned)__builtin_amdgcn_readlane(vi, 16))) + (__uint_as_float((unsigned)__builtin_amdgcn_readlane(vi, 32)) + __uint_as_float((unsigned)__builtin_amdgcn_readlane(vi, 48)));
}
__device__ __forceinline__ void my_sincos(float x, float& s, float& c) {
  const double xd = (double)x; const double kd = rint(xd * 0.63661977236758134); const double r = xd - kd * 1.5707963267948966;
  const double r2 = r * r;
  const double sn = r * (1.0 - r2 * (1.0 / 6.0) * (1.0 - r2 * (1.0 / 20.0) * (1.0 - r2 * (1.0 / 42.0) * (1.0 - r2 * (1.0 / 72.0) * (1.0 - r2 * (1.0 / 110.0) * (1.0 - r2 * (1.0 / 156.0)))))));
  const double cs = 1.0 - r2 * 0.5 * (1.0 - r2 * (1.0 / 12.0) * (1.0 - r2 * (1.0 / 30.0) * (1.0 - r2 * (1.0 / 56.0) * (1.0 - r2 * (1.0 / 90.0) * (1.0 - r2 * (1.0 / 132.0))))));
  const int q = ((int)kd) & 3;
  const double ss = (q == 0) ? sn : (q == 1) ? cs : (q == 2) ? -sn : -cs;
  const double cc = (q == 0) ? cs : (q == 1) ? -sn : (q == 2) ? -cs : sn;
  s = (float)ss; c = (float)cc;
}
__device__ __forceinline__ float sigmoidf_(float x) { return __builtin_amdgcn_rcpf(1.f + __builtin_amdgcn_exp2f(x * -1.4426950408889634f)); }
__device__ __forceinline__ float gelu_tanh(float y) { const float u = 0.7978845608028654f * (y + 0.044715f * y * y * y); return y * sigmoidf_(2.f * u); }

namespace gm {
constexpr int BM = 256, BK = 64, HALF = 128, HTB = HALF * BK * 2, NXCD = 8, WGM = 8;
__device__ __forceinline__ int lds_byte(int r, int c) { const int st = (r >> 4) * 2 + (c >> 5), rr = r & 15, cc = c & 31, ob = rr * 64 + cc * 2; return st * 1024 + (ob ^ (((ob >> 9) & 1) << 5)); }
__device__ __forceinline__ void stage_rc(int b, int& R, int& C) { const int st = b / 1024, sb = b % 1024, swz = sb ^ (((sb >> 9) & 1) << 5); R = (st >> 1) * 16 + swz / 64; C = (st & 1) * 32 + (swz % 64) / 2; }
__device__ __forceinline__ void tile_of(int wgid, int nM, int nN, int& pm, int& pn) {
  const int nwg = nM * nN; { const int q = nwg / NXCD, r = nwg % NXCD, xcd = wgid % NXCD, off = wgid / NXCD; wgid = (xcd < r ? xcd * (q + 1) : r * (q + 1) + (xcd - r) * q) + off; }
  const int nig = WGM * nN, gid = wgid / nig, fm = gid * WGM, gsz = (nM - fm) < WGM ? (nM - fm) : WGM;
  pm = fm + ((wgid % nig) % gsz); pn = (wgid % nig) / gsz;
}
struct Unit { int pm, pn; };

template <bool SWAP, bool PERM = false, class Epi, class Sched>
__device__ __forceinline__ void gemm_phase(LAS unsigned char* lds, const int lda, const int ldb, const int K, const Sched& S, const Epi& E) {
  int tid_ = threadIdx.x; asm volatile("" : "+v"(tid_));
  const int tid = tid_, wid = __builtin_amdgcn_readfirstlane(tid >> 6), lane = tid & 63, wr = wid >> 2, wc = wid & 3, fr = lane & 15, fq = lane >> 4;
  const int nt = K / BK;
  unsigned voffA[2], voffB[2];
#pragma unroll
  for (int i = 0; i < 2; ++i) { int R, C; stage_rc(tid * 16 + i * 8192, R, C); voffA[i] = (unsigned)(R * lda + C) * 2u;
    const int rho = R & 31, Rb = PERM ? ((R & ~31) + 8 * ((rho & 15) >> 2) + 4 * (rho >> 4) + (rho & 3)) : R;
    voffB[i] = (unsigned)(Rb * ldb + C) * 2u; }
  const size_t kstep = (size_t)(BK * 2), hstepA = (size_t)HALF * lda * 2, hstepB = (size_t)HALF * ldb * 2;
  const unsigned ldsw = (unsigned)wid * 1024u;
  const int aoff = lds_byte(wr * 64 + fr, fq * 8), boff = lds_byte(wc * 32 + fr, fq * 8);
#define PG8_SA(b, h) (((b) * 2 + (h)) * HTB)
#define PG8_SB(b, h) ((4 + (b) * 2 + (h)) * HTB)
#define PG8_STAGE(bufoff, gbase, voff) do { _Pragma("unroll") for (int _i = 0; _i < 2; ++_i) \
    __builtin_amdgcn_global_load_lds((const unsigned*)((const char*)(gbase) + (voff)[_i]), (LAS unsigned*)(lds + (bufoff) + ldsw + _i * 8192), 16, 0, 0); } while (0)
#define PG8_LDA(dst, b, h) do { _Pragma("unroll") for (int m = 0; m < 4; ++m) _Pragma("unroll") for (int k = 0; k < 2; ++k) dst[m][k] = *(const LAS bf16x8*)(lds + PG8_SA(b, h) + aoff + m * 2048 + k * 1024); } while (0)
#define PG8_LDB(dst, b, h) do { _Pragma("unroll") for (int n = 0; n < 2; ++n) _Pragma("unroll") for (int k = 0; k < 2; ++k) dst[n][k] = *(const LAS bf16x8*)(lds + PG8_SB(b, h) + boff + n * 2048 + k * 1024); } while (0)
#define PG8_MMA(ai, bj, At, Bt) do { __builtin_amdgcn_s_setprio(1); _Pragma("unroll") for (int m = 0; m < 4; ++m) _Pragma("unroll") for (int n = 0; n < 2; ++n) _Pragma("unroll") for (int k = 0; k < 2; ++k) \
    acc[ai][bj][m][n] = SWAP ? __builtin_amdgcn_mfma_f32_16x16x32_bf16(Bt[n][k], At[m][k], acc[ai][bj][m][n], 0, 0, 0) \
                             : __builtin_amdgcn_mfma_f32_16x16x32_bf16(At[m][k], Bt[n][k], acc[ai][bj][m][n], 0, 0, 0); __builtin_amdgcn_s_setprio(0); } while (0)
#define PG8_WAIT_V(n) asm volatile("s_waitcnt vmcnt(" #n ")" ::: "memory")
#define PG8_WAIT_L(n) asm volatile("s_waitcnt lgkmcnt(" #n ")" ::: "memory")
#define PG8_BAR __builtin_amdgcn_s_barrier()
#define PG8_SCHED __builtin_amdgcn_sched_barrier(0)
  Unit cur, nxt; int ui = 0;
  if (!S.next(0, cur)) return;
  f32x4 acc[2][2][4][2];
#pragma unroll
  for (int a = 0; a < 2; ++a)
#pragma unroll
    for (int b = 0; b < 2; ++b)
#pragma unroll
      for (int m = 0; m < 4; ++m)
#pragma unroll
        for (int n = 0; n < 2; ++n) acc[a][b][m][n] = (f32x4){0.f, 0.f, 0.f, 0.f};
  bf16x8 At[4][2], B0[2][2], B1[2][2];
  const char* cA = S.pA(cur); const char* cB = S.pB(cur);
  PG8_STAGE(PG8_SB(0, 0), cB, voffB); PG8_STAGE(PG8_SB(0, 1), cB + hstepB, voffB); PG8_STAGE(PG8_SA(0, 0), cA, voffA); PG8_STAGE(PG8_SA(0, 1), cA + hstepA, voffA);
  if (wr == 1) PG8_BAR;
  PG8_WAIT_V(2); PG8_BAR;
  PG8_STAGE(PG8_SB(1, 0), cB + kstep, voffB); PG8_STAGE(PG8_SA(1, 0), cA + kstep, voffA); PG8_STAGE(PG8_SB(1, 1), cB + hstepB + kstep, voffB);
  PG8_WAIT_V(6); PG8_BAR;
  for (;;) {
    const bool has_next = S.next(ui + 1, nxt);
    const char* nA = has_next ? S.pA(nxt) : cA; const char* nB = has_next ? S.pB(nxt) : cB;
    for (int t = 0; t < nt; t += 2) {
      const bool last = (t == nt - 2);
      const char* a1 = cA + (size_t)(t + 1) * kstep;
      const char* a2 = last ? nA : cA + (size_t)(t + 2) * kstep; const char* b2 = last ? nB : cB + (size_t)(t + 2) * kstep;
      const char* a3 = a2 + kstep; const char* b3 = b2 + kstep;
      PG8_LDB(B0, 0, 0); PG8_LDB(B1, 0, 1); PG8_SCHED; PG8_LDA(At, 0, 0); PG8_STAGE(PG8_SA(1, 1), a1 + hstepA, voffA);
      PG8_WAIT_V(8); PG8_WAIT_L(0); PG8_BAR; PG8_MMA(0, 0, At, B0); PG8_MMA(0, 1, At, B1); PG8_BAR; PG8_SCHED;
      PG8_LDA(At, 0, 1); PG8_STAGE(PG8_SB(0, 0), b2, voffB); PG8_STAGE(PG8_SB(0, 1), b2 + hstepB, voffB); PG8_STAGE(PG8_SA(0, 0), a2, voffA);
      PG8_WAIT_V(8); PG8_WAIT_L(0); PG8_BAR; PG8_MMA(1, 0, At, B0); PG8_MMA(1, 1, At, B1); PG8_BAR; PG8_SCHED;
      PG8_LDB(B0, 1, 0); PG8_LDB(B1, 1, 1); PG8_SCHED; PG8_LDA(At, 1, 0); PG8_STAGE(PG8_SA(0, 1), a2 + hstepA, voffA);
      PG8_WAIT_V(8); PG8_WAIT_L(0); PG8_BAR; PG8_MMA(0, 0, At, B0); PG8_MMA(0, 1, At, B1); PG8_BAR; PG8_SCHED;
      PG8_LDA(At, 1, 1); PG8_STAGE(PG8_SB(1, 0), b3, voffB); PG8_STAGE(PG8_SB(1, 1), b3 + hstepB, voffB); PG8_STAGE(PG8_SA(1, 0), a3, voffA);
      PG8_WAIT_V(8); PG8_WAIT_L(0); PG8_BAR; PG8_MMA(1, 0, At, B0); PG8_MMA(1, 1, At, B1); PG8_BAR; PG8_SCHED;
    }
    if (wr == 0) PG8_BAR;
    { int fr2 = fr, fq2 = fq; asm volatile("" : "+v"(fr2), "+v"(fq2));
      E(acc, cur, wr, wc, fr2, fq2); }
    if (!has_next) break;
#pragma unroll
    for (int a = 0; a < 2; ++a)
#pragma unroll
      for (int b = 0; b < 2; ++b)
#pragma unroll
        for (int m = 0; m < 4; ++m)
#pragma unroll
          for (int n = 0; n < 2; ++n) acc[a][b][m][n] = (f32x4){0.f, 0.f, 0.f, 0.f};
    cur = nxt; cA = nA; cB = nB; ++ui;
    if (wr == 1) PG8_BAR;
  }
  PG8_WAIT_V(0);
  PG8_BAR;
#undef PG8_SA
#undef PG8_SB
#undef PG8_STAGE
#undef PG8_LDA
#undef PG8_LDB
#undef PG8_MMA
#undef PG8_WAIT_V
#undef PG8_WAIT_L
#undef PG8_BAR
#undef PG8_SCHED
}
}

namespace at {
constexpr int D = 128, NW = 8, QBLK = 32, KVBLK = 64;
constexpr float SCALE = 0.088388347648318440f;
constexpr float THR = 8.f;
constexpr int LDQ = 1024, LDK = 1024, LDV = 1024, LDO = 2048;
constexpr size_t SHM_V = KVBLK * D * 2, SHM_K = KVBLK * D * 2;
#define KSWZ(row, colB) ((row) * 256 + ((colB) ^ (((row) & 7) << 4)))
#define SBAR() __builtin_amdgcn_sched_barrier(0)
__device__ __forceinline__ int crow(int r, int hi) { return (r & 3) + 8 * (r >> 2) + 4 * hi; }
__device__ __forceinline__ void partialSM(f32x16& p0, f32x16& p1, float& m_reg, float& mn, float& alpha) {
  constexpr float C = SCALE * 1.4426950408889634f;
  float pmax = p0[0];
#pragma unroll
  for (int r = 1; r < 16; ++r) pmax = fmaxf(pmax, p0[r]);
#pragma unroll
  for (int r = 0; r < 16; ++r) pmax = fmaxf(pmax, p1[r]);
  { auto rr = __builtin_amdgcn_permlane32_swap(__float_as_uint(pmax), __float_as_uint(pmax), false, false);
    pmax = fmaxf(__uint_as_float(rr[0]), __uint_as_float(rr[1])); }
  if (__builtin_expect(__all(pmax - m_reg <= THR / SCALE), 1)) { mn = m_reg; alpha = 1.f; }
  else { mn = fmaxf(m_reg, pmax); alpha = __builtin_amdgcn_exp2f((m_reg - mn) * C); m_reg = mn; }
  float mnC = -mn * C;
#pragma unroll
  for (int r = 0; r < 16; ++r) p0[r] = fmaf(p0[r], C, mnC);
#pragma unroll
  for (int r = 0; r < 16; ++r) p1[r] = fmaf(p1[r], C, mnC);
#pragma unroll
  for (int r = 0; r < 16; ++r) p0[r] = __builtin_amdgcn_exp2f(p0[r]);
}
__device__ __forceinline__ void finishSM(f32x16& p0, f32x16& p1, float alpha, float& l_reg, bf16x8& pa0, bf16x8& pa1, bf16x8& pa2, bf16x8& pa3) {
#pragma unroll
  for (int r = 0; r < 16; ++r) p1[r] = __builtin_amdgcn_exp2f(p1[r]);
  float ps = 0;
#pragma unroll
  for (int r = 0; r < 16; ++r) ps += p0[r];
#pragma unroll
  for (int r = 0; r < 16; ++r) ps += p1[r];
  { auto rr = __builtin_amdgcn_permlane32_swap(__float_as_uint(ps), __float_as_uint(ps), false, false);
    ps = __uint_as_float(rr[0]) + __uint_as_float(rr[1]); }
  l_reg = l_reg * alpha + ps;
#define PK4(P, BASE, OUT) do { unsigned a0 = cvtpk(P[BASE + 0], P[BASE + 1]), a1 = cvtpk(P[BASE + 2], P[BASE + 3]);   \
    unsigned b0 = cvtpk(P[BASE + 4], P[BASE + 5]), b1 = cvtpk(P[BASE + 6], P[BASE + 7]);                              \
    auto r0 = __builtin_amdgcn_permlane32_swap(a0, b0, false, false); auto r1 = __builtin_amdgcn_permlane32_swap(a1, b1, false, false); \
    u32x4 w = {r0[0], r1[0], r0[1], r1[1]}; OUT = *reinterpret_cast<bf16x8*>(&w); } while (0)
  PK4(p0, 0, pa0); PK4(p0, 8, pa1); PK4(p1, 0, pa2); PK4(p1, 8, pa3);
#undef PK4
}
__device__ __forceinline__ void qkt(f32x16& p0, f32x16& p1, const char* Ks, const bf16x8* qr, int r32, int hi) {
  p0 = f32x16{}; p1 = f32x16{};
#pragma unroll
  for (int d0 = 0; d0 < 8; ++d0) { int cb = (d0 * 16 + hi * 8) * 2;
    bf16x8 b0 = *reinterpret_cast<const bf16x8*>(Ks + KSWZ(r32, cb));
    bf16x8 b1 = *reinterpret_cast<const bf16x8*>(Ks + KSWZ(32 + r32, cb));
    p0 = __builtin_amdgcn_mfma_f32_32x32x16_bf16(b0, qr[d0], p0, 0, 0, 0);
    p1 = __builtin_amdgcn_mfma_f32_32x32x16_bf16(b1, qr[d0], p1, 0, 0, 0); }
}
__device__ __forceinline__ int v_st(int k, int c) { const int kk = (k & ~0xC) | ((k & 4) << 1) | ((k & 8) >> 1); return ((kk >> 3) * 8 + (c >> 5)) * 512 + ((kk & 7) * 32 + (c & 31)) * 2; }
__device__ __forceinline__ int v_rd_base(int lane) { return ((lane & 3) << 3) | (((lane >> 2) & 3) << 6) | (((lane >> 4) & 1) << 5) | (((lane >> 5) & 1) << 8); }
constexpr int v_rd_off(int d0, int ks, int half) { return d0 * 512 + ks * 8192 + half * 4096; }
template <int OFF> __device__ __forceinline__ s16x4 tr_read(int vb) {
  s16x4 r; asm volatile("ds_read_b64_tr_b16 %0, %1 offset:%2" : "=&v"(r) : "v"(vb), "i"(OFF) : "memory"); return r;
}
struct VFrag { s16x4 l0, h0, l1, h1, l2, h2, l3, h3; };
template <int D0> __device__ __forceinline__ void v_load(VFrag& f, int vb) {
  f.l0 = tr_read<v_rd_off(D0, 0, 0)>(vb); f.h0 = tr_read<v_rd_off(D0, 0, 1)>(vb); f.l1 = tr_read<v_rd_off(D0, 1, 0)>(vb); f.h1 = tr_read<v_rd_off(D0, 1, 1)>(vb);
  f.l2 = tr_read<v_rd_off(D0, 2, 0)>(vb); f.h2 = tr_read<v_rd_off(D0, 2, 1)>(vb); f.l3 = tr_read<v_rd_off(D0, 3, 0)>(vb); f.h3 = tr_read<v_rd_off(D0, 3, 1)>(vb);
}
__device__ __forceinline__ void pv_mma(f32x16& od, const VFrag& f, bf16x8 pa0, bf16x8 pa1, bf16x8 pa2, bf16x8 pa3) {
#define PK(L, H) (bf16x8){L[0], L[1], L[2], L[3], H[0], H[1], H[2], H[3]}
  od = __builtin_amdgcn_mfma_f32_32x32x16_bf16(pa0, PK(f.l0, f.h0), od, 0, 0, 0);
  od = __builtin_amdgcn_mfma_f32_32x32x16_bf16(pa1, PK(f.l1, f.h1), od, 0, 0, 0);
  od = __builtin_amdgcn_mfma_f32_32x32x16_bf16(pa2, PK(f.l2, f.h2), od, 0, 0, 0);
  od = __builtin_amdgcn_mfma_f32_32x32x16_bf16(pa3, PK(f.l3, f.h3), od, 0, 0, 0);
#undef PK
}
__device__ __forceinline__ void pv_all(f32x16* o, int vb, bf16x8 pa0, bf16x8 pa1, bf16x8 pa2, bf16x8 pa3) {
  VFrag fa, fb;
  v_load<0>(fa, vb);
#define STEP(D, CUR, NXT) v_load<D + 1>(NXT, vb); asm volatile("s_waitcnt lgkmcnt(8)" ::: "memory"); SBAR(); pv_mma(o[D], CUR, pa0, pa1, pa2, pa3); SBAR();
  STEP(0, fa, fb) STEP(1, fb, fa) STEP(2, fa, fb) STEP(3, fb, fa) STEP(4, fa, fb) STEP(5, fb, fa) STEP(6, fa, fb)
#undef STEP
  asm volatile("s_waitcnt lgkmcnt(0)" ::: "memory"); SBAR(); pv_mma(o[7], fb, pa0, pa1, pa2, pa3);
}
__device__ __forceinline__ void body(const bf16_t* __restrict__ Qb, const bf16_t* __restrict__ Kh, const bf16_t* __restrict__ Vh, bf16_t* __restrict__ Ob, int seq, char* lds) {
  int tid_ = threadIdx.x; asm volatile("" : "+v"(tid_));
  const int tid = tid_, wid = tid >> 6, lane = tid & 63, r32 = lane & 31, hi = lane >> 5;
  constexpr int SV = 64 * 256 * 2, SK = 64 * 128 * 2;
  char* V_lds = lds; char* K_lds = lds + 2 * SV;
  float* ws = (float*)(lds + 2 * SV + 2 * SK) + wid * 64; float* li_l = ws; float* al_l = ws + 32;
  float m_reg = -1e30f, l_reg = 0; f32x16 o[8] = {}; bf16x8 qr[8];
  const bf16_t* Qw = Qb + (long)(wid * QBLK + r32) * LDQ + hi * 8;
#pragma unroll
  for (int d0 = 0; d0 < 8; ++d0) qr[d0] = *reinterpret_cast<const bf16x8*>(Qw + d0 * 16);
  const int wu = __builtin_amdgcn_readfirstlane(wid);
  int koff[2], voff[4];
#pragma unroll
  for (int q = 0; q < 2; ++q) { const int row = 4 * (wu * 2 + q) + (lane >> 4); koff[q] = row * LDK + ((((lane & 15) << 4) ^ ((row & 7) << 4)) >> 1); }
#pragma unroll
  for (int q = 0; q < 4; ++q) { const int s = 2 * (wu * 4 + q) + (lane >> 5), kk = (s >> 3) * 8 + ((lane & 31) >> 2), k = (kk & ~0xC) | ((kk & 4) << 1) | ((kk & 8) >> 1);
    voff[q] = k * LDV + (s & 7) * 32 + (lane & 3) * 8; }
  const int vb0 = (int)(uintptr_t)(LAS char*)V_lds + v_rd_base(lane);
  LAS char* Vl = (LAS char*)V_lds; LAS char* Kl = (LAS char*)K_lds;
#define STAGE(b, k0) do { const bf16_t* kg = Kh + (long)(k0) * LDK; const bf16_t* vg = Vh + (long)(k0) * LDV; \
    _Pragma("unroll") for (int q = 0; q < 2; ++q) __builtin_amdgcn_global_load_lds((const unsigned*)(kg + koff[q]), (LAS unsigned*)(Kl + (b) * SK + (wu * 2 + q) * 1024), 16, 0, 0); \
    _Pragma("unroll") for (int q = 0; q < 4; ++q) __builtin_amdgcn_global_load_lds((const unsigned*)(vg + voff[q]), (LAS unsigned*)(Vl + (b) * SV + (wu * 4 + q) * 1024), 16, 0, 0); } while (0)
  const int NT = seq / KVBLK;
  STAGE(0, 0);
  asm volatile("s_waitcnt vmcnt(0) lgkmcnt(0)" ::: "memory"); __builtin_amdgcn_s_barrier(); asm volatile("" ::: "memory");
  for (int j = 0; j < NT; ++j) {
    const int b = j & 1;
    f32x16 p0, p1; float mn, al; bf16x8 pa0, pa1, pa2, pa3;
    if (j + 1 < NT) STAGE(b ^ 1, (j + 1) * KVBLK);
    SBAR(); qkt(p0, p1, K_lds + b * SK, qr, r32, hi);
    partialSM(p0, p1, m_reg, mn, al);
    if (__any(al < 1.f)) { if (hi == 0) al_l[r32] = al; asm volatile("s_waitcnt lgkmcnt(0)" ::: "memory");
#pragma unroll
      for (int d = 0; d < 8; ++d)
#pragma unroll
        for (int r = 0; r < 16; ++r) o[d][r] *= al_l[crow(r, hi)]; }
    finishSM(p0, p1, al, l_reg, pa0, pa1, pa2, pa3); SBAR();
    const int vb = vb0 + b * SV;
    pv_all(o, vb, pa0, pa1, pa2, pa3);
    asm volatile("s_waitcnt vmcnt(0) lgkmcnt(0)" ::: "memory"); __builtin_amdgcn_s_barrier(); asm volatile("" ::: "memory");
  }
  if (hi == 0) li_l[r32] = l_reg; asm volatile("s_waitcnt lgkmcnt(0)" ::: "memory");
  float rli[16];
#pragma unroll
  for (int r = 0; r < 16; ++r) rli[r] = __builtin_amdgcn_rcpf(li_l[crow(r, hi)]);
  bf16_t* Ow = Ob + (long)(wid * QBLK) * LDO;
#pragma unroll
  for (int r = 0; r < 16; ++r) { int orow = crow(r, hi);
#pragma unroll
    for (int d0 = 0; d0 < 8; ++d0) Ow[(long)orow * LDO + d0 * 32 + r32] = (bf16_t)(cvtpk(o[d0][r] * rli[r], 0.f) & 0xffff); }
#undef STAGE
  __syncthreads();
}
}

struct Ctx {
  int tid, wid, lane, blk, nblk, gwave, nwave; long gtid, nthr;
};

__device__ __forceinline__ const float* modp(const Params& p, int l, int v, int j) { return (const float*)(p.ws + OFF_MOD) + ((size_t)(l * 5 + v) * NMODC + (size_t)j * DM); }

__device__ __forceinline__ void convert_weights(const Params& p, const Ctx& c, int l, float* lds) {
  constexpr int T0 = 14 * 32, T1 = 8 * 32, T2 = 44 * 32, T3 = 8 * 88, T4 = 2 * 8, TALL = T0 + T1 + T2 + T3 + T4;
  for (int it = c.blk; it < TALL; it += c.nblk) {
    int mat, ti = it;
    if (ti < T0) mat = 0; else if ((ti -= T0) < T1) mat = 1; else if ((ti -= T1) < T2) mat = 2; else if ((ti -= T2) < T3) mat = 3; else { ti -= T3; mat = 4; }
    const float* src; long ld; bf16_t* dst; long dld; int nkt;
    if (mat == 0) { src = p.w_in + (size_t)l * DM * 4096; ld = 4096; dst = (bf16_t*)(p.ws + OFF_WIN); dld = DM; nkt = 32; }
    else if (mat == 1) { src = p.w_out + (size_t)l * DM * DM; ld = DM; dst = (bf16_t*)(p.ws + OFF_WOUT); dld = DM; nkt = 32; }
    else if (mat == 2) { src = p.w_gate + (size_t)l * DM * DFF; ld = DFF; dst = (bf16_t*)(p.ws + OFF_WGU); dld = DM; nkt = 32; }
    else if (mat == 3) { src = p.w_down + (size_t)l * DFF * DM; ld = DM; dst = (bf16_t*)(p.ws + OFF_WD); dld = DFF; nkt = 88; }
    else { src = p.w_glu + (size_t)l * 512 * 512; ld = 512; dst = (bf16_t*)(p.ws + OFF_WGLU); dld = 512; nkt = 8; }
    const int n0 = (ti / nkt) * 256, k0 = (ti % nkt) * 64;
    {
      const int nn = c.tid & 255, kk0 = c.tid >> 8, np = n0 + nn; int scol = np;
      if (mat == 0) { if (np < 2048) { const int ph = np & 127; scol = (np & ~127) | (ph & 64) | (((ph >> 2) & 1) << 5) | (((ph >> 5) & 1) << 4) | (((ph >> 3) & 3) << 2) | (ph & 3); } }
      else if (mat == 2) { const int pn = np >> 8, bj = (np >> 7) & 1; scol = pn * 128 + (np & 127); if (bj) src = p.w_up + (size_t)l * DM * DFF; }
      const float* sp = src + (size_t)(k0 + kk0) * ld + scol; float v[32];
#pragma unroll
      for (int i = 0; i < 32; ++i) v[i] = sp[(size_t)(2 * i) * ld];
#pragma unroll
      for (int i = 0; i < 32; ++i) lds[(kk0 + 2 * i) * 257 + nn] = v[i];
    }
    __syncthreads();
    {
      const int kc = (c.tid & 7) * 8;
#pragma unroll
      for (int j = 0; j < 4; ++j) { const int nn = (c.tid >> 3) + 64 * j; float v[8];
#pragma unroll
        for (int i = 0; i < 8; ++i) v[i] = lds[(kc + i) * 257 + nn];
        u32x4 w = {cvtpk(v[0], v[1]), cvtpk(v[2], v[3]), cvtpk(v[4], v[5]), cvtpk(v[6], v[7])};
        *(u32x4*)(dst + (size_t)(n0 + nn) * dld + k0 + kc) = w; }
    }
    __syncthreads();
  }
}

__device__ __forceinline__ void fold_four(const Params& p, const Ctx& c, int l, float* lds) {
  float* WlT = lds;
  float* Wc = lds + 128 * 68;
  const float* wcs = (const float*)(p.ws + OFF_WCS) + (size_t)l * 2 * 4 * 128 * 128;
  bf16_t* dstb = (bf16_t*)(p.ws + OFF_WIN);
  for (int u = c.blk; u < 256; u += c.nblk) {
    const int kt = u & 31, cs = (u >> 5) & 1, g = u >> 6, k0 = kt * 64;
    const float* src = p.w_in + (size_t)l * DM * 4096 + 3584 + g * 128;
    for (int i = c.tid; i < 64 * 128; i += NTHREADS) { const int kk = i >> 7, cc = i & 127; WlT[cc * 68 + kk] = src[(size_t)(k0 + kk) * 4096 + cc]; }
    const float* wsrc = wcs + (size_t)(cs * 4 + g) * 128 * 128;
    for (int i = c.tid; i < 128 * 128; i += NTHREADS) Wc[i] = wsrc[i];
    __syncthreads();
    const int kq = c.tid & 15, dq = c.tid >> 4;
    f32x4 acc[4] = {};
    for (int cc = 0; cc < 128; ++cc) {
      const f32x4 a = *(const f32x4*)(WlT + cc * 68 + kq * 4), w = *(const f32x4*)(Wc + cc * 128 + dq * 4);
#pragma unroll
      for (int di = 0; di < 4; ++di) acc[di] += a * w[di];
    }
#pragma unroll
    for (int di = 0; di < 4; ++di) { u32x2 o = {cvtpk(acc[di][0], acc[di][1]), cvtpk(acc[di][2], acc[di][3])};
      *(u32x2*)(dstb + (size_t)(3584 + cs * 512 + g * 128 + dq * 4 + di) * DM + k0 + kq * 4) = o; }
    __syncthreads();
  }
}


__device__ __forceinline__ void ssm_tables(const Params& p, const Ctx& c) {
  float2* PW = (float2*)(p.ws + OFF_PW); float2* BB = (float2*)(p.ws + OFF_BB);
  for (long i = c.gtid; i < 2L * 32 * 2 * 33 * 64; i += c.nthr) { const int pp = (int)(i & 63), j = (int)((i >> 6) % 33), idx = (int)((i >> 6) / 33);
    const int d = idx & 1, g = (idx >> 1) & 31, l = idx >> 6, iidx = (l * 2 + d) * 32 + g;
    const float lre = p.ssm_a_re[iidx * 64 + pp], lim = p.ssm_a_im[iidx * 64 + pp], dt = expf(p.ssm_log_dt[iidx]);
    const float mag = expf(lre * dt * (float)j); float sn, cs; my_sincos(lim * dt * (float)j, sn, cs);
    PW[i] = make_float2(mag * cs, mag * sn); }
  for (long i = c.gtid; i < 2L * 32 * 2 * 64; i += c.nthr) { const int pp = (int)(i & 63), idx = (int)(i >> 6);
    const int d = idx & 1, g = (idx >> 1) & 31, l = idx >> 6, iidx = (l * 2 + d) * 32 + g;
    const float lre = p.ssm_a_re[iidx * 64 + pp], lim = p.ssm_a_im[iidx * 64 + pp], dt = expf(p.ssm_log_dt[iidx]);
    const float mag = expf(lre * dt); float sn, cs; my_sincos(lim * dt, sn, cs); const float ar = mag * cs, ai = mag * sn;
    const float nr = ar - 1.f, ni = ai, den = 1.f / (lre * lre + lim * lim), cr = (nr * lre + ni * lim) * den, ci = (ni * lre - nr * lim) * den;
    const float* br = p.ssm_b_re + ((size_t)iidx * 64 + pp) * 16; const float* bi = p.ssm_b_im + ((size_t)iidx * 64 + pp) * 16;
    for (int h = 0; h < 16; ++h) BB[((size_t)idx * 64 + pp) * 16 + h] = make_float2(cr * br[h] - ci * bi[h], cr * bi[h] + ci * br[h]); }
}
__device__ __forceinline__ void ssm_build_mef(const Params& p, const Ctx& c, int l) {
  const float2* PW = (const float2*)(p.ws + OFF_PW) + (size_t)l * 32 * 2 * 33 * 64; const float2* BB = (const float2*)(p.ws + OFF_BB) + (size_t)l * 32 * 2 * 64 * 16;
  float* MK = (float*)(p.ws + OFF_MK) + (size_t)l * 32 * 2 * 32 * 256; bf16_t* EM = (bf16_t*)(p.ws + OFF_EM); bf16_t* TF = (bf16_t*)(p.ws + OFF_TF);
  for (long i = c.gtid; i < 32L * 2 * 32 * 256; i += c.nthr) { const int hp = (int)(i & 15), h = (int)((i >> 4) & 15), j = (int)((i >> 8) & 31), gd = (int)(i >> 13), d = gd & 1, g = gd >> 1;
    const size_t ci = ((size_t)((l * 2 + d) * 32 + g) * 16 + h) * 64; const float2* pw = PW + ((size_t)gd * 33 + j) * 64; const float2* bb = BB + (size_t)gd * 64 * 16 + hp; float a = 0.f;
    for (int pp = 0; pp < 64; ++pp) { const float cr = p.ssm_c_re[ci + pp], cim = p.ssm_c_im[ci + pp]; const float2 b = bb[pp * 16], w = pw[pp];
      const float wr = cr * b.x - cim * b.y, wi = cr * b.y + cim * b.x; a += wr * w.x - wi * w.y; }
    MK[i] = a; }
  for (long i = c.gtid; i < 32L * 256 * 32 * 2; i += c.nthr) { const int hh = (int)(i & 1), s = (int)((i >> 1) & 31), n = (int)((i >> 6) & 255), g = (int)(i >> 14), ri = n & 1, pp = (n >> 1) & 63, d = n >> 7;
    const int gd = g * 2 + d, e = d ? s : 31 - s; const float2 w = PW[((size_t)gd * 33 + e) * 64 + pp]; const float2* bb = BB + ((size_t)gd * 64 + pp) * 16 + hh * 8; float v[8];
#pragma unroll
    for (int k = 0; k < 8; ++k) { const float2 b = bb[k]; v[k] = ri ? (w.x * b.y + w.y * b.x) : (w.x * b.x - w.y * b.y); }
    u32x4 o = {cvtpk(v[0], v[1]), cvtpk(v[2], v[3]), cvtpk(v[4], v[5]), cvtpk(v[6], v[7])}; *(u32x4*)(EM + ((size_t)g * 256 + n) * 512 + s * 16 + hh * 8) = o; }
  for (long i = c.gtid; i < 32L * 512 * 2 * 16; i += c.nthr) { const int pq = (int)(i & 15), d = (int)((i >> 4) & 1), n = (int)((i >> 5) & 511), g = (int)(i >> 14), h = n & 15, t = n >> 4;
    const int gd = g * 2 + d, f = d ? 32 - t : t + 1; const size_t ci = ((size_t)((l * 2 + d) * 32 + g) * 16 + h) * 64 + pq * 4; const float2* pw = PW + ((size_t)gd * 33 + f) * 64 + pq * 4; float v[8];
#pragma unroll
    for (int k = 0; k < 4; ++k) { const float cr = p.ssm_c_re[ci + k], cim = p.ssm_c_im[ci + k]; const float2 w = pw[k]; v[2 * k] = cr * w.x - cim * w.y; v[2 * k + 1] = -(cr * w.y + cim * w.x); }
    u32x4 o = {cvtpk(v[0], v[1]), cvtpk(v[2], v[3]), cvtpk(v[4], v[5]), cvtpk(v[6], v[7])}; *(u32x4*)(TF + ((size_t)g * 512 + n) * 768 + 512 + d * 128 + pq * 8) = o; }
}
__device__ __forceinline__ void ssm_build_t(const Params& p, const Ctx& c, int l) {
  const float* MK = (const float*)(p.ws + OFF_MK) + (size_t)l * 32 * 2 * 32 * 256; bf16_t* TF = (bf16_t*)(p.ws + OFF_TF);
  for (long i = c.gtid; i < 32L * 512 * 32 * 2; i += c.nthr) { const int hh = (int)(i & 1), s = (int)((i >> 1) & 31), n = (int)((i >> 6) & 511), g = (int)(i >> 15), h = n & 15, t = n >> 4;
    const int lag = t - s; float v[8];
    if (lag != 0) { const float* m = MK + ((size_t)((g * 2 + (lag < 0 ? 1 : 0)) * 32 + (lag < 0 ? -lag : lag)) * 16 + h) * 16 + hh * 8;
#pragma unroll
      for (int k = 0; k < 8; ++k) v[k] = m[k]; }
    else { const float* m0 = MK + ((size_t)((g * 2) * 32) * 16 + h) * 16 + hh * 8; const float* m1 = MK + ((size_t)((g * 2 + 1) * 32) * 16 + h) * 16 + hh * 8; const float dsk = p.ssm_d[(size_t)l * 512 + g * 16 + h];
#pragma unroll
      for (int k = 0; k < 8; ++k) v[k] = m0[k] + m1[k] + ((hh * 8 + k) == h ? dsk : 0.f); }
    u32x4 o = {cvtpk(v[0], v[1]), cvtpk(v[2], v[3]), cvtpk(v[4], v[5]), cvtpk(v[6], v[7])}; *(u32x4*)(TF + ((size_t)g * 512 + n) * 768 + s * 16 + hh * 8) = o; }
}
__device__ __forceinline__ void ssm_carry(const Params& p, const Ctx& c, int l, float* lds) {
  const float2* PW = (const float2*)(p.ws + OFF_PW) + (size_t)l * 32 * 2 * 33 * 64; const float* SB = (const float*)(p.ws + OFF_Z2 + Z2_SB); bf16_t* UG = (bf16_t*)(p.ws + OFF_Z2 + Z2_UG);
  float2* E = (float2*)lds;
  for (int base = c.blk * 64; base < NB * 32 * 2 * 64; base += c.nblk * 64) {
  const int i = base + c.lane; const bool act = true; const int ii = i;
  const int pp = ii & 63, d = (ii >> 6) & 1, g = (ii >> 7) & 31, b = ii >> 12, w = c.wid;
  const float2 a32 = PW[((size_t)(g * 2 + d) * 33 + 32) * 64 + pp];
  const size_t rbase = (size_t)g * 768 + b * 136; const int col = (d * 64 + pp) * 2;
  float2 s[17], hl[17];
#pragma unroll
  for (int kk = 0; kk < 17; ++kk) { const int k = 17 * w + kk; const int ch = d == 0 ? k : (k < 8 ? 7 - k : 143 - k); s[kk] = *(const float2*)(SB + (rbase + ch) * 256 + col); }
  float hr = 0.f, hi = 0.f;
#pragma unroll
  for (int kk = 0; kk < 17; ++kk) { hl[kk] = make_float2(hr, hi); const float nr = a32.x * hr - a32.y * hi + s[kk].x, ni = a32.x * hi + a32.y * hr + s[kk].y; hr = nr; hi = ni; }
  E[w * 64 + c.lane] = make_float2(hr, hi);
  float ar = a32.x, ai = a32.y;
#pragma unroll
  for (int q = 0; q < 4; ++q) { const float t = ar * ar - ai * ai; ai = 2.f * ar * ai; ar = t; }
  { const float t = ar * a32.x - ai * a32.y; ai = ar * a32.y + ai * a32.x; ar = t; }
  __syncthreads();
  float pr = 0.f, pi = 0.f;
  for (int q = 0; q < w; ++q) { const float2 e = E[q * 64 + c.lane]; const float nr = ar * pr - ai * pi + e.x, ni = ar * pi + ai * pr + e.y; pr = nr; pi = ni; }
  if (act) {
#pragma unroll
    for (int kk = 0; kk < 17; ++kk) { const int k = 17 * w + kk; const int ch = d == 0 ? k : (k < 8 ? 7 - k : 143 - k);
      *(unsigned*)(UG + (rbase + ch) * 768 + 512 + col) = cvtpk(hl[kk].x + pr, hl[kk].y + pi);
      const float nr = a32.x * pr - a32.y * pi, ni = a32.x * pi + a32.y * pr; pr = nr; pi = ni; } }
  __syncthreads();
  }
}

__device__ __forceinline__ void phase0a(const Params& p, const Ctx& c, float* lds) {
  for (int i = c.tid; i < 5 * DM; i += NTHREADS) { const float v = i < 4 * DM ? p.c[i] : p.c_ctx[i - 4 * DM]; lds[i] = v * sigmoidf_(v); }
  __syncthreads();
  {
    float* MP = (float*)(p.ws + OFF_MP);
    for (long it = c.gtid; it < 16 * 6144; it += c.nthr) {
      const int cq = (int)(it % 6144), ks = (int)(it / 6144); const int gc = cq * 4, l = gc / NMODC, col = gc % NMODC;
      const float* wp = p.w_mod + ((size_t)l * DM + (size_t)ks * 128) * NMODC + col;
      f32x4 a[5] = {};
#pragma unroll 8
      for (int k = 0; k < 128; ++k) { const f32x4 w = *(const f32x4*)(wp + (size_t)k * NMODC);
#pragma unroll
        for (int v = 0; v < 5; ++v) a[v] += w * lds[v * DM + ks * 128 + k]; }
#pragma unroll
      for (int v = 0; v < 5; ++v) *(f32x4*)(MP + ((size_t)ks * 5 + v) * 24576 + gc) = a[v];
    }
  }
  __syncthreads();
  {
    float* rc = (float*)(p.ws + OFF_ROPE); float* rs = rc + 64 * 32;
    for (long i = c.gtid; i < 64 * 32; i += c.nthr) { const int pos = (int)(i >> 5), pp = (int)(i & 31);
      const float inv = (float)exp2(-(double)pp / 32.0 * 13.287712379549449); float s, cc; my_sincos((float)pos * inv, s, cc); rc[i] = cc; rs[i] = s; }
  }
  {
    bf16_t* DB = (bf16_t*)(p.ws + OFF_DFTC);
    for (long i = c.gtid; i < 256L * 64; i += c.nthr) { const int k = (int)(i >> 6), c0 = (int)(i & 63) * 8, part = c0 >> 8, t0 = c0 & 255; float v[8];
#pragma unroll
      for (int j = 0; j < 8; ++j) { const float ph = (float)((k * (t0 + j)) & 255) * (1.f / 256.f); v[j] = (part ? __builtin_amdgcn_sinf(ph) : __builtin_amdgcn_cosf(ph)) * (1.f / 16.f); }
      u32x4 w = {cvtpk(v[0], v[1]), cvtpk(v[2], v[3]), cvtpk(v[4], v[5]), cvtpk(v[6], v[7])}; *(u32x4*)(DB + i * 8) = w; }
  }
  {
    float* W = (float*)(p.ws + OFF_WCS);
    for (long i = c.gtid; i < 2L * 2 * 4 * 128 * 128; i += c.nthr) { const int d = (int)(i & 127), cc = (int)((i >> 7) & 127), g = (int)((i >> 14) & 3), cs = (int)((i >> 16) & 1), l = (int)(i >> 17);
      const float* wf = p.w_four + ((size_t)(l * 4 + g) * 128) * 128 + d; float a = 0.f;
      for (int j = 0; j < 128; ++j) { const float ph = (float)((j * cc) & 127) * (1.f / 128.f); a += (cs ? __builtin_amdgcn_sinf(ph) : __builtin_amdgcn_cosf(ph)) * wf[(size_t)j * 128]; }
      W[i] = a * 0.08838834764831845f; }
  }
}

__device__ __forceinline__ void reduce_mod(const Params& p, const Ctx& c) {
  const float* MP = (const float*)(p.ws + OFF_MP); float* MOD = (float*)(p.ws + OFF_MOD);
  for (long o = c.gtid; o < 5L * 24576; o += c.nthr) { const int v = (int)(o / 24576), gc = (int)(o % 24576), l = gc / NMODC, col = gc % NMODC;
    float a = p.b_mod[gc];
#pragma unroll
    for (int ks = 0; ks < 16; ++ks) a += MP[((size_t)ks * 5 + v) * 24576 + gc];
    MOD[(size_t)(l * 5 + v) * NMODC + col] = a; }
}

__device__ __forceinline__ void prenorm_row(const f32x4 (&x)[8], float rinv, const float* g, const float* sc, const float* sh, bf16_t* dst, int lane) {
#pragma unroll
  for (int i = 0; i < 8; ++i) { const int col = (lane + 64 * i) * 4; const f32x4 gg = *(const f32x4*)(g + col), s1 = *(const f32x4*)(sc + col), s0 = *(const f32x4*)(sh + col);
    const f32x4 y = (x[i] * rinv * gg) * (s1 + 1.f) + s0; u32x2 o = {cvtpk(y[0], y[1]), cvtpk(y[2], y[3])}; *(u32x2*)(dst + col) = o; }
}
__device__ __forceinline__ float sumsq8(const f32x4 (&x)[8]) { float s = 0.f;
#pragma unroll
  for (int i = 0; i < 8; ++i) s += x[i][0] * x[i][0] + x[i][1] * x[i][1] + x[i][2] * x[i][2] + x[i][3] * x[i][3];
  return wave_sum(s); }

typedef _Float16 h16x4 __attribute__((ext_vector_type(4)));
__device__ __forceinline__ f32x4 ldx(const _Float16* p) { const h16x4 h = *(const h16x4*)p; return __builtin_convertvector(h, f32x4); }
__device__ __forceinline__ void stx(_Float16* p, f32x4 v) { *(h16x4*)p = __builtin_convertvector(v, h16x4); }
__device__ __forceinline__ const float* xrow_src(const Params& p, int l, int b, int t, int row) {
  const float* base = t < CTXL ? p.ctx : p.x; const size_t off = t < CTXL ? ((size_t)b * CTXL + t) * DM : ((size_t)b * SEQ + (t - CTXL)) * DM; return base + off;
}
__device__ __forceinline__ void phase_prenorm(const Params& p, const Ctx& c, int l) {
  bf16_t* Hn = (bf16_t*)(p.ws + OFF_HN);
  for (int row = c.gwave; row < TT; row += c.nwave) { const int b = row / TPB, t = row % TPB, v = t < CTXL ? 4 : b;
    f32x4 x[8]; const f32x4* xr = (const f32x4*)xrow_src(p, l, b, t, row);
#pragma unroll
    for (int i = 0; i < 8; ++i) x[i] = xr[c.lane + 64 * i];
    const float rinv = rsqrtf(sumsq8(x) * (1.f / DM) + 1e-6f);
    prenorm_row(x, rinv, p.g_mix_pre + (size_t)l * DM, modp(p, l, v, 1), modp(p, l, v, 0), Hn + (size_t)row * DM, c.lane); }
}
__device__ __forceinline__ f32x4 bf4(const u32x2 w) { return (f32x4){__uint_as_float(w[0] << 16), __uint_as_float(w[0] & 0xffff0000u), __uint_as_float(w[1] << 16), __uint_as_float(w[1] & 0xffff0000u)}; }
__device__ __forceinline__ void phase_postmix(const Params& p, const Ctx& c, int l, bool last) {
  _Float16* X = (_Float16*)(p.ws + OFF_X); const bf16_t* MIX = (const bf16_t*)(p.ws + OFF_Z1); bf16_t* Hn = (bf16_t*)(p.ws + OFF_HN);
  auto valid = [&](int r) { return !(last && (r % TPB) < CTXL); };
  auto load = [&](int row, f32x4 (&m)[8], f32x4 (&x)[8]) { const int b = row / TPB, t = row % TPB;
    const u32x2* mr = (const u32x2*)(MIX + (size_t)row * DM); const _Float16* xr = X + (size_t)row * DM; const f32x4* xs = (const f32x4*)xrow_src(p, 0, b, t, row);
    if (t < CTXL) { const u32x2* sl = (const u32x2*)(p.ws + OFF_Z2) + ((size_t)b * CTXL + t) * (DM / 4);
#pragma unroll
      for (int i = 0; i < 8; ++i) { m[i] = (f32x4){0.f, 0.f, 0.f, 0.f}; x[i] = xs[c.lane + 64 * i]; }
      for (int s = 0; s < 8; ++s) {
#pragma unroll
        for (int i = 0; i < 8; ++i) m[i] += bf4(sl[(size_t)s * NB * CTXL * (DM / 4) + c.lane + 64 * i]); } }
    else {
#pragma unroll
      for (int i = 0; i < 8; ++i) { m[i] = bf4(mr[c.lane + 64 * i]); x[i] = (l == 0) ? xs[c.lane + 64 * i] : ldx(xr + (c.lane + 64 * i) * 4); } } };
  auto process = [&](int row, f32x4 (&m)[8], f32x4 (&x)[8]) { const int b = row / TPB, t = row % TPB, v = t < CTXL ? 4 : b; _Float16* xr = X + (size_t)row * DM;
    const float r1 = rsqrtf(sumsq8(m) * (1.f / DM) + 1e-6f); const float* gp = p.g_mix_post + (size_t)l * DM; const float* m2 = modp(p, l, v, 2);
#pragma unroll
    for (int i = 0; i < 8; ++i) { const int col = (c.lane + 64 * i) * 4; x[i] += *(const f32x4*)(m2 + col) * (m[i] * r1 * *(const f32x4*)(gp + col)); stx(xr + col, x[i]); }
    const float r2 = rsqrtf(sumsq8(x) * (1.f / DM) + 1e-6f);
    prenorm_row(x, r2, p.g_ffn_pre + (size_t)l * DM, modp(p, l, v, 4), modp(p, l, v, 3), Hn + (size_t)row * DM, c.lane); };
  int row = c.gwave; while (row < TT && !valid(row)) row += c.nwave;
  if (row >= TT) return;
  f32x4 mA[8], xA[8], mB[8], xB[8]; load(row, mA, xA);
  for (;;) { int nrow = row + c.nwave; while (nrow < TT && !valid(nrow)) nrow += c.nwave;
    if (nrow < TT) load(nrow, mB, xB);
    process(row, mA, xA);
    if (nrow >= TT) break;
#pragma unroll
    for (int i = 0; i < 8; ++i) { mA[i] = mB[i]; xA[i] = xB[i]; }
    row = nrow; }
}
__device__ __forceinline__ void phase_postffn(const Params& p, const Ctx& c, int l, bool last) {
  _Float16* X = (_Float16*)(p.ws + OFF_X); const bf16_t* F = (const bf16_t*)(p.ws + OFF_Z1 + (size_t)TT * DM * 2); bf16_t* Hn = (bf16_t*)(p.ws + OFF_HN);
  auto valid = [&](int r) { return !(last && (r % TPB) < CTXL); };
  auto load = [&](int row, f32x4 (&m)[8], f32x4 (&x)[8]) { const int b = row / TPB, t = row % TPB;
    const u32x2* mr = (const u32x2*)(F + (size_t)row * DM); const _Float16* xr = X + (size_t)row * DM;
    if (t < CTXL) { const u32x2* sl = (const u32x2*)(p.ws + OFF_Z1) + ((size_t)b * CTXL + t) * (DM / 4);
#pragma unroll
      for (int i = 0; i < 8; ++i) { m[i] = (f32x4){0.f, 0.f, 0.f, 0.f}; x[i] = ldx(xr + (c.lane + 64 * i) * 4); }
      for (int s = 0; s < 11; ++s) {
#pragma unroll
        for (int i = 0; i < 8; ++i) m[i] += bf4(sl[(size_t)s * NB * CTXL * (DM / 4) + c.lane + 64 * i]); } }
    else {
#pragma unroll
      for (int i = 0; i < 8; ++i) { m[i] = bf4(mr[c.lane + 64 * i]); x[i] = ldx(xr + (c.lane + 64 * i) * 4); } } };
  auto process = [&](int row, f32x4 (&m)[8], f32x4 (&x)[8]) { const int b = row / TPB, t = row % TPB, v = t < CTXL ? 4 : b; _Float16* xr = X + (size_t)row * DM;
    const float r1 = rsqrtf(sumsq8(m) * (1.f / DM) + 1e-6f); const float* gp = p.g_ffn_post + (size_t)l * DM; const float* m5 = modp(p, l, v, 5);
#pragma unroll
    for (int i = 0; i < 8; ++i) { const int col = (c.lane + 64 * i) * 4; x[i] += *(const f32x4*)(m5 + col) * (m[i] * r1 * *(const f32x4*)(gp + col)); }
    if (last) { f32x4* o = (f32x4*)(p.out + ((size_t)b * SEQ + (t - CTXL)) * DM);
#pragma unroll
      for (int i = 0; i < 8; ++i) o[c.lane + 64 * i] = x[i]; }
    else {
#pragma unroll
      for (int i = 0; i < 8; ++i) stx(xr + (c.lane + 64 * i) * 4, x[i]);
      const float r2 = rsqrtf(sumsq8(x) * (1.f / DM) + 1e-6f);
      prenorm_row(x, r2, p.g_mix_pre + (size_t)(l + 1) * DM, modp(p, l + 1, v, 1), modp(p, l + 1, v, 0), Hn + (size_t)row * DM, c.lane); } };
  int row = c.gwave; while (row < TT && !valid(row)) row += c.nwave;
  if (row >= TT) return;
  f32x4 mA[8], xA[8], mB[8], xB[8]; load(row, mA, xA);
  for (;;) { int nrow = row + c.nwave; while (nrow < TT && !valid(nrow)) nrow += c.nwave;
    if (nrow < TT) load(nrow, mB, xB);
    process(row, mA, xA);
    if (nrow >= TT) break;
#pragma unroll
    for (int i = 0; i < 8; ++i) { mA[i] = mB[i]; xA[i] = xB[i]; }
    row = nrow; }
}

typedef f32x4 Acc[2][2][4][2];
__device__ __forceinline__ int lat_pm(int i) { return (i >> 4) * 17 + 1 + (i & 15); }

struct SchedMN {
  const char* A; const char* B; size_t strA, strB;
  int nM, nN, pn0, latonly, nextra, blk, nblk;
  __device__ __forceinline__ bool next(int i, gm::Unit& u) const {
    const int it = i * nblk + blk, nmain = nM * nN;
    if (it < nmain) { gm::tile_of(it, nM, nN, u.pm, u.pn); if (latonly) u.pm = lat_pm(u.pm); u.pn += pn0; return true; }
    if (it < nmain + nextra) { const int j = it - nmain; u.pm = (j / 10) * 17; u.pn = 4 + (j % 10); return true; }
    return false;
  }
  __device__ __forceinline__ const char* pA(const gm::Unit& u) const { return A + (size_t)u.pm * strA; }
  __device__ __forceinline__ const char* pB(const gm::Unit& u) const { return B + (size_t)u.pn * strB; }
};

struct EpiIn {
  bf16_t *Qb, *Kb, *Vb, *UG, *PT; const float *rc, *rs;
  __device__ __forceinline__ void operator()(const Acc& acc, const gm::Unit& u, int wr, int wc, int fr, int fq) const {
    const int pm = u.pm, pn = u.pn; const bool isctx = (pm % 17) == 0; const int brow = pm * 256;
#pragma unroll
    for (int ai = 0; ai < 2; ++ai)
#pragma unroll
      for (int m = 0; m < 4; ++m) { const int row = brow + ai * 128 + wr * 64 + m * 16 + fr;
        if (pn < 8) { bf16_t* dst = Qb + (size_t)(pn >> 2) * TT * 1024 + (size_t)row * 1024 + (pn & 3) * 256 + wc * 32 + fq * 8;
          f32x4 cs = {1.f, 1.f, 1.f, 1.f}, sn = {0.f, 0.f, 0.f, 0.f};
          if (!isctx) { const int tl = (row % TPB) - CTXL; const int pos = (wc >> 1) ? (tl & 63) : (tl >> 6); const int p0 = (wc & 1) * 16 + fq * 4;
            cs = *(const f32x4*)(rc + pos * 32 + p0); sn = *(const f32x4*)(rs + pos * 32 + p0); }
#pragma unroll
          for (int bj = 0; bj < 2; ++bj) { const f32x4 v1 = acc[ai][bj][m][0], v2 = acc[ai][bj][m][1]; const f32x4 o1 = v1 * cs - v2 * sn, o2 = v2 * cs + v1 * sn;
            u32x4 w = {cvtpk(o1[0], o1[1]), cvtpk(o1[2], o1[3]), cvtpk(o2[0], o2[1]), cvtpk(o2[2], o2[3])}; *(u32x4*)(dst + bj * 128) = w; } }
        else if (pn < 12) { bf16_t* dst = Vb + (size_t)row * 1024 + (pn - 8) * 256 + wc * 32 + fq * 8;
#pragma unroll
          for (int bj = 0; bj < 2; ++bj) { const f32x4 v0 = acc[ai][bj][m][0], v1 = acc[ai][bj][m][1]; u32x4 w = {cvtpk(v0[0], v0[1]), cvtpk(v0[2], v0[3]), cvtpk(v1[0], v1[1]), cvtpk(v1[2], v1[3])}; *(u32x4*)(dst + bj * 128) = w; } }
        else if (pn < 14) { const int b = row / TPB, t = row % TPB; bf16_t* dst = UG + ((size_t)(b * 136 + (t >> 5))) * 768 + (t & 31) * 16 + ((fq * 8) & 15);
#pragma unroll
          for (int bj = 0; bj < 2; ++bj) { const int g = ((pn - 12) * 256 + bj * 128 + wc * 32 + fq * 8) >> 4; const f32x4 v0 = acc[ai][bj][m][0], v1 = acc[ai][bj][m][1];
            u32x4 w = {cvtpk(v0[0], v0[1]), cvtpk(v0[2], v0[3]), cvtpk(v1[0], v1[1]), cvtpk(v1[2], v1[3])}; *(u32x4*)(dst + (size_t)g * 768 * 768) = w; } }
        else {
          const int b = pm / 17, tt = pm % 17, part = (pn - 14) >> 1; const size_t cb = (size_t)(part * NB + b) * 512 + (pn & 1) * 256; const size_t ld = tt == 0 ? 256 : 4096;
          bf16_t* dstm = PT + (tt == 0 ? (size_t)2 * NB * 512 * 4096 + cb * 256 : cb * 4096 + (size_t)(tt - 1) * 256) + ai * 128 + wr * 64 + m * 16 + fr;
#pragma unroll
          for (int bj = 0; bj < 2; ++bj)
#pragma unroll
            for (int n = 0; n < 2; ++n) { const f32x4 v = acc[ai][bj][m][n]; const unsigned w0 = cvtpk(v[0], v[1]), w1 = cvtpk(v[2], v[3]); bf16_t* d = dstm + (size_t)(bj * 128 + wc * 32 + fq * 8 + n * 4) * ld;
              d[0] = (bf16_t)(w0 & 0xffff); d[ld] = (bf16_t)(w0 >> 16); d[2 * ld] = (bf16_t)(w1 & 0xffff); d[3 * ld] = (bf16_t)(w1 >> 16); } } }
  }
};
__device__ __forceinline__ void phase_gemm_in(const Params& p, const Ctx& c, int l, LAS unsigned char* lds) {
  SchedMN S; S.A = p.ws + OFF_HN; S.B = p.ws + OFF_WIN; S.strA = (size_t)256 * DM * 2; S.strB = (size_t)256 * DM * 2; S.blk = c.blk; S.nblk = c.nblk;
  S.nM = l == 0 ? 68 : 64; S.latonly = l == 0 ? 0 : 1;
  { S.nN = 18; S.pn0 = 0; S.nextra = l == 0 ? 0 : 40;
    EpiIn E; E.PT = (bf16_t*)(p.ws + OFF_Z2 + Z2_CAT); E.Qb = (bf16_t*)(p.ws + OFF_Z1 + Z1_Q); E.Kb = (bf16_t*)(p.ws + OFF_Z1 + Z1_K); E.Vb = (bf16_t*)(p.ws + OFF_Z1 + Z1_V); E.UG = (bf16_t*)(p.ws + OFF_Z2 + Z2_UG);
    E.rc = (const float*)(p.ws + OFF_ROPE); E.rs = E.rc + 64 * 32;
    gm::gemm_phase<true, true>(lds, DM, DM, DM, S, E); }
}

__device__ __forceinline__ void fourier_stage_a(const Params& p, const Ctx& c, int l) {
  const bf16_t* PT = (const bf16_t*)(p.ws + OFF_Z2 + Z2_CAT); bf16_t* Y = (bf16_t*)(p.ws + OFF_Z2 + Z2_FC);
  constexpr float C16[16] = {1.f, 0.92387953251f, 0.70710678119f, 0.38268343237f, 0.f, -0.38268343237f, -0.70710678119f, -0.92387953251f, -1.f, -0.92387953251f, -0.70710678119f, -0.38268343237f, 0.f, 0.38268343237f, 0.70710678119f, 0.92387953251f};
  constexpr float S16[16] = {0.f, 0.38268343237f, 0.70710678119f, 0.92387953251f, 1.f, 0.92387953251f, 0.70710678119f, 0.38268343237f, 0.f, -0.38268343237f, -0.70710678119f, -0.92387953251f, -1.f, -0.92387953251f, -0.70710678119f, -0.38268343237f};
  for (long i = c.gtid; i < (long)NB * 512 * 256; i += c.nthr) { const int t2 = (int)(i & 255), ch = (int)((i >> 8) & 511), b = (int)(i >> 17);
    const bf16_t* Pb = PT + ((size_t)(0 * NB + b) * 512 + ch) * 4096 + t2; const bf16_t* Qb = PT + ((size_t)(1 * NB + b) * 512 + ch) * 4096 + t2;
    float zr[16], zq[16];
#pragma unroll
    for (int t1 = 0; t1 < 16; ++t1) { zr[t1] = bf2f(Pb[256 * t1]); zq[t1] = bf2f(Qb[256 * t1]); }
    bf16_t* Yo = Y + ((size_t)(b * 16) * 512 + ch) * 512 + t2;
#pragma unroll
    for (int k1 = 0; k1 < 16; ++k1) { float ar = 0.f, ai = 0.f;
#pragma unroll
      for (int t1 = 0; t1 < 16; ++t1) { const float cc = C16[(k1 * t1) & 15], ss = S16[(k1 * t1) & 15]; ar += zr[t1] * cc - zq[t1] * ss; ai -= zr[t1] * ss + zq[t1] * cc; }
      const float ph = (float)(k1 * t2) * (1.f / 4096.f), ct = __builtin_amdgcn_cosf(ph), st = __builtin_amdgcn_sinf(ph);
      const float yr = (ar * ct + ai * st) * 0.25f, yi = (ai * ct - ar * st) * 0.25f;
      bf16_t* yo = Yo + (size_t)k1 * 512 * 512; const unsigned w = cvtpk(yr, yi); yo[0] = (bf16_t)(w & 0xffff); yo[256] = (bf16_t)(w >> 16); } }
  if (l == 0) {
    const bf16_t* PC = PT + (size_t)2 * NB * 512 * 4096;
    for (long i = c.gtid; i < (long)NB * 512 * 64; i += c.nthr) { const int t0 = (int)(i & 31) * 8, ri = (int)((i >> 5) & 1), ch = (int)((i >> 6) & 511), b = (int)(i >> 15);
      u32x4 w = *(const u32x4*)(PC + ((size_t)(ri * NB + b) * 512 + ch) * 256 + t0); if (ri) { w[0] ^= 0x80008000u; w[1] ^= 0x80008000u; w[2] ^= 0x80008000u; w[3] ^= 0x80008000u; }
      *(u32x4*)(Y + ((size_t)32768 + b * 512 + ch) * 512 + ri * 256 + t0) = w; } }
}
struct SchedFB { const char *DB, *Y; int nunits, blk, nblk;
  __device__ __forceinline__ bool next(int i, gm::Unit& u) const { const int it = i * nblk + blk; if (it >= nunits) return false; u.pm = it; u.pn = 0; return true; }
  __device__ __forceinline__ const char* pA(const gm::Unit&) const { return DB; }
  __device__ __forceinline__ const char* pB(const gm::Unit& u) const { const int it = u.pm; const size_t row = it < 128 ? (size_t)it * 256 : (size_t)32768 + (it - 128) * 256; return Y + row * 1024; } };
struct EpiFB { bf16_t* Cat; const float* bf;
  __device__ __forceinline__ void operator()(const Acc& acc, const gm::Unit& u, int wr, int wc, int fr, int fq) const { const int it = u.pm;
    int b, tok0, tstride, chb; if (it < 128) { b = it >> 5; const int pn = it & 31; tok0 = CTXL + (pn >> 1); tstride = 16; chb = (pn & 1) * 256; } else { const int j = it - 128; b = j >> 1; tok0 = 0; tstride = 1; chb = (j & 1) * 256; }
#pragma unroll
    for (int ai = 0; ai < 2; ++ai)
#pragma unroll
      for (int m = 0; m < 4; ++m) { const int k2 = ai * 128 + wr * 64 + m * 16 + fr; bf16_t* dr = Cat + ((size_t)b * TPB + tok0 + tstride * k2) * DM + 1536 + chb + wc * 32 + fq * 4;
#pragma unroll
        for (int bj = 0; bj < 2; ++bj)
#pragma unroll
          for (int n = 0; n < 2; ++n) { const f32x4 v = acc[ai][bj][m][n] + *(const f32x4*)(bf + chb + bj * 128 + wc * 32 + n * 16 + fq * 4); u32x2 w = {cvtpk(v[0], v[1]), cvtpk(v[2], v[3])}; *(u32x2*)(dr + bj * 128 + n * 16) = w; } }
  } };
__device__ __forceinline__ void fourier_stage_b(const Params& p, const Ctx& c, int l, LAS unsigned char* lds) {
  const SchedFB S{p.ws + OFF_DFTC, p.ws + OFF_Z2 + Z2_FC, l == 0 ? 136 : 128, c.blk, c.nblk}; const EpiFB E{(bf16_t*)(p.ws + OFF_Z2 + Z2_CAT), p.b_four + (size_t)l * 512};
  gm::gemm_phase<true>(lds, 512, 512, 512, S, E);
}

struct SchedSsmS { const char *UG, *EM; int blk, nblk;
  __device__ __forceinline__ bool next(int i, gm::Unit& u) const { const int it = i * nblk + blk; if (it >= 96) return false; u.pm = it; u.pn = 0; return true; }
  __device__ __forceinline__ const char* pA(const gm::Unit& u) const { const int g = u.pm / 3, pm = u.pm % 3; return UG + ((size_t)g * 768 + pm * 256) * 768 * 2; }
  __device__ __forceinline__ const char* pB(const gm::Unit& u) const { const int g = u.pm / 3; return EM + (size_t)g * 256 * 512 * 2; } };
struct EpiSsmS { float* SB;
  __device__ __forceinline__ void operator()(const Acc& acc, const gm::Unit& u, int wr, int wc, int fr, int fq) const { const int g = u.pm / 3, pm = u.pm % 3;
#pragma unroll
    for (int ai = 0; ai < 2; ++ai)
#pragma unroll
      for (int m = 0; m < 4; ++m) { const int r = pm * 256 + ai * 128 + wr * 64 + m * 16 + fr; if (r >= 544) continue; float* dr = SB + ((size_t)g * 768 + r) * 256 + wc * 32 + fq * 4;
#pragma unroll
        for (int bj = 0; bj < 2; ++bj)
#pragma unroll
          for (int n = 0; n < 2; ++n) *(f32x4*)(dr + bj * 128 + n * 16) = acc[ai][bj][m][n]; }
  } };
__device__ __forceinline__ void phase_ssm_states(const Params& p, const Ctx& c, LAS unsigned char* lds) {
  const SchedSsmS S{p.ws + OFF_Z2 + Z2_UG, p.ws + OFF_EM, c.blk, c.nblk}; const EpiSsmS E{(float*)(p.ws + OFF_Z2 + Z2_SB)};
  gm::gemm_phase<true>(lds, 768, 512, 512, S, E);
}
struct SchedSsmY { const char *UG, *TF; int blk, nblk;
  __device__ __forceinline__ bool next(int i, gm::Unit& u) const { const int it = i * nblk + blk; if (it >= 192) return false; u.pm = it >> 1; u.pn = it & 1; return true; }
  __device__ __forceinline__ const char* pA(const gm::Unit& u) const { const int g = u.pm / 3, pm = u.pm % 3; return UG + ((size_t)g * 768 + pm * 256) * 768 * 2; }
  __device__ __forceinline__ const char* pB(const gm::Unit& u) const { const int g = u.pm / 3; return TF + ((size_t)g * 512 + u.pn * 256) * 768 * 2; } };
struct EpiSsmY { bf16_t* Gg; int last;
  __device__ __forceinline__ void operator()(const Acc& acc, const gm::Unit& u, int wr, int wc, int fr, int fq) const { const int g = u.pm / 3, pm = u.pm % 3;
#pragma unroll
    for (int ai = 0; ai < 2; ++ai)
#pragma unroll
      for (int m = 0; m < 4; ++m) { const int r = pm * 256 + ai * 128 + wr * 64 + m * 16 + fr; if (r >= 544) continue; const int b = r / 136, ch = r % 136; if (last && ch < 8) continue;
        bf16_t* dr = Gg + ((size_t)b * TPB + ch * 32) * 512 + g * 16 + ((fq * 4) & 15);
#pragma unroll
        for (int bj = 0; bj < 2; ++bj)
#pragma unroll
          for (int n = 0; n < 2; ++n) { const int t = (u.pn * 256 + bj * 128 + wc * 32 + n * 16 + fq * 4) >> 4; const f32x4 y = acc[ai][bj][m][n];
            u32x2 w = {cvtpk(gelu_tanh(y[0]), gelu_tanh(y[1])), cvtpk(gelu_tanh(y[2]), gelu_tanh(y[3]))}; *(u32x2*)(dr + (size_t)t * 512) = w; } }
  } };
__device__ __forceinline__ void phase_ssm_y(const Params& p, const Ctx& c, bool last, LAS unsigned char* lds) {
  const SchedSsmY S{p.ws + OFF_Z2 + Z2_UG, p.ws + OFF_TF, c.blk, c.nblk}; const EpiSsmY E{(bf16_t*)(p.ws + OFF_Z2 + Z2_GG), last ? 1 : 0};
  gm::gemm_phase<true>(lds, 768, 768, 768, S, E);
}

struct EpiGlu {
  const bf16_t* Gg; bf16_t* Cat; const float* bg;
  __device__ __forceinline__ void operator()(const Acc& acc, const gm::Unit& u, int wr, int wc, int fr, int fq) const { const int pm = u.pm, pn = u.pn;
#pragma unroll
    for (int ai = 0; ai < 2; ++ai)
#pragma unroll
      for (int m = 0; m < 4; ++m) { const int row = pm * 256 + ai * 128 + wr * 64 + m * 16 + fr;
#pragma unroll
        for (int bj = 0; bj < 2; ++bj)
#pragma unroll
          for (int n = 0; n < 2; ++n) { const int col = pn * 256 + bj * 128 + wc * 32 + n * 16 + fq * 4; const f32x4 z = acc[ai][bj][m][n] + *(const f32x4*)(bg + col);
            const u32x2 gw = *(const u32x2*)(Gg + (size_t)row * 512 + col);
            const float g0 = __uint_as_float(gw[0] << 16), g1 = __uint_as_float(gw[0] & 0xffff0000u), g2 = __uint_as_float(gw[1] << 16), g3 = __uint_as_float(gw[1] & 0xffff0000u);
            u32x2 w = {cvtpk(g0 * sigmoidf_(z[0]), g1 * sigmoidf_(z[1])), cvtpk(g2 * sigmoidf_(z[2]), g3 * sigmoidf_(z[3]))};
            *(u32x2*)(Cat + (size_t)row * DM + 1024 + col) = w; } }
  }
};
__device__ __forceinline__ void phase_glu(const Params& p, const Ctx& c, int l, bool last, LAS unsigned char* lds) {
  SchedMN S; S.A = p.ws + OFF_Z2 + Z2_GG; S.B = p.ws + OFF_WGLU; S.strA = (size_t)256 * 512 * 2; S.strB = (size_t)256 * 512 * 2; S.blk = c.blk; S.nblk = c.nblk;
  S.nM = last ? 64 : 68; S.latonly = last ? 1 : 0; S.nN = 2; S.pn0 = 0; S.nextra = 0;
  EpiGlu E; E.Gg = (const bf16_t*)(p.ws + OFF_Z2 + Z2_GG); E.Cat = (bf16_t*)(p.ws + OFF_Z2 + Z2_CAT); E.bg = p.b_glu + (size_t)l * 512;
  gm::gemm_phase<true>(lds, 512, 512, 512, S, E);
}

struct EpiF32 {
  bf16_t* O;
  __device__ __forceinline__ void operator()(const Acc& acc, const gm::Unit& u, int wr, int wc, int fr, int fq) const {
    bf16_t* dst = O + (size_t)u.pm * 256 * DM + u.pn * 256 + wc * 32 + fq * 8;
#pragma unroll
    for (int ai = 0; ai < 2; ++ai)
#pragma unroll
      for (int m = 0; m < 4; ++m) { bf16_t* dr = dst + (size_t)(ai * 128 + wr * 64 + m * 16 + fr) * DM;
#pragma unroll
        for (int bj = 0; bj < 2; ++bj) { const f32x4 v0 = acc[ai][bj][m][0], v1 = acc[ai][bj][m][1]; u32x4 w = {cvtpk(v0[0], v0[1]), cvtpk(v0[2], v0[3]), cvtpk(v1[0], v1[1]), cvtpk(v1[2], v1[3])}; *(u32x4*)(dr + bj * 128) = w; } }
  }
};
struct SchedSplit { const char *A, *B; size_t strA, strB, kbytes; int nunits, blk, nblk;
  __device__ __forceinline__ bool next(int i, gm::Unit& u) const { const int it = i * nblk + blk; if (it >= nunits) return false; u.pm = it; u.pn = 0; return true; }
  __device__ __forceinline__ const char* pA(const gm::Unit& u) const { const int tile = u.pm & 31, sp = u.pm >> 5; return A + (size_t)((tile >> 3) * 17) * strA + sp * kbytes; }
  __device__ __forceinline__ const char* pB(const gm::Unit& u) const { const int tile = u.pm & 31, sp = u.pm >> 5; return B + (size_t)(tile & 7) * strB + sp * kbytes; } };
struct EpiAcc { bf16_t* SLAB;
  __device__ __forceinline__ void operator()(const Acc& acc, const gm::Unit& u, int wr, int wc, int fr, int fq) const { const int tile = u.pm & 31, sp = u.pm >> 5;
    bf16_t* dst = SLAB + ((size_t)sp * NB * CTXL + (tile >> 3) * 256) * DM + (tile & 7) * 256 + wc * 32 + fq * 8;
#pragma unroll
    for (int ai = 0; ai < 2; ++ai)
#pragma unroll
      for (int m = 0; m < 4; ++m) { bf16_t* dr = dst + (size_t)(ai * 128 + wr * 64 + m * 16 + fr) * DM;
#pragma unroll
        for (int bj = 0; bj < 2; ++bj) { const f32x4 v0 = acc[ai][bj][m][0], v1 = acc[ai][bj][m][1]; u32x4 w = {cvtpk(v0[0], v0[1]), cvtpk(v0[2], v0[3]), cvtpk(v1[0], v1[1]), cvtpk(v1[2], v1[3])}; *(u32x4*)(dr + bj * 128) = w; } }
  } };
template <int KK, int NSPLIT>
__device__ __forceinline__ void phase_gemm_f32out(const Params& p, const Ctx& c, bool last, const char* A, const char* W, char* outp, char* slab, LAS unsigned char* lds) {
  SchedMN S; S.A = A; S.B = W; S.strA = (size_t)256 * KK * 2; S.strB = (size_t)256 * KK * 2; S.blk = c.blk; S.nblk = c.nblk;
  S.nM = 64; S.latonly = 1; S.nN = 8; S.pn0 = 0; S.nextra = 0;
  EpiF32 E; E.O = (bf16_t*)outp;
  gm::gemm_phase<true, true>(lds, KK, KK, KK, S, E);
  if (!last) { const SchedSplit S2{A, W, (size_t)256 * KK * 2, (size_t)256 * KK * 2, (size_t)(KK / NSPLIT) * 2, 32 * NSPLIT, c.blk, c.nblk}; const EpiAcc E2{(bf16_t*)slab};
    gm::gemm_phase<true, true>(lds, KK, KK, KK / NSPLIT, S2, E2); }
}

struct EpiGU {
  bf16_t* ACT;
  __device__ __forceinline__ void operator()(const Acc& acc, const gm::Unit& u, int wr, int wc, int fr, int fq) const {
    bf16_t* dst = ACT + (size_t)u.pm * 256 * DFF + u.pn * 128 + wc * 32 + fq * 8;
#pragma unroll
    for (int ai = 0; ai < 2; ++ai)
#pragma unroll
      for (int m = 0; m < 4; ++m) { bf16_t* dr = dst + (size_t)(ai * 128 + wr * 64 + m * 16 + fr) * DFF; u32x4 w;
#pragma unroll
        for (int n = 0; n < 2; ++n) { const f32x4 g = acc[ai][0][m][n], uu = acc[ai][1][m][n];
          w[2 * n] = cvtpk(g[0] * sigmoidf_(g[0]) * uu[0], g[1] * sigmoidf_(g[1]) * uu[1]); w[2 * n + 1] = cvtpk(g[2] * sigmoidf_(g[2]) * uu[2], g[3] * sigmoidf_(g[3]) * uu[3]); }
        *(u32x4*)dr = w; }
  }
};
__device__ __forceinline__ void phase_gemm_gu(const Params& p, const Ctx& c, bool last, LAS unsigned char* lds) {
  SchedMN S; S.A = p.ws + OFF_HN; S.B = p.ws + OFF_WGU; S.strA = (size_t)256 * DM * 2; S.strB = (size_t)256 * DM * 2; S.blk = c.blk; S.nblk = c.nblk;
  S.nM = last ? 64 : 68; S.latonly = last ? 1 : 0; S.nN = 44; S.pn0 = 0; S.nextra = 0;
  EpiGU E; E.ACT = (bf16_t*)(p.ws + OFF_Z2);
  gm::gemm_phase<true, true>(lds, DM, DM, DM, S, E);
}

__device__ __forceinline__ void phase_attn(const Params& p, const Ctx& c, int l, char* lds) {
  const bf16_t* Qb = (const bf16_t*)(p.ws + OFF_Z1 + Z1_Q); const bf16_t* Kb = (const bf16_t*)(p.ws + OFF_Z1 + Z1_K); const bf16_t* Vb = (const bf16_t*)(p.ws + OFF_Z1 + Z1_V);
  bf16_t* O = (bf16_t*)(p.ws + OFF_HN);
  const int ntot = (l == 0) ? 512 + 32 : 512;
  for (int v = c.blk; v < ntot; v += c.nblk) {
    int combo, qb, seq;
    if (v < 512) { const int rd = v >> 8, w = v & 255; combo = rd * 16 + (w & 7) * 2 + ((w >> 3) >> 4); qb = 1 + ((w >> 3) & 15); seq = TPB; }
    else { combo = v - 512; qb = 0; seq = CTXL; }
    const int mp = combo & 1, h = (combo >> 1) & 3, b = combo >> 3;
    const size_t r0 = (size_t)b * TPB;
    at::body(Qb + (r0 + qb * 256) * 1024 + (h * 2 + mp) * 128, Kb + r0 * 1024 + (h * 2 + mp) * 128, Vb + r0 * 1024 + h * 256,
             O + (r0 + qb * 256) * DM + (h * 2 + mp) * 256, seq, lds);
  }
}

__device__ __forceinline__ void phase_combine(const Params& p, const Ctx& c, int l, bool last) {
  const bf16_t* O = (const bf16_t*)(p.ws + OFF_HN); bf16_t* Cat = (bf16_t*)(p.ws + OFF_Z2 + Z2_CAT);
  const float lam_init = 0.8f - 0.6f * expf(-0.3f * (float)l);
  float lam;
  { const float a1 = p.lam_q1[l * 128 + c.lane] * p.lam_k1[l * 128 + c.lane] + p.lam_q1[l * 128 + 64 + c.lane] * p.lam_k1[l * 128 + 64 + c.lane];
    const float a2 = p.lam_q2[l * 128 + c.lane] * p.lam_k2[l * 128 + c.lane] + p.lam_q2[l * 128 + 64 + c.lane] * p.lam_k2[l * 128 + 64 + c.lane];
    lam = expf(wave_sum(a1)) - expf(wave_sum(a2)) + lam_init; }
  const f32x4 gs = *(const f32x4*)(p.g_subln + (size_t)l * 256 + c.lane * 4);
  for (int row = c.gwave; row < TT; row += c.nwave) { const int t = row % TPB; if (last && t < CTXL) continue;
    const bf16_t* orow = O + (size_t)row * DM; bf16_t* crow_ = Cat + (size_t)row * DM;
#pragma unroll
    for (int h = 0; h < 4; ++h) { const u32x2 a = *(const u32x2*)(orow + (h * 2) * 256 + c.lane * 4), bq = *(const u32x2*)(orow + (h * 2 + 1) * 256 + c.lane * 4);
      f32x4 o; o[0] = __uint_as_float(a[0] << 16) - lam * __uint_as_float(bq[0] << 16); o[1] = __uint_as_float(a[0] & 0xffff0000u) - lam * __uint_as_float(bq[0] & 0xffff0000u);
      o[2] = __uint_as_float(a[1] << 16) - lam * __uint_as_float(bq[1] << 16); o[3] = __uint_as_float(a[1] & 0xffff0000u) - lam * __uint_as_float(bq[1] & 0xffff0000u);
      const float ss = wave_sum(o[0] * o[0] + o[1] * o[1] + o[2] * o[2] + o[3] * o[3]); const float r = rsqrtf(ss * (1.f / 256.f) + 1e-5f) * (1.f - lam_init);
      o = o * r * gs; u32x2 w = {cvtpk(o[0], o[1]), cvtpk(o[2], o[3])}; *(u32x2*)(crow_ + h * 256 + c.lane * 4) = w; }
  }
}


#define XB_TMO      128
#define XB_XCNT(j)  (256  + 64 * (j))
#define XB_XSUB(j)  (1280 + 64 * (j))
#define XB_XGEN(j)  (2304 + 64 * (j))
#define XB_TOP      3328
#define XB_TOPGEN   3392
#define XCD_BAR_WORDS 3456
#define XB_SPIN_CAP (1u << 18)
__device__ __forceinline__ unsigned xb_ld(unsigned* p)              { return __hip_atomic_load(p, __ATOMIC_RELAXED, __HIP_MEMORY_SCOPE_AGENT); }
__device__ __forceinline__ unsigned xb_add(unsigned* p, unsigned v) { return __hip_atomic_fetch_add(p, v, __ATOMIC_RELAXED, __HIP_MEMORY_SCOPE_AGENT); }
__device__ __forceinline__ unsigned xb_xcc_id() { return (unsigned)__builtin_amdgcn_s_getreg((3 << 11) | 20) & 0xFu; }
#define XB_SPIN(cond, bar) do { unsigned _sp = 0; while (cond) { __builtin_amdgcn_s_sleep(1); \
    if ((++_sp & 255u) == 0u) { if (xb_ld(&(bar)[XB_TMO])) break; if (_sp > XB_SPIN_CAP) { atomicAdd(&(bar)[XB_TMO], 1u); break; } } } } while (0)
struct XcdBarrier { unsigned* bar; unsigned x; volatile LAS unsigned* st; };
__device__ __forceinline__ XcdBarrier xcd_barrier_post(unsigned* bar, volatile LAS unsigned* st) {
  XcdBarrier b; b.bar = bar; b.x = xb_xcc_id(); b.st = st;
  if (threadIdx.x == 0) (void)xb_add(&bar[XB_XCNT(b.x)], 1u);
  return b;
}
__device__ __forceinline__ void xcd_barrier_complete(unsigned* bar, unsigned x, unsigned& nloc, unsigned& nx) {
  const unsigned G = gridDim.x * gridDim.y * gridDim.z;
  unsigned sum, cnt, mine, sp = 0u;
  for (;;) {
    sum = 0u; cnt = 0u; mine = 0u;
#pragma unroll
    for (unsigned j = 0; j < 16; ++j) { const unsigned c = xb_ld(&bar[XB_XCNT(j)]); sum += c; cnt += (c > 0u) ? 1u : 0u; mine = (j == x) ? c : mine; }
    if (sum == G) break;
    __builtin_amdgcn_s_sleep(1);
    if ((++sp & 255u) == 0u) { if (xb_ld(&bar[XB_TMO])) break; if (sp > XB_SPIN_CAP) { atomicAdd(&bar[XB_TMO], 1u); break; } }
  }
  nloc = mine > 0u ? mine : 1u; nx = cnt > 0u ? cnt : 1u;
}
__device__ __forceinline__ void xcd_barrier(const XcdBarrier& b) {
  asm volatile("s_waitcnt vmcnt(0)" ::: "memory");
  __syncthreads();
  if (threadIdx.x == 0) {
    unsigned* bar = b.bar;
    __builtin_amdgcn_s_waitcnt(0);
    unsigned nloc = b.st[0], nx = b.st[1];
    if (nloc == 0u) { xcd_barrier_complete(bar, b.x, nloc, nx); b.st[0] = nloc; b.st[1] = nx; }
    const unsigned old = xb_add(&bar[XB_XSUB(b.x)], 1u);
    const unsigned gen = old / nloc;
    if (old + 1u == (gen + 1u) * nloc) {
      __builtin_amdgcn_fence(__ATOMIC_RELEASE, "agent");
      asm volatile("s_waitcnt vmcnt(0)" ::: "memory");
      const unsigned og = xb_add(&bar[XB_TOP], 1u);
      const unsigned tg = og / nx;
      if (og + 1u == (tg + 1u) * nx) xb_add(&bar[XB_TOPGEN], 1u);
      else XB_SPIN(xb_ld(&bar[XB_TOPGEN]) == tg, bar);
      __builtin_amdgcn_fence(__ATOMIC_ACQUIRE, "agent");
      xb_add(&bar[XB_XGEN(b.x)], 1u);
      asm volatile("s_waitcnt vmcnt(0)" ::: "memory");
    } else {
      XB_SPIN(xb_ld(&bar[XB_XGEN(b.x)]) == gen, bar);
      __builtin_amdgcn_fence(__ATOMIC_ACQUIRE, "agent");
      asm volatile("s_waitcnt vmcnt(0)" ::: "memory");
    }
  }
  __syncthreads();
}

__global__ void __launch_bounds__(NTHREADS) mega(Params p_arg) {
  extern __shared__ __attribute__((aligned(16))) char shm[];
  __shared__ uint4 xb_words;
  cg::grid_group grid = cg::this_grid();
  typedef const __attribute__((address_space(4))) Params* KP;
  KP kp = (KP)__builtin_amdgcn_kernarg_segment_ptr();
  unsigned* bar = (unsigned*)(p_arg.ws + OFF_BAR);
  if (threadIdx.x == 0) xb_words = make_uint4(0u, 0u, 0u, 0u);
  if (p_arg.out == nullptr) grid.sync();
  if (threadIdx.x == 0) (void)xb_add(bar + XB_XCNT(xb_xcc_id()), 1u);
  __syncthreads();
  Ctx c;
#define RECTX() do { asm volatile("" : "+s"(kp)); int t_ = threadIdx.x; asm volatile("" : "+v"(t_)); int b_ = blockIdx.x; asm volatile("" : "+s"(b_)); \
    c.tid = t_; c.wid = t_ >> 6; c.lane = t_ & 63; c.blk = b_; c.nblk = gridDim.x; c.gwave = c.blk * 8 + c.wid; c.nwave = c.nblk * 8; \
    c.gtid = (long)c.blk * NTHREADS + c.tid; c.nthr = (long)c.nblk * NTHREADS; } while (0)
  RECTX();
  LAS unsigned char* gshm = (LAS unsigned char*)shm; float* fl = (float*)shm;

#define PP (*(const Params*)kp)
#define GSYNC() do { RECTX(); XcdBarrier xb_; xb_.bar = (unsigned*)(kp->ws + OFF_BAR); xb_.x = xb_xcc_id(); xb_.st = (volatile LAS unsigned*)&xb_words; xcd_barrier(xb_); } while (0)
  phase0a(PP, c, fl);
  RECTX(); ssm_tables(PP, c);
  RECTX(); convert_weights(PP, c, 0, fl);
  GSYNC();
  RECTX(); reduce_mod(PP, c);
  RECTX(); fold_four(PP, c, 0, fl);
  RECTX(); ssm_build_mef(PP, c, 0);
  GSYNC();
  RECTX(); ssm_build_t(PP, c, 0);
  RECTX(); phase_prenorm(PP, c, 0);
  GSYNC();
  for (int l = 0; l < 2; ++l) {
    const bool last = (l == 1);
    RECTX(); phase_gemm_in(PP, c, l, gshm);
    GSYNC();
    RECTX(); fourier_stage_a(PP, c, l);
    RECTX(); phase_ssm_states(PP, c, gshm);
    GSYNC();
    RECTX(); ssm_carry(PP, c, l, fl);
    RECTX(); phase_attn(PP, c, l, shm);
    GSYNC();
    RECTX(); phase_ssm_y(PP, c, last, gshm);
    RECTX(); phase_combine(PP, c, l, last);
    GSYNC();
    RECTX(); phase_glu(PP, c, l, last, gshm);
    RECTX(); fourier_stage_b(PP, c, l, gshm);
    GSYNC();
    RECTX(); phase_gemm_f32out<DM, 8>(PP, c, last, kp->ws + OFF_Z2 + Z2_CAT, kp->ws + OFF_WOUT, kp->ws + OFF_Z1, kp->ws + OFF_Z2, gshm);
    GSYNC();
    if (!last) { RECTX(); ssm_build_mef(PP, c, 1); }
    RECTX(); phase_postmix(PP, c, l, last);
    GSYNC();
    RECTX(); phase_gemm_gu(PP, c, last, gshm);
    GSYNC();
    RECTX(); phase_gemm_f32out<DFF, 11>(PP, c, last, kp->ws + OFF_Z2, kp->ws + OFF_WD, kp->ws + OFF_Z1 + (size_t)TT * DM * 2, kp->ws + OFF_Z1, gshm);
    GSYNC();
    if (!last) { RECTX(); ssm_build_t(PP, c, 1); }
    RECTX(); phase_postffn(PP, c, l, last);
    if (!last) { RECTX(); convert_weights(PP, c, 1, fl); RECTX(); fold_four(PP, c, 1, fl); GSYNC(); }
  }
}

extern "C" void kernel_launch(void* const* d_in, const int* in_sizes, int n_in, void* d_out, int out_size, void* d_ws, size_t ws_size,
                              hipStream_t stream) {
  static int grid_blocks = 0;
  if (!grid_blocks) {
    (void)hipFuncSetAttribute((const void*)mega, hipFuncAttributeMaxDynamicSharedMemorySize, SHM_BYTES);
    int dev = 0, cus = 0, per_cu = 0;
    (void)hipGetDevice(&dev);
    (void)hipDeviceGetAttribute(&cus, hipDeviceAttributeMultiprocessorCount, dev);
    (void)hipOccupancyMaxActiveBlocksPerMultiprocessor(&per_cu, mega, NTHREADS, SHM_BYTES);
    if (per_cu < 1) per_cu = 1;
    grid_blocks = cus;
  }
  if (n_in != 32 || ws_size < WS_NEED) { fprintf(stderr, "kernel_launch: bad n_in %d or ws %zu < %zu\n", n_in, ws_size, WS_NEED); return; }
  Params p{};
  const float** f = (const float**)&p;
  for (int i = 0; i < 32; ++i) f[i] = (const float*)d_in[i];
  p.out = (float*)d_out; p.ws = (char*)d_ws;
  (void)hipMemsetAsync((char*)d_ws + OFF_BAR, 0, 16384, stream);
  void* args[] = {&p};
  hipError_t e = hipLaunchCooperativeKernel((void*)mega, dim3(grid_blocks), dim3(NTHREADS), args, SHM_BYTES, stream);
  if (e != hipSuccess) fprintf(stderr, "cooperative launch failed: %s (grid %d)\n", hipGetErrorString(e), grid_blocks);
}
```
